# Optimizing an MI355X kernel written in HIP

```python
import math
import jax, jax.numpy as jnp
from jax import lax
import numpy as np

D_MODEL = 2048
BATCH = 2
SEQ = 16384
DEPTH = 2

S5_WIDTH = D_MODEL // 2
S5_GROUP = 16
S5_GROUPS = S5_WIDTH // S5_GROUP
S5_STATE = 64
DA_HEADS = 8
DA_HEAD_DIM = 64
DA_V_DIM = 2 * DA_HEAD_DIM
DA_WIDTH = DA_HEADS * DA_V_DIM
E_IN = 2 * S5_WIDTH + 4 * DA_WIDTH
E_OUT = S5_WIDTH + DA_WIDTH
FOX_HEADS = 16
FOX_HEAD_DIM = D_MODEL // FOX_HEADS
FOX_WIDTH = FOX_HEADS * FOX_HEAD_DIM
O_IN = 4 * FOX_WIDTH + FOX_HEADS
Q_BLOCK = 128
N_EVEN = (DEPTH + 1) // 2
N_ODD = DEPTH // 2
EPS = 1e-6

kernel_name = "hybrid_s5_diffattn_fox_block"


def _rms(x, g):
    xf = x.astype(jnp.float32)
    r = lax.rsqrt(jnp.mean(xf * xf, axis=-1, keepdims=True) + EPS)
    return (xf * r * g.astype(jnp.float32)).astype(x.dtype)


def _alibi_slopes(n):
    return np.array([2.0 ** (-8.0 * (h + 1) / n) for h in range(n)], dtype=np.float32)


def _block_sweep(block_fn, seq):
    nb = seq // Q_BLOCK
    out = lax.map(block_fn, jnp.arange(nb))
    nbk, bsz, h, qb, dv = out.shape
    return out.transpose(1, 0, 3, 2, 4).reshape(bsz, seq, h * dv)


def _complex_linear_combine(e1, e2):
    a1r, a1i, b1r, b1i = e1
    a2r, a2i, b2r, b2i = e2
    ar = a1r * a2r - a1i * a2i
    ai = a1r * a2i + a1i * a2r
    br = a2r * b1r - a2i * b1i + b2r
    bi = a2r * b1i + a2i * b1r + b2i
    return (ar, ai, br, bi)


def _s5_mixer(u, lam_re, lam_im, log_dt, b_re, b_im, c_re, c_im, d, w_glu, b_glu):
    bsz, seq, _ = u.shape
    f32 = jnp.float32
    uf = u.astype(f32).reshape(bsz, seq, S5_GROUPS, S5_GROUP)
    dt = jnp.exp(log_dt.astype(f32))[:, None]
    lr = lam_re.astype(f32)
    li = lam_im.astype(f32)
    mag = jnp.exp(lr * dt)
    ar = mag * jnp.cos(li * dt)
    ai = mag * jnp.sin(li * dt)
    den = lr * lr + li * li
    nr = ar - 1.0
    ni = ai
    kr = (nr * lr + ni * li) / den
    ki = (ni * lr - nr * li) / den
    br = b_re.astype(f32)
    bi = b_im.astype(f32)
    bbr = kr[..., None] * br - ki[..., None] * bi
    bbi = kr[..., None] * bi + ki[..., None] * br
    xr = jnp.einsum('blgh,gph->blgp', uf, bbr)
    xi = jnp.einsum('blgh,gph->blgp', uf, bbi)
    a_r = jnp.broadcast_to(ar, (1, seq, S5_GROUPS, S5_STATE))
    a_i = jnp.broadcast_to(ai, (1, seq, S5_GROUPS, S5_STATE))
    _, _, hr, hi = lax.associative_scan(_complex_linear_combine, (a_r, a_i, xr, xi), axis=1)
    y = (jnp.einsum('blgp,ghp->blgh', hr, c_re.astype(f32))
         - jnp.einsum('blgp,ghp->blgh', hi, c_im.astype(f32)))
    y = y.reshape(bsz, seq, S5_WIDTH) + d.astype(f32) * u.astype(f32)
    y = jax.nn.gelu(y)
    y = y * jax.nn.sigmoid(y @ w_glu.astype(f32) + b_glu.astype(f32))
    return y.astype(u.dtype)


def _diff_attention(q, k, v, q_gain, k_gain, lq1, lk1, lq2, lk2, out_gain, lambda_init):
    bsz, seq = q.shape[:2]
    q = _rms(q.reshape(bsz, seq, DA_HEADS, 2, DA_HEAD_DIM), q_gain.reshape(2, DA_HEAD_DIM))
    k = _rms(k.reshape(bsz, seq, DA_HEADS, 2, DA_HEAD_DIM), k_gain.reshape(2, DA_HEAD_DIM))
    q = q.transpose(0, 2, 3, 1, 4)
    k = k.transpose(0, 2, 3, 1, 4)
    v = v.reshape(bsz, seq, DA_HEADS, DA_V_DIM).transpose(0, 2, 1, 3)
    f32 = jnp.float32
    lam = (jnp.exp(jnp.sum(lq1.astype(f32) * lk1.astype(f32)))
           - jnp.exp(jnp.sum(lq2.astype(f32) * lk2.astype(f32))) + lambda_init)
    slopes = jnp.asarray(_alibi_slopes(DA_HEADS))[:, None, None, None]
    scale = DA_HEAD_DIM ** -0.5
    kpos = jnp.arange(seq)

    def blk(i):
        start = i * Q_BLOCK
        qb = lax.dynamic_slice_in_dim(q, start, Q_BLOCK, axis=3)
        s = jnp.einsum('bhcqd,bhckd->bhcqk', qb, k).astype(f32) * scale
        dist = (start + jnp.arange(Q_BLOCK))[:, None] - kpos[None, :]
        s = s - slopes * dist.astype(f32)
        s = jnp.where(dist >= 0, s, -jnp.inf)
        p = jax.nn.softmax(s, axis=-1)
        p = p[:, :, 0] - lam * p[:, :, 1]
        return jnp.einsum('bhqk,bhkd->bhqd', p.astype(v.dtype), v)

    o = _block_sweep(blk, seq).reshape(bsz, seq, DA_HEADS, DA_V_DIM)
    o = _rms(o, out_gain) * (1.0 - lambda_init)
    return o.reshape(bsz, seq, DA_WIDTH)


def _forgetting_attention(q, k, v, f_logit, b_f, q_gain, k_gain):
    bsz, seq = q.shape[:2]
    f32 = jnp.float32
    q = _rms(q.reshape(bsz, seq, FOX_HEADS, FOX_HEAD_DIM), q_gain).transpose(0, 2, 1, 3)
    k = _rms(k.reshape(bsz, seq, FOX_HEADS, FOX_HEAD_DIM), k_gain).transpose(0, 2, 1, 3)
    v = v.reshape(bsz, seq, FOX_HEADS, FOX_HEAD_DIM).transpose(0, 2, 1, 3)
    logf = jax.nn.log_sigmoid(f_logit.astype(f32) + b_f.astype(f32))
    c = jnp.cumsum(logf, axis=1).transpose(0, 2, 1)
    scale = FOX_HEAD_DIM ** -0.5
    kpos = jnp.arange(seq)

    def blk(i):
        start = i * Q_BLOCK
        qb = lax.dynamic_slice_in_dim(q, start, Q_BLOCK, axis=2)
        cq = lax.dynamic_slice_in_dim(c, start, Q_BLOCK, axis=2)
        s = jnp.einsum('bhqd,bhkd->bhqk', qb, k).astype(f32) * scale
        s = s + cq[..., :, None] - c[..., None, :]
        causal = (start + jnp.arange(Q_BLOCK))[:, None] >= kpos[None, :]
        s = jnp.where(causal, s, -jnp.inf)
        p = jax.nn.softmax(s, axis=-1)
        return jnp.einsum('bhqk,bhkd->bhqd', p.astype(v.dtype), v)

    return _block_sweep(blk, seq)


def setup_inputs(seed: int = 0) -> dict:
    key = jax.random.key(seed)
    ks = iter(jax.random.split(key, 40))
    f32 = jnp.float32

    def nrm(shape, scale):
        return jax.random.normal(next(ks), shape, f32) * scale

    ne, no, g, p, gs = N_EVEN, N_ODD, S5_GROUPS, S5_STATE, S5_GROUP
    x = nrm((BATCH, SEQ, D_MODEL), 1.0)
    e_norm = 1.0 + nrm((ne, D_MODEL), 0.02)
    e_w_in = nrm((ne, D_MODEL, E_IN), D_MODEL ** -0.5)
    e_w_out = nrm((ne, E_OUT, D_MODEL), E_OUT ** -0.5)
    n_idx = jnp.arange(p, dtype=f32)
    s5_lambda_re = -0.5 + nrm((ne, g, p), 0.01)
    s5_lambda_im = math.pi * n_idx + nrm((ne, g, p), 0.01)
    s5_log_dt = jax.random.uniform(next(ks), (ne, g), f32, math.log(1e-3), math.log(1e-1))
    s5_b_re = nrm((ne, g, p, gs), (2.0 * gs) ** -0.5)
    s5_b_im = nrm((ne, g, p, gs), (2.0 * gs) ** -0.5)
    s5_c_re = nrm((ne, g, gs, p), (2.0 * p) ** -0.5)
    s5_c_im = nrm((ne, g, gs, p), (2.0 * p) ** -0.5)
    s5_d = nrm((ne, S5_WIDTH), 1.0)
    s5_w_glu = nrm((ne, S5_WIDTH, S5_WIDTH), S5_WIDTH ** -0.5)
    s5_b_glu = nrm((ne, S5_WIDTH), 0.01)
    da_q_norm = 1.0 + nrm((ne, DA_V_DIM), 0.02)
    da_k_norm = 1.0 + nrm((ne, DA_V_DIM), 0.02)
    da_lambda_q1 = nrm((ne, DA_HEAD_DIM), 0.1)
    da_lambda_k1 = nrm((ne, DA_HEAD_DIM), 0.1)
    da_lambda_q2 = nrm((ne, DA_HEAD_DIM), 0.1)
    da_lambda_k2 = nrm((ne, DA_HEAD_DIM), 0.1)
    da_out_norm = 1.0 + nrm((ne, DA_V_DIM), 0.02)
    o_norm = 1.0 + nrm((no, D_MODEL), 0.02)
    o_w_in = nrm((no, D_MODEL, O_IN), D_MODEL ** -0.5)
    o_b_f = jax.random.uniform(next(ks), (no, FOX_HEADS), f32, 1.0, 6.0)
    o_w_out = nrm((no, FOX_WIDTH, D_MODEL), FOX_WIDTH ** -0.5)
    fox_q_norm = 1.0 + nrm((no, FOX_HEAD_DIM), 0.02)
    fox_k_norm = 1.0 + nrm((no, FOX_HEAD_DIM), 0.02)
    return {
        "x": x, "e_norm": e_norm, "e_w_in": e_w_in, "e_w_out": e_w_out,
        "s5_lambda_re": s5_lambda_re, "s5_lambda_im": s5_lambda_im, "s5_log_dt": s5_log_dt,
        "s5_b_re": s5_b_re, "s5_b_im": s5_b_im, "s5_c_re": s5_c_re, "s5_c_im": s5_c_im,
        "s5_d": s5_d, "s5_w_glu": s5_w_glu, "s5_b_glu": s5_b_glu,
        "da_q_norm": da_q_norm, "da_k_norm": da_k_norm,
        "da_lambda_q1": da_lambda_q1, "da_lambda_k1": da_lambda_k1,
        "da_lambda_q2": da_lambda_q2, "da_lambda_k2": da_lambda_k2, "da_out_norm": da_out_norm,
        "o_norm": o_norm, "o_w_in": o_w_in, "o_b_f": o_b_f, "o_w_out": o_w_out,
        "fox_q_norm": fox_q_norm, "fox_k_norm": fox_k_norm,
    }


def reference(x, e_norm, e_w_in, e_w_out, s5_lambda_re, s5_lambda_im, s5_log_dt,
              s5_b_re, s5_b_im, s5_c_re, s5_c_im, s5_d, s5_w_glu, s5_b_glu,
              da_q_norm, da_k_norm, da_lambda_q1, da_lambda_k1, da_lambda_q2, da_lambda_k2,
              da_out_norm, o_norm, o_w_in, o_b_f, o_w_out, fox_q_norm, fox_k_norm):
    e_splits = [S5_WIDTH, 2 * S5_WIDTH, 2 * S5_WIDTH + DA_WIDTH,
                2 * S5_WIDTH + 2 * DA_WIDTH, 2 * S5_WIDTH + 3 * DA_WIDTH]
    o_splits = [FOX_WIDTH, 2 * FOX_WIDTH, 3 * FOX_WIDTH, 4 * FOX_WIDTH]
    for layer in range(DEPTH):
        j = layer // 2
        if layer % 2 == 0:
            h = _rms(x, e_norm[j])
            proj = h @ e_w_in[j]
            u, z_s5, q, k, v, z_da = jnp.split(proj, e_splits, axis=-1)
            y_s5 = _s5_mixer(u, s5_lambda_re[j], s5_lambda_im[j], s5_log_dt[j],
                             s5_b_re[j], s5_b_im[j], s5_c_re[j], s5_c_im[j],
                             s5_d[j], s5_w_glu[j], s5_b_glu[j]) * jax.nn.silu(z_s5)
            lambda_init = 0.8 - 0.6 * math.exp(-0.3 * layer)
            y_da = _diff_attention(q, k, v, da_q_norm[j], da_k_norm[j],
                                   da_lambda_q1[j], da_lambda_k1[j],
                                   da_lambda_q2[j], da_lambda_k2[j],
                                   da_out_norm[j], lambda_init) * jax.nn.silu(z_da)
            x = x + jnp.concatenate([y_s5, y_da], axis=-1) @ e_w_out[j]
        else:
            h = _rms(x, o_norm[j])
            proj = h @ o_w_in[j]
            q, k, v, z, f_logit = jnp.split(proj, o_splits, axis=-1)
            y = _forgetting_attention(q, k, v, f_logit, o_b_f[j],
                                      fox_q_norm[j], fox_k_norm[j]) * jax.nn.silu(z)
            x = x + y @ o_w_out[j]
    return x
```

```cpp
#include <hip/hip_runtime.h>
#include <hip/hip_cooperative_groups.h>
#include <cstdio>
#include <cstdint>
#include <cmath>
namespace cg = cooperative_groups;
namespace pg8 {
#define PG8_LAS __attribute__((address_space(3)))
typedef unsigned short bf16_t;
typedef short bf16x8 __attribute__((ext_vector_type(8)));
typedef float f32x4 __attribute__((ext_vector_type(4)));
typedef unsigned u32x4 __attribute__((ext_vector_type(4)));
constexpr int BM = 256, BK = 64, HALF = 128, HTB = HALF * BK * 2  , STAGE_BYTES = 8 * HTB, NXCD = 8, WGM = 8;

__host__ __device__ __forceinline__ int lds_byte(int r, int c) { const int st = (r >> 4) * 2 + (c >> 5), rr = r & 15, cc = c & 31, ob = rr * 64 + cc * 2; return st * 1024 + (ob ^ (((ob >> 9) & 1) << 5)); }
__host__ __device__ __forceinline__ void stage_rc(int b, int& R, int& C) { const int st = b / 1024, sb = b % 1024, swz = sb ^ (((sb >> 9) & 1) << 5); R = (st >> 1) * 16 + swz / 64; C = (st & 1) * 32 + (swz % 64) / 2; }
__host__ __device__ __forceinline__ int perm32(int rho) { const int n = rho >> 4, i = rho & 15; return 8 * (i >> 2) + 4 * n + (i & 3); }

struct Unit { int pm, pn; };
struct Gemm { const bf16_t* A; const bf16_t* Bt; int M, N, K; };

struct StaticOrder {
    int nM, nN, nwg, G, c;
    __host__ __device__ void init(int M, int N, int G_, int c_) { nM = M / BM; nN = N / BM; nwg = nM * nN; G = G_; c = c_; }
    __host__ __device__ bool next(int i, Unit& u) const {
        const long L = (long)i * G + c; if (L >= nwg) return false;
        int wgid = (int)L; { const int q = nwg / NXCD, r = nwg % NXCD, xcd = wgid % NXCD, off = wgid / NXCD; wgid = (xcd < r ? xcd * (q + 1) : r * (q + 1) + (xcd - r) * q) + off; }
        const int nig = WGM * nN, gid = wgid / nig, fm = gid * WGM, gsz = (nM - fm) < WGM ? (nM - fm) : WGM;
        u.pm = fm + ((wgid % nig) % gsz); u.pn = (wgid % nig) / gsz; return true;
    }
    __device__ __forceinline__ void a_ready(const Unit&) const {}
    __device__ __forceinline__ void done(const Unit&) const {}
};

__device__ __forceinline__ unsigned cvt_pk_bf16(float lo, float hi) { unsigned r; asm volatile("v_cvt_pk_bf16_f32 %0, %1, %2" : "=v"(r) : "v"(lo), "v"(hi)); return r; }
typedef float f32x2 __attribute__((ext_vector_type(2)));
__device__ __forceinline__ f32x2 gelu_pk(f32x2 v) {
    const f32x2 av = __builtin_elementwise_abs(v), d = av * 0.2316418882f + 1.0f;
    f32x2 t; t.x = __builtin_amdgcn_rcpf(d.x); t.y = __builtin_amdgcn_rcpf(d.y);
    f32x2 q = t * 0.5307027145f + (-0.7265760135f); q = q * t + 0.7107068705f; q = q * t + (-0.142248368f); q = q * t + 0.127414796f; q = q * t;
    const f32x2 s = (v * v) * (-0.72134752044f);
    f32x2 e; e.x = __builtin_amdgcn_exp2f(s.x); e.y = __builtin_amdgcn_exp2f(s.y);
    const f32x2 m = v * (q * e), r = v - m;
    f32x2 o; o.x = v.x < 0.f ? m.x : r.x; o.y = v.y < 0.f ? m.y : r.y; return o;
}

template <int ACT  > struct EpiBf16 {
    static constexpr bool PERM = true, AFTER_DRAIN = false; static_assert(ACT == 0 || ACT == 1, "EpiBf16: ACT is 0 (none) or 1 (gelu_pk)");
    bf16_t* O; int ldc; const float* bias; int split_cols; size_t split_stride; float scale0;
    __device__ __forceinline__ void operator()(const f32x4 (&acc)[2][2][4][2], const Unit& u, int wr, int wc, int fr, int fq) const {
        const int row0 = u.pm * BM + wr * 64 + fr; int colt = u.pn * BM; bf16_t* base = O;
        float sc = 1.f; if (split_cols) { const int t = colt / split_cols; base += (size_t)t * split_stride; colt -= t * split_cols; if (t == 0) sc = scale0; }
        const int col0 = colt + wc * 32 + 8 * fq, bcol0 = u.pn * BM + wc * 32 + 8 * fq;
        f32x4 bv[2][2];
#pragma unroll
        for (int bj = 0; bj < 2; ++bj)
#pragma unroll
            for (int n = 0; n < 2; ++n) bv[bj][n] = bias ? *(const f32x4*)(bias + bcol0 + bj * HALF + 4 * n) : (f32x4){0.f, 0.f, 0.f, 0.f};
#pragma unroll
        for (int ai = 0; ai < 2; ++ai)
#pragma unroll
            for (int m = 0; m < 4; ++m) { bf16_t* rowp = base + (size_t)(row0 + ai * HALF + m * 16) * ldc + col0;
#pragma unroll
                for (int bj = 0; bj < 2; ++bj) { f32x4 v0 = acc[ai][bj][m][0] + bv[bj][0], v1 = acc[ai][bj][m][1] + bv[bj][1];
                    if (ACT == 1) { f32x2 a = gelu_pk((f32x2){v0[0], v0[1]}), b = gelu_pk((f32x2){v0[2], v0[3]}), c = gelu_pk((f32x2){v1[0], v1[1]}), d = gelu_pk((f32x2){v1[2], v1[3]});
                        v0 = (f32x4){a.x, a.y, b.x, b.y}; v1 = (f32x4){c.x, c.y, d.x, d.y}; }
                    v0 = v0 * sc; v1 = v1 * sc; u32x4 w; w.x = cvt_pk_bf16(v0[0], v0[1]); w.y = cvt_pk_bf16(v0[2], v0[3]); w.z = cvt_pk_bf16(v1[0], v1[1]); w.w = cvt_pk_bf16(v1[2], v1[3]);
                    *(u32x4*)(rowp + bj * HALF) = w; } }
    }
};
template <class Epi, class Sched, bool ALIGN_EPI = false, bool SP2 = false>
__device__ __forceinline__ void gemm_phase(PG8_LAS unsigned char* lds, const Gemm g, const Sched& S, const Epi& E, const int wid, const int lane) {
    const int tid = wid * 64 + lane, wr = wid >> 2, wc = wid & 3, fr = lane & 15, fq = lane >> 4;
    const int K = g.K, nt = K / BK;
    unsigned voffA[2], voffB[2];
#pragma unroll
    for (int i = 0; i < 2; ++i) { int R, C; stage_rc(tid * 16 + i * 8192, R, C); const int Rb = Epi::PERM ? ((R & ~31) + perm32(R & 31)) : R;
        voffA[i] = (unsigned)(R * K + C) * 2u; voffB[i] = (unsigned)(Rb * K + C) * 2u; }
    const size_t kstep = (size_t)(BK * 2);
    const size_t hstep = (size_t)HALF * K * 2;
    const size_t tstep = 2 * hstep;
    const unsigned ldsw = (unsigned)wid * 1024u;
    const int aoff = lds_byte(wr * 64 + fr, fq * 8), boff = lds_byte(wc * 32 + fr, fq * 8);
#define PG8_SA(b, h) (((b) * 2 + (h)) * HTB)
#define PG8_SB(b, h) ((4 + (b) * 2 + (h)) * HTB)
#define PG8_STAGE(bufoff, gbase, voff) do { _Pragma("unroll") for (int _i = 0; _i < 2; ++_i) \
        __builtin_amdgcn_global_load_lds((const unsigned*)((const char*)(gbase) + (voff)[_i]), (PG8_LAS unsigned*)(lds + (bufoff) + ldsw + _i * 8192), 16, 0, 0); } while (0)
#define PG8_LDA(dst, b, h) do { _Pragma("unroll") for (int m = 0; m < 4; ++m) _Pragma("unroll") for (int k = 0; k < 2; ++k) dst[m][k] = *(const PG8_LAS bf16x8*)(lds + PG8_SA(b, h) + aoff + m * 2048 + k * 1024); } while (0)
#define PG8_LDB(dst, b, h) do { _Pragma("unroll") for (int n = 0; n < 2; ++n) _Pragma("unroll") for (int k = 0; k < 2; ++k) dst[n][k] = *(const PG8_LAS bf16x8*)(lds + PG8_SB(b, h) + boff + n * 2048 + k * 1024); } while (0)
#define PG8_MMA(ai, bj, At, Bt) do { __builtin_amdgcn_s_setprio(1); _Pragma("unroll") for (int m = 0; m < 4; ++m) _Pragma("unroll") for (int n = 0; n < 2; ++n) _Pragma("unroll") for (int k = 0; k < 2; ++k) \
        acc[ai][bj][m][n] = __builtin_amdgcn_mfma_f32_16x16x32_bf16(Bt[n][k], At[m][k], acc[ai][bj][m][n], 0, 0, 0); __builtin_amdgcn_s_setprio(0); } while (0)
#define PG8_WAIT_V(n) asm volatile("s_waitcnt vmcnt(" #n ")" ::: "memory")
#define PG8_WAIT_L(n) asm volatile("s_waitcnt lgkmcnt(" #n ")" ::: "memory")
#define PG8_BAR __builtin_amdgcn_s_barrier()
#define PG8_SCHED __builtin_amdgcn_sched_barrier(0)
    Unit cur, nxt; int ui = 0;
    if (!S.next(0, cur)) return;
    f32x4 acc[2][2][4][2];
#pragma unroll
    for (int a = 0; a < 2; ++a)
#pragma unroll
        for (int b = 0; b < 2; ++b)
#pragma unroll
            for (int m = 0; m < 4; ++m)
#pragma unroll
                for (int n = 0; n < 2; ++n) acc[a][b][m][n] = (f32x4){0.f, 0.f, 0.f, 0.f};
    bf16x8 At[4][2], B0[2][2], B1[2][2];
    const char* cA = (const char*)g.A + (size_t)cur.pm * tstep; const char* cB = (const char*)g.Bt + (size_t)cur.pn * tstep;
    S.a_ready(cur);
    if constexpr (SP2) {
        PG8_STAGE(PG8_SB(0, 0), cB, voffB); PG8_STAGE(PG8_SB(0, 1), cB + hstep, voffB); PG8_STAGE(PG8_SA(0, 0), cA, voffA); PG8_STAGE(PG8_SA(0, 1), cA + hstep, voffA);
        if (wr == 1) PG8_BAR;
        PG8_WAIT_V(2); PG8_BAR;
        PG8_STAGE(PG8_SB(1, 0), cB + kstep, voffB); PG8_STAGE(PG8_SA(1, 0), cA + kstep, voffA); PG8_STAGE(PG8_SB(1, 1), cB + hstep + kstep, voffB);
        PG8_WAIT_V(6); PG8_BAR;
    } else {
        PG8_STAGE(PG8_SB(0, 0), cB, voffB); PG8_STAGE(PG8_SA(0, 0), cA, voffA); PG8_STAGE(PG8_SB(0, 1), cB + hstep, voffB); PG8_STAGE(PG8_SA(0, 1), cA + hstep, voffA);
        if (wr == 1) PG8_BAR;
        PG8_WAIT_V(4); PG8_BAR;
        PG8_STAGE(PG8_SB(1, 0), cB + kstep, voffB); PG8_STAGE(PG8_SA(1, 0), cA + kstep, voffA); PG8_STAGE(PG8_SB(1, 1), cB + hstep + kstep, voffB);
        PG8_WAIT_V(6); PG8_BAR;
    }
    for (;;) {
        const bool has_next = S.next(ui + 1, nxt);
        const char* nA = has_next ? (const char*)g.A + (size_t)nxt.pm * tstep : cA; const char* nB = has_next ? (const char*)g.Bt + (size_t)nxt.pn * tstep : cB;
        for (int t = 0; t < nt; t += 2) {
            const bool last = (t == nt - 2);
            const char* a1 = cA + (size_t)(t + 1) * kstep;
            const char* a2 = last ? nA : cA + (size_t)(t + 2) * kstep; const char* b2 = last ? nB : cB + (size_t)(t + 2) * kstep;
            const char* a3 = a2 + kstep; const char* b3 = b2 + kstep;
            if (last && has_next) S.a_ready(nxt);
            if constexpr (SP2) {
            PG8_LDB(B0, 0, 0); PG8_LDB(B1, 0, 1); PG8_SCHED; PG8_LDA(At, 0, 0); PG8_STAGE(PG8_SA(1, 1), a1 + hstep, voffA);
            PG8_WAIT_V(8); PG8_WAIT_L(0); PG8_BAR; PG8_MMA(0, 0, At, B0); PG8_MMA(0, 1, At, B1); PG8_BAR; PG8_SCHED;
            PG8_LDA(At, 0, 1); PG8_STAGE(PG8_SB(0, 0), b2, voffB); PG8_STAGE(PG8_SB(0, 1), b2 + hstep, voffB); PG8_STAGE(PG8_SA(0, 0), a2, voffA);
            PG8_WAIT_V(8); PG8_WAIT_L(0); PG8_BAR; PG8_MMA(1, 0, At, B0); PG8_MMA(1, 1, At, B1); PG8_BAR; PG8_SCHED;
            PG8_LDB(B0, 1, 0); PG8_LDB(B1, 1, 1); PG8_SCHED; PG8_LDA(At, 1, 0); PG8_STAGE(PG8_SA(0, 1), a2 + hstep, voffA);
            PG8_WAIT_V(8); PG8_WAIT_L(0); PG8_BAR; PG8_MMA(0, 0, At, B0); PG8_MMA(0, 1, At, B1); PG8_BAR; PG8_SCHED;
            PG8_LDA(At, 1, 1); PG8_STAGE(PG8_SB(1, 0), b3, voffB); PG8_STAGE(PG8_SB(1, 1), b3 + hstep, voffB); PG8_STAGE(PG8_SA(1, 0), a3, voffA);
            PG8_WAIT_V(8); PG8_WAIT_L(0); PG8_BAR; PG8_MMA(1, 0, At, B0); PG8_MMA(1, 1, At, B1); PG8_BAR; PG8_SCHED;
            } else {
            PG8_LDB(B0, 0, 0); PG8_SCHED; PG8_LDA(At, 0, 0); PG8_STAGE(PG8_SA(1, 1), a1 + hstep, voffA);
            PG8_WAIT_L(8); PG8_BAR; PG8_WAIT_L(0); PG8_MMA(0, 0, At, B0); PG8_BAR; PG8_SCHED;
            PG8_LDB(B1, 0, 1); PG8_STAGE(PG8_SB(0, 0), b2, voffB);
            PG8_BAR; PG8_WAIT_L(0); PG8_MMA(0, 1, At, B1); PG8_BAR;
            PG8_LDA(At, 0, 1); PG8_STAGE(PG8_SA(0, 0), a2, voffA);
            PG8_BAR; PG8_WAIT_L(0); PG8_MMA(1, 0, At, B0); PG8_BAR; PG8_SCHED;
            PG8_STAGE(PG8_SB(0, 1), b2 + hstep, voffB);
            PG8_WAIT_V(6); PG8_BAR; PG8_MMA(1, 1, At, B1); PG8_BAR;
            PG8_LDB(B0, 1, 0); PG8_SCHED; PG8_LDA(At, 1, 0); PG8_STAGE(PG8_SA(0, 1), a2 + hstep, voffA);
            PG8_WAIT_L(8); PG8_BAR; PG8_WAIT_L(0); PG8_MMA(0, 0, At, B0); PG8_BAR; PG8_SCHED;
            PG8_LDB(B1, 1, 1); PG8_STAGE(PG8_SB(1, 0), b3, voffB);
            PG8_BAR; PG8_WAIT_L(0); PG8_MMA(0, 1, At, B1); PG8_BAR;
            PG8_LDA(At, 1, 1); PG8_STAGE(PG8_SA(1, 0), a3, voffA);
            PG8_BAR; PG8_WAIT_L(0); PG8_MMA(1, 0, At, B0); PG8_BAR; PG8_SCHED;
            PG8_STAGE(PG8_SB(1, 1), b3 + hstep, voffB);
            PG8_WAIT_V(6); PG8_BAR; PG8_MMA(1, 1, At, B1); PG8_BAR;
            }
        }
        if constexpr (ALIGN_EPI) { if (wr == 0) PG8_BAR; }
        if constexpr (!Epi::AFTER_DRAIN) { E(acc, cur, wr, wc, fr, fq); S.done(cur); }
        if (!has_next) break;
#pragma unroll
        for (int a = 0; a < 2; ++a)
#pragma unroll
            for (int b = 0; b < 2; ++b)
#pragma unroll
                for (int m = 0; m < 4; ++m)
#pragma unroll
                    for (int n = 0; n < 2; ++n) acc[a][b][m][n] = (f32x4){0.f, 0.f, 0.f, 0.f};
        cur = nxt; cA = nA; cB = nB; ++ui;
        if constexpr (ALIGN_EPI) { if (wr == 1) PG8_BAR; }
    }
    PG8_WAIT_V(0);
    if constexpr (!ALIGN_EPI) { if (wr == 0) PG8_BAR; }
    PG8_BAR;
    if constexpr (Epi::AFTER_DRAIN) { E.fused(acc, cur, wr, wc, fr, fq, lds, wid, lane); S.done(cur); }
#undef PG8_SA
#undef PG8_SB
#undef PG8_STAGE
#undef PG8_LDA
#undef PG8_LDB
#undef PG8_MMA
#undef PG8_WAIT_V
#undef PG8_WAIT_L
#undef PG8_BAR
#undef PG8_SCHED
}
}
constexpr int BATCH = 2, SEQ = 16384, DM = 2048, MTOK = BATCH * SEQ;
constexpr int E_IN = 6144, O_INP = 8448  , O_LD = 8192;
constexpr int S5G = 64, S5P = 64, S5T = 128, S5NC = SEQ / S5T;
constexpr float LOG2E = 1.4426950408889634f;
constexpr float RMS_EPS = 1e-6f;
constexpr int NWAVES = 8;

#define LAS __attribute__((address_space(3)))
typedef unsigned short bf16_t;
typedef short bf16x8 __attribute__((ext_vector_type(8)));
typedef float f32x4 __attribute__((ext_vector_type(4)));
typedef float f32x2 __attribute__((ext_vector_type(2)));
typedef float f32x16 __attribute__((ext_vector_type(16)));
typedef unsigned u32x4 __attribute__((ext_vector_type(4)));
typedef unsigned u32x2 __attribute__((ext_vector_type(2)));
typedef short v4i16_t __attribute__((ext_vector_type(4)));
typedef __bf16 bf16x2_t __attribute__((ext_vector_type(2)));

constexpr size_t MiB = 1u << 20;
constexpr size_t WS_CTL = 0;
constexpr size_t WS_LAMB = 1 * MiB;
constexpr size_t WS_LAMT = 1 * MiB + 65536;
constexpr size_t WS_BBAR = 2 * MiB;
constexpr size_t WS_CMAT = 3 * MiB;
constexpr size_t WS_BIASDA = 4 * MiB;
constexpr size_t WS_BIASF = 5 * MiB;
constexpr size_t WS_FLOG = 7 * MiB;
constexpr size_t WS_S5ST = 9 * MiB;
constexpr size_t WS_WIN0 = 20 * MiB;
constexpr size_t WS_WOUT0 = 44 * MiB;
constexpr size_t WS_WGLU = 52 * MiB;
constexpr size_t WS_WIN1 = 54 * MiB;
constexpr size_t WS_WOUT1 = 87 * MiB;
constexpr size_t WS_HBUF = 96 * MiB;
constexpr size_t WS_PROJ = 224 * MiB;
constexpr size_t WS_YCAT = 736 * MiB;
constexpr size_t WS_END = 864 * MiB;
constexpr int CW_QDA = 64, CW_QFOX = 128, CW_LAM = 192;

constexpr int LDS_MISC = 135168;
constexpr int LDS_BYTES = 147456;
constexpr int AL_K = 0, AL_V = 32768, AL_B = 65536;
constexpr int LDS_STASH = 69632;

__device__ __forceinline__ float bf2f(unsigned b) { return __uint_as_float(b << 16); }
__device__ __forceinline__ unsigned pk2(float lo, float hi) { f32x2 v = {lo, hi}; bf16x2_t b = __builtin_convertvector(v, bf16x2_t); return __builtin_bit_cast(unsigned, b); }
__device__ __forceinline__ float bflo(unsigned w) { return __uint_as_float(w << 16); }
__device__ __forceinline__ float bfhi(unsigned w) { return __uint_as_float(w & 0xffff0000u); }
__device__ __forceinline__ float sigmoidf_(float x) { return 1.f / (1.f + __expf(-x)); }
__device__ __forceinline__ float siluf_(float x) { return x * sigmoidf_(x); }
__device__ __forceinline__ float gelu_tanh(float x) { const float z = 0.7978845608028654f * (x + 0.044715f * x * x * x); const float t = 1.f - 2.f / (1.f + __expf(2.f * z)); return 0.5f * x * (1.f + t); }
__device__ __forceinline__ int crow(int r, int hi) { return (r & 3) + 8 * (r >> 2) + 4 * hi; }
__device__ __forceinline__ float wave_sum(float v) {
#pragma unroll
    for (int o = 1; o < 64; o <<= 1) v += __shfl_xor(v, o);
    return v;
}

struct Args {
    const float* in[27];
    float* out; unsigned char* ws;
    int ph_lo, ph_hi;
};

namespace pg8 {
struct EpiProj1 {
    static constexpr bool PERM = true, AFTER_DRAIN = false;
    bf16_t* O; float* flog;
    __device__ __forceinline__ void operator()(const f32x4 (&acc)[2][2][4][2], const Unit& u, int wr, int wc, int fr, int fq) const {
        const int row0 = u.pm * BM + wr * 64 + fr;
        if (u.pn < 32) {
            const int col0 = u.pn * BM + wc * 32 + 8 * fq;
#pragma unroll
            for (int ai = 0; ai < 2; ++ai)
#pragma unroll
                for (int m = 0; m < 4; ++m) { bf16_t* rowp = O + (size_t)(row0 + ai * HALF + m * 16) * O_LD + col0;
#pragma unroll
                    for (int bj = 0; bj < 2; ++bj) { const f32x4 v0 = acc[ai][bj][m][0], v1 = acc[ai][bj][m][1];
                        u32x4 w; w.x = cvt_pk_bf16(v0[0], v0[1]); w.y = cvt_pk_bf16(v0[2], v0[3]); w.z = cvt_pk_bf16(v1[0], v1[1]); w.w = cvt_pk_bf16(v1[2], v1[3]);
                        *(u32x4*)(rowp + bj * HALF) = w; } }
        } else if (wc == 0 && fq < 2) {
#pragma unroll
            for (int ai = 0; ai < 2; ++ai)
#pragma unroll
                for (int m = 0; m < 4; ++m) { float* rp = flog + (size_t)(row0 + ai * HALF + m * 16) * 16 + 8 * fq;
                    *(f32x4*)(rp) = acc[ai][0][m][0]; *(f32x4*)(rp + 4) = acc[ai][0][m][1]; }
        }
    }
};
struct EpiGlu {
    static constexpr bool PERM = true, AFTER_DRAIN = false;
    bf16_t* O; const bf16_t* yg; const bf16_t* proj0; const float* bglu;
    __device__ __forceinline__ void operator()(const f32x4 (&acc)[2][2][4][2], const Unit& u, int wr, int wc, int fr, int fq) const {
        const int row0 = u.pm * BM + wr * 64 + fr; const int col0 = u.pn * BM + wc * 32 + 8 * fq;
#pragma unroll
        for (int ai = 0; ai < 2; ++ai)
#pragma unroll
            for (int m = 0; m < 4; ++m) { const size_t row = (size_t)(row0 + ai * HALF + m * 16);
#pragma unroll
                for (int bj = 0; bj < 2; ++bj) { const int c = col0 + bj * HALF;
                    const f32x4 b0 = *(const f32x4*)(bglu + c), b1 = *(const f32x4*)(bglu + c + 4);
                    const u32x4 yv = *(const u32x4*)(yg + row * 1024 + c); const u32x4 zv = *(const u32x4*)(proj0 + row * E_IN + 1024 + c);
                    const f32x4 v0 = acc[ai][bj][m][0] + b0, v1 = acc[ai][bj][m][1] + b1;
                    float r[8];
#pragma unroll
                    for (int e = 0; e < 4; ++e) { const unsigned yw = yv[e], zw = zv[e];
                        const float a0 = e < 2 ? v0[2 * e] : v1[2 * e - 4], a1 = e < 2 ? v0[2 * e + 1] : v1[2 * e - 3];
                        r[2 * e] = bflo(yw) * sigmoidf_(a0) * siluf_(bflo(zw)); r[2 * e + 1] = bfhi(yw) * sigmoidf_(a1) * siluf_(bfhi(zw)); }
                    u32x4 w; w.x = cvt_pk_bf16(r[0], r[1]); w.y = cvt_pk_bf16(r[2], r[3]); w.z = cvt_pk_bf16(r[4], r[5]); w.w = cvt_pk_bf16(r[6], r[7]);
                    *(u32x4*)(O + row * DM + c) = w; } }
    }
};
struct EpiResid {
    static constexpr bool PERM = false, AFTER_DRAIN = false;
    const float* base; float* out;
    __device__ __forceinline__ void operator()(const f32x4 (&acc)[2][2][4][2], const Unit& u, int wr, int wc, int fr, int fq) const {
        const int row0 = u.pm * BM + wr * 64 + fr; const int col0 = u.pn * BM + wc * 32 + 4 * fq;
#pragma unroll
        for (int ai = 0; ai < 2; ++ai)
#pragma unroll
            for (int m = 0; m < 4; ++m) { const size_t off = (size_t)(row0 + ai * HALF + m * 16) * DM + col0;
#pragma unroll
                for (int bj = 0; bj < 2; ++bj)
#pragma unroll
                    for (int n = 0; n < 2; ++n) { const f32x4 bs = *(const f32x4*)(base + off + bj * HALF + n * 16); *(f32x4*)(out + off + bj * HALF + n * 16) = bs + acc[ai][bj][m][n]; } }
    }
};
}

__device__ __forceinline__ void transpose_item(const float* __restrict__ W, int K, int N, bf16_t* __restrict__ WT, LAS float* scr, int item, int nblk, int lane) {
    const int kb = item / nblk, nb = item % nblk, k0 = 64 * kb, n0 = 32 * nb;
    const int nc = n0 + (lane & 31);
#pragma unroll 8
    for (int i = 0; i < 32; ++i) { const int kk = 2 * i + (lane >> 5); scr[kk * 33 + (lane & 31)] = (nc < N) ? W[(size_t)(k0 + kk) * N + nc] : 0.f; }
    asm volatile("s_waitcnt lgkmcnt(0)" ::: "memory");
    const int c = lane & 7;
#pragma unroll
    for (int j = 0; j < 4; ++j) { const int n = (lane >> 3) + 8 * j; const LAS float* s = scr + (8 * c) * 33 + n;
        u32x4 o; o.x = pk2(s[0 * 33], s[1 * 33]); o.y = pk2(s[2 * 33], s[3 * 33]); o.z = pk2(s[4 * 33], s[5 * 33]); o.w = pk2(s[6 * 33], s[7 * 33]);
        *(u32x4*)(WT + (size_t)(n0 + n) * K + k0 + 8 * c) = o; }
    asm volatile("s_waitcnt lgkmcnt(0)" ::: "memory");
}
__device__ __forceinline__ void rms_row_to_bf16(const float* __restrict__ xrow, const float* __restrict__ gain, bf16_t* __restrict__ orow, int lane) {
    const f32x4* xr = (const f32x4*)xrow + lane; const f32x4* gr = (const f32x4*)gain + lane;
    f32x4 v[8]; float s = 0.f;
#pragma unroll
    for (int j = 0; j < 8; ++j) { v[j] = xr[64 * j]; s += (v[j].x * v[j].x + v[j].y * v[j].y) + (v[j].z * v[j].z + v[j].w * v[j].w); }
    const float r = 1.f / sqrtf(wave_sum(s) * (1.f / DM) + RMS_EPS);
    u32x2* o8 = (u32x2*)orow + lane;
#pragma unroll
    for (int j = 0; j < 8; ++j) { const f32x4 g = gr[64 * j]; u32x2 w; w.x = pk2(v[j].x * r * g.x, v[j].y * r * g.y); w.y = pk2(v[j].z * r * g.z, v[j].w * r * g.w); o8[64 * j] = w; }
}
template <int LPS>
__device__ __forceinline__ void qknorm16(bf16_t* p, const float* __restrict__ gain16, float mul, float inv_n) {
    u32x4 a = *(u32x4*)p, b = *(u32x4*)(p + 8);
    float v[16];
#pragma unroll
    for (int e = 0; e < 4; ++e) { v[2 * e] = bflo(a[e]); v[2 * e + 1] = bfhi(a[e]); v[8 + 2 * e] = bflo(b[e]); v[9 + 2 * e] = bfhi(b[e]); }
    float s = 0.f;
#pragma unroll
    for (int e = 0; e < 16; ++e) s += v[e] * v[e];
#pragma unroll
    for (int o = 1; o < LPS; o <<= 1) s += __shfl_xor(s, o);
    const float r = mul / sqrtf(s * inv_n + RMS_EPS);
#pragma unroll
    for (int e = 0; e < 16; ++e) v[e] = v[e] * r * gain16[e];
#pragma unroll
    for (int e = 0; e < 4; ++e) { a[e] = pk2(v[2 * e], v[2 * e + 1]); b[e] = pk2(v[8 + 2 * e], v[9 + 2 * e]); }
    *(u32x4*)p = a; *(u32x4*)(p + 8) = b;
}

template <int DQK>
__device__ __forceinline__ void attn_pass(LAS unsigned char* lds, const bf16_t* __restrict__ Qg, const bf16_t* __restrict__ Kg, const bf16_t* __restrict__ Vg,
                                          const float* __restrict__ btab, const float bscale, const int pitch, const int q0, const int t_lo, f32x16 (&o)[4], const int wid, const int lane) {
    constexpr int NCH = DQK / 8, KS = DQK / 16, KROWB = DQK * 2, KI = NCH / 8;
    const int tid = wid * 64 + lane, r32 = lane & 31, hi = lane >> 5;
    const int NT = (q0 + 256) / 64;
    const int qrel = wid * 32 + r32;
    bf16x8 qf[KS];
#pragma unroll
    for (int s = 0; s < KS; ++s) qf[s] = *(const bf16x8*)(Qg + (size_t)(q0 + qrel) * pitch + 16 * s + 8 * hi);
    int kgo[KI], klo[KI], vgo[2], vlo[2];
#pragma unroll
    for (int i = 0; i < KI; ++i) { const int cid = tid + 512 * i, row = cid / NCH, ch = cid % NCH; const int sw = (DQK == 128) ? (row & 15) : ((row >> 1) & 7);
        kgo[i] = row * pitch + ch * 8; klo[i] = row * KROWB + ((ch ^ sw) << 4); }
#pragma unroll
    for (int i = 0; i < 2; ++i) { const int cid = tid + 512 * i, row = cid >> 4, ch = cid & 15;
        vgo[i] = row * pitch + ch * 8; vlo[i] = (ch >> 2) * 4096 + (row >> 3) * 512 + (row & 7) * 64 + (ch & 3) * 16; }
    const float bref = btab[q0];
    u32x4 kreg[KI], vreg[2]; float breg = 0.f;
#define AT_LOAD(t) do { const size_t kvb_ = (size_t)(64 * (t)) * pitch; \
        _Pragma("unroll") for (int i = 0; i < KI; ++i) kreg[i] = *(const u32x4*)(Kg + kvb_ + kgo[i]); \
        _Pragma("unroll") for (int i = 0; i < 2; ++i) vreg[i] = *(const u32x4*)(Vg + kvb_ + vgo[i]); \
        if (tid < 64) breg = (btab[64 * (t) + tid] - bref) * bscale; } while (0)
#define AT_STORE(buf) do { \
        _Pragma("unroll") for (int i = 0; i < KI; ++i) *(LAS u32x4*)(lds + AL_K + (buf) * 16384 + klo[i]) = kreg[i]; \
        _Pragma("unroll") for (int i = 0; i < 2; ++i) *(LAS u32x4*)(lds + AL_V + (buf) * 16384 + vlo[i]) = vreg[i]; \
        if (tid < 64) *(LAS float*)(lds + AL_B + (buf) * 256 + tid * 4) = breg; } while (0)
    float m_run = -INFINITY, l_run = 0.f;
#pragma unroll
    for (int b = 0; b < 4; ++b)
#pragma unroll
        for (int r = 0; r < 16; ++r) o[b][r] = 0.f;
    AT_LOAD(t_lo); AT_STORE(0); __syncthreads();
    const int ksw = (DQK == 128) ? (r32 & 15) : ((r32 >> 1) & 7);
    const int vlane = (4 * hi + ((lane & 15) >> 2)) * 64 + ((lane >> 4) & 1) * 32 + (lane & 3) * 8;
    for (int t = t_lo; t < NT; ++t) {
        const int cur = (t - t_lo) & 1;
        if (t + 1 < NT) AT_LOAD(t + 1);
        const int jb = t - (NT - 4);
        const bool skip = (jb >= 0) && (2 * jb > wid);
        if (!skip) {
            LAS const unsigned char* Kb = lds + AL_K + cur * 16384;
            f32x16 s0, s1;
#pragma unroll
            for (int r = 0; r < 16; ++r) { s0[r] = 0.f; s1[r] = 0.f; }
#pragma unroll
            for (int s = 0; s < KS; ++s) { const int ch = 2 * s + hi;
                const bf16x8 a0 = *(LAS const bf16x8*)(Kb + r32 * KROWB + ((ch ^ ksw) << 4));
                const bf16x8 a1 = *(LAS const bf16x8*)(Kb + (32 + r32) * KROWB + ((ch ^ ksw) << 4));
                s0 = __builtin_amdgcn_mfma_f32_32x32x16_bf16(a0, qf[s], s0, 0, 0, 0);
                s1 = __builtin_amdgcn_mfma_f32_32x32x16_bf16(a1, qf[s], s1, 0, 0, 0); }
            LAS const float* bl = (LAS const float*)(lds + AL_B + cur * 256);
#pragma unroll
            for (int g = 0; g < 4; ++g) { const f32x4 b0 = *(LAS const f32x4*)(bl + 8 * g + 4 * hi), b1 = *(LAS const f32x4*)(bl + 32 + 8 * g + 4 * hi);
#pragma unroll
                for (int e = 0; e < 4; ++e) { s0[4 * g + e] += b0[e]; s1[4 * g + e] += b1[e]; } }
            if ((jb >= 0) && (2 * jb + 1 >= wid)) {
#pragma unroll
                for (int r = 0; r < 16; ++r) { const int kv = 64 * jb + crow(r, hi); if (kv > qrel) s0[r] = -INFINITY; if (kv + 32 > qrel) s1[r] = -INFINITY; }
            }
            float mx = fmaxf(s0[0], s1[0]);
#pragma unroll
            for (int r = 1; r < 16; ++r) mx = fmaxf(mx, fmaxf(s0[r], s1[r]));
            mx = fmaxf(mx, __shfl_xor(mx, 32));
            const float m_new = fmaxf(m_run, mx);
            const float alpha = __builtin_amdgcn_exp2f(m_run - m_new);
            m_run = m_new;
            float rs = 0.f;
#pragma unroll
            for (int r = 0; r < 16; ++r) { s0[r] = __builtin_amdgcn_exp2f(s0[r] - m_new); s1[r] = __builtin_amdgcn_exp2f(s1[r] - m_new); rs += s0[r] + s1[r]; }
            l_run = l_run * alpha + rs;
#pragma unroll
            for (int b = 0; b < 4; ++b)
#pragma unroll
                for (int r = 0; r < 16; ++r) o[b][r] *= alpha;
            u32x4 pw[4];
#pragma unroll
            for (int e = 0; e < 4; ++e) { pw[0][e] = pk2(s0[2 * e], s0[2 * e + 1]); pw[1][e] = pk2(s0[8 + 2 * e], s0[9 + 2 * e]); pw[2][e] = pk2(s1[2 * e], s1[2 * e + 1]); pw[3][e] = pk2(s1[8 + 2 * e], s1[9 + 2 * e]); }
            LAS const unsigned char* Vb = lds + AL_V + cur * 16384 + vlane;
#pragma unroll
            for (int b = 0; b < 4; ++b)
#pragma unroll
                for (int ks = 0; ks < 4; ++ks) {
                    const v4i16_t lo = __builtin_amdgcn_ds_read_tr16_b64_v4i16((LAS v4i16_t*)(Vb + b * 4096 + ks * 1024));
                    const v4i16_t hh = __builtin_amdgcn_ds_read_tr16_b64_v4i16((LAS v4i16_t*)(Vb + b * 4096 + ks * 1024 + 512));
                    const bf16x8 af = {lo[0], lo[1], lo[2], lo[3], hh[0], hh[1], hh[2], hh[3]};
                    o[b] = __builtin_amdgcn_mfma_f32_32x32x16_bf16(af, __builtin_bit_cast(bf16x8, pw[ks]), o[b], 0, 0, 0);
                }
        }
        if (t + 1 < NT) AT_STORE(cur ^ 1);
        __syncthreads();
    }
#undef AT_LOAD
#undef AT_STORE
    const float l = l_run + __shfl_xor(l_run, 32);
    const float inv = 1.f / l;
#pragma unroll
    for (int b = 0; b < 4; ++b)
#pragma unroll
        for (int r = 0; r < 16; ++r) o[b][r] *= inv;
}

__global__ void __launch_bounds__(NWAVES * 64, 2) hybrid_fwd(Args args) {
    extern __shared__ __attribute__((aligned(16))) unsigned char lds_raw[];
    LAS unsigned char* lds = (LAS unsigned char*)lds_raw;
    const int wave = __builtin_amdgcn_readfirstlane((int)threadIdx.x >> 6);
#define LANE_FRESH() int lane; asm volatile("v_mbcnt_lo_u32_b32 %0, -1, 0\n\tv_mbcnt_hi_u32_b32 %0, -1, %0" : "=v"(lane)); const int tid = wave * 64 + lane; (void)tid
    const int G = gridDim.x, bid = blockIdx.x;
    const int gw = bid * NWAVES + wave, NGW = G * NWAVES;
    typedef const Args __attribute__((address_space(4)))* KArgP;
    KArgP ka0 = (KArgP)__builtin_amdgcn_kernarg_segment_ptr();
#define KA_FRESH() KArgP ka = ka0; asm volatile("" : "+s"(ka))
#define AIN(i) (ka->in[i])
    unsigned char* ws = args.ws;
    unsigned* ctl = (unsigned*)(ws + WS_CTL);
    bf16_t* win0 = (bf16_t*)(ws + WS_WIN0); bf16_t* wout0 = (bf16_t*)(ws + WS_WOUT0); bf16_t* wglu = (bf16_t*)(ws + WS_WGLU);
    bf16_t* win1 = (bf16_t*)(ws + WS_WIN1); bf16_t* wout1 = (bf16_t*)(ws + WS_WOUT1);
    bf16_t* hbuf = (bf16_t*)(ws + WS_HBUF); bf16_t* ygelu = (bf16_t*)(ws + WS_HBUF); bf16_t* proj = (bf16_t*)(ws + WS_PROJ); bf16_t* ycat = (bf16_t*)(ws + WS_YCAT);
    f32x2* lamb = (f32x2*)(ws + WS_LAMB); f32x2* lamt = (f32x2*)(ws + WS_LAMT); f32x2* bbar = (f32x2*)(ws + WS_BBAR); bf16_t* cmat = (bf16_t*)(ws + WS_CMAT);
    float* biasda = (float*)(ws + WS_BIASDA); float* biasf = (float*)(ws + WS_BIASF); float* flog = (float*)(ws + WS_FLOG); f32x2* s5st = (f32x2*)(ws + WS_S5ST);
    cg::grid_group grid = cg::this_grid();
    const int lo = args.ph_lo, hi_ph = args.ph_hi;
#ifndef PH_MASK
#define PH_MASK 0x7ff
#endif
#define IN(k) (((PH_MASK >> (k)) & 1) && lo <= (k) && (k) < hi_ph)
#define SEAM(k) do { if (IN(k) && IN((k) + 1)) grid.sync(); } while (0)

    if (IN(0)) {
        KA_FRESH(); LANE_FRESH(); const float* x = AIN(0); float* out = ka->out; (void)x; (void)out;
        LAS float* scr = (LAS float*)(lds + wave * 16384);
        constexpr int I_IN0 = 32 * 192, I_OUT = 32 * 64, I_GLU = 16 * 32, I_IN1 = 32 * 264;
        constexpr int NITEMS = I_IN0 + 2 * I_OUT + I_GLU + I_IN1;
        for (int it = gw; it < NITEMS; it += NGW) {
            int r = it;
            if (r < I_IN0) { transpose_item(AIN(2), 2048, E_IN, win0, scr, r, 192, lane); continue; } r -= I_IN0;
            if (r < I_OUT) { transpose_item(AIN(3), 2048, 2048, wout0, scr, r, 64, lane); continue; } r -= I_OUT;
            if (r < I_GLU) { transpose_item(AIN(12), 1024, 1024, wglu, scr, r, 32, lane); continue; } r -= I_GLU;
            if (r < I_IN1) { transpose_item(AIN(22), 2048, 8208, win1, scr, r, 264, lane); continue; } r -= I_IN1;
            transpose_item(AIN(24), 2048, 2048, wout1, scr, r, 64, lane);
        }
        for (int m = gw; m < MTOK; m += NGW) rms_row_to_bf16(x + (size_t)m * DM, AIN(1), hbuf + (size_t)m * DM, lane);
        const int gt = bid * 512 + tid, NGT = G * 512;
        for (int i = gt; i < S5G * S5P; i += NGT) {
            const int g = i >> 6;
            const double dt = exp((double)AIN(6)[g]);
            const double lr = (double)AIN(4)[i], li = (double)AIN(5)[i];
            const double mag = exp(lr * dt), ar = mag * cos(li * dt), ai = mag * sin(li * dt);
            const double den = lr * lr + li * li, nr = ar - 1.0, ni = ai;
            const double kr = (nr * lr + ni * li) / den, ki = (ni * lr - nr * li) / den;
            lamb[i] = (f32x2){(float)ar, (float)ai};
            const double magT = exp(lr * dt * (double)S5T);
            lamt[i] = (f32x2){(float)(magT * cos(li * dt * (double)S5T)), (float)(magT * sin(li * dt * (double)S5T))};
#pragma unroll 4
            for (int h = 0; h < 16; ++h) { const double br = (double)AIN(7)[i * 16 + h], bi = (double)AIN(8)[i * 16 + h];
                bbar[i * 16 + h] = (f32x2){(float)(kr * br - ki * bi), (float)(kr * bi + ki * br)}; }
        }
        for (int i = gt; i < S5G * 32 * 128; i += NGT) { const int k = i & 127, n = (i >> 7) & 31, g = i >> 12;
            float v = 0.f; if (n < 16) v = (k < 64) ? AIN(9)[(g * 16 + n) * 64 + k] : -AIN(10)[(g * 16 + n) * 64 + (k - 64)];
            cmat[i] = (bf16_t)(pk2(v, 0.f) & 0xffffu); }
        for (int i = gt; i < 8 * SEQ; i += NGT) { const int h = i / SEQ, j = i % SEQ; biasda[i] = exp2f(-(float)(h + 1)) * (float)j; }
        if (bid == 0 && tid == 0) {
            float d1 = 0.f, d2 = 0.f;
            for (int i = 0; i < 64; ++i) { d1 += AIN(16)[i] * AIN(17)[i]; d2 += AIN(18)[i] * AIN(19)[i]; }
            ((float*)ctl)[CW_LAM] = expf(d1) - expf(d2) + 0.2f;
            ctl[CW_QDA] = 0u; ctl[CW_QFOX] = 0u;
        }
    }
    SEAM(0);
    if (IN(1)) {
        KA_FRESH(); LANE_FRESH(); const float* x = AIN(0); float* out = ka->out; (void)x; (void)out;
        pg8::Gemm g{hbuf, win0, MTOK, E_IN, DM}; pg8::StaticOrder S; S.init(MTOK, E_IN, G, bid);
        pg8::EpiBf16<0> E{proj, E_IN, nullptr, 0, 0, 1.f};
        pg8::gemm_phase<pg8::EpiBf16<0>, pg8::StaticOrder, true, true>(lds, g, S, E, wave, lane);
    }
    SEAM(1);
    if (IN(2)) {
        KA_FRESH(); LANE_FRESH(); const float* x = AIN(0); float* out = ka->out; (void)x; (void)out;
        const float qmul = 0.125f * LOG2E;
        for (int m = gw; m < MTOK; m += NGW) {
#pragma unroll
            for (int it = 0; it < 2; ++it) { const int col = 2048 + it * 1024 + lane * 16;
                const float* gp = (it == 0 ? AIN(14) : AIN(15)) + (col & 127);
                float g16[16];
#pragma unroll
                for (int e = 0; e < 4; ++e) { const f32x4 gg = *(const f32x4*)(gp + 4 * e); g16[4 * e] = gg.x; g16[4 * e + 1] = gg.y; g16[4 * e + 2] = gg.z; g16[4 * e + 3] = gg.w; }
                qknorm16<4>(proj + (size_t)m * E_IN + col, g16, it == 0 ? qmul : 1.f, 1.f / 64.f); }
        }
        for (int u = gw; u < BATCH * S5G * S5NC; u += NGW) {
            const int g = u & 63, c = (u >> 6) & (S5NC - 1), b = u >> 13;
            const int gp = g * 64 + lane;
            const f32x2 la = lamb[gp];
            f32x2 bb[16];
#pragma unroll
            for (int h = 0; h < 16; ++h) bb[h] = bbar[gp * 16 + h];
            float hr = 0.f, hi = 0.f;
            const bf16_t* up = proj + (size_t)(b * SEQ + c * S5T) * E_IN + g * 16;
#pragma unroll 4
            for (int t = 0; t < S5T; ++t) {
                const u32x4 ua = *(const u32x4*)(up + (size_t)t * E_IN), ub = *(const u32x4*)(up + (size_t)t * E_IN + 8);
                float xr = 0.f, xi = 0.f;
#pragma unroll
                for (int e = 0; e < 4; ++e) { const float u0 = bflo(ua[e]), u1 = bfhi(ua[e]), u2 = bflo(ub[e]), u3 = bfhi(ub[e]);
                    xr += u0 * bb[2 * e].x + u1 * bb[2 * e + 1].x + u2 * bb[8 + 2 * e].x + u3 * bb[9 + 2 * e].x;
                    xi += u0 * bb[2 * e].y + u1 * bb[2 * e + 1].y + u2 * bb[8 + 2 * e].y + u3 * bb[9 + 2 * e].y; }
                const float nhr = la.x * hr - la.y * hi + xr, nhi = la.x * hi + la.y * hr + xi;
                hr = nhr; hi = nhi;
            }
            s5st[((size_t)(b * S5NC + c) * 64 + g) * 64 + lane] = (f32x2){hr, hi};
        }
    }
    SEAM(2);
    if (IN(3)) {
        KA_FRESH(); LANE_FRESH(); const float* x = AIN(0); float* out = ka->out; (void)x; (void)out;
        {
            LAS unsigned char* Ht = lds + wave * 8192;
            const int r32 = lane & 31, hi = lane >> 5;
            for (int u = gw; u < BATCH * S5G * S5NC; u += NGW) {
                const int g = u & 63, c = (u >> 6) & (S5NC - 1), b = u >> 13;
                const int gp = g * 64 + lane;
                const f32x2 la = lamb[gp], lt = lamt[gp];
                f32x2 bb[16];
#pragma unroll
                for (int h = 0; h < 16; ++h) bb[h] = bbar[gp * 16 + h];
                float hr = 0.f, hi_s = 0.f;
                for (int cc = 0; cc < c; ++cc) { const f32x2 s = s5st[((size_t)(b * S5NC + cc) * 64 + g) * 64 + lane];
                    const float nhr = lt.x * hr - lt.y * hi_s + s.x, nhi = lt.x * hi_s + lt.y * hr + s.y; hr = nhr; hi_s = nhi; }
                bf16x8 cfr[8];
#pragma unroll
                for (int s = 0; s < 8; ++s) cfr[s] = *(const bf16x8*)(cmat + (size_t)(g * 32 + r32) * 128 + 16 * s + 8 * hi);
                const float dvec = AIN(11)[g * 16 + (r32 & 15)];
                const size_t row0 = (size_t)(b * SEQ + c * S5T);
                const bf16_t* up = proj + row0 * E_IN + g * 16;
                for (int sb = 0; sb < 4; ++sb) {
#pragma unroll 4
                    for (int tt = 0; tt < 32; ++tt) { const int t = sb * 32 + tt;
                        const u32x4 ua = *(const u32x4*)(up + (size_t)t * E_IN), ub = *(const u32x4*)(up + (size_t)t * E_IN + 8);
                        float xr = 0.f, xi = 0.f;
#pragma unroll
                        for (int e = 0; e < 4; ++e) { const float u0 = bflo(ua[e]), u1 = bfhi(ua[e]), u2 = bflo(ub[e]), u3 = bfhi(ub[e]);
                            xr += u0 * bb[2 * e].x + u1 * bb[2 * e + 1].x + u2 * bb[8 + 2 * e].x + u3 * bb[9 + 2 * e].x;
                            xi += u0 * bb[2 * e].y + u1 * bb[2 * e + 1].y + u2 * bb[8 + 2 * e].y + u3 * bb[9 + 2 * e].y; }
                        const float nhr = la.x * hr - la.y * hi_s + xr, nhi = la.x * hi_s + la.y * hr + xi;
                        hr = nhr; hi_s = nhi;
                        const unsigned w = pk2(hr, hi_s);
                        const int sw = tt & 15;
                        *(LAS unsigned short*)(Ht + tt * 256 + ((((lane >> 3)) ^ sw) << 4) + ((lane & 7) << 1)) = (unsigned short)(w & 0xffffu);
                        *(LAS unsigned short*)(Ht + tt * 256 + ((((64 + lane) >> 3) ^ sw) << 4) + ((lane & 7) << 1)) = (unsigned short)(w >> 16);
                    }
                    asm volatile("s_waitcnt lgkmcnt(0)" ::: "memory");
                    f32x16 acc;
#pragma unroll
                    for (int r = 0; r < 16; ++r) acc[r] = 0.f;
#pragma unroll
                    for (int s = 0; s < 8; ++s) { const bf16x8 a = *(LAS const bf16x8*)(Ht + r32 * 256 + (((2 * s + hi) ^ (r32 & 15)) << 4));
                        acc = __builtin_amdgcn_mfma_f32_32x32x16_bf16(a, cfr[s], acc, 0, 0, 0); }
                    asm volatile("s_waitcnt lgkmcnt(0)" ::: "memory");
                    if (r32 < 16) {
#pragma unroll
                        for (int r = 0; r < 16; ++r) { const size_t row = row0 + sb * 32 + crow(r, hi);
                            const float uval = bf2f(proj[row * E_IN + g * 16 + r32]);
                            const float y = gelu_tanh(acc[r] + dvec * uval);
                            ygelu[row * 1024 + g * 16 + r32] = (bf16_t)(pk2(y, 0.f) & 0xffffu); }
                    }
                }
            }
        }
        __syncthreads();
        {
            LANE_FRESH();
            LAS volatile int* misc = (LAS volatile int*)(lds + LDS_MISC);
            const float lam = ((const float*)ctl)[CW_LAM];
            const int r32 = lane & 31, hi = lane >> 5;
            for (;;) {
                if (tid == 0) misc[0] = (int)atomicAdd(ctl + CW_QDA, 1u);
                __syncthreads();
                const int ui = misc[0];
                __syncthreads();
                if (ui >= BATCH * 8 * 64) break;
                const int qb = 63 - (ui >> 4), bh = ui & 15, b = bh >> 3, h = bh & 7;
                const int q0 = qb * 256;
                const bf16_t* pb = proj + (size_t)b * SEQ * E_IN;
                f32x16 o[4];
                LAS unsigned* stash = (LAS unsigned*)(lds + LDS_STASH) + wave * 2048 + lane;
                attn_pass<64>(lds, pb + 2048 + h * 128, pb + 3072 + h * 128, pb + 4096 + h * 128, biasda + h * SEQ, LOG2E, E_IN, q0, 0, o, wave, lane);
#pragma unroll
                for (int bl = 0; bl < 4; ++bl)
#pragma unroll
                    for (int e = 0; e < 8; ++e) stash[(bl * 8 + e) * 64] = pk2(o[bl][2 * e], o[bl][2 * e + 1]);
                attn_pass<64>(lds, pb + 2048 + h * 128 + 64, pb + 3072 + h * 128 + 64, pb + 4096 + h * 128, biasda + h * SEQ, LOG2E, E_IN, q0, 0, o, wave, lane);
                float ssq = 0.f;
#pragma unroll
                for (int bl = 0; bl < 4; ++bl)
#pragma unroll
                    for (int e = 0; e < 8; ++e) { const unsigned w0 = stash[(bl * 8 + e) * 64]; const float v0 = bflo(w0) - lam * o[bl][2 * e], v1 = bfhi(w0) - lam * o[bl][2 * e + 1];
                        o[bl][2 * e] = v0; o[bl][2 * e + 1] = v1; ssq += v0 * v0 + v1 * v1; }
                ssq += __shfl_xor(ssq, 32);
                const float rr = 0.8f / sqrtf(ssq * (1.f / 128.f) + RMS_EPS);
                const size_t tok = (size_t)b * SEQ + q0 + wave * 32 + r32;
#pragma unroll
                for (int bl = 0; bl < 4; ++bl)
#pragma unroll
                    for (int g = 0; g < 4; ++g) { const int dv0 = 32 * bl + 8 * g + 4 * hi;
                        const f32x4 gn = *(const f32x4*)(AIN(20) + dv0);
                        const u32x2 zw = *(const u32x2*)(proj + tok * E_IN + 5120 + h * 128 + dv0);
                        const float y0 = o[bl][4 * g] * rr * gn.x * siluf_(bflo(zw.x)), y1 = o[bl][4 * g + 1] * rr * gn.y * siluf_(bfhi(zw.x));
                        const float y2 = o[bl][4 * g + 2] * rr * gn.z * siluf_(bflo(zw.y)), y3 = o[bl][4 * g + 3] * rr * gn.w * siluf_(bfhi(zw.y));
                        u32x2 w; w.x = pk2(y0, y1); w.y = pk2(y2, y3);
                        *(u32x2*)(ycat + tok * DM + 1024 + h * 128 + dv0) = w; }
            }
        }
    }
    SEAM(3);
    if (IN(4)) {
        KA_FRESH(); LANE_FRESH(); const float* x = AIN(0); float* out = ka->out; (void)x; (void)out;
        pg8::Gemm g{ygelu, wglu, MTOK, 1024, 1024}; pg8::StaticOrder S; S.init(MTOK, 1024, G, bid);
        pg8::EpiGlu E{ycat, ygelu, proj, AIN(13)};
        pg8::gemm_phase<pg8::EpiGlu, pg8::StaticOrder, true, true>(lds, g, S, E, wave, lane);
    }
    SEAM(4);
    if (IN(5)) {
        KA_FRESH(); LANE_FRESH(); const float* x = AIN(0); float* out = ka->out; (void)x; (void)out;
        pg8::Gemm g{ycat, wout0, MTOK, DM, DM}; pg8::StaticOrder S; S.init(MTOK, DM, G, bid);
        pg8::EpiResid E{x, out};
        pg8::gemm_phase<pg8::EpiResid, pg8::StaticOrder, true, true>(lds, g, S, E, wave, lane);
    }
    SEAM(5);
    if (IN(6)) {
        KA_FRESH(); LANE_FRESH(); const float* x = AIN(0); float* out = ka->out; (void)x; (void)out;
        for (int m = gw; m < MTOK; m += NGW) rms_row_to_bf16(out + (size_t)m * DM, AIN(21), hbuf + (size_t)m * DM, lane);
    }
    SEAM(6);
    if (IN(7)) {
        KA_FRESH(); LANE_FRESH(); const float* x = AIN(0); float* out = ka->out; (void)x; (void)out;
        pg8::Gemm g{hbuf, win1, MTOK, O_INP, DM}; pg8::StaticOrder S; S.init(MTOK, O_INP, G, bid);
        pg8::EpiProj1 E{proj, flog};
        pg8::gemm_phase<pg8::EpiProj1, pg8::StaticOrder, true, true>(lds, g, S, E, wave, lane);
    }
    SEAM(7);
    if (IN(8)) {
        KA_FRESH(); LANE_FRESH(); const float* x = AIN(0); float* out = ka->out; (void)x; (void)out;
        if (bid < 32) {
            const int b = bid >> 4, h = bid & 15;
            LAS double* dsum = (LAS double*)lds;
            const float bf_ = AIN(23)[h];
            const float* fl = flog + ((size_t)b * SEQ + tid * 32) * 16 + h;
            double tot = 0.0;
#pragma unroll 4
            for (int i = 0; i < 32; ++i) { const float xv = fl[i * 16] + bf_; tot += (double)(fminf(xv, 0.f) - log1pf(expf(-fabsf(xv)))); }
            dsum[tid] = tot;
            __syncthreads();
            double pre = 0.0;
            for (int i = 0; i < tid; ++i) pre += dsum[i];
            float* bo = biasf + ((size_t)(b * 16 + h)) * SEQ + tid * 32;
#pragma unroll 4
            for (int i = 0; i < 32; ++i) { const float xv = fl[i * 16] + bf_; pre += (double)(fminf(xv, 0.f) - log1pf(expf(-fabsf(xv)))); bo[i] = (float)(-pre); }
            __syncthreads();
        }
        const float qmul = 0.08838834764831845f * LOG2E;
        for (int m = gw; m < MTOK; m += NGW) {
#pragma unroll
            for (int it = 0; it < 4; ++it) { const int col = it * 1024 + lane * 16;
                const float* gp = (it < 2 ? AIN(25) : AIN(26)) + (col & 127);
                float g16[16];
#pragma unroll
                for (int e = 0; e < 4; ++e) { const f32x4 gg = *(const f32x4*)(gp + 4 * e); g16[4 * e] = gg.x; g16[4 * e + 1] = gg.y; g16[4 * e + 2] = gg.z; g16[4 * e + 3] = gg.w; }
                qknorm16<8>(proj + (size_t)m * O_LD + col, g16, it < 2 ? qmul : 1.f, 1.f / 128.f); }
        }
    }
    SEAM(8);
    if (IN(9)) {
        KA_FRESH(); LANE_FRESH(); const float* x = AIN(0); float* out = ka->out; (void)x; (void)out;
        LAS volatile int* misc = (LAS volatile int*)(lds + LDS_MISC);
        const int r32 = lane & 31, hi = lane >> 5;
        for (;;) {
            if (tid == 0) misc[0] = (int)atomicAdd(ctl + CW_QFOX, 1u);
            __syncthreads();
            const int ui = misc[0];
            __syncthreads();
            if (ui >= BATCH * 16 * 64) break;
            const int qb = 63 - (ui >> 5), bh = ui & 31, b = bh >> 4, h = bh & 15;
            const int q0 = qb * 256;
            const bf16_t* pb = proj + (size_t)b * SEQ * O_LD;
            f32x16 o[4];
            attn_pass<128>(lds, pb + h * 128, pb + 2048 + h * 128, pb + 4096 + h * 128, biasf + (size_t)bh * SEQ, LOG2E, O_LD, q0, 0, o, wave, lane);
            const size_t tok = (size_t)b * SEQ + q0 + wave * 32 + r32;
#pragma unroll
            for (int bl = 0; bl < 4; ++bl)
#pragma unroll
                for (int g = 0; g < 4; ++g) { const int dv0 = 32 * bl + 8 * g + 4 * hi;
                    const u32x2 zw = *(const u32x2*)(proj + tok * O_LD + 6144 + h * 128 + dv0);
                    const float y0 = o[bl][4 * g] * siluf_(bflo(zw.x)), y1 = o[bl][4 * g + 1] * siluf_(bfhi(zw.x));
                    const float y2 = o[bl][4 * g + 2] * siluf_(bflo(zw.y)), y3 = o[bl][4 * g + 3] * siluf_(bfhi(zw.y));
                    u32x2 w; w.x = pk2(y0, y1); w.y = pk2(y2, y3);
                    *(u32x2*)(ycat + tok * DM + h * 128 + dv0) = w; }
        }
    }
    SEAM(9);
    if (IN(10)) {
        KA_FRESH(); LANE_FRESH(); const float* x = AIN(0); float* out = ka->out; (void)x; (void)out;
        pg8::Gemm g{ycat, wout1, MTOK, DM, DM}; pg8::StaticOrder S; S.init(MTOK, DM, G, bid);
        pg8::EpiResid E{out, out};
        pg8::gemm_phase<pg8::EpiResid, pg8::StaticOrder, true, true>(lds, g, S, E, wave, lane);
    }
#undef IN
#undef SEAM
}

#ifndef ONE_LAUNCH
#define ONE_LAUNCH 0
#endif
constexpr int NPHASE = 11;
extern "C" void kernel_launch(void* const* d_in, const int* in_sizes, int n_in, void* d_out, int out_size, void* d_ws, size_t ws_size, hipStream_t stream) {
    static int grid = 0;
    if (grid == 0) {
        if (n_in != 27 || out_size != MTOK * DM || ws_size < WS_END) { fprintf(stderr, "kernel_launch: unexpected problem (n_in %d out %d ws %zu)\n", n_in, out_size, ws_size); grid = -1; return; }
        int dev = 0, cus = 0, per_cu = 0;
        hipGetDevice(&dev);
        hipDeviceGetAttribute(&cus, hipDeviceAttributeMultiprocessorCount, dev);
        if (hipFuncSetAttribute((const void*)hybrid_fwd, hipFuncAttributeMaxDynamicSharedMemorySize, LDS_BYTES) != hipSuccess) { fprintf(stderr, "kernel_launch: hipFuncSetAttribute failed\n"); grid = -1; return; }
        if (hipOccupancyMaxActiveBlocksPerMultiprocessor(&per_cu, (const void*)hybrid_fwd, NWAVES * 64, LDS_BYTES) != hipSuccess || per_cu < 1) { fprintf(stderr, "kernel_launch: occupancy query says %d\n", per_cu); per_cu = 1; }
        (void)hipGetLastError();
        grid = cus * 1;
    }
    if (grid < 0) return;
    Args a{};
    for (int i = 0; i < 27; ++i) a.in[i] = (const float*)d_in[i];
    a.out = (float*)d_out; a.ws = (unsigned char*)d_ws;
#if ONE_LAUNCH
    a.ph_lo = 0; a.ph_hi = NPHASE;
    void* kargs[] = {&a};
    hipError_t e = hipLaunchCooperativeKernel((const void*)hybrid_fwd, dim3(grid), dim3(NWAVES * 64), kargs, LDS_BYTES, stream);
    if (e != hipSuccess) fprintf(stderr, "cooperative launch failed: %s (grid %d)\n", hipGetErrorString(e), grid);
#else
    for (int p = 0; p < NPHASE; ++p) {
        a.ph_lo = p; a.ph_hi = p + 1;
        hipLaunchKernelGGL(hybrid_fwd, dim3(grid), dim3(NWAVES * 64), LDS_BYTES, stream, a);
    }
#endif
}
```

```cpp
#include <hip/hip_runtime.h>
#include <hip/hip_cooperative_groups.h>
#include <cstdio>
#include <cstdint>
#include <cmath>
namespace cg = cooperative_groups;
namespace pg8 {
#define PG8_LAS __attribute__((address_space(3)))
typedef unsigned short bf16_t;
typedef short bf16x8 __attribute__((ext_vector_type(8)));
typedef float f32x4 __attribute__((ext_vector_type(4)));
typedef unsigned u32x4 __attribute__((ext_vector_type(4)));
constexpr int BM = 256, BK = 64, HALF = 128, HTB = HALF * BK * 2  , STAGE_BYTES = 8 * HTB, NXCD = 8, WGM = 8;

__host__ __device__ __forceinline__ int lds_byte(int r, int c) { const int st = (r >> 4) * 2 + (c >> 5), rr = r & 15, cc = c & 31, ob = rr * 64 + cc * 2; return st * 1024 + (ob ^ (((ob >> 9) & 1) << 5)); }
__host__ __device__ __forceinline__ void stage_rc(int b, int& R, int& C) { const int st = b / 1024, sb = b % 1024, swz = sb ^ (((sb >> 9) & 1) << 5); R = (st >> 1) * 16 + swz / 64; C = (st & 1) * 32 + (swz % 64) / 2; }
__host__ __device__ __forceinline__ int perm32(int rho) { const int n = rho >> 4, i = rho & 15; return 8 * (i >> 2) + 4 * n + (i & 3); }

struct Unit { int pm, pn; };
struct Gemm { const bf16_t* A; const bf16_t* Bt; int M, N, K; };

struct StaticOrder {
    int nM, nN, nwg, G, c;
    __host__ __device__ void init(int M, int N, int G_, int c_) { nM = M / BM; nN = N / BM; nwg = nM * nN; G = G_; c = c_; }
    __host__ __device__ bool next(int i, Unit& u) const {
        const long L = (long)i * G + c; if (L >= nwg) return false;
        int wgid = (int)L; { const int q = nwg / NXCD, r = nwg % NXCD, xcd = wgid % NXCD, off = wgid / NXCD; wgid = (xcd < r ? xcd * (q + 1) : r * (q + 1) + (xcd - r) * q) + off; }
        const int nig = WGM * nN, gid = wgid / nig, fm = gid * WGM, gsz = (nM - fm) < WGM ? (nM - fm) : WGM;
        u.pm = fm + ((wgid % nig) % gsz); u.pn = (wgid % nig) / gsz; return true;
    }
    __device__ __forceinline__ void a_ready(const Unit&) const {}
    __device__ __forceinline__ void done(const Unit&) const {}
};

__device__ __forceinline__ unsigned cvt_pk_bf16(float lo, float hi) { unsigned r; asm volatile("v_cvt_pk_bf16_f32 %0, %1, %2" : "=v"(r) : "v"(lo), "v"(hi)); return r; }
typedef float f32x2 __attribute__((ext_vector_type(2)));
__device__ __forceinline__ f32x2 gelu_pk(f32x2 v) {
    const f32x2 av = __builtin_elementwise_abs(v), d = av * 0.2316418882f + 1.0f;
    f32x2 t; t.x = __builtin_amdgcn_rcpf(d.x); t.y = __builtin_amdgcn_rcpf(d.y);
    f32x2 q = t * 0.5307027145f + (-0.7265760135f); q = q * t + 0.7107068705f; q = q * t + (-0.142248368f); q = q * t + 0.127414796f; q = q * t;
    const f32x2 s = (v * v) * (-0.72134752044f);
    f32x2 e; e.x = __builtin_amdgcn_exp2f(s.x); e.y = __builtin_amdgcn_exp2f(s.y);
    const f32x2 m = v * (q * e), r = v - m;
    f32x2 o; o.x = v.x < 0.f ? m.x : r.x; o.y = v.y < 0.f ? m.y : r.y; return o;
}

template <int ACT  > struct EpiBf16 {
    static constexpr bool PERM = true, AFTER_DRAIN = false; static_assert(ACT == 0 || ACT == 1, "EpiBf16: ACT is 0 (none) or 1 (gelu_pk)");
    bf16_t* O; int ldc; const float* bias; int split_cols; size_t split_stride; float scale0;
    __device__ __forceinline__ void operator()(const f32x4 (&acc)[2][2][4][2], const Unit& u, int wr, int wc, int fr, int fq) const {
        const int row0 = u.pm * BM + wr * 64 + fr; int colt = u.pn * BM; bf16_t* base = O;
        float sc = 1.f; if (split_cols) { const int t = colt / split_cols; base += (size_t)t * split_stride; colt -= t * split_cols; if (t == 0) sc = scale0; }
        const int col0 = colt + wc * 32 + 8 * fq, bcol0 = u.pn * BM + wc * 32 + 8 * fq;
        f32x4 bv[2][2];
#pragma unroll
        for (int bj = 0; bj < 2; ++bj)
#pragma unroll
            for (int n = 0; n < 2; ++n) bv[bj][n] = bias ? *(const f32x4*)(bias + bcol0 + bj * HALF + 4 * n) : (f32x4){0.f, 0.f, 0.f, 0.f};
#pragma unroll
        for (int ai = 0; ai < 2; ++ai)
#pragma unroll
            for (int m = 0; m < 4; ++m) { bf16_t* rowp = base + (size_t)(row0 + ai * HALF + m * 16) * ldc + col0;
#pragma unroll
                for (int bj = 0; bj < 2; ++bj) { f32x4 v0 = acc[ai][bj][m][0] + bv[bj][0], v1 = acc[ai][bj][m][1] + bv[bj][1];
                    if (ACT == 1) { f32x2 a = gelu_pk((f32x2){v0[0], v0[1]}), b = gelu_pk((f32x2){v0[2], v0[3]}), c = gelu_pk((f32x2){v1[0], v1[1]}), d = gelu_pk((f32x2){v1[2], v1[3]});
                        v0 = (f32x4){a.x, a.y, b.x, b.y}; v1 = (f32x4){c.x, c.y, d.x, d.y}; }
                    v0 = v0 * sc; v1 = v1 * sc; u32x4 w; w.x = cvt_pk_bf16(v0[0], v0[1]); w.y = cvt_pk_bf16(v0[2], v0[3]); w.z = cvt_pk_bf16(v1[0], v1[1]); w.w = cvt_pk_bf16(v1[2], v1[3]);
                    *(u32x4*)(rowp + bj * HALF) = w; } }
    }
};
template <class Epi, class Sched, bool ALIGN_EPI = false, bool SP2 = false>
__device__ __forceinline__ void gemm_phase(PG8_LAS unsigned char* lds, const Gemm g, const Sched& S, const Epi& E, const int wid, const int lane) {
    const int tid = wid * 64 + lane, wr = wid >> 2, wc = wid & 3, fr = lane & 15, fq = lane >> 4;
    const int K = g.K, nt = K / BK;
    unsigned voffA[2], voffB[2];
#pragma unroll
    for (int i = 0; i < 2; ++i) { int R, C; stage_rc(tid * 16 + i * 8192, R, C); const int Rb = Epi::PERM ? ((R & ~31) + perm32(R & 31)) : R;
        voffA[i] = (unsigned)(R * K + C) * 2u; voffB[i] = (unsigned)(Rb * K + C) * 2u; }
    const size_t kstep = (size_t)(BK * 2);
    const size_t hstep = (size_t)HALF * K * 2;
    const size_t tstep = 2 * hstep;
    const unsigned ldsw = (unsigned)wid * 1024u;
    const int aoff = lds_byte(wr * 64 + fr, fq * 8), boff = lds_byte(wc * 32 + fr, fq * 8);
#define PG8_SA(b, h) (((b) * 2 + (h)) * HTB)
#define PG8_SB(b, h) ((4 + (b) * 2 + (h)) * HTB)
#define PG8_STAGE(bufoff, gbase, voff) do { _Pragma("unroll") for (int _i = 0; _i < 2; ++_i) \
        __builtin_amdgcn_global_load_lds((const unsigned*)((const char*)(gbase) + (voff)[_i]), (PG8_LAS unsigned*)(lds + (bufoff) + ldsw + _i * 8192), 16, 0, 0); } while (0)
#define PG8_LDA(dst, b, h) do { _Pragma("unroll") for (int m = 0; m < 4; ++m) _Pragma("unroll") for (int k = 0; k < 2; ++k) dst[m][k] = *(const PG8_LAS bf16x8*)(lds + PG8_SA(b, h) + aoff + m * 2048 + k * 1024); } while (0)
#define PG8_LDB(dst, b, h) do { _Pragma("unroll") for (int n = 0; n < 2; ++n) _Pragma("unroll") for (int k = 0; k < 2; ++k) dst[n][k] = *(const PG8_LAS bf16x8*)(lds + PG8_SB(b, h) + boff + n * 2048 + k * 1024); } while (0)
#define PG8_MMA(ai, bj, At, Bt) do { __builtin_amdgcn_s_setprio(1); _Pragma("unroll") for (int m = 0; m < 4; ++m) _Pragma("unroll") for (int n = 0; n < 2; ++n) _Pragma("unroll") for (int k = 0; k < 2; ++k) \
        acc[ai][bj][m][n] = __builtin_amdgcn_mfma_f32_16x16x32_bf16(Bt[n][k], At[m][k], acc[ai][bj][m][n], 0, 0, 0); __builtin_amdgcn_s_setprio(0); } while (0)
#define PG8_WAIT_V(n) asm volatile("s_waitcnt vmcnt(" #n ")" ::: "memory")
#define PG8_WAIT_L(n) asm volatile("s_waitcnt lgkmcnt(" #n ")" ::: "memory")
#define PG8_BAR __builtin_amdgcn_s_barrier()
#define PG8_SCHED __builtin_amdgcn_sched_barrier(0)
    Unit cur, nxt; int ui = 0;
    if (!S.next(0, cur)) return;
    f32x4 acc[2][2][4][2];
#pragma unroll
    for (int a = 0; a < 2; ++a)
#pragma unroll
        for (int b = 0; b < 2; ++b)
#pragma unroll
            for (int m = 0; m < 4; ++m)
#pragma unroll
                for (int n = 0; n < 2; ++n) acc[a][b][m][n] = (f32x4){0.f, 0.f, 0.f, 0.f};
    bf16x8 At[4][2], B0[2][2], B1[2][2];
    const char* cA = (const char*)g.A + (size_t)cur.pm * tstep; const char* cB = (const char*)g.Bt + (size_t)cur.pn * tstep;
    S.a_ready(cur);
    if constexpr (SP2) {
        PG8_STAGE(PG8_SB(0, 0), cB, voffB); PG8_STAGE(PG8_SB(0, 1), cB + hstep, voffB); PG8_STAGE(PG8_SA(0, 0), cA, voffA); PG8_STAGE(PG8_SA(0, 1), cA + hstep, voffA);
        if (wr == 1) PG8_BAR;
        PG8_WAIT_V(2); PG8_BAR;
        PG8_STAGE(PG8_SB(1, 0), cB + kstep, voffB); PG8_STAGE(PG8_SA(1, 0), cA + kstep, voffA); PG8_STAGE(PG8_SB(1, 1), cB + hstep + kstep, voffB);
        PG8_WAIT_V(6); PG8_BAR;
    } else {
        PG8_STAGE(PG8_SB(0, 0), cB, voffB); PG8_STAGE(PG8_SA(0, 0), cA, voffA); PG8_STAGE(PG8_SB(0, 1), cB + hstep, voffB); PG8_STAGE(PG8_SA(0, 1), cA + hstep, voffA);
        if (wr == 1) PG8_BAR;
        PG8_WAIT_V(4); PG8_BAR;
        PG8_STAGE(PG8_SB(1, 0), cB + kstep, voffB); PG8_STAGE(PG8_SA(1, 0), cA + kstep, voffA); PG8_STAGE(PG8_SB(1, 1), cB + hstep + kstep, voffB);
        PG8_WAIT_V(6); PG8_BAR;
    }
    for (;;) {
        const bool has_next = S.next(ui + 1, nxt);
        const char* nA = has_next ? (const char*)g.A + (size_t)nxt.pm * tstep : cA; const char* nB = has_next ? (const char*)g.Bt + (size_t)nxt.pn * tstep : cB;
        for (int t = 0; t < nt; t += 2) {
            const bool last = (t == nt - 2);
            const char* a1 = cA + (size_t)(t + 1) * kstep;
            const char* a2 = last ? nA : cA + (size_t)(t + 2) * kstep; const char* b2 = last ? nB : cB + (size_t)(t + 2) * kstep;
            const char* a3 = a2 + kstep; const char* b3 = b2 + kstep;
            if (last && has_next) S.a_ready(nxt);
            if constexpr (SP2) {
            PG8_LDB(B0, 0, 0); PG8_LDB(B1, 0, 1); PG8_SCHED; PG8_LDA(At, 0, 0); PG8_STAGE(PG8_SA(1, 1), a1 + hstep, voffA);
            PG8_WAIT_V(8); PG8_WAIT_L(0); PG8_BAR; PG8_MMA(0, 0, At, B0); PG8_MMA(0, 1, At, B1); PG8_BAR; PG8_SCHED;
            PG8_LDA(At, 0, 1); PG8_STAGE(PG8_SB(0, 0), b2, voffB); PG8_STAGE(PG8_SB(0, 1), b2 + hstep, voffB); PG8_STAGE(PG8_SA(0, 0), a2, voffA);
            PG8_WAIT_V(8); PG8_WAIT_L(0); PG8_BAR; PG8_MMA(1, 0, At, B0); PG8_MMA(1, 1, At, B1); PG8_BAR; PG8_SCHED;
            PG8_LDB(B0, 1, 0); PG8_LDB(B1, 1, 1); PG8_SCHED; PG8_LDA(At, 1, 0); PG8_STAGE(PG8_SA(0, 1), a2 + hstep, voffA);
            PG8_WAIT_V(8); PG8_WAIT_L(0); PG8_BAR; PG8_MMA(0, 0, At, B0); PG8_MMA(0, 1, At, B1); PG8_BAR; PG8_SCHED;
            PG8_LDA(At, 1, 1); PG8_STAGE(PG8_SB(1, 0), b3, voffB); PG8_STAGE(PG8_SB(1, 1), b3 + hstep, voffB); PG8_STAGE(PG8_SA(1, 0), a3, voffA);
            PG8_WAIT_V(8); PG8_WAIT_L(0); PG8_BAR; PG8_MMA(1, 0, At, B0); PG8_MMA(1, 1, At, B1); PG8_BAR; PG8_SCHED;
            } else {
            PG8_LDB(B0, 0, 0); PG8_SCHED; PG8_LDA(At, 0, 0); PG8_STAGE(PG8_SA(1, 1), a1 + hstep, voffA);
            PG8_WAIT_L(8); PG8_BAR; PG8_WAIT_L(0); PG8_MMA(0, 0, At, B0); PG8_BAR; PG8_SCHED;
            PG8_LDB(B1, 0, 1); PG8_STAGE(PG8_SB(0, 0), b2, voffB);
            PG8_BAR; PG8_WAIT_L(0); PG8_MMA(0, 1, At, B1); PG8_BAR;
            PG8_LDA(At, 0, 1); PG8_STAGE(PG8_SA(0, 0), a2, voffA);
            PG8_BAR; PG8_WAIT_L(0); PG8_MMA(1, 0, At, B0); PG8_BAR; PG8_SCHED;
            PG8_STAGE(PG8_SB(0, 1), b2 + hstep, voffB);
            PG8_WAIT_V(6); PG8_BAR; PG8_MMA(1, 1, At, B1); PG8_BAR;
            PG8_LDB(B0, 1, 0); PG8_SCHED; PG8_LDA(At, 1, 0); PG8_STAGE(PG8_SA(0, 1), a2 + hstep, voffA);
            PG8_WAIT_L(8); PG8_BAR; PG8_WAIT_L(0); PG8_MMA(0, 0, At, B0); PG8_BAR; PG8_SCHED;
            PG8_LDB(B1, 1, 1); PG8_STAGE(PG8_SB(1, 0), b3, voffB);
            PG8_BAR; PG8_WAIT_L(0); PG8_MMA(0, 1, At, B1); PG8_BAR;
            PG8_LDA(At, 1, 1); PG8_STAGE(PG8_SA(1, 0), a3, voffA);
            PG8_BAR; PG8_WAIT_L(0); PG8_MMA(1, 0, At, B0); PG8_BAR; PG8_SCHED;
            PG8_STAGE(PG8_SB(1, 1), b3 + hstep, voffB);
            PG8_WAIT_V(6); PG8_BAR; PG8_MMA(1, 1, At, B1); PG8_BAR;
            }
        }
        if constexpr (ALIGN_EPI) { if (wr == 0) PG8_BAR; }
        if constexpr (!Epi::AFTER_DRAIN) { E(acc, cur, wr, wc, fr, fq); S.done(cur); }
        if (!has_next) break;
#pragma unroll
        for (int a = 0; a < 2; ++a)
#pragma unroll
            for (int b = 0; b < 2; ++b)
#pragma unroll
                for (int m = 0; m < 4; ++m)
#pragma unroll
                    for (int n = 0; n < 2; ++n) acc[a][b][m][n] = (f32x4){0.f, 0.f, 0.f, 0.f};
        cur = nxt; cA = nA; cB = nB; ++ui;
        if constexpr (ALIGN_EPI) { if (wr == 1) PG8_BAR; }
    }
    PG8_WAIT_V(0);
    if constexpr (!ALIGN_EPI) { if (wr == 0) PG8_BAR; }
    PG8_BAR;
    if constexpr (Epi::AFTER_DRAIN) { E.fused(acc, cur, wr, wc, fr, fq, lds, wid, lane); S.done(cur); }
#undef PG8_SA
#undef PG8_SB
#undef PG8_STAGE
#undef PG8_LDA
#undef PG8_LDB
#undef PG8_MMA
#undef PG8_WAIT_V
#undef PG8_WAIT_L
#undef PG8_BAR
#undef PG8_SCHED
}
}
constexpr int BATCH = 2, SEQ = 16384, DM = 2048, MTOK = BATCH * SEQ;
constexpr int E_IN = 6144, O_INP = 8448  , O_LD = 8192;
constexpr int S5G = 64, S5P = 64, S5T = 128, S5NC = SEQ / S5T;
constexpr float LOG2E = 1.4426950408889634f;
constexpr float RMS_EPS = 1e-6f;
constexpr int NWAVES = 8;

#define LAS __attribute__((address_space(3)))
typedef unsigned short bf16_t;
typedef short bf16x8 __attribute__((ext_vector_type(8)));
typedef float f32x4 __attribute__((ext_vector_type(4)));
typedef float f32x2 __attribute__((ext_vector_type(2)));
typedef float f32x16 __attribute__((ext_vector_type(16)));
typedef unsigned u32x4 __attribute__((ext_vector_type(4)));
typedef unsigned u32x2 __attribute__((ext_vector_type(2)));
typedef short v4i16_t __attribute__((ext_vector_type(4)));
typedef __bf16 bf16x2_t __attribute__((ext_vector_type(2)));

constexpr size_t MiB = 1u << 20;
constexpr size_t WS_CTL = 0;
constexpr size_t WS_LAMB = 1 * MiB;
constexpr size_t WS_LAMT = 1 * MiB + 65536;
constexpr size_t WS_BBAR = 2 * MiB;
constexpr size_t WS_CMAT = 3 * MiB;
constexpr size_t WS_BIASDA = 4 * MiB;
constexpr size_t WS_BIASF = 5 * MiB;
constexpr size_t WS_FLOG = 7 * MiB;
constexpr size_t WS_S5ST = 9 * MiB;
constexpr size_t WS_WIN0 = 20 * MiB;
constexpr size_t WS_WOUT0 = 44 * MiB;
constexpr size_t WS_WGLU = 52 * MiB;
constexpr size_t WS_WIN1 = 54 * MiB;
constexpr size_t WS_WOUT1 = 87 * MiB;
constexpr size_t WS_HBUF = 96 * MiB;
constexpr size_t WS_PROJ = 224 * MiB;
constexpr size_t WS_YCAT = 736 * MiB;
constexpr size_t WS_END = 864 * MiB;
constexpr int CW_QDA = 64, CW_QFOX = 128, CW_LAM = 192;

constexpr int LDS_MISC = 135168;
constexpr int LDS_BYTES = 147456;
constexpr int AL_K = 0, AL_V = 32768, AL_B = 65536;
constexpr int LDS_STASH = 69632;

__device__ __forceinline__ float bf2f(unsigned b) { return __uint_as_float(b << 16); }
__device__ __forceinline__ unsigned pk2(float lo, float hi) { f32x2 v = {lo, hi}; bf16x2_t b = __builtin_convertvector(v, bf16x2_t); return __builtin_bit_cast(unsigned, b); }
__device__ __forceinline__ float bflo(unsigned w) { return __uint_as_float(w << 16); }
__device__ __forceinline__ float bfhi(unsigned w) { return __uint_as_float(w & 0xffff0000u); }
__device__ __forceinline__ float sigmoidf_(float x) { return 1.f / (1.f + __expf(-x)); }
__device__ __forceinline__ float siluf_(float x) { return x * sigmoidf_(x); }
__device__ __forceinline__ float gelu_tanh(float x) { const float z = 0.7978845608028654f * (x + 0.044715f * x * x * x); const float t = 1.f - 2.f / (1.f + __expf(2.f * z)); return 0.5f * x * (1.f + t); }
__device__ __forceinline__ int crow(int r, int hi) { return (r & 3) + 8 * (r >> 2) + 4 * hi; }
__device__ __forceinline__ float wave_sum(float v) {
#pragma unroll
    for (int o = 1; o < 64; o <<= 1) v += __shfl_xor(v, o);
    return v;
}

struct Args {
    const float* in[27];
    float* out; unsigned char* ws;
    int ph_lo, ph_hi;
};

namespace pg8 {
struct EpiProj1 {
    static constexpr bool PERM = true, AFTER_DRAIN = false;
    bf16_t* O; float* flog;
    __device__ __forceinline__ void operator()(const f32x4 (&acc)[2][2][4][2], const Unit& u, int wr, int wc, int fr, int fq) const {
        const int row0 = u.pm * BM + wr * 64 + fr;
        if (u.pn < 32) {
            const int col0 = u.pn * BM + wc * 32 + 8 * fq;
#pragma unroll
            for (int ai = 0; ai < 2; ++ai)
#pragma unroll
                for (int m = 0; m < 4; ++m) { bf16_t* rowp = O + (size_t)(row0 + ai * HALF + m * 16) * O_LD + col0;
#pragma unroll
                    for (int bj = 0; bj < 2; ++bj) { const f32x4 v0 = acc[ai][bj][m][0], v1 = acc[ai][bj][m][1];
                        u32x4 w; w.x = cvt_pk_bf16(v0[0], v0[1]); w.y = cvt_pk_bf16(v0[2], v0[3]); w.z = cvt_pk_bf16(v1[0], v1[1]); w.w = cvt_pk_bf16(v1[2], v1[3]);
                        *(u32x4*)(rowp + bj * HALF) = w; } }
        } else if (wc == 0 && fq < 2) {
#pragma unroll
            for (int ai = 0; ai < 2; ++ai)
#pragma unroll
                for (int m = 0; m < 4; ++m) { float* rp = flog + (size_t)(row0 + ai * HALF + m * 16) * 16 + 8 * fq;
                    *(f32x4*)(rp) = acc[ai][0][m][0]; *(f32x4*)(rp + 4) = acc[ai][0][m][1]; }
        }
    }
};
struct EpiGlu {
    static constexpr bool PERM = true, AFTER_DRAIN = false;
    bf16_t* O; const bf16_t* yg; const bf16_t* proj0; const float* bglu;
    __device__ __forceinline__ void operator()(const f32x4 (&acc)[2][2][4][2], const Unit& u, int wr, int wc, int fr, int fq) const {
        const int row0 = u.pm * BM + wr * 64 + fr; const int col0 = u.pn * BM + wc * 32 + 8 * fq;
#pragma unroll
        for (int ai = 0; ai < 2; ++ai)
#pragma unroll
            for (int m = 0; m < 4; ++m) { const size_t row = (size_t)(row0 + ai * HALF + m * 16);
#pragma unroll
                for (int bj = 0; bj < 2; ++bj) { const int c = col0 + bj * HALF;
                    const f32x4 b0 = *(const f32x4*)(bglu + c), b1 = *(const f32x4*)(bglu + c + 4);
                    const u32x4 yv = *(const u32x4*)(yg + row * 1024 + c); const u32x4 zv = *(const u32x4*)(proj0 + row * E_IN + 1024 + c);
                    const f32x4 v0 = acc[ai][bj][m][0] + b0, v1 = acc[ai][bj][m][1] + b1;
                    float r[8];
#pragma unroll
                    for (int e = 0; e < 4; ++e) { const unsigned yw = yv[e], zw = zv[e];
                        const float a0 = e < 2 ? v0[2 * e] : v1[2 * e - 4], a1 = e < 2 ? v0[2 * e + 1] : v1[2 * e - 3];
                        r[2 * e] = bflo(yw) * sigmoidf_(a0) * siluf_(bflo(zw)); r[2 * e + 1] = bfhi(yw) * sigmoidf_(a1) * siluf_(bfhi(zw)); }
                    u32x4 w; w.x = cvt_pk_bf16(r[0], r[1]); w.y = cvt_pk_bf16(r[2], r[3]); w.z = cvt_pk_bf16(r[4], r[5]); w.w = cvt_pk_bf16(r[6], r[7]);
                    *(u32x4*)(O + row * DM + c) = w; } }
    }
};
struct EpiResid {
    static constexpr bool PERM = false, AFTER_DRAIN = false;
    const float* base; float* out;
    __device__ __forceinline__ void operator()(const f32x4 (&acc)[2][2][4][2], const Unit& u, int wr, int wc, int fr, int fq) const {
        const int row0 = u.pm * BM + wr * 64 + fr; const int col0 = u.pn * BM + wc * 32 + 4 * fq;
#pragma unroll
        for (int ai = 0; ai < 2; ++ai)
#pragma unroll
            for (int m = 0; m < 4; ++m) { const size_t off = (size_t)(row0 + ai * HALF + m * 16) * DM + col0;
#pragma unroll
                for (int bj = 0; bj < 2; ++bj)
#pragma unroll
                    for (int n = 0; n < 2; ++n) { const f32x4 bs = *(const f32x4*)(base + off + bj * HALF + n * 16); *(f32x4*)(out + off + bj * HALF + n * 16) = bs + acc[ai][bj][m][n]; } }
    }
};
}

__device__ __forceinline__ void transpose_item(const float* __restrict__ W, int K, int N, bf16_t* __restrict__ WT, LAS float* scr, int item, int nblk, int lane) {
    const int kb = item / nblk, nb = item % nblk, k0 = 64 * kb, n0 = 32 * nb;
    const int nc = n0 + (lane & 31);
#pragma unroll 8
    for (int i = 0; i < 32; ++i) { const int kk = 2 * i + (lane >> 5); scr[kk * 33 + (lane & 31)] = (nc < N) ? W[(size_t)(k0 + kk) * N + nc] : 0.f; }
    asm volatile("s_waitcnt lgkmcnt(0)" ::: "memory");
    const int c = lane & 7;
#pragma unroll
    for (int j = 0; j < 4; ++j) { const int n = (lane >> 3) + 8 * j; const LAS float* s = scr + (8 * c) * 33 + n;
        u32x4 o; o.x = pk2(s[0 * 33], s[1 * 33]); o.y = pk2(s[2 * 33], s[3 * 33]); o.z = pk2(s[4 * 33], s[5 * 33]); o.w = pk2(s[6 * 33], s[7 * 33]);
        *(u32x4*)(WT + (size_t)(n0 + n) * K + k0 + 8 * c) = o; }
    asm volatile("s_waitcnt lgkmcnt(0)" ::: "memory");
}
__device__ __forceinline__ void rms_row_to_bf16(const float* __restrict__ xrow, const float* __restrict__ gain, bf16_t* __restrict__ orow, int lane) {
    const f32x4* xr = (const f32x4*)xrow + lane; const f32x4* gr = (const f32x4*)gain + lane;
    f32x4 v[8]; float s = 0.f;
#pragma unroll
    for (int j = 0; j < 8; ++j) { v[j] = xr[64 * j]; s += (v[j].x * v[j].x + v[j].y * v[j].y) + (v[j].z * v[j].z + v[j].w * v[j].w); }
    const float r = 1.f / sqrtf(wave_sum(s) * (1.f / DM) + RMS_EPS);
    u32x2* o8 = (u32x2*)orow + lane;
#pragma unroll
    for (int j = 0; j < 8; ++j) { const f32x4 g = gr[64 * j]; u32x2 w; w.x = pk2(v[j].x * r * g.x, v[j].y * r * g.y); w.y = pk2(v[j].z * r * g.z, v[j].w * r * g.w); o8[64 * j] = w; }
}
template <int LPS>
__device__ __forceinline__ void qknorm16(bf16_t* p, const float* __restrict__ gain16, float mul, float inv_n) {
    u32x4 a = *(u32x4*)p, b = *(u32x4*)(p + 8);
    float v[16];
#pragma unroll
    for (int e = 0; e < 4; ++e) { v[2 * e] = bflo(a[e]); v[2 * e + 1] = bfhi(a[e]); v[8 + 2 * e] = bflo(b[e]); v[9 + 2 * e] = bfhi(b[e]); }
    float s = 0.f;
#pragma unroll
    for (int e = 0; e < 16; ++e) s += v[e] * v[e];
#pragma unroll
    for (int o = 1; o < LPS; o <<= 1) s += __shfl_xor(s, o);
    const float r = mul / sqrtf(s * inv_n + RMS_EPS);
#pragma unroll
    for (int e = 0; e < 16; ++e) v[e] = v[e] * r * gain16[e];
#pragma unroll
    for (int e = 0; e < 4; ++e) { a[e] = pk2(v[2 * e], v[2 * e + 1]); b[e] = pk2(v[8 + 2 * e], v[9 + 2 * e]); }
    *(u32x4*)p = a; *(u32x4*)(p + 8) = b;
}

template <int DQK>
__device__ __forceinline__ void attn_pass(LAS unsigned char* lds, const bf16_t* __restrict__ Qg, const bf16_t* __restrict__ Kg, const bf16_t* __restrict__ Vg,
                                          const float* __restrict__ btab, const float bscale, const int pitch, const int q0, const int t_lo, f32x16 (&o)[4], const int wid, const int lane) {
    constexpr int NCH = DQK / 8, KS = DQK / 16, KROWB = DQK * 2, KI = NCH / 8;
    const int tid = wid * 64 + lane, r32 = lane & 31, hi = lane >> 5;
    const int NT = (q0 + 256) / 64;
    const int qrel = wid * 32 + r32;
    bf16x8 qf[KS];
#pragma unroll
    for (int s = 0; s < KS; ++s) qf[s] = *(const bf16x8*)(Qg + (size_t)(q0 + qrel) * pitch + 16 * s + 8 * hi);
    int kgo[KI], klo[KI], vgo[2], vlo[2];
#pragma unroll
    for (int i = 0; i < KI; ++i) { const int cid = tid + 512 * i, row = cid / NCH, ch = cid % NCH; const int sw = (DQK == 128) ? (row & 15) : ((row >> 1) & 7);
        kgo[i] = row * pitch + ch * 8; klo[i] = row * KROWB + ((ch ^ sw) << 4); }
#pragma unroll
    for (int i = 0; i < 2; ++i) { const int cid = tid + 512 * i, row = cid >> 4, ch = cid & 15;
        vgo[i] = row * pitch + ch * 8; vlo[i] = (ch >> 2) * 4096 + (row >> 3) * 512 + (row & 7) * 64 + (ch & 3) * 16; }
    const float bref = btab[q0];
    u32x4 kreg[KI], vreg[2]; float breg = 0.f;
#define AT_LOAD(t) do { const size_t kvb_ = (size_t)(64 * (t)) * pitch; \
        _Pragma("unroll") for (int i = 0; i < KI; ++i) kreg[i] = *(const u32x4*)(Kg + kvb_ + kgo[i]); \
        _Pragma("unroll") for (int i = 0; i < 2; ++i) vreg[i] = *(const u32x4*)(Vg + kvb_ + vgo[i]); \
        if (tid < 64) breg = (btab[64 * (t) + tid] - bref) * bscale; } while (0)
#define AT_STORE(buf) do { \
        _Pragma("unroll") for (int i = 0; i < KI; ++i) *(LAS u32x4*)(lds + AL_K + (buf) * 16384 + klo[i]) = kreg[i]; \
        _Pragma("unroll") for (int i = 0; i < 2; ++i) *(LAS u32x4*)(lds + AL_V + (buf) * 16384 + vlo[i]) = vreg[i]; \
        if (tid < 64) *(LAS float*)(lds + AL_B + (buf) * 256 + tid * 4) = breg; } while (0)
    float m_run = -INFINITY, l_run = 0.f;
#pragma unroll
    for (int b = 0; b < 4; ++b)
#pragma unroll
        for (int r = 0; r < 16; ++r) o[b][r] = 0.f;
    AT_LOAD(t_lo); AT_STORE(0); __syncthreads();
    const int ksw = (DQK == 128) ? (r32 & 15) : ((r32 >> 1) & 7);
    const int vlane = (4 * hi + ((lane & 15) >> 2)) * 64 + ((lane >> 4) & 1) * 32 + (lane & 3) * 8;
    for (int t = t_lo; t < NT; ++t) {
        const int cur = (t - t_lo) & 1;
        if (t + 1 < NT) AT_LOAD(t + 1);
        const int jb = t - (NT - 4);
        const bool skip = (jb >= 0) && (2 * jb > wid);
        if (!skip) {
            LAS const unsigned char* Kb = lds + AL_K + cur * 16384;
            f32x16 s0, s1;
#pragma unroll
            for (int r = 0; r < 16; ++r) { s0[r] = 0.f; s1[r] = 0.f; }
#pragma unroll
            for (int s = 0; s < KS; ++s) { const int ch = 2 * s + hi;
                const bf16x8 a0 = *(LAS const bf16x8*)(Kb + r32 * KROWB + ((ch ^ ksw) << 4));
                const bf16x8 a1 = *(LAS const bf16x8*)(Kb + (32 + r32) * KROWB + ((ch ^ ksw) << 4));
                s0 = __builtin_amdgcn_mfma_f32_32x32x16_bf16(a0, qf[s], s0, 0, 0, 0);
                s1 = __builtin_amdgcn_mfma_f32_32x32x16_bf16(a1, qf[s], s1, 0, 0, 0); }
            LAS const float* bl = (LAS const float*)(lds + AL_B + cur * 256);
#pragma unroll
            for (int g = 0; g < 4; ++g) { const f32x4 b0 = *(LAS const f32x4*)(bl + 8 * g + 4 * hi), b1 = *(LAS const f32x4*)(bl + 32 + 8 * g + 4 * hi);
#pragma unroll
                for (int e = 0; e < 4; ++e) { s0[4 * g + e] += b0[e]; s1[4 * g + e] += b1[e]; } }
            if ((jb >= 0) && (2 * jb + 1 >= wid)) {
#pragma unroll
                for (int r = 0; r < 16; ++r) { const int kv = 64 * jb + crow(r, hi); if (kv > qrel) s0[r] = -INFINITY; if (kv + 32 > qrel) s1[r] = -INFINITY; }
            }
            float mx = fmaxf(s0[0], s1[0]);
#pragma unroll
            for (int r = 1; r < 16; ++r) mx = fmaxf(mx, fmaxf(s0[r], s1[r]));
            mx = fmaxf(mx, __shfl_xor(mx, 32));
            const float m_new = fmaxf(m_run, mx);
            const float alpha = __builtin_amdgcn_exp2f(m_run - m_new);
            m_run = m_new;
            float rs = 0.f;
#pragma unroll
            for (int r = 0; r < 16; ++r) { s0[r] = __builtin_amdgcn_exp2f(s0[r] - m_new); s1[r] = __builtin_amdgcn_exp2f(s1[r] - m_new); rs += s0[r] + s1[r]; }
            l_run = l_run * alpha + rs;
#pragma unroll
            for (int b = 0; b < 4; ++b)
#pragma unroll
                for (int r = 0; r < 16; ++r) o[b][r] *= alpha;
            u32x4 pw[4];
#pragma unroll
            for (int e = 0; e < 4; ++e) { pw[0][e] = pk2(s0[2 * e], s0[2 * e + 1]); pw[1][e] = pk2(s0[8 + 2 * e], s0[9 + 2 * e]); pw[2][e] = pk2(s1[2 * e], s1[2 * e + 1]); pw[3][e] = pk2(s1[8 + 2 * e], s1[9 + 2 * e]); }
            LAS const unsigned char* Vb = lds + AL_V + cur * 16384 + vlane;
#pragma unroll
            for (int b = 0; b < 4; ++b)
#pragma unroll
                for (int ks = 0; ks < 4; ++ks) {
                    const v4i16_t lo = __builtin_amdgcn_ds_read_tr16_b64_v4i16((LAS v4i16_t*)(Vb + b * 4096 + ks * 1024));
                    const v4i16_t hh = __builtin_amdgcn_ds_read_tr16_b64_v4i16((LAS v4i16_t*)(Vb + b * 4096 + ks * 1024 + 512));
                    const bf16x8 af = {lo[0], lo[1], lo[2], lo[3], hh[0], hh[1], hh[2], hh[3]};
                    o[b] = __builtin_amdgcn_mfma_f32_32x32x16_bf16(af, __builtin_bit_cast(bf16x8, pw[ks]), o[b], 0, 0, 0);
                }
        }
        if (t + 1 < NT) AT_STORE(cur ^ 1);
        __syncthreads();
    }
#undef AT_LOAD
#undef AT_STORE
    const float l = l_run + __shfl_xor(l_run, 32);
    const float inv = 1.f / l;
#pragma unroll
    for (int b = 0; b < 4; ++b)
#pragma unroll
        for (int r = 0; r < 16; ++r) o[b][r] *= inv;
}

__global__ void __launch_bounds__(NWAVES * 64, 2) hybrid_fwd(Args args) {
    extern __shared__ __attribute__((aligned(16))) unsigned char lds_raw[];
    LAS unsigned char* lds = (LAS unsigned char*)lds_raw;
    const int wave = __builtin_amdgcn_readfirstlane((int)threadIdx.x >> 6);
#define LANE_FRESH() int lane; asm volatile("v_mbcnt_lo_u32_b32 %0, -1, 0\n\tv_mbcnt_hi_u32_b32 %0, -1, %0" : "=v"(lane)); const int tid = wave * 64 + lane; (void)tid
    const int G = gridDim.x, bid = blockIdx.x;
    const int gw = bid * NWAVES + wave, NGW = G * NWAVES;
    typedef const Args __attribute__((address_space(4)))* KArgP;
    KArgP ka0 = (KArgP)__builtin_amdgcn_kernarg_segment_ptr();
#define KA_FRESH() KArgP ka = ka0; asm volatile("" : "+s"(ka))
#define AIN(i) (ka->in[i])
    unsigned char* ws = args.ws;
    unsigned* ctl = (unsigned*)(ws + WS_CTL);
    bf16_t* win0 = (bf16_t*)(ws + WS_WIN0); bf16_t* wout0 = (bf16_t*)(ws + WS_WOUT0); bf16_t* wglu = (bf16_t*)(ws + WS_WGLU);
    bf16_t* win1 = (bf16_t*)(ws + WS_WIN1); bf16_t* wout1 = (bf16_t*)(ws + WS_WOUT1);
    bf16_t* hbuf = (bf16_t*)(ws + WS_HBUF); bf16_t* ygelu = (bf16_t*)(ws + WS_HBUF); bf16_t* proj = (bf16_t*)(ws + WS_PROJ); bf16_t* ycat = (bf16_t*)(ws + WS_YCAT);
    f32x2* lamb = (f32x2*)(ws + WS_LAMB); f32x2* lamt = (f32x2*)(ws + WS_LAMT); f32x2* bbar = (f32x2*)(ws + WS_BBAR); bf16_t* cmat = (bf16_t*)(ws + WS_CMAT);
    float* biasda = (float*)(ws + WS_BIASDA); float* biasf = (float*)(ws + WS_BIASF); float* flog = (float*)(ws + WS_FLOG); f32x2* s5st = (f32x2*)(ws + WS_S5ST);
    cg::grid_group grid = cg::this_grid();
    const int lo = args.ph_lo, hi_ph = args.ph_hi;
#ifndef PH_MASK
#define PH_MASK 0x7ff
#endif
#define IN(k) (((PH_MASK >> (k)) & 1) && lo <= (k) && (k) < hi_ph)
#define SEAM(k) do { if (IN(k) && IN((k) + 1)) grid.sync(); } while (0)

    if (IN(0)) {
        KA_FRESH(); LANE_FRESH(); const float* x = AIN(0); float* out = ka->out; (void)x; (void)out;
        LAS float* scr = (LAS float*)(lds + wave * 16384);
        constexpr int I_IN0 = 32 * 192, I_OUT = 32 * 64, I_GLU = 16 * 32, I_IN1 = 32 * 264;
        constexpr int NITEMS = I_IN0 + 2 * I_OUT + I_GLU + I_IN1;
        for (int it = gw; it < NITEMS; it += NGW) {
            int r = it;
            if (r < I_IN0) { transpose_item(AIN(2), 2048, E_IN, win0, scr, r, 192, lane); continue; } r -= I_IN0;
            if (r < I_OUT) { transpose_item(AIN(3), 2048, 2048, wout0, scr, r, 64, lane); continue; } r -= I_OUT;
            if (r < I_GLU) { transpose_item(AIN(12), 1024, 1024, wglu, scr, r, 32, lane); continue; } r -= I_GLU;
            if (r < I_IN1) { transpose_item(AIN(22), 2048, 8208, win1, scr, r, 264, lane); continue; } r -= I_IN1;
            transpose_item(AIN(24), 2048, 2048, wout1, scr, r, 64, lane);
        }
        for (int m = gw; m < MTOK; m += NGW) rms_row_to_bf16(x + (size_t)m * DM, AIN(1), hbuf + (size_t)m * DM, lane);
        const int gt = bid * 512 + tid, NGT = G * 512;
        for (int i = gt; i < S5G * S5P; i += NGT) {
            const int g = i >> 6;
            const double dt = exp((double)AIN(6)[g]);
            const double lr = (double)AIN(4)[i], li = (double)AIN(5)[i];
            const double mag = exp(lr * dt), ar = mag * cos(li * dt), ai = mag * sin(li * dt);
            const double den = lr * lr + li * li, nr = ar - 1.0, ni = ai;
            const double kr = (nr * lr + ni * li) / den, ki = (ni * lr - nr * li) / den;
            lamb[i] = (f32x2){(float)ar, (float)ai};
            const double magT = exp(lr * dt * (double)S5T);
            lamt[i] = (f32x2){(float)(magT * cos(li * dt * (double)S5T)), (float)(magT * sin(li * dt * (double)S5T))};
#pragma unroll 4
            for (int h = 0; h < 16; ++h) { const double br = (double)AIN(7)[i * 16 + h], bi = (double)AIN(8)[i * 16 + h];
                bbar[i * 16 + h] = (f32x2){(float)(kr * br - ki * bi), (float)(kr * bi + ki * br)}; }
        }
        for (int i = gt; i < S5G * 32 * 128; i += NGT) { const int k = i & 127, n = (i >> 7) & 31, g = i >> 12;
            float v = 0.f; if (n < 16) v = (k < 64) ? AIN(9)[(g * 16 + n) * 64 + k] : -AIN(10)[(g * 16 + n) * 64 + (k - 64)];
            cmat[i] = (bf16_t)(pk2(v, 0.f) & 0xffffu); }
        for (int i = gt; i < 8 * SEQ; i += NGT) { const int h = i / SEQ, j = i % SEQ; biasda[i] = exp2f(-(float)(h + 1)) * (float)j; }
        if (bid == 0 && tid == 0) {
            float d1 = 0.f, d2 = 0.f;
            for (int i = 0; i < 64; ++i) { d1 += AIN(16)[i] * AIN(17)[i]; d2 += AIN(18)[i] * AIN(19)[i]; }
            ((float*)ctl)[CW_LAM] = expf(d1) - expf(d2) + 0.2f;
            ctl[CW_QDA] = 0u; ctl[CW_QFOX] = 0u;
        }
    }
    SEAM(0);
    if (IN(1)) {
        KA_FRESH(); LANE_FRESH(); const float* x = AIN(0); float* out = ka->out; (void)x; (void)out;
        pg8::Gemm g{hbuf, win0, MTOK, E_IN, DM}; pg8::StaticOrder S; S.init(MTOK, E_IN, G, bid);
        pg8::EpiBf16<0> E{proj, E_IN, nullptr, 0, 0, 1.f};
        pg8::gemm_phase<pg8::EpiBf16<0>, pg8::StaticOrder, true, true>(lds, g, S, E, wave, lane);
    }
    SEAM(1);
    if (IN(2)) {
        KA_FRESH(); LANE_FRESH(); const float* x = AIN(0); float* out = ka->out; (void)x; (void)out;
        const float qmul = 0.125f * LOG2E;
        for (int m = gw; m < MTOK; m += NGW) {
#pragma unroll
            for (int it = 0; it < 2; ++it) { const int col = 2048 + it * 1024 + lane * 16;
                const float* gp = (it == 0 ? AIN(14) : AIN(15)) + (col & 127);
                float g16[16];
#pragma unroll
                for (int e = 0; e < 4; ++e) { const f32x4 gg = *(const f32x4*)(gp + 4 * e); g16[4 * e] = gg.x; g16[4 * e + 1] = gg.y; g16[4 * e + 2] = gg.z; g16[4 * e + 3] = gg.w; }
                qknorm16<4>(proj + (size_t)m * E_IN + col, g16, it == 0 ? qmul : 1.f, 1.f / 64.f); }
        }
        for (int u = gw; u < BATCH * S5G * S5NC; u += NGW) {
            const int g = u & 63, c = (u >> 6) & (S5NC - 1), b = u >> 13;
            const int gp = g * 64 + lane;
            const f32x2 la = lamb[gp];
            f32x2 bb[16];
#pragma unroll
            for (int h = 0; h < 16; ++h) bb[h] = bbar[gp * 16 + h];
            float hr = 0.f, hi = 0.f;
            const bf16_t* up = proj + (size_t)(b * SEQ + c * S5T) * E_IN + g * 16;
#pragma unroll 4
            for (int t = 0; t < S5T; ++t) {
                const u32x4 ua = *(const u32x4*)(up + (size_t)t * E_IN), ub = *(const u32x4*)(up + (size_t)t * E_IN + 8);
                float xr = 0.f, xi = 0.f;
#pragma unroll
                for (int e = 0; e < 4; ++e) { const float u0 = bflo(ua[e]), u1 = bfhi(ua[e]), u2 = bflo(ub[e]), u3 = bfhi(ub[e]);
                    xr += u0 * bb[2 * e].x + u1 * bb[2 * e + 1].x + u2 * bb[8 + 2 * e].x + u3 * bb[9 + 2 * e].x;
                    xi += u0 * bb[2 * e].y + u1 * bb[2 * e + 1].y + u2 * bb[8 + 2 * e].y + u3 * bb[9 + 2 * e].y; }
                const float nhr = la.x * hr - la.y * hi + xr, nhi = la.x * hi + la.y * hr + xi;
                hr = nhr; hi = nhi;
            }
            s5st[((size_t)(b * S5NC + c) * 64 + g) * 64 + lane] = (f32x2){hr, hi};
        }
    }
    SEAM(2);
    if (IN(3)) {
        KA_FRESH(); LANE_FRESH(); const float* x = AIN(0); float* out = ka->out; (void)x; (void)out;
        {
            LAS unsigned char* Ht = lds + wave * 8192;
            const int r32 = lane & 31, hi = lane >> 5;
            for (int u = gw; u < BATCH * S5G * S5NC; u += NGW) {
                const int g = u & 63, c = (u >> 6) & (S5NC - 1), b = u >> 13;
                const int gp = g * 64 + lane;
                const f32x2 la = lamb[gp], lt = lamt[gp];
                f32x2 bb[16];
#pragma unroll
                for (int h = 0; h < 16; ++h) bb[h] = bbar[gp * 16 + h];
                float hr = 0.f, hi_s = 0.f;
                for (int cc = 0; cc < c; ++cc) { const f32x2 s = s5st[((size_t)(b * S5NC + cc) * 64 + g) * 64 + lane];
                    const float nhr = lt.x * hr - lt.y * hi_s + s.x, nhi = lt.x * hi_s + lt.y * hr + s.y; hr = nhr; hi_s = nhi; }
                bf16x8 cfr[8];
#pragma unroll
                for (int s = 0; s < 8; ++s) cfr[s] = *(const bf16x8*)(cmat + (size_t)(g * 32 + r32) * 128 + 16 * s + 8 * hi);
                const float dvec = AIN(11)[g * 16 + (r32 & 15)];
                const size_t row0 = (size_t)(b * SEQ + c * S5T);
                const bf16_t* up = proj + row0 * E_IN + g * 16;
                for (int sb = 0; sb < 4; ++sb) {
#pragma unroll 4
                    for (int tt = 0; tt < 32; ++tt) { const int t = sb * 32 + tt;
                        const u32x4 ua = *(const u32x4*)(up + (size_t)t * E_IN), ub = *(const u32x4*)(up + (size_t)t * E_IN + 8);
                        float xr = 0.f, xi = 0.f;
#pragma unroll
                        for (int e = 0; e < 4; ++e) { const float u0 = bflo(ua[e]), u1 = bfhi(ua[e]), u2 = bflo(ub[e]), u3 = bfhi(ub[e]);
                            xr += u0 * bb[2 * e].x + u1 * bb[2 * e + 1].x + u2 * bb[8 + 2 * e].x + u3 * bb[9 + 2 * e].x;
                            xi += u0 * bb[2 * e].y + u1 * bb[2 * e + 1].y + u2 * bb[8 + 2 * e].y + u3 * bb[9 + 2 * e].y; }
                        const float nhr = la.x * hr - la.y * hi_s + xr, nhi = la.x * hi_s + la.y * hr + xi;
                        hr = nhr; hi_s = nhi;
                        const unsigned w = pk2(hr, hi_s);
                        const int sw = tt & 15;
                        *(LAS unsigned short*)(Ht + tt * 256 + ((((lane >> 3)) ^ sw) << 4) + ((lane & 7) << 1)) = (unsigned short)(w & 0xffffu);
                        *(LAS unsigned short*)(Ht + tt * 256 + ((((64 + lane) >> 3) ^ sw) << 4) + ((lane & 7) << 1)) = (unsigned short)(w >> 16);
                    }
                    asm volatile("s_waitcnt lgkmcnt(0)" ::: "memory");
                    f32x16 acc;
#pragma unroll
                    for (int r = 0; r < 16; ++r) acc[r] = 0.f;
#pragma unroll
                    for (int s = 0; s < 8; ++s) { const bf16x8 a = *(LAS const bf16x8*)(Ht + r32 * 256 + (((2 * s + hi) ^ (r32 & 15)) << 4));
                        acc = __builtin_amdgcn_mfma_f32_32x32x16_bf16(a, cfr[s], acc, 0, 0, 0); }
                    asm volatile("s_waitcnt lgkmcnt(0)" ::: "memory");
                    if (r32 < 16) {
#pragma unroll
                        for (int r = 0; r < 16; ++r) { const size_t row = row0 + sb * 32 + crow(r, hi);
                            const float uval = bf2f(proj[row * E_IN + g * 16 + r32]);
                            const float y = gelu_tanh(acc[r] + dvec * uval);
                            ygelu[row * 1024 + g * 16 + r32] = (bf16_t)(pk2(y, 0.f) & 0xffffu); }
                    }
                }
            }
        }
        __syncthreads();
        {
            LANE_FRESH();
            LAS volatile int* misc = (LAS volatile int*)(lds + LDS_MISC);
            const float lam = ((const float*)ctl)[CW_LAM];
            const int r32 = lane & 31, hi = lane >> 5;
            for (;;) {
                if (tid == 0) misc[0] = (int)atomicAdd(ctl + CW_QDA, 1u);
                __syncthreads();
                const int ui = misc[0];
                __syncthreads();
                if (ui >= BATCH * 8 * 64) break;
                const int qb = 63 - (ui >> 4), bh = ui & 15, b = bh >> 3, h = bh & 7;
                const int q0 = qb * 256;
                const bf16_t* pb = proj + (size_t)b * SEQ * E_IN;
                f32x16 o[4];
                LAS unsigned* stash = (LAS unsigned*)(lds + LDS_STASH) + wave * 2048 + lane;
                attn_pass<64>(lds, pb + 2048 + h * 128, pb + 3072 + h * 128, pb + 4096 + h * 128, biasda + h * SEQ, LOG2E, E_IN, q0, 0, o, wave, lane);
#pragma unroll
                for (int bl = 0; bl < 4; ++bl)
#pragma unroll
                    for (int e = 0; e < 8; ++e) stash[(bl * 8 + e) * 64] = pk2(o[bl][2 * e], o[bl][2 * e + 1]);
                attn_pass<64>(lds, pb + 2048 + h * 128 + 64, pb + 3072 + h * 128 + 64, pb + 4096 + h * 128, biasda + h * SEQ, LOG2E, E_IN, q0, 0, o, wave, lane);
                float ssq = 0.f;
#pragma unroll
                for (int bl = 0; bl < 4; ++bl)
#pragma unroll
                    for (int e = 0; e < 8; ++e) { const unsigned w0 = stash[(bl * 8 + e) * 64]; const float v0 = bflo(w0) - lam * o[bl][2 * e], v1 = bfhi(w0) - lam * o[bl][2 * e + 1];
                        o[bl][2 * e] = v0; o[bl][2 * e + 1] = v1; ssq += v0 * v0 + v1 * v1; }
                ssq += __shfl_xor(ssq, 32);
                const float rr = 0.8f / sqrtf(ssq * (1.f / 128.f) + RMS_EPS);
                const size_t tok = (size_t)b * SEQ + q0 + wave * 32 + r32;
#pragma unroll
                for (int bl = 0; bl < 4; ++bl)
#pragma unroll
                    for (int g = 0; g < 4; ++g) { const int dv0 = 32 * bl + 8 * g + 4 * hi;
                        const f32x4 gn = *(const f32x4*)(AIN(20) + dv0);
                        const u32x2 zw = *(const u32x2*)(proj + tok * E_IN + 5120 + h * 128 + dv0);
                        const float y0 = o[bl][4 * g] * rr * gn.x * siluf_(bflo(zw.x)), y1 = o[bl][4 * g + 1] * rr * gn.y * siluf_(bfhi(zw.x));
                        const float y2 = o[bl][4 * g + 2] * rr * gn.z * siluf_(bflo(zw.y)), y3 = o[bl][4 * g + 3] * rr * gn.w * siluf_(bfhi(zw.y));
                        u32x2 w; w.x = pk2(y0, y1); w.y = pk2(y2, y3);
                        *(u32x2*)(ycat + tok * DM + 1024 + h * 128 + dv0) = w; }
            }
        }
    }
    SEAM(3);
    if (IN(4)) {
        KA_FRESH(); LANE_FRESH(); const float* x = AIN(0); float* out = ka->out; (void)x; (void)out;
        pg8::Gemm g{ygelu, wglu, MTOK, 1024, 1024}; pg8::StaticOrder S; S.init(MTOK, 1024, G, bid);
        pg8::EpiGlu E{ycat, ygelu, proj, AIN(13)};
        pg8::gemm_phase<pg8::EpiGlu, pg8::StaticOrder, true, true>(lds, g, S, E, wave, lane);
    }
    SEAM(4);
    if (IN(5)) {
        KA_FRESH(); LANE_FRESH(); const float* x = AIN(0); float* out = ka->out; (void)x; (void)out;
        pg8::Gemm g{ycat, wout0, MTOK, DM, DM}; pg8::StaticOrder S; S.init(MTOK, DM, G, bid);
        pg8::EpiResid E{x, out};
        pg8::gemm_phase<pg8::EpiResid, pg8::StaticOrder, true, true>(lds, g, S, E, wave, lane);
    }
    SEAM(5);
    if (IN(6)) {
        KA_FRESH(); LANE_FRESH(); const float* x = AIN(0); float* out = ka->out; (void)x; (void)out;
        for (int m = gw; m < MTOK; m += NGW) rms_row_to_bf16(out + (size_t)m * DM, AIN(21), hbuf + (size_t)m * DM, lane);
    }
    SEAM(6);
    if (IN(7)) {
        KA_FRESH(); LANE_FRESH(); const float* x = AIN(0); float* out = ka->out; (void)x; (void)out;
        pg8::Gemm g{hbuf, win1, MTOK, O_INP, DM}; pg8::StaticOrder S; S.init(MTOK, O_INP, G, bid);
        pg8::EpiProj1 E{proj, flog};
        pg8::gemm_phase<pg8::EpiProj1, pg8::StaticOrder, true, true>(lds, g, S, E, wave, lane);
    }
    SEAM(7);
    if (IN(8)) {
        KA_FRESH(); LANE_FRESH(); const float* x = AIN(0); float* out = ka->out; (void)x; (void)out;
        if (bid < 32) {
            const int b = bid >> 4, h = bid & 15;
            LAS double* dsum = (LAS double*)lds;
            const float bf_ = AIN(23)[h];
            const float* fl = flog + ((size_t)b * SEQ + tid * 32) * 16 + h;
            double tot = 0.0;
#pragma unroll 4
            for (int i = 0; i < 32; ++i) { const float xv = fl[i * 16] + bf_; tot += (double)(fminf(xv, 0.f) - log1pf(expf(-fabsf(xv)))); }
            dsum[tid] = tot;
            __syncthreads();
            double pre = 0.0;
            for (int i = 0; i < tid; ++i) pre += dsum[i];
            float* bo = biasf + ((size_t)(b * 16 + h)) * SEQ + tid * 32;
#pragma unroll 4
            for (int i = 0; i < 32; ++i) { const float xv = fl[i * 16] + bf_; pre += (double)(fminf(xv, 0.f) - log1pf(expf(-fabsf(xv)))); bo[i] = (float)(-pre); }
            __syncthreads();
        }
        const float qmul = 0.08838834764831845f * LOG2E;
        for (int m = gw; m < MTOK; m += NGW) {
#pragma unroll
            for (int it = 0; it < 4; ++it) { const int col = it * 1024 + lane * 16;
                const float* gp = (it < 2 ? AIN(25) : AIN(26)) + (col & 127);
                float g16[16];
#pragma unroll
                for (int e = 0; e < 4; ++e) { const f32x4 gg = *(const f32x4*)(gp + 4 * e); g16[4 * e] = gg.x; g16[4 * e + 1] = gg.y; g16[4 * e + 2] = gg.z; g16[4 * e + 3] = gg.w; }
                qknorm16<8>(proj + (size_t)m * O_LD + col, g16, it < 2 ? qmul : 1.f, 1.f / 128.f); }
        }
    }
    SEAM(8);
    if (IN(9)) {
        KA_FRESH(); LANE_FRESH(); const float* x = AIN(0); float* out = ka->out; (void)x; (void)out;
        LAS volatile int* misc = (LAS volatile int*)(lds + LDS_MISC);
        const int r32 = lane & 31, hi = lane >> 5;
        for (;;) {
            if (tid == 0) misc[0] = (int)atomicAdd(ctl + CW_QFOX, 1u);
            __syncthreads();
            const int ui = misc[0];
            __syncthreads();
            if (ui >= BATCH * 16 * 64) break;
            const int qb = 63 - (ui >> 5), bh = ui & 31, b = bh >> 4, h = bh & 15;
            const int q0 = qb * 256;
            const bf16_t* pb = proj + (size_t)b * SEQ * O_LD;
            f32x16 o[4];
            attn_pass<128>(lds, pb + h * 128, pb + 2048 + h * 128, pb + 4096 + h * 128, biasf + (size_t)bh * SEQ, LOG2E, O_LD, q0, 0, o, wave, lane);
            const size_t tok = (size_t)b * SEQ + q0 + wave * 32 + r32;
#pragma unroll
            for (int bl = 0; bl < 4; ++bl)
#pragma unroll
                for (int g = 0; g < 4; ++g) { const int dv0 = 32 * bl + 8 * g + 4 * hi;
                    const u32x2 zw = *(const u32x2*)(proj + tok * O_LD + 6144 + h * 128 + dv0);
                    const float y0 = o[bl][4 * g] * siluf_(bflo(zw.x)), y1 = o[bl][4 * g + 1] * siluf_(bfhi(zw.x));
                    const float y2 = o[bl][4 * g + 2] * siluf_(bflo(zw.y)), y3 = o[bl][4 * g + 3] * siluf_(bfhi(zw.y));
                    u32x2 w; w.x = pk2(y0, y1); w.y = pk2(y2, y3);
                    *(u32x2*)(ycat + tok * DM + h * 128 + dv0) = w; }
        }
    }
    SEAM(9);
    if (IN(10)) {
        KA_FRESH(); LANE_FRESH(); const float* x = AIN(0); float* out = ka->out; (void)x; (void)out;
        pg8::Gemm g{ycat, wout1, MTOK, DM, DM}; pg8::StaticOrder S; S.init(MTOK, DM, G, bid);
        pg8::EpiResid E{out, out};
        pg8::gemm_phase<pg8::EpiResid, pg8::StaticOrder, true, true>(lds, g, S, E, wave, lane);
    }
#undef IN
#undef SEAM
}

#ifndef ONE_LAUNCH
#define ONE_LAUNCH 1
#endif
constexpr int NPHASE = 11;
extern "C" void kernel_launch(void* const* d_in, const int* in_sizes, int n_in, void* d_out, int out_size, void* d_ws, size_t ws_size, hipStream_t stream) {
    static int grid = 0;
    if (grid == 0) {
        if (n_in != 27 || out_size != MTOK * DM || ws_size < WS_END) { fprintf(stderr, "kernel_launch: unexpected problem (n_in %d out %d ws %zu)\n", n_in, out_size, ws_size); grid = -1; return; }
        int dev = 0, cus = 0, per_cu = 0;
        hipGetDevice(&dev);
        hipDeviceGetAttribute(&cus, hipDeviceAttributeMultiprocessorCount, dev);
        if (hipFuncSetAttribute((const void*)hybrid_fwd, hipFuncAttributeMaxDynamicSharedMemorySize, LDS_BYTES) != hipSuccess) { fprintf(stderr, "kernel_launch: hipFuncSetAttribute failed\n"); grid = -1; return; }
        if (hipOccupancyMaxActiveBlocksPerMultiprocessor(&per_cu, (const void*)hybrid_fwd, NWAVES * 64, LDS_BYTES) != hipSuccess || per_cu < 1) { fprintf(stderr, "kernel_launch: occupancy query says %d\n", per_cu); per_cu = 1; }
        (void)hipGetLastError();
        grid = cus * 1;
    }
    if (grid < 0) return;
    Args a{};
    for (int i = 0; i < 27; ++i) a.in[i] = (const float*)d_in[i];
    a.out = (float*)d_out; a.ws = (unsigned char*)d_ws;
#if ONE_LAUNCH
    a.ph_lo = 0; a.ph_hi = NPHASE;
    void* kargs[] = {&a};
    hipError_t e = hipLaunchCooperativeKernel((const void*)hybrid_fwd, dim3(grid), dim3(NWAVES * 64), kargs, LDS_BYTES, stream);
    if (e != hipSuccess) fprintf(stderr, "cooperative launch failed: %s (grid %d)\n", hipGetErrorString(e), grid);
#else
    for (int p = 0; p < NPHASE; ++p) {
        a.ph_lo = p; a.ph_hi = p + 1;
        hipLaunchKernelGGL(hybrid_fwd, dim3(grid), dim3(NWAVES * 64), LDS_BYTES, stream, a);
    }
#endif
}
```

```cpp
#include <hip/hip_runtime.h>
#include <hip/hip_cooperative_groups.h>
#include <cstdio>
#include <cstdint>
#include <cmath>
namespace cg = cooperative_groups;
namespace pg8 {
#define PG8_LAS __attribute__((address_space(3)))
typedef unsigned short bf16_t;
typedef short bf16x8 __attribute__((ext_vector_type(8)));
typedef float f32x4 __attribute__((ext_vector_type(4)));
typedef unsigned u32x4 __attribute__((ext_vector_type(4)));
constexpr int BM = 256, BK = 64, HALF = 128, HTB = HALF * BK * 2  , STAGE_BYTES = 8 * HTB, NXCD = 8, WGM = 8;

__host__ __device__ __forceinline__ int lds_byte(int r, int c) { const int st = (r >> 4) * 2 + (c >> 5), rr = r & 15, cc = c & 31, ob = rr * 64 + cc * 2; return st * 1024 + (ob ^ (((ob >> 9) & 1) << 5)); }
__host__ __device__ __forceinline__ void stage_rc(int b, int& R, int& C) { const int st = b / 1024, sb = b % 1024, swz = sb ^ (((sb >> 9) & 1) << 5); R = (st >> 1) * 16 + swz / 64; C = (st & 1) * 32 + (swz % 64) / 2; }
__host__ __device__ __forceinline__ int perm32(int rho) { const int n = rho >> 4, i = rho & 15; return 8 * (i >> 2) + 4 * n + (i & 3); }

struct Unit { int pm, pn; };
struct Gemm { const bf16_t* A; const bf16_t* Bt; int M, N, K; };

struct StaticOrder {
    int nM, nN, nwg, G, c;
    __host__ __device__ void init(int M, int N, int G_, int c_) { nM = M / BM; nN = N / BM; nwg = nM * nN; G = G_; c = c_; }
    __host__ __device__ bool next(int i, Unit& u) const {
        const long L = (long)i * G + c; if (L >= nwg) return false;
        int wgid = (int)L; { const int q = nwg / NXCD, r = nwg % NXCD, xcd = wgid % NXCD, off = wgid / NXCD; wgid = (xcd < r ? xcd * (q + 1) : r * (q + 1) + (xcd - r) * q) + off; }
        const int nig = WGM * nN, gid = wgid / nig, fm = gid * WGM, gsz = (nM - fm) < WGM ? (nM - fm) : WGM;
        u.pm = fm + ((wgid % nig) % gsz); u.pn = (wgid % nig) / gsz; return true;
    }
    __device__ __forceinline__ void a_ready(const Unit&) const {}
    __device__ __forceinline__ void done(const Unit&) const {}
};

__device__ __forceinline__ unsigned cvt_pk_bf16(float lo, float hi) { unsigned r; asm volatile("v_cvt_pk_bf16_f32 %0, %1, %2" : "=v"(r) : "v"(lo), "v"(hi)); return r; }
typedef float f32x2 __attribute__((ext_vector_type(2)));
__device__ __forceinline__ f32x2 gelu_pk(f32x2 v) {
    const f32x2 av = __builtin_elementwise_abs(v), d = av * 0.2316418882f + 1.0f;
    f32x2 t; t.x = __builtin_amdgcn_rcpf(d.x); t.y = __builtin_amdgcn_rcpf(d.y);
    f32x2 q = t * 0.5307027145f + (-0.7265760135f); q = q * t + 0.7107068705f; q = q * t + (-0.142248368f); q = q * t + 0.127414796f; q = q * t;
    const f32x2 s = (v * v) * (-0.72134752044f);
    f32x2 e; e.x = __builtin_amdgcn_exp2f(s.x); e.y = __builtin_amdgcn_exp2f(s.y);
    const f32x2 m = v * (q * e), r = v - m;
    f32x2 o; o.x = v.x < 0.f ? m.x : r.x; o.y = v.y < 0.f ? m.y : r.y; return o;
}

template <int ACT  > struct EpiBf16 {
    static constexpr bool PERM = true, AFTER_DRAIN = false; static_assert(ACT == 0 || ACT == 1, "EpiBf16: ACT is 0 (none) or 1 (gelu_pk)");
    bf16_t* O; int ldc; const float* bias; int split_cols; size_t split_stride; float scale0;
    __device__ __forceinline__ void operator()(const f32x4 (&acc)[2][2][4][2], const Unit& u, int wr, int wc, int fr, int fq) const {
        const int row0 = u.pm * BM + wr * 64 + fr; int colt = u.pn * BM; bf16_t* base = O;
        float sc = 1.f; if (split_cols) { const int t = colt / split_cols; base += (size_t)t * split_stride; colt -= t * split_cols; if (t == 0) sc = scale0; }
        const int col0 = colt + wc * 32 + 8 * fq, bcol0 = u.pn * BM + wc * 32 + 8 * fq;
        f32x4 bv[2][2];
#pragma unroll
        for (int bj = 0; bj < 2; ++bj)
#pragma unroll
            for (int n = 0; n < 2; ++n) bv[bj][n] = bias ? *(const f32x4*)(bias + bcol0 + bj * HALF + 4 * n) : (f32x4){0.f, 0.f, 0.f, 0.f};
#pragma unroll
        for (int ai = 0; ai < 2; ++ai)
#pragma unroll
            for (int m = 0; m < 4; ++m) { bf16_t* rowp = base + (size_t)(row0 + ai * HALF + m * 16) * ldc + col0;
#pragma unroll
                for (int bj = 0; bj < 2; ++bj) { f32x4 v0 = acc[ai][bj][m][0] + bv[bj][0], v1 = acc[ai][bj][m][1] + bv[bj][1];
                    if (ACT == 1) { f32x2 a = gelu_pk((f32x2){v0[0], v0[1]}), b = gelu_pk((f32x2){v0[2], v0[3]}), c = gelu_pk((f32x2){v1[0], v1[1]}), d = gelu_pk((f32x2){v1[2], v1[3]});
                        v0 = (f32x4){a.x, a.y, b.x, b.y}; v1 = (f32x4){c.x, c.y, d.x, d.y}; }
                    v0 = v0 * sc; v1 = v1 * sc; u32x4 w; w.x = cvt_pk_bf16(v0[0], v0[1]); w.y = cvt_pk_bf16(v0[2], v0[3]); w.z = cvt_pk_bf16(v1[0], v1[1]); w.w = cvt_pk_bf16(v1[2], v1[3]);
                    *(u32x4*)(rowp + bj * HALF) = w; } }
    }
};
template <class Epi, class Sched, bool ALIGN_EPI = false, bool SP2 = false>
__device__ __forceinline__ void gemm_phase(PG8_LAS unsigned char* lds, const Gemm g, const Sched& S, const Epi& E, const int wid, const int lane) {
    const int tid = wid * 64 + lane, wr = wid >> 2, wc = wid & 3, fr = lane & 15, fq = lane >> 4;
    const int K = g.K, nt = K / BK;
    unsigned voffA[2], voffB[2];
#pragma unroll
    for (int i = 0; i < 2; ++i) { int R, C; stage_rc(tid * 16 + i * 8192, R, C); const int Rb = Epi::PERM ? ((R & ~31) + perm32(R & 31)) : R;
        voffA[i] = (unsigned)(R * K + C) * 2u; voffB[i] = (unsigned)(Rb * K + C) * 2u; }
    const size_t kstep = (size_t)(BK * 2);
    const size_t hstep = (size_t)HALF * K * 2;
    const size_t tstep = 2 * hstep;
    const unsigned ldsw = (unsigned)wid * 1024u;
    const int aoff = lds_byte(wr * 64 + fr, fq * 8), boff = lds_byte(wc * 32 + fr, fq * 8);
#define PG8_SA(b, h) (((b) * 2 + (h)) * HTB)
#define PG8_SB(b, h) ((4 + (b) * 2 + (h)) * HTB)
#define PG8_STAGE(bufoff, gbase, voff) do { _Pragma("unroll") for (int _i = 0; _i < 2; ++_i) \
        __builtin_amdgcn_global_load_lds((const unsigned*)((const char*)(gbase) + (voff)[_i]), (PG8_LAS unsigned*)(lds + (bufoff) + ldsw + _i * 8192), 16, 0, 0); } while (0)
#define PG8_LDA(dst, b, h) do { _Pragma("unroll") for (int m = 0; m < 4; ++m) _Pragma("unroll") for (int k = 0; k < 2; ++k) dst[m][k] = *(const PG8_LAS bf16x8*)(lds + PG8_SA(b, h) + aoff + m * 2048 + k * 1024); } while (0)
#define PG8_LDB(dst, b, h) do { _Pragma("unroll") for (int n = 0; n < 2; ++n) _Pragma("unroll") for (int k = 0; k < 2; ++k) dst[n][k] = *(const PG8_LAS bf16x8*)(lds + PG8_SB(b, h) + boff + n * 2048 + k * 1024); } while (0)
#define PG8_MMA(ai, bj, At, Bt) do { __builtin_amdgcn_s_setprio(1); _Pragma("unroll") for (int m = 0; m < 4; ++m) _Pragma("unroll") for (int n = 0; n < 2; ++n) _Pragma("unroll") for (int k = 0; k < 2; ++k) \
        acc[ai][bj][m][n] = __builtin_amdgcn_mfma_f32_16x16x32_bf16(Bt[n][k], At[m][k], acc[ai][bj][m][n], 0, 0, 0); __builtin_amdgcn_s_setprio(0); } while (0)
#define PG8_WAIT_V(n) asm volatile("s_waitcnt vmcnt(" #n ")" ::: "memory")
#define PG8_WAIT_L(n) asm volatile("s_waitcnt lgkmcnt(" #n ")" ::: "memory")
#define PG8_BAR __builtin_amdgcn_s_barrier()
#define PG8_SCHED __builtin_amdgcn_sched_barrier(0)
    Unit cur, nxt; int ui = 0;
    if (!S.next(0, cur)) return;
    f32x4 acc[2][2][4][2];
#pragma unroll
    for (int a = 0; a < 2; ++a)
#pragma unroll
        for (int b = 0; b < 2; ++b)
#pragma unroll
            for (int m = 0; m < 4; ++m)
#pragma unroll
                for (int n = 0; n < 2; ++n) acc[a][b][m][n] = (f32x4){0.f, 0.f, 0.f, 0.f};
    bf16x8 At[4][2], B0[2][2], B1[2][2];
    const char* cA = (const char*)g.A + (size_t)cur.pm * tstep; const char* cB = (const char*)g.Bt + (size_t)cur.pn * tstep;
    S.a_ready(cur);
    if constexpr (SP2) {
        PG8_STAGE(PG8_SB(0, 0), cB, voffB); PG8_STAGE(PG8_SB(0, 1), cB + hstep, voffB); PG8_STAGE(PG8_SA(0, 0), cA, voffA); PG8_STAGE(PG8_SA(0, 1), cA + hstep, voffA);
        if (wr == 1) PG8_BAR;
        PG8_WAIT_V(2); PG8_BAR;
        PG8_STAGE(PG8_SB(1, 0), cB + kstep, voffB); PG8_STAGE(PG8_SA(1, 0), cA + kstep, voffA); PG8_STAGE(PG8_SB(1, 1), cB + hstep + kstep, voffB);
        PG8_WAIT_V(6); PG8_BAR;
    } else {
        PG8_STAGE(PG8_SB(0, 0), cB, voffB); PG8_STAGE(PG8_SA(0, 0), cA, voffA); PG8_STAGE(PG8_SB(0, 1), cB + hstep, voffB); PG8_STAGE(PG8_SA(0, 1), cA + hstep, voffA);
        if (wr == 1) PG8_BAR;
        PG8_WAIT_V(4); PG8_BAR;
        PG8_STAGE(PG8_SB(1, 0), cB + kstep, voffB); PG8_STAGE(PG8_SA(1, 0), cA + kstep, voffA); PG8_STAGE(PG8_SB(1, 1), cB + hstep + kstep, voffB);
        PG8_WAIT_V(6); PG8_BAR;
    }
    for (;;) {
        const bool has_next = S.next(ui + 1, nxt);
        const char* nA = has_next ? (const char*)g.A + (size_t)nxt.pm * tstep : cA; const char* nB = has_next ? (const char*)g.Bt + (size_t)nxt.pn * tstep : cB;
        for (int t = 0; t < nt; t += 2) {
            const bool last = (t == nt - 2);
            const char* a1 = cA + (size_t)(t + 1) * kstep;
            const char* a2 = last ? nA : cA + (size_t)(t + 2) * kstep; const char* b2 = last ? nB : cB + (size_t)(t + 2) * kstep;
            const char* a3 = a2 + kstep; const char* b3 = b2 + kstep;
            if (last && has_next) S.a_ready(nxt);
            if constexpr (SP2) {
            PG8_LDB(B0, 0, 0); PG8_LDB(B1, 0, 1); PG8_SCHED; PG8_LDA(At, 0, 0); PG8_STAGE(PG8_SA(1, 1), a1 + hstep, voffA);
            PG8_WAIT_V(8); PG8_WAIT_L(0); PG8_BAR; PG8_MMA(0, 0, At, B0); PG8_MMA(0, 1, At, B1); PG8_BAR; PG8_SCHED;
            PG8_LDA(At, 0, 1); PG8_STAGE(PG8_SB(0, 0), b2, voffB); PG8_STAGE(PG8_SB(0, 1), b2 + hstep, voffB); PG8_STAGE(PG8_SA(0, 0), a2, voffA);
            PG8_WAIT_V(8); PG8_WAIT_L(0); PG8_BAR; PG8_MMA(1, 0, At, B0); PG8_MMA(1, 1, At, B1); PG8_BAR; PG8_SCHED;
            PG8_LDB(B0, 1, 0); PG8_LDB(B1, 1, 1); PG8_SCHED; PG8_LDA(At, 1, 0); PG8_STAGE(PG8_SA(0, 1), a2 + hstep, voffA);
            PG8_WAIT_V(8); PG8_WAIT_L(0); PG8_BAR; PG8_MMA(0, 0, At, B0); PG8_MMA(0, 1, At, B1); PG8_BAR; PG8_SCHED;
            PG8_LDA(At, 1, 1); PG8_STAGE(PG8_SB(1, 0), b3, voffB); PG8_STAGE(PG8_SB(1, 1), b3 + hstep, voffB); PG8_STAGE(PG8_SA(1, 0), a3, voffA);
            PG8_WAIT_V(8); PG8_WAIT_L(0); PG8_BAR; PG8_MMA(1, 0, At, B0); PG8_MMA(1, 1, At, B1); PG8_BAR; PG8_SCHED;
            } else {
            PG8_LDB(B0, 0, 0); PG8_SCHED; PG8_LDA(At, 0, 0); PG8_STAGE(PG8_SA(1, 1), a1 + hstep, voffA);
            PG8_WAIT_L(8); PG8_BAR; PG8_WAIT_L(0); PG8_MMA(0, 0, At, B0); PG8_BAR; PG8_SCHED;
            PG8_LDB(B1, 0, 1); PG8_STAGE(PG8_SB(0, 0), b2, voffB);
            PG8_BAR; PG8_WAIT_L(0); PG8_MMA(0, 1, At, B1); PG8_BAR;
            PG8_LDA(At, 0, 1); PG8_STAGE(PG8_SA(0, 0), a2, voffA);
            PG8_BAR; PG8_WAIT_L(0); PG8_MMA(1, 0, At, B0); PG8_BAR; PG8_SCHED;
            PG8_STAGE(PG8_SB(0, 1), b2 + hstep, voffB);
            PG8_WAIT_V(6); PG8_BAR; PG8_MMA(1, 1, At, B1); PG8_BAR;
            PG8_LDB(B0, 1, 0); PG8_SCHED; PG8_LDA(At, 1, 0); PG8_STAGE(PG8_SA(0, 1), a2 + hstep, voffA);
            PG8_WAIT_L(8); PG8_BAR; PG8_WAIT_L(0); PG8_MMA(0, 0, At, B0); PG8_BAR; PG8_SCHED;
            PG8_LDB(B1, 1, 1); PG8_STAGE(PG8_SB(1, 0), b3, voffB);
            PG8_BAR; PG8_WAIT_L(0); PG8_MMA(0, 1, At, B1); PG8_BAR;
            PG8_LDA(At, 1, 1); PG8_STAGE(PG8_SA(1, 0), a3, voffA);
            PG8_BAR; PG8_WAIT_L(0); PG8_MMA(1, 0, At, B0); PG8_BAR; PG8_SCHED;
            PG8_STAGE(PG8_SB(1, 1), b3 + hstep, voffB);
            PG8_WAIT_V(6); PG8_BAR; PG8_MMA(1, 1, At, B1); PG8_BAR;
            }
        }
        if constexpr (ALIGN_EPI) { if (wr == 0) PG8_BAR; }
        if constexpr (!Epi::AFTER_DRAIN) { E(acc, cur, wr, wc, fr, fq); S.done(cur); }
        if (!has_next) break;
#pragma unroll
        for (int a = 0; a < 2; ++a)
#pragma unroll
            for (int b = 0; b < 2; ++b)
#pragma unroll
                for (int m = 0; m < 4; ++m)
#pragma unroll
                    for (int n = 0; n < 2; ++n) acc[a][b][m][n] = (f32x4){0.f, 0.f, 0.f, 0.f};
        cur = nxt; cA = nA; cB = nB; ++ui;
        if constexpr (ALIGN_EPI) { if (wr == 1) PG8_BAR; }
    }
    PG8_WAIT_V(0);
    if constexpr (!ALIGN_EPI) { if (wr == 0) PG8_BAR; }
    PG8_BAR;
    if constexpr (Epi::AFTER_DRAIN) { E.fused(acc, cur, wr, wc, fr, fq, lds, wid, lane); S.done(cur); }
#undef PG8_SA
#undef PG8_SB
#undef PG8_STAGE
#undef PG8_LDA
#undef PG8_LDB
#undef PG8_MMA
#undef PG8_WAIT_V
#undef PG8_WAIT_L
#undef PG8_BAR
#undef PG8_SCHED
}
}
constexpr int BATCH = 2, SEQ = 16384, DM = 2048, MTOK = BATCH * SEQ;
constexpr int E_IN = 6144, O_INP = 8448  , O_LD = 8192;
constexpr int S5G = 64, S5P = 64, S5T = 128, S5NC = SEQ / S5T;
constexpr float LOG2E = 1.4426950408889634f;
constexpr float RMS_EPS = 1e-6f;
constexpr int NWAVES = 8;

#define LAS __attribute__((address_space(3)))
typedef unsigned short bf16_t;
typedef short bf16x8 __attribute__((ext_vector_type(8)));
typedef float f32x4 __attribute__((ext_vector_type(4)));
typedef float f32x2 __attribute__((ext_vector_type(2)));
typedef float f32x16 __attribute__((ext_vector_type(16)));
typedef unsigned u32x4 __attribute__((ext_vector_type(4)));
typedef unsigned u32x2 __attribute__((ext_vector_type(2)));
typedef short v4i16_t __attribute__((ext_vector_type(4)));
typedef __bf16 bf16x2_t __attribute__((ext_vector_type(2)));

constexpr size_t MiB = 1u << 20;
constexpr size_t WS_CTL = 0;
constexpr size_t WS_LAMB = 1 * MiB;
constexpr size_t WS_LAMT = 1 * MiB + 65536;
constexpr size_t WS_BBAR = 2 * MiB;
constexpr size_t WS_CMAT = 3 * MiB;
constexpr size_t WS_BIASDA = 4 * MiB;
constexpr size_t WS_BIASF = 5 * MiB;
constexpr size_t WS_FLOG = 7 * MiB;
constexpr size_t WS_S5ST = 9 * MiB;
constexpr size_t WS_WIN0 = 20 * MiB;
constexpr size_t WS_WOUT0 = 44 * MiB;
constexpr size_t WS_WGLU = 52 * MiB;
constexpr size_t WS_WIN1 = 54 * MiB;
constexpr size_t WS_WOUT1 = 87 * MiB;
constexpr size_t WS_HBUF = 96 * MiB;
constexpr size_t WS_PROJ = 224 * MiB;
constexpr size_t WS_YCAT = 736 * MiB;
constexpr size_t WS_END = 864 * MiB;
constexpr int CW_QDA = 64, CW_QFOX = 128, CW_LAM = 192, CW_THRDA = 193, CW_THRF = 194;
constexpr float ZERO_THR = 105.f;

constexpr int LDS_MISC = 135168;
constexpr int LDS_BYTES = 147456;
constexpr int AL_K = 0, AL_V = 32768, AL_B = 65536;
constexpr int LDS_STASH = 69632;

__device__ __forceinline__ float bf2f(unsigned b) { return __uint_as_float(b << 16); }
__device__ __forceinline__ unsigned pk2(float lo, float hi) { f32x2 v = {lo, hi}; bf16x2_t b = __builtin_convertvector(v, bf16x2_t); return __builtin_bit_cast(unsigned, b); }
__device__ __forceinline__ float bflo(unsigned w) { return __uint_as_float(w << 16); }
__device__ __forceinline__ float bfhi(unsigned w) { return __uint_as_float(w & 0xffff0000u); }
__device__ __forceinline__ float sigmoidf_(float x) { return 1.f / (1.f + __expf(-x)); }
__device__ __forceinline__ float siluf_(float x) { return x * sigmoidf_(x); }
__device__ __forceinline__ float gelu_tanh(float x) { const float z = 0.7978845608028654f * (x + 0.044715f * x * x * x); const float t = 1.f - 2.f / (1.f + __expf(2.f * z)); return 0.5f * x * (1.f + t); }
__device__ __forceinline__ int crow(int r, int hi) { return (r & 3) + 8 * (r >> 2) + 4 * hi; }
__device__ __forceinline__ float wave_sum(float v) {
#pragma unroll
    for (int o = 1; o < 64; o <<= 1) v += __shfl_xor(v, o);
    return v;
}

struct Args {
    const float* in[27];
    float* out; unsigned char* ws;
    int ph_lo, ph_hi;
};

namespace pg8 {
struct EpiProj1 {
    static constexpr bool PERM = true, AFTER_DRAIN = false;
    bf16_t* O; float* flog;
    __device__ __forceinline__ void operator()(const f32x4 (&acc)[2][2][4][2], const Unit& u, int wr, int wc, int fr, int fq) const {
        const int row0 = u.pm * BM + wr * 64 + fr;
        if (u.pn < 32) {
            const int col0 = u.pn * BM + wc * 32 + 8 * fq;
#pragma unroll
            for (int ai = 0; ai < 2; ++ai)
#pragma unroll
                for (int m = 0; m < 4; ++m) { bf16_t* rowp = O + (size_t)(row0 + ai * HALF + m * 16) * O_LD + col0;
#pragma unroll
                    for (int bj = 0; bj < 2; ++bj) { const f32x4 v0 = acc[ai][bj][m][0], v1 = acc[ai][bj][m][1];
                        u32x4 w; w.x = cvt_pk_bf16(v0[0], v0[1]); w.y = cvt_pk_bf16(v0[2], v0[3]); w.z = cvt_pk_bf16(v1[0], v1[1]); w.w = cvt_pk_bf16(v1[2], v1[3]);
                        *(u32x4*)(rowp + bj * HALF) = w; } }
        } else if (wc == 0 && fq < 2) {
#pragma unroll
            for (int ai = 0; ai < 2; ++ai)
#pragma unroll
                for (int m = 0; m < 4; ++m) { float* rp = flog + (size_t)(row0 + ai * HALF + m * 16) * 16 + 8 * fq;
                    *(f32x4*)(rp) = acc[ai][0][m][0]; *(f32x4*)(rp + 4) = acc[ai][0][m][1]; }
        }
    }
};
struct EpiGlu {
    static constexpr bool PERM = true, AFTER_DRAIN = false;
    bf16_t* O; const bf16_t* yg; const bf16_t* proj0; const float* bglu;
    __device__ __forceinline__ void operator()(const f32x4 (&acc)[2][2][4][2], const Unit& u, int wr, int wc, int fr, int fq) const {
        const int row0 = u.pm * BM + wr * 64 + fr; const int col0 = u.pn * BM + wc * 32 + 8 * fq;
#pragma unroll
        for (int ai = 0; ai < 2; ++ai)
#pragma unroll
            for (int m = 0; m < 4; ++m) { const size_t row = (size_t)(row0 + ai * HALF + m * 16);
#pragma unroll
                for (int bj = 0; bj < 2; ++bj) { const int c = col0 + bj * HALF;
                    const f32x4 b0 = *(const f32x4*)(bglu + c), b1 = *(const f32x4*)(bglu + c + 4);
                    const u32x4 yv = *(const u32x4*)(yg + row * 1024 + c); const u32x4 zv = *(const u32x4*)(proj0 + row * E_IN + 1024 + c);
                    const f32x4 v0 = acc[ai][bj][m][0] + b0, v1 = acc[ai][bj][m][1] + b1;
                    float r[8];
#pragma unroll
                    for (int e = 0; e < 4; ++e) { const unsigned yw = yv[e], zw = zv[e];
                        const float a0 = e < 2 ? v0[2 * e] : v1[2 * e - 4], a1 = e < 2 ? v0[2 * e + 1] : v1[2 * e - 3];
                        r[2 * e] = bflo(yw) * sigmoidf_(a0) * siluf_(bflo(zw)); r[2 * e + 1] = bfhi(yw) * sigmoidf_(a1) * siluf_(bfhi(zw)); }
                    u32x4 w; w.x = cvt_pk_bf16(r[0], r[1]); w.y = cvt_pk_bf16(r[2], r[3]); w.z = cvt_pk_bf16(r[4], r[5]); w.w = cvt_pk_bf16(r[6], r[7]);
                    *(u32x4*)(O + row * DM + c) = w; } }
    }
};
struct EpiResid {
    static constexpr bool PERM = false, AFTER_DRAIN = false;
    const float* base; float* out;
    __device__ __forceinline__ void operator()(const f32x4 (&acc)[2][2][4][2], const Unit& u, int wr, int wc, int fr, int fq) const {
        const int row0 = u.pm * BM + wr * 64 + fr; const int col0 = u.pn * BM + wc * 32 + 4 * fq;
#pragma unroll
        for (int ai = 0; ai < 2; ++ai)
#pragma unroll
            for (int m = 0; m < 4; ++m) { const size_t off = (size_t)(row0 + ai * HALF + m * 16) * DM + col0;
#pragma unroll
                for (int bj = 0; bj < 2; ++bj)
#pragma unroll
                    for (int n = 0; n < 2; ++n) { const f32x4 bs = *(const f32x4*)(base + off + bj * HALF + n * 16); *(f32x4*)(out + off + bj * HALF + n * 16) = bs + acc[ai][bj][m][n]; } }
    }
};
}

__device__ __forceinline__ void transpose_item(const float* __restrict__ W, int K, int N, bf16_t* __restrict__ WT, LAS float* scr, int item, int nblk, int lane) {
    const int kb = item / nblk, nb = item % nblk, k0 = 64 * kb, n0 = 32 * nb;
    const int nc = n0 + (lane & 31);
#pragma unroll 8
    for (int i = 0; i < 32; ++i) { const int kk = 2 * i + (lane >> 5); scr[kk * 33 + (lane & 31)] = (nc < N) ? W[(size_t)(k0 + kk) * N + nc] : 0.f; }
    asm volatile("s_waitcnt lgkmcnt(0)" ::: "memory");
    const int c = lane & 7;
#pragma unroll
    for (int j = 0; j < 4; ++j) { const int n = (lane >> 3) + 8 * j; const LAS float* s = scr + (8 * c) * 33 + n;
        u32x4 o; o.x = pk2(s[0 * 33], s[1 * 33]); o.y = pk2(s[2 * 33], s[3 * 33]); o.z = pk2(s[4 * 33], s[5 * 33]); o.w = pk2(s[6 * 33], s[7 * 33]);
        *(u32x4*)(WT + (size_t)(n0 + n) * K + k0 + 8 * c) = o; }
    asm volatile("s_waitcnt lgkmcnt(0)" ::: "memory");
}
__device__ __forceinline__ void rms_row_to_bf16(const float* __restrict__ xrow, const float* __restrict__ gain, bf16_t* __restrict__ orow, int lane) {
    const f32x4* xr = (const f32x4*)xrow + lane; const f32x4* gr = (const f32x4*)gain + lane;
    f32x4 v[8]; float s = 0.f;
#pragma unroll
    for (int j = 0; j < 8; ++j) { v[j] = xr[64 * j]; s += (v[j].x * v[j].x + v[j].y * v[j].y) + (v[j].z * v[j].z + v[j].w * v[j].w); }
    const float r = 1.f / sqrtf(wave_sum(s) * (1.f / DM) + RMS_EPS);
    u32x2* o8 = (u32x2*)orow + lane;
#pragma unroll
    for (int j = 0; j < 8; ++j) { const f32x4 g = gr[64 * j]; u32x2 w; w.x = pk2(v[j].x * r * g.x, v[j].y * r * g.y); w.y = pk2(v[j].z * r * g.z, v[j].w * r * g.w); o8[64 * j] = w; }
}
template <int LPS>
__device__ __forceinline__ void qknorm16(bf16_t* p, const float* __restrict__ gain16, float mul, float inv_n) {
    u32x4 a = *(u32x4*)p, b = *(u32x4*)(p + 8);
    float v[16];
#pragma unroll
    for (int e = 0; e < 4; ++e) { v[2 * e] = bflo(a[e]); v[2 * e + 1] = bfhi(a[e]); v[8 + 2 * e] = bflo(b[e]); v[9 + 2 * e] = bfhi(b[e]); }
    float s = 0.f;
#pragma unroll
    for (int e = 0; e < 16; ++e) s += v[e] * v[e];
#pragma unroll
    for (int o = 1; o < LPS; o <<= 1) s += __shfl_xor(s, o);
    const float r = mul / sqrtf(s * inv_n + RMS_EPS);
#pragma unroll
    for (int e = 0; e < 16; ++e) v[e] = v[e] * r * gain16[e];
#pragma unroll
    for (int e = 0; e < 4; ++e) { a[e] = pk2(v[2 * e], v[2 * e + 1]); b[e] = pk2(v[8 + 2 * e], v[9 + 2 * e]); }
    *(u32x4*)p = a; *(u32x4*)(p + 8) = b;
}

template <int DQK>
__device__ __forceinline__ void attn_pass(LAS unsigned char* lds, const bf16_t* __restrict__ Qg, const bf16_t* __restrict__ Kg, const bf16_t* __restrict__ Vg,
                                          const float* __restrict__ btab, const float bscale, const int pitch, const int q0, const int t_lo, f32x16 (&o)[4], const int wid, const int lane) {
    constexpr int NCH = DQK / 8, KS = DQK / 16, KROWB = DQK * 2, KI = NCH / 8;
    const int tid = wid * 64 + lane, r32 = lane & 31, hi = lane >> 5;
    const int NT = (q0 + 256) / 64;
    const int qrel = wid * 32 + r32;
    bf16x8 qf[KS];
#pragma unroll
    for (int s = 0; s < KS; ++s) qf[s] = *(const bf16x8*)(Qg + (size_t)(q0 + qrel) * pitch + 16 * s + 8 * hi);
    int kgo[KI], klo[KI], vgo[2], vlo[2];
#pragma unroll
    for (int i = 0; i < KI; ++i) { const int cid = tid + 512 * i, row = cid / NCH, ch = cid % NCH; const int sw = (DQK == 128) ? (row & 15) : ((row >> 1) & 7);
        kgo[i] = row * pitch + ch * 8; klo[i] = row * KROWB + ((ch ^ sw) << 4); }
#pragma unroll
    for (int i = 0; i < 2; ++i) { const int cid = tid + 512 * i, row = cid >> 4, ch = cid & 15;
        vgo[i] = row * pitch + ch * 8; vlo[i] = (ch >> 2) * 4096 + (row >> 3) * 512 + (row & 7) * 64 + (ch & 3) * 16; }
    const float bref = btab[q0];
    u32x4 kreg[KI], vreg[2]; float breg = 0.f;
#define AT_LOAD(t) do { const size_t kvb_ = (size_t)(64 * (t)) * pitch; \
        _Pragma("unroll") for (int i = 0; i < KI; ++i) kreg[i] = *(const u32x4*)(Kg + kvb_ + kgo[i]); \
        _Pragma("unroll") for (int i = 0; i < 2; ++i) vreg[i] = *(const u32x4*)(Vg + kvb_ + vgo[i]); \
        if (tid < 64) breg = (btab[64 * (t) + tid] - bref) * bscale; } while (0)
#define AT_STORE(buf) do { \
        _Pragma("unroll") for (int i = 0; i < KI; ++i) *(LAS u32x4*)(lds + AL_K + (buf) * 16384 + klo[i]) = kreg[i]; \
        _Pragma("unroll") for (int i = 0; i < 2; ++i) *(LAS u32x4*)(lds + AL_V + (buf) * 16384 + vlo[i]) = vreg[i]; \
        if (tid < 64) *(LAS float*)(lds + AL_B + (buf) * 256 + tid * 4) = breg; } while (0)
    float m_run = -INFINITY, l_run = 0.f;
#pragma unroll
    for (int b = 0; b < 4; ++b)
#pragma unroll
        for (int r = 0; r < 16; ++r) o[b][r] = 0.f;
    AT_LOAD(t_lo); AT_STORE(0); __syncthreads();
    const int ksw = (DQK == 128) ? (r32 & 15) : ((r32 >> 1) & 7);
    const int vlane = (4 * hi + ((lane & 15) >> 2)) * 64 + ((lane >> 4) & 1) * 32 + (lane & 3) * 8;
    for (int t = t_lo; t < NT; ++t) {
        const int cur = (t - t_lo) & 1;
        if (t + 1 < NT) AT_LOAD(t + 1);
        const int jb = t - (NT - 4);
        const bool skip = (jb >= 0) && (2 * jb > wid);
        if (!skip) {
            LAS const unsigned char* Kb = lds + AL_K + cur * 16384;
            f32x16 s0, s1;
            LAS const float* bl = (LAS const float*)(lds + AL_B + cur * 256);
#pragma unroll
            for (int g = 0; g < 4; ++g) { const f32x4 b0 = *(LAS const f32x4*)(bl + 8 * g + 4 * hi), b1 = *(LAS const f32x4*)(bl + 32 + 8 * g + 4 * hi);
#pragma unroll
                for (int e = 0; e < 4; ++e) { s0[4 * g + e] = b0[e]; s1[4 * g + e] = b1[e]; } }
#pragma unroll
            for (int s = 0; s < KS; ++s) { const int ch = 2 * s + hi;
                const bf16x8 a0 = *(LAS const bf16x8*)(Kb + r32 * KROWB + ((ch ^ ksw) << 4));
                const bf16x8 a1 = *(LAS const bf16x8*)(Kb + (32 + r32) * KROWB + ((ch ^ ksw) << 4));
                s0 = __builtin_amdgcn_mfma_f32_32x32x16_bf16(a0, qf[s], s0, 0, 0, 0);
                s1 = __builtin_amdgcn_mfma_f32_32x32x16_bf16(a1, qf[s], s1, 0, 0, 0); }
            if ((jb >= 0) && (2 * jb + 1 >= wid)) {
#pragma unroll
                for (int r = 0; r < 16; ++r) { const int kv = 64 * jb + crow(r, hi); if (kv > qrel) s0[r] = -INFINITY; if (kv + 32 > qrel) s1[r] = -INFINITY; }
            }
            float mx = fmaxf(s0[0], s1[0]);
#pragma unroll
            for (int r = 1; r < 16; ++r) mx = fmaxf(mx, fmaxf(s0[r], s1[r]));
            mx = fmaxf(mx, __shfl_xor(mx, 32));
            if (__any(mx > m_run + 8.f)) {
                const float m_new = fmaxf(m_run, mx);
                const float alpha = __builtin_amdgcn_exp2f(m_run - m_new);
                m_run = m_new; l_run *= alpha;
#pragma unroll
                for (int b = 0; b < 4; ++b)
#pragma unroll
                    for (int r = 0; r < 16; ++r) o[b][r] *= alpha;
            }
            float rs = 0.f;
#pragma unroll
            for (int r = 0; r < 16; ++r) { s0[r] = __builtin_amdgcn_exp2f(s0[r] - m_run); s1[r] = __builtin_amdgcn_exp2f(s1[r] - m_run); rs += s0[r] + s1[r]; }
            l_run += rs;
            u32x4 pw[4];
#pragma unroll
            for (int e = 0; e < 4; ++e) { pw[0][e] = pk2(s0[2 * e], s0[2 * e + 1]); pw[1][e] = pk2(s0[8 + 2 * e], s0[9 + 2 * e]); pw[2][e] = pk2(s1[2 * e], s1[2 * e + 1]); pw[3][e] = pk2(s1[8 + 2 * e], s1[9 + 2 * e]); }
            LAS const unsigned char* Vb = lds + AL_V + cur * 16384 + vlane;
#pragma unroll
            for (int b = 0; b < 4; ++b)
#pragma unroll
                for (int ks = 0; ks < 4; ++ks) {
                    const v4i16_t lo = __builtin_amdgcn_ds_read_tr16_b64_v4i16((LAS v4i16_t*)(Vb + b * 4096 + ks * 1024));
                    const v4i16_t hh = __builtin_amdgcn_ds_read_tr16_b64_v4i16((LAS v4i16_t*)(Vb + b * 4096 + ks * 1024 + 512));
                    const bf16x8 af = {lo[0], lo[1], lo[2], lo[3], hh[0], hh[1], hh[2], hh[3]};
                    o[b] = __builtin_amdgcn_mfma_f32_32x32x16_bf16(af, __builtin_bit_cast(bf16x8, pw[ks]), o[b], 0, 0, 0);
                }
        }
        if (t + 1 < NT) AT_STORE(cur ^ 1);
        __syncthreads();
    }
#undef AT_LOAD
#undef AT_STORE
    const float l = l_run + __shfl_xor(l_run, 32);
    const float inv = 1.f / l;
#pragma unroll
    for (int b = 0; b < 4; ++b)
#pragma unroll
        for (int r = 0; r < 16; ++r) o[b][r] *= inv;
}

__global__ void __launch_bounds__(NWAVES * 64, 2) hybrid_fwd(Args args) {
    extern __shared__ __attribute__((aligned(16))) unsigned char lds_raw[];
    LAS unsigned char* lds = (LAS unsigned char*)lds_raw;
    const int wave = __builtin_amdgcn_readfirstlane((int)threadIdx.x >> 6);
#define LANE_FRESH() int lane; asm volatile("v_mbcnt_lo_u32_b32 %0, -1, 0\n\tv_mbcnt_hi_u32_b32 %0, -1, %0" : "=v"(lane)); const int tid = wave * 64 + lane; (void)tid
    const int G = gridDim.x, bid = blockIdx.x;
    const int gw = bid * NWAVES + wave, NGW = G * NWAVES;
    typedef const Args __attribute__((address_space(4)))* KArgP;
    KArgP ka0 = (KArgP)__builtin_amdgcn_kernarg_segment_ptr();
#define KA_FRESH() KArgP ka = ka0; asm volatile("" : "+s"(ka))
#define AIN(i) (ka->in[i])
    unsigned char* ws = args.ws;
    unsigned* ctl = (unsigned*)(ws + WS_CTL);
    bf16_t* win0 = (bf16_t*)(ws + WS_WIN0); bf16_t* wout0 = (bf16_t*)(ws + WS_WOUT0); bf16_t* wglu = (bf16_t*)(ws + WS_WGLU);
    bf16_t* win1 = (bf16_t*)(ws + WS_WIN1); bf16_t* wout1 = (bf16_t*)(ws + WS_WOUT1);
    bf16_t* hbuf = (bf16_t*)(ws + WS_HBUF); bf16_t* ygelu = (bf16_t*)(ws + WS_HBUF); bf16_t* proj = (bf16_t*)(ws + WS_PROJ); bf16_t* ycat = (bf16_t*)(ws + WS_YCAT);
    f32x2* lamb = (f32x2*)(ws + WS_LAMB); f32x2* lamt = (f32x2*)(ws + WS_LAMT); f32x2* bbar = (f32x2*)(ws + WS_BBAR); bf16_t* cmat = (bf16_t*)(ws + WS_CMAT);
    float* biasda = (float*)(ws + WS_BIASDA); float* biasf = (float*)(ws + WS_BIASF); float* flog = (float*)(ws + WS_FLOG); f32x2* s5st = (f32x2*)(ws + WS_S5ST);
    cg::grid_group grid = cg::this_grid();
    const int lo = args.ph_lo, hi_ph = args.ph_hi;
#ifndef PH_MASK
#define PH_MASK 0x7ff
#endif
#define IN(k) (((PH_MASK >> (k)) & 1) && lo <= (k) && (k) < hi_ph)
#define SEAM(k) do { if (IN(k) && IN((k) + 1)) grid.sync(); } while (0)

    if (IN(0)) {
        KA_FRESH(); LANE_FRESH(); const float* x = AIN(0); float* out = ka->out; (void)x; (void)out;
        LAS float* scr = (LAS float*)(lds + wave * 16384);
        constexpr int I_IN0 = 32 * 192, I_OUT = 32 * 64, I_GLU = 16 * 32, I_IN1 = 32 * 264;
        constexpr int NITEMS = I_IN0 + 2 * I_OUT + I_GLU + I_IN1;
        for (int it = gw; it < NITEMS; it += NGW) {
            int r = it;
            if (r < I_IN0) { transpose_item(AIN(2), 2048, E_IN, win0, scr, r, 192, lane); continue; } r -= I_IN0;
            if (r < I_OUT) { transpose_item(AIN(3), 2048, 2048, wout0, scr, r, 64, lane); continue; } r -= I_OUT;
            if (r < I_GLU) { transpose_item(AIN(12), 1024, 1024, wglu, scr, r, 32, lane); continue; } r -= I_GLU;
            if (r < I_IN1) { transpose_item(AIN(22), 2048, 8208, win1, scr, r, 264, lane); continue; } r -= I_IN1;
            transpose_item(AIN(24), 2048, 2048, wout1, scr, r, 64, lane);
        }
        for (int m = gw; m < MTOK; m += NGW) rms_row_to_bf16(x + (size_t)m * DM, AIN(1), hbuf + (size_t)m * DM, lane);
        const int gt = bid * 512 + tid, NGT = G * 512;
        for (int i = gt; i < S5G * S5P; i += NGT) {
            const int g = i >> 6;
            const double dt = exp((double)AIN(6)[g]);
            const double lr = (double)AIN(4)[i], li = (double)AIN(5)[i];
            const double mag = exp(lr * dt), ar = mag * cos(li * dt), ai = mag * sin(li * dt);
            const double den = lr * lr + li * li, nr = ar - 1.0, ni = ai;
            const double kr = (nr * lr + ni * li) / den, ki = (ni * lr - nr * li) / den;
            lamb[i] = (f32x2){(float)ar, (float)ai};
            const double magT = exp(lr * dt * (double)S5T);
            lamt[i] = (f32x2){(float)(magT * cos(li * dt * (double)S5T)), (float)(magT * sin(li * dt * (double)S5T))};
#pragma unroll 4
            for (int h = 0; h < 16; ++h) { const double br = (double)AIN(7)[i * 16 + h], bi = (double)AIN(8)[i * 16 + h];
                bbar[i * 16 + h] = (f32x2){(float)(kr * br - ki * bi), (float)(kr * bi + ki * br)}; }
        }
        for (int i = gt; i < S5G * 32 * 128; i += NGT) { const int k = i & 127, n = (i >> 7) & 31, g = i >> 12;
            float v = 0.f; if (n < 16) v = (k < 64) ? AIN(9)[(g * 16 + n) * 64 + k] : -AIN(10)[(g * 16 + n) * 64 + (k - 64)];
            cmat[i] = (bf16_t)(pk2(v, 0.f) & 0xffffu); }
        for (int i = gt; i < 8 * SEQ; i += NGT) { const int h = i / SEQ, j = i % SEQ; biasda[i] = exp2f(-(float)(h + 1)) * (float)j; }
        if (bid == 0 && tid == 0) {
            float d1 = 0.f, d2 = 0.f;
            for (int i = 0; i < 64; ++i) { d1 += AIN(16)[i] * AIN(17)[i]; d2 += AIN(18)[i] * AIN(19)[i]; }
            ((float*)ctl)[CW_LAM] = expf(d1) - expf(d2) + 0.2f;
            float gq = 0.f, gk = 0.f, fq_ = 0.f, fk_ = 0.f;
            for (int i = 0; i < 128; ++i) { gq = fmaxf(gq, fabsf(AIN(14)[i])); gk = fmaxf(gk, fabsf(AIN(15)[i])); fq_ = fmaxf(fq_, fabsf(AIN(25)[i])); fk_ = fmaxf(fk_, fabsf(AIN(26)[i])); }
            ((float*)ctl)[CW_THRDA] = ZERO_THR + 2.f * 8.f * gq * gk * 1.02f;
            ((float*)ctl)[CW_THRF] = ZERO_THR + 2.f * 11.3137085f * fq_ * fk_ * 1.02f;
            ctl[CW_QDA] = 0u; ctl[CW_QFOX] = 0u;
        }
    }
    SEAM(0);
    if (IN(1)) {
        KA_FRESH(); LANE_FRESH(); const float* x = AIN(0); float* out = ka->out; (void)x; (void)out;
        pg8::Gemm g{hbuf, win0, MTOK, E_IN, DM}; pg8::StaticOrder S; S.init(MTOK, E_IN, G, bid);
        pg8::EpiBf16<0> E{proj, E_IN, nullptr, 0, 0, 1.f};
        pg8::gemm_phase<pg8::EpiBf16<0>, pg8::StaticOrder, true, true>(lds, g, S, E, wave, lane);
    }
    SEAM(1);
    if (IN(2)) {
        KA_FRESH(); LANE_FRESH(); const float* x = AIN(0); float* out = ka->out; (void)x; (void)out;
        const float qmul = 0.125f * LOG2E;
        for (int m = gw; m < MTOK; m += NGW) {
#pragma unroll
            for (int it = 0; it < 2; ++it) { const int col = 2048 + it * 1024 + lane * 16;
                const float* gp = (it == 0 ? AIN(14) : AIN(15)) + (col & 127);
                float g16[16];
#pragma unroll
                for (int e = 0; e < 4; ++e) { const f32x4 gg = *(const f32x4*)(gp + 4 * e); g16[4 * e] = gg.x; g16[4 * e + 1] = gg.y; g16[4 * e + 2] = gg.z; g16[4 * e + 3] = gg.w; }
                qknorm16<4>(proj + (size_t)m * E_IN + col, g16, it == 0 ? qmul : 1.f, 1.f / 64.f); }
        }
        for (int u = gw; u < BATCH * S5G * S5NC; u += NGW) {
            const int g = u & 63, c = (u >> 6) & (S5NC - 1), b = u >> 13;
            const int gp = g * 64 + lane;
            const f32x2 la = lamb[gp];
            f32x2 bb[16];
#pragma unroll
            for (int h = 0; h < 16; ++h) bb[h] = bbar[gp * 16 + h];
            float hr = 0.f, hi = 0.f;
            const bf16_t* up = proj + (size_t)(b * SEQ + c * S5T) * E_IN + g * 16;
#pragma unroll 4
            for (int t = 0; t < S5T; ++t) {
                const u32x4 ua = *(const u32x4*)(up + (size_t)t * E_IN), ub = *(const u32x4*)(up + (size_t)t * E_IN + 8);
                float xr = 0.f, xi = 0.f;
#pragma unroll
                for (int e = 0; e < 4; ++e) { const float u0 = bflo(ua[e]), u1 = bfhi(ua[e]), u2 = bflo(ub[e]), u3 = bfhi(ub[e]);
                    xr += u0 * bb[2 * e].x + u1 * bb[2 * e + 1].x + u2 * bb[8 + 2 * e].x + u3 * bb[9 + 2 * e].x;
                    xi += u0 * bb[2 * e].y + u1 * bb[2 * e + 1].y + u2 * bb[8 + 2 * e].y + u3 * bb[9 + 2 * e].y; }
                const float nhr = la.x * hr - la.y * hi + xr, nhi = la.x * hi + la.y * hr + xi;
                hr = nhr; hi = nhi;
            }
            s5st[((size_t)(b * S5NC + c) * 64 + g) * 64 + lane] = (f32x2){hr, hi};
        }
    }
    SEAM(2);
    if (IN(3)) {
        KA_FRESH(); LANE_FRESH(); const float* x = AIN(0); float* out = ka->out; (void)x; (void)out;
        {
            LAS unsigned char* Ht = lds + wave * 8192;
            const int r32 = lane & 31, hi = lane >> 5;
            for (int u = gw; u < BATCH * S5G * S5NC; u += NGW) {
                const int g = u & 63, c = (u >> 6) & (S5NC - 1), b = u >> 13;
                const int gp = g * 64 + lane;
                const f32x2 la = lamb[gp], lt = lamt[gp];
                f32x2 bb[16];
#pragma unroll
                for (int h = 0; h < 16; ++h) bb[h] = bbar[gp * 16 + h];
                float hr = 0.f, hi_s = 0.f;
                for (int cc = 0; cc < c; ++cc) { const f32x2 s = s5st[((size_t)(b * S5NC + cc) * 64 + g) * 64 + lane];
                    const float nhr = lt.x * hr - lt.y * hi_s + s.x, nhi = lt.x * hi_s + lt.y * hr + s.y; hr = nhr; hi_s = nhi; }
                bf16x8 cfr[8];
#pragma unroll
                for (int s = 0; s < 8; ++s) cfr[s] = *(const bf16x8*)(cmat + (size_t)(g * 32 + r32) * 128 + 16 * s + 8 * hi);
                const float dvec = AIN(11)[g * 16 + (r32 & 15)];
                const size_t row0 = (size_t)(b * SEQ + c * S5T);
                const bf16_t* up = proj + row0 * E_IN + g * 16;
                for (int sb = 0; sb < 4; ++sb) {
#pragma unroll 4
                    for (int tt = 0; tt < 32; ++tt) { const int t = sb * 32 + tt;
                        const u32x4 ua = *(const u32x4*)(up + (size_t)t * E_IN), ub = *(const u32x4*)(up + (size_t)t * E_IN + 8);
                        float xr = 0.f, xi = 0.f;
#pragma unroll
                        for (int e = 0; e < 4; ++e) { const float u0 = bflo(ua[e]), u1 = bfhi(ua[e]), u2 = bflo(ub[e]), u3 = bfhi(ub[e]);
                            xr += u0 * bb[2 * e].x + u1 * bb[2 * e + 1].x + u2 * bb[8 + 2 * e].x + u3 * bb[9 + 2 * e].x;
                            xi += u0 * bb[2 * e].y + u1 * bb[2 * e + 1].y + u2 * bb[8 + 2 * e].y + u3 * bb[9 + 2 * e].y; }
                        const float nhr = la.x * hr - la.y * hi_s + xr, nhi = la.x * hi_s + la.y * hr + xi;
                        hr = nhr; hi_s = nhi;
                        const unsigned w = pk2(hr, hi_s);
                        const int sw = tt & 15;
                        *(LAS unsigned short*)(Ht + tt * 256 + ((((lane >> 3)) ^ sw) << 4) + ((lane & 7) << 1)) = (unsigned short)(w & 0xffffu);
                        *(LAS unsigned short*)(Ht + tt * 256 + ((((64 + lane) >> 3) ^ sw) << 4) + ((lane & 7) << 1)) = (unsigned short)(w >> 16);
                    }
                    asm volatile("s_waitcnt lgkmcnt(0)" ::: "memory");
                    f32x16 acc;
#pragma unroll
                    for (int r = 0; r < 16; ++r) acc[r] = 0.f;
#pragma unroll
                    for (int s = 0; s < 8; ++s) { const bf16x8 a = *(LAS const bf16x8*)(Ht + r32 * 256 + (((2 * s + hi) ^ (r32 & 15)) << 4));
                        acc = __builtin_amdgcn_mfma_f32_32x32x16_bf16(a, cfr[s], acc, 0, 0, 0); }
                    asm volatile("s_waitcnt lgkmcnt(0)" ::: "memory");
                    if (r32 < 16) {
#pragma unroll
                        for (int r = 0; r < 16; ++r) { const size_t row = row0 + sb * 32 + crow(r, hi);
                            const float uval = bf2f(proj[row * E_IN + g * 16 + r32]);
                            const float y = gelu_tanh(acc[r] + dvec * uval);
                            ygelu[row * 1024 + g * 16 + r32] = (bf16_t)(pk2(y, 0.f) & 0xffffu); }
                    }
                }
            }
        }
        __syncthreads();
        {
            LANE_FRESH();
            LAS volatile int* misc = (LAS volatile int*)(lds + LDS_MISC);
            const float lam = ((const float*)ctl)[CW_LAM]; const float thr_da = ((const float*)ctl)[CW_THRDA];
            const int r32 = lane & 31, hi = lane >> 5;
            for (;;) {
                if (tid == 0) misc[0] = (int)atomicAdd(ctl + CW_QDA, 1u);
                __syncthreads();
                const int ui = misc[0];
                __syncthreads();
                if (ui >= BATCH * 8 * 64) break;
                const int qb = 63 - (ui >> 4), bh = ui & 15, b = bh >> 3, h = bh & 7;
                const int q0 = qb * 256;
                const bf16_t* pb = proj + (size_t)b * SEQ * E_IN;
                const float dskip = thr_da * exp2f((float)(h + 1));
                const int t_lo = max(0, (int)ceilf(((float)q0 - dskip - 63.f) * (1.f / 64.f)));
                f32x16 o[4];
                LAS unsigned* stash = (LAS unsigned*)(lds + LDS_STASH) + wave * 2048 + lane;
                attn_pass<64>(lds, pb + 2048 + h * 128, pb + 3072 + h * 128, pb + 4096 + h * 128, biasda + h * SEQ, LOG2E, E_IN, q0, t_lo, o, wave, lane);
#pragma unroll
                for (int bl = 0; bl < 4; ++bl)
#pragma unroll
                    for (int e = 0; e < 8; ++e) stash[(bl * 8 + e) * 64] = pk2(o[bl][2 * e], o[bl][2 * e + 1]);
                attn_pass<64>(lds, pb + 2048 + h * 128 + 64, pb + 3072 + h * 128 + 64, pb + 4096 + h * 128, biasda + h * SEQ, LOG2E, E_IN, q0, t_lo, o, wave, lane);
                float ssq = 0.f;
#pragma unroll
                for (int bl = 0; bl < 4; ++bl)
#pragma unroll
                    for (int e = 0; e < 8; ++e) { const unsigned w0 = stash[(bl * 8 + e) * 64]; const float v0 = bflo(w0) - lam * o[bl][2 * e], v1 = bfhi(w0) - lam * o[bl][2 * e + 1];
                        o[bl][2 * e] = v0; o[bl][2 * e + 1] = v1; ssq += v0 * v0 + v1 * v1; }
                ssq += __shfl_xor(ssq, 32);
                const float rr = 0.8f / sqrtf(ssq * (1.f / 128.f) + RMS_EPS);
                const size_t tok = (size_t)b * SEQ + q0 + wave * 32 + r32;
#pragma unroll
                for (int bl = 0; bl < 4; ++bl)
#pragma unroll
                    for (int g = 0; g < 4; ++g) { const int dv0 = 32 * bl + 8 * g + 4 * hi;
                        const f32x4 gn = *(const f32x4*)(AIN(20) + dv0);
                        const u32x2 zw = *(const u32x2*)(proj + tok * E_IN + 5120 + h * 128 + dv0);
                        const float y0 = o[bl][4 * g] * rr * gn.x * siluf_(bflo(zw.x)), y1 = o[bl][4 * g + 1] * rr * gn.y * siluf_(bfhi(zw.x));
                        const float y2 = o[bl][4 * g + 2] * rr * gn.z * siluf_(bflo(zw.y)), y3 = o[bl][4 * g + 3] * rr * gn.w * siluf_(bfhi(zw.y));
                        u32x2 w; w.x = pk2(y0, y1); w.y = pk2(y2, y3);
                        *(u32x2*)(ycat + tok * DM + 1024 + h * 128 + dv0) = w; }
            }
        }
    }
    SEAM(3);
    if (IN(4)) {
        KA_FRESH(); LANE_FRESH(); const float* x = AIN(0); float* out = ka->out; (void)x; (void)out;
        pg8::Gemm g{ygelu, wglu, MTOK, 1024, 1024}; pg8::StaticOrder S; S.init(MTOK, 1024, G, bid);
        pg8::EpiGlu E{ycat, ygelu, proj, AIN(13)};
        pg8::gemm_phase<pg8::EpiGlu, pg8::StaticOrder, true, true>(lds, g, S, E, wave, lane);
    }
    SEAM(4);
    if (IN(5)) {
        KA_FRESH(); LANE_FRESH(); const float* x = AIN(0); float* out = ka->out; (void)x; (void)out;
        pg8::Gemm g{ycat, wout0, MTOK, DM, DM}; pg8::StaticOrder S; S.init(MTOK, DM, G, bid);
        pg8::EpiResid E{x, out};
        pg8::gemm_phase<pg8::EpiResid, pg8::StaticOrder, true, true>(lds, g, S, E, wave, lane);
    }
    SEAM(5);
    if (IN(6)) {
        KA_FRESH(); LANE_FRESH(); const float* x = AIN(0); float* out = ka->out; (void)x; (void)out;
        for (int m = gw; m < MTOK; m += NGW) rms_row_to_bf16(out + (size_t)m * DM, AIN(21), hbuf + (size_t)m * DM, lane);
    }
    SEAM(6);
    if (IN(7)) {
        KA_FRESH(); LANE_FRESH(); const float* x = AIN(0); float* out = ka->out; (void)x; (void)out;
        pg8::Gemm g{hbuf, win1, MTOK, O_INP, DM}; pg8::StaticOrder S; S.init(MTOK, O_INP, G, bid);
        pg8::EpiProj1 E{proj, flog};
        pg8::gemm_phase<pg8::EpiProj1, pg8::StaticOrder, true, true>(lds, g, S, E, wave, lane);
    }
    SEAM(7);
    if (IN(8)) {
        KA_FRESH(); LANE_FRESH(); const float* x = AIN(0); float* out = ka->out; (void)x; (void)out;
        if (bid < 32) {
            const int b = bid >> 4, h = bid & 15;
            LAS double* dsum = (LAS double*)lds;
            const float bf_ = AIN(23)[h];
            const float* fl = flog + ((size_t)b * SEQ + tid * 32) * 16 + h;
            double tot = 0.0;
#pragma unroll 4
            for (int i = 0; i < 32; ++i) { const float xv = fl[i * 16] + bf_; tot += (double)(fminf(xv, 0.f) - log1pf(expf(-fabsf(xv)))); }
            dsum[tid] = tot;
            __syncthreads();
            double pre = 0.0;
            for (int i = 0; i < tid; ++i) pre += dsum[i];
            float* bo = biasf + ((size_t)(b * 16 + h)) * SEQ + tid * 32;
#pragma unroll 4
            for (int i = 0; i < 32; ++i) { const float xv = fl[i * 16] + bf_; pre += (double)(fminf(xv, 0.f) - log1pf(expf(-fabsf(xv)))); bo[i] = (float)(-pre); }
            __syncthreads();
        }
        const float qmul = 0.08838834764831845f * LOG2E;
        for (int m = gw; m < MTOK; m += NGW) {
#pragma unroll
            for (int it = 0; it < 4; ++it) { const int col = it * 1024 + lane * 16;
                const float* gp = (it < 2 ? AIN(25) : AIN(26)) + (col & 127);
                float g16[16];
#pragma unroll
                for (int e = 0; e < 4; ++e) { const f32x4 gg = *(const f32x4*)(gp + 4 * e); g16[4 * e] = gg.x; g16[4 * e + 1] = gg.y; g16[4 * e + 2] = gg.z; g16[4 * e + 3] = gg.w; }
                qknorm16<8>(proj + (size_t)m * O_LD + col, g16, it < 2 ? qmul : 1.f, 1.f / 128.f); }
        }
    }
    SEAM(8);
    if (IN(9)) {
        KA_FRESH(); LANE_FRESH(); const float* x = AIN(0); float* out = ka->out; (void)x; (void)out;
        LAS volatile int* misc = (LAS volatile int*)(lds + LDS_MISC);
        const int r32 = lane & 31, hi = lane >> 5;
        const float thr_f = ((const float*)ctl)[CW_THRF];
        for (;;) {
            if (wave == 0) {
                int u0 = 0; if (lane == 0) u0 = (int)atomicAdd(ctl + CW_QFOX, 1u);
                u0 = __shfl(u0, 0);
                int tl = 0;
                if (u0 < BATCH * 16 * 64) {
                    const int qb_ = 63 - (u0 >> 5), bh_ = u0 & 31; const float* bt = biasf + (size_t)bh_ * SEQ; const float bref = bt[qb_ * 256];
#pragma unroll
                    for (int r = 0; r < 4; ++r) { const int t = lane + 64 * r; bool dead = false;
                        if (t < 4 * qb_) dead = (bt[64 * t + 63] - bref) < -thr_f;
                        tl += __popcll(__ballot(dead)); }
                }
                if (lane == 0) { misc[0] = u0; misc[1] = tl; }
            }
            __syncthreads();
            const int ui = misc[0], t_lo = misc[1];
            __syncthreads();
            if (ui >= BATCH * 16 * 64) break;
            const int qb = 63 - (ui >> 5), bh = ui & 31, b = bh >> 4, h = bh & 15;
            const int q0 = qb * 256;
            const bf16_t* pb = proj + (size_t)b * SEQ * O_LD;
            f32x16 o[4];
            attn_pass<128>(lds, pb + h * 128, pb + 2048 + h * 128, pb + 4096 + h * 128, biasf + (size_t)bh * SEQ, LOG2E, O_LD, q0, t_lo, o, wave, lane);
            const size_t tok = (size_t)b * SEQ + q0 + wave * 32 + r32;
#pragma unroll
            for (int bl = 0; bl < 4; ++bl)
#pragma unroll
                for (int g = 0; g < 4; ++g) { const int dv0 = 32 * bl + 8 * g + 4 * hi;
                    const u32x2 zw = *(const u32x2*)(proj + tok * O_LD + 6144 + h * 128 + dv0);
                    const float y0 = o[bl][4 * g] * siluf_(bflo(zw.x)), y1 = o[bl][4 * g + 1] * siluf_(bfhi(zw.x));
                    const float y2 = o[bl][4 * g + 2] * siluf_(bflo(zw.y)), y3 = o[bl][4 * g + 3] * siluf_(bfhi(zw.y));
                    u32x2 w; w.x = pk2(y0, y1); w.y = pk2(y2, y3);
                    *(u32x2*)(ycat + tok * DM + h * 128 + dv0) = w; }
        }
    }
    SEAM(9);
    if (IN(10)) {
        KA_FRESH(); LANE_FRESH(); const float* x = AIN(0); float* out = ka->out; (void)x; (void)out;
        pg8::Gemm g{ycat, wout1, MTOK, DM, DM}; pg8::StaticOrder S; S.init(MTOK, DM, G, bid);
        pg8::EpiResid E{out, out};
        pg8::gemm_phase<pg8::EpiResid, pg8::StaticOrder, true, true>(lds, g, S, E, wave, lane);
    }
#undef IN
#undef SEAM
}

#ifndef ONE_LAUNCH
#define ONE_LAUNCH 1
#endif
constexpr int NPHASE = 11;
extern "C" void kernel_launch(void* const* d_in, const int* in_sizes, int n_in, void* d_out, int out_size, void* d_ws, size_t ws_size, hipStream_t stream) {
    static int grid = 0;
    if (grid == 0) {
        if (n_in != 27 || out_size != MTOK * DM || ws_size < WS_END) { fprintf(stderr, "kernel_launch: unexpected problem (n_in %d out %d ws %zu)\n", n_in, out_size, ws_size); grid = -1; return; }
        int dev = 0, cus = 0, per_cu = 0;
        hipGetDevice(&dev);
        hipDeviceGetAttribute(&cus, hipDeviceAttributeMultiprocessorCount, dev);
        if (hipFuncSetAttribute((const void*)hybrid_fwd, hipFuncAttributeMaxDynamicSharedMemorySize, LDS_BYTES) != hipSuccess) { fprintf(stderr, "kernel_launch: hipFuncSetAttribute failed\n"); grid = -1; return; }
        if (hipOccupancyMaxActiveBlocksPerMultiprocessor(&per_cu, (const void*)hybrid_fwd, NWAVES * 64, LDS_BYTES) != hipSuccess || per_cu < 1) { fprintf(stderr, "kernel_launch: occupancy query says %d\n", per_cu); per_cu = 1; }
        (void)hipGetLastError();
        grid = cus * 1;
    }
    if (grid < 0) return;
    Args a{};
    for (int i = 0; i < 27; ++i) a.in[i] = (const float*)d_in[i];
    a.out = (float*)d_out; a.ws = (unsigned char*)d_ws;
#if ONE_LAUNCH
    a.ph_lo = 0; a.ph_hi = NPHASE;
    void* kargs[] = {&a};
    hipError_t e = hipLaunchCooperativeKernel((const void*)hybrid_fwd, dim3(grid), dim3(NWAVES * 64), kargs, LDS_BYTES, stream);
    if (e != hipSuccess) fprintf(stderr, "cooperative launch failed: %s (grid %d)\n", hipGetErrorString(e), grid);
#else
    for (int p = 0; p < NPHASE; ++p) {
        a.ph_lo = p; a.ph_hi = p + 1;
        hipLaunchKernelGGL(hybrid_fwd, dim3(grid), dim3(NWAVES * 64), LDS_BYTES, stream, a);
    }
#endif
}
```

```cpp
#include <hip/hip_runtime.h>
#include <hip/hip_cooperative_groups.h>
#include <cstdio>
#include <cstdint>
#include <cmath>
namespace cg = cooperative_groups;
#define DUP_MASK 0
namespace pg8 {
#define PG8_LAS __attribute__((address_space(3)))
typedef unsigned short bf16_t;
typedef short bf16x8 __attribute__((ext_vector_type(8)));
typedef float f32x4 __attribute__((ext_vector_type(4)));
typedef unsigned u32x4 __attribute__((ext_vector_type(4)));
constexpr int BM = 256, BK = 64, HALF = 128, HTB = HALF * BK * 2  , STAGE_BYTES = 8 * HTB, NXCD = 8, WGM = 8;

__host__ __device__ __forceinline__ int lds_byte(int r, int c) { const int st = (r >> 4) * 2 + (c >> 5), rr = r & 15, cc = c & 31, ob = rr * 64 + cc * 2; return st * 1024 + (ob ^ (((ob >> 9) & 1) << 5)); }
__host__ __device__ __forceinline__ void stage_rc(int b, int& R, int& C) { const int st = b / 1024, sb = b % 1024, swz = sb ^ (((sb >> 9) & 1) << 5); R = (st >> 1) * 16 + swz / 64; C = (st & 1) * 32 + (swz % 64) / 2; }
__host__ __device__ __forceinline__ int perm32(int rho) { const int n = rho >> 4, i = rho & 15; return 8 * (i >> 2) + 4 * n + (i & 3); }

struct Unit { int pm, pn; };
struct Gemm { const bf16_t* A; const bf16_t* Bt; int M, N, K; };

struct StaticOrder {
    int nM, nN, nwg, G, c;
    __host__ __device__ void init(int M, int N, int G_, int c_) { nM = M / BM; nN = N / BM; nwg = nM * nN; G = G_; c = c_; }
    __host__ __device__ bool next(int i, Unit& u) const {
        const long L = (long)i * G + c; if (L >= nwg) return false;
        int wgid = (int)L; { const int q = nwg / NXCD, r = nwg % NXCD, xcd = wgid % NXCD, off = wgid / NXCD; wgid = (xcd < r ? xcd * (q + 1) : r * (q + 1) + (xcd - r) * q) + off; }
        const int nig = WGM * nN, gid = wgid / nig, fm = gid * WGM, gsz = (nM - fm) < WGM ? (nM - fm) : WGM;
        u.pm = fm + ((wgid % nig) % gsz); u.pn = (wgid % nig) / gsz; return true;
    }
    __device__ __forceinline__ void a_ready(const Unit&) const {}
    __device__ __forceinline__ void done(const Unit&) const {}
};

__device__ __forceinline__ unsigned cvt_pk_bf16(float lo, float hi) { unsigned r; asm volatile("v_cvt_pk_bf16_f32 %0, %1, %2" : "=v"(r) : "v"(lo), "v"(hi)); return r; }
typedef float f32x2 __attribute__((ext_vector_type(2)));
__device__ __forceinline__ f32x2 gelu_pk(f32x2 v) {
    const f32x2 av = __builtin_elementwise_abs(v), d = av * 0.2316418882f + 1.0f;
    f32x2 t; t.x = __builtin_amdgcn_rcpf(d.x); t.y = __builtin_amdgcn_rcpf(d.y);
    f32x2 q = t * 0.5307027145f + (-0.7265760135f); q = q * t + 0.7107068705f; q = q * t + (-0.142248368f); q = q * t + 0.127414796f; q = q * t;
    const f32x2 s = (v * v) * (-0.72134752044f);
    f32x2 e; e.x = __builtin_amdgcn_exp2f(s.x); e.y = __builtin_amdgcn_exp2f(s.y);
    const f32x2 m = v * (q * e), r = v - m;
    f32x2 o; o.x = v.x < 0.f ? m.x : r.x; o.y = v.y < 0.f ? m.y : r.y; return o;
}

template <int ACT  > struct EpiBf16 {
    static constexpr bool PERM = true, AFTER_DRAIN = false; static_assert(ACT == 0 || ACT == 1, "EpiBf16: ACT is 0 (none) or 1 (gelu_pk)");
    bf16_t* O; int ldc; const float* bias; int split_cols; size_t split_stride; float scale0;
    __device__ __forceinline__ void operator()(const f32x4 (&acc)[2][2][4][2], const Unit& u, int wr, int wc, int fr, int fq) const {
        const int row0 = u.pm * BM + wr * 64 + fr; int colt = u.pn * BM; bf16_t* base = O;
        float sc = 1.f; if (split_cols) { const int t = colt / split_cols; base += (size_t)t * split_stride; colt -= t * split_cols; if (t == 0) sc = scale0; }
        const int col0 = colt + wc * 32 + 8 * fq, bcol0 = u.pn * BM + wc * 32 + 8 * fq;
        f32x4 bv[2][2];
#pragma unroll
        for (int bj = 0; bj < 2; ++bj)
#pragma unroll
            for (int n = 0; n < 2; ++n) bv[bj][n] = bias ? *(const f32x4*)(bias + bcol0 + bj * HALF + 4 * n) : (f32x4){0.f, 0.f, 0.f, 0.f};
#pragma unroll
        for (int ai = 0; ai < 2; ++ai)
#pragma unroll
            for (int m = 0; m < 4; ++m) { bf16_t* rowp = base + (size_t)(row0 + ai * HALF + m * 16) * ldc + col0;
#pragma unroll
                for (int bj = 0; bj < 2; ++bj) { f32x4 v0 = acc[ai][bj][m][0] + bv[bj][0], v1 = acc[ai][bj][m][1] + bv[bj][1];
                    if (ACT == 1) { f32x2 a = gelu_pk((f32x2){v0[0], v0[1]}), b = gelu_pk((f32x2){v0[2], v0[3]}), c = gelu_pk((f32x2){v1[0], v1[1]}), d = gelu_pk((f32x2){v1[2], v1[3]});
                        v0 = (f32x4){a.x, a.y, b.x, b.y}; v1 = (f32x4){c.x, c.y, d.x, d.y}; }
                    v0 = v0 * sc; v1 = v1 * sc; u32x4 w; w.x = cvt_pk_bf16(v0[0], v0[1]); w.y = cvt_pk_bf16(v0[2], v0[3]); w.z = cvt_pk_bf16(v1[0], v1[1]); w.w = cvt_pk_bf16(v1[2], v1[3]);
                    *(u32x4*)(rowp + bj * HALF) = w; } }
    }
};
template <class Epi, class Sched, bool ALIGN_EPI = false, bool SP2 = false>
__device__ __forceinline__ void gemm_phase(PG8_LAS unsigned char* lds, const Gemm g, const Sched& S, const Epi& E, const int wid, const int lane) {
    const int tid = wid * 64 + lane, wr = wid >> 2, wc = wid & 3, fr = lane & 15, fq = lane >> 4;
    const int K = g.K, nt = K / BK;
    unsigned voffA[2], voffB[2];
#pragma unroll
    for (int i = 0; i < 2; ++i) { int R, C; stage_rc(tid * 16 + i * 8192, R, C); const int Rb = Epi::PERM ? ((R & ~31) + perm32(R & 31)) : R;
        voffA[i] = (unsigned)(R * K + C) * 2u; voffB[i] = (unsigned)(Rb * K + C) * 2u; }
    const size_t kstep = (size_t)(BK * 2);
    const size_t hstep = (size_t)HALF * K * 2;
    const size_t tstep = 2 * hstep;
    const unsigned ldsw = (unsigned)wid * 1024u;
    const int aoff = lds_byte(wr * 64 + fr, fq * 8), boff = lds_byte(wc * 32 + fr, fq * 8);
#define PG8_SA(b, h) (((b) * 2 + (h)) * HTB)
#define PG8_SB(b, h) ((4 + (b) * 2 + (h)) * HTB)
#define PG8_STAGE(bufoff, gbase, voff) do { _Pragma("unroll") for (int _i = 0; _i < 2; ++_i) \
        __builtin_amdgcn_global_load_lds((const unsigned*)((const char*)(gbase) + (voff)[_i]), (PG8_LAS unsigned*)(lds + (bufoff) + ldsw + _i * 8192), 16, 0, 0); } while (0)
#define PG8_LDA(dst, b, h) do { _Pragma("unroll") for (int m = 0; m < 4; ++m) _Pragma("unroll") for (int k = 0; k < 2; ++k) dst[m][k] = *(const PG8_LAS bf16x8*)(lds + PG8_SA(b, h) + aoff + m * 2048 + k * 1024); } while (0)
#define PG8_LDB(dst, b, h) do { _Pragma("unroll") for (int n = 0; n < 2; ++n) _Pragma("unroll") for (int k = 0; k < 2; ++k) dst[n][k] = *(const PG8_LAS bf16x8*)(lds + PG8_SB(b, h) + boff + n * 2048 + k * 1024); } while (0)
#define PG8_MMA(ai, bj, At, Bt) do { __builtin_amdgcn_s_setprio(1); _Pragma("unroll") for (int m = 0; m < 4; ++m) _Pragma("unroll") for (int n = 0; n < 2; ++n) _Pragma("unroll") for (int k = 0; k < 2; ++k) \
        acc[ai][bj][m][n] = __builtin_amdgcn_mfma_f32_16x16x32_bf16(Bt[n][k], At[m][k], acc[ai][bj][m][n], 0, 0, 0); __builtin_amdgcn_s_setprio(0); } while (0)
#define PG8_WAIT_V(n) asm volatile("s_waitcnt vmcnt(" #n ")" ::: "memory")
#define PG8_WAIT_L(n) asm volatile("s_waitcnt lgkmcnt(" #n ")" ::: "memory")
#define PG8_BAR __builtin_amdgcn_s_barrier()
#define PG8_SCHED __builtin_amdgcn_sched_barrier(0)
    Unit cur, nxt; int ui = 0;
    if (!S.next(0, cur)) return;
    f32x4 acc[2][2][4][2];
#pragma unroll
    for (int a = 0; a < 2; ++a)
#pragma unroll
        for (int b = 0; b < 2; ++b)
#pragma unroll
            for (int m = 0; m < 4; ++m)
#pragma unroll
                for (int n = 0; n < 2; ++n) acc[a][b][m][n] = (f32x4){0.f, 0.f, 0.f, 0.f};
    bf16x8 At[4][2], B0[2][2], B1[2][2];
    const char* cA = (const char*)g.A + (size_t)cur.pm * tstep; const char* cB = (const char*)g.Bt + (size_t)cur.pn * tstep;
    S.a_ready(cur);
    if constexpr (SP2) {
        PG8_STAGE(PG8_SB(0, 0), cB, voffB); PG8_STAGE(PG8_SB(0, 1), cB + hstep, voffB); PG8_STAGE(PG8_SA(0, 0), cA, voffA); PG8_STAGE(PG8_SA(0, 1), cA + hstep, voffA);
        if (wr == 1) PG8_BAR;
        PG8_WAIT_V(2); PG8_BAR;
        PG8_STAGE(PG8_SB(1, 0), cB + kstep, voffB); PG8_STAGE(PG8_SA(1, 0), cA + kstep, voffA); PG8_STAGE(PG8_SB(1, 1), cB + hstep + kstep, voffB);
        PG8_WAIT_V(6); PG8_BAR;
    } else {
        PG8_STAGE(PG8_SB(0, 0), cB, voffB); PG8_STAGE(PG8_SA(0, 0), cA, voffA); PG8_STAGE(PG8_SB(0, 1), cB + hstep, voffB); PG8_STAGE(PG8_SA(0, 1), cA + hstep, voffA);
        if (wr == 1) PG8_BAR;
        PG8_WAIT_V(4); PG8_BAR;
        PG8_STAGE(PG8_SB(1, 0), cB + kstep, voffB); PG8_STAGE(PG8_SA(1, 0), cA + kstep, voffA); PG8_STAGE(PG8_SB(1, 1), cB + hstep + kstep, voffB);
        PG8_WAIT_V(6); PG8_BAR;
    }
    for (;;) {
        const bool has_next = S.next(ui + 1, nxt);
        const char* nA = has_next ? (const char*)g.A + (size_t)nxt.pm * tstep : cA; const char* nB = has_next ? (const char*)g.Bt + (size_t)nxt.pn * tstep : cB;
        for (int t = 0; t < nt; t += 2) {
            const bool last = (t == nt - 2);
            const char* a1 = cA + (size_t)(t + 1) * kstep;
            const char* a2 = last ? nA : cA + (size_t)(t + 2) * kstep; const char* b2 = last ? nB : cB + (size_t)(t + 2) * kstep;
            const char* a3 = a2 + kstep; const char* b3 = b2 + kstep;
            if (last && has_next) S.a_ready(nxt);
            if constexpr (SP2) {
            PG8_LDB(B0, 0, 0); PG8_LDB(B1, 0, 1); PG8_SCHED; PG8_LDA(At, 0, 0); PG8_STAGE(PG8_SA(1, 1), a1 + hstep, voffA);
            PG8_WAIT_V(8); PG8_WAIT_L(0); PG8_BAR; PG8_MMA(0, 0, At, B0); PG8_MMA(0, 1, At, B1); PG8_BAR; PG8_SCHED;
            PG8_LDA(At, 0, 1); PG8_STAGE(PG8_SB(0, 0), b2, voffB); PG8_STAGE(PG8_SB(0, 1), b2 + hstep, voffB); PG8_STAGE(PG8_SA(0, 0), a2, voffA);
            PG8_WAIT_V(8); PG8_WAIT_L(0); PG8_BAR; PG8_MMA(1, 0, At, B0); PG8_MMA(1, 1, At, B1); PG8_BAR; PG8_SCHED;
            PG8_LDB(B0, 1, 0); PG8_LDB(B1, 1, 1); PG8_SCHED; PG8_LDA(At, 1, 0); PG8_STAGE(PG8_SA(0, 1), a2 + hstep, voffA);
            PG8_WAIT_V(8); PG8_WAIT_L(0); PG8_BAR; PG8_MMA(0, 0, At, B0); PG8_MMA(0, 1, At, B1); PG8_BAR; PG8_SCHED;
            PG8_LDA(At, 1, 1); PG8_STAGE(PG8_SB(1, 0), b3, voffB); PG8_STAGE(PG8_SB(1, 1), b3 + hstep, voffB); PG8_STAGE(PG8_SA(1, 0), a3, voffA);
            PG8_WAIT_V(8); PG8_WAIT_L(0); PG8_BAR; PG8_MMA(1, 0, At, B0); PG8_MMA(1, 1, At, B1); PG8_BAR; PG8_SCHED;
            } else {
            PG8_LDB(B0, 0, 0); PG8_SCHED; PG8_LDA(At, 0, 0); PG8_STAGE(PG8_SA(1, 1), a1 + hstep, voffA);
            PG8_WAIT_L(8); PG8_BAR; PG8_WAIT_L(0); PG8_MMA(0, 0, At, B0); PG8_BAR; PG8_SCHED;
            PG8_LDB(B1, 0, 1); PG8_STAGE(PG8_SB(0, 0), b2, voffB);
            PG8_BAR; PG8_WAIT_L(0); PG8_MMA(0, 1, At, B1); PG8_BAR;
            PG8_LDA(At, 0, 1); PG8_STAGE(PG8_SA(0, 0), a2, voffA);
            PG8_BAR; PG8_WAIT_L(0); PG8_MMA(1, 0, At, B0); PG8_BAR; PG8_SCHED;
            PG8_STAGE(PG8_SB(0, 1), b2 + hstep, voffB);
            PG8_WAIT_V(6); PG8_BAR; PG8_MMA(1, 1, At, B1); PG8_BAR;
            PG8_LDB(B0, 1, 0); PG8_SCHED; PG8_LDA(At, 1, 0); PG8_STAGE(PG8_SA(0, 1), a2 + hstep, voffA);
            PG8_WAIT_L(8); PG8_BAR; PG8_WAIT_L(0); PG8_MMA(0, 0, At, B0); PG8_BAR; PG8_SCHED;
            PG8_LDB(B1, 1, 1); PG8_STAGE(PG8_SB(1, 0), b3, voffB);
            PG8_BAR; PG8_WAIT_L(0); PG8_MMA(0, 1, At, B1); PG8_BAR;
            PG8_LDA(At, 1, 1); PG8_STAGE(PG8_SA(1, 0), a3, voffA);
            PG8_BAR; PG8_WAIT_L(0); PG8_MMA(1, 0, At, B0); PG8_BAR; PG8_SCHED;
            PG8_STAGE(PG8_SB(1, 1), b3 + hstep, voffB);
            PG8_WAIT_V(6); PG8_BAR; PG8_MMA(1, 1, At, B1); PG8_BAR;
            }
        }
        if constexpr (ALIGN_EPI) { if (wr == 0) PG8_BAR; }
        if constexpr (!Epi::AFTER_DRAIN) { E(acc, cur, wr, wc, fr, fq); S.done(cur); }
        if (!has_next) break;
#pragma unroll
        for (int a = 0; a < 2; ++a)
#pragma unroll
            for (int b = 0; b < 2; ++b)
#pragma unroll
                for (int m = 0; m < 4; ++m)
#pragma unroll
                    for (int n = 0; n < 2; ++n) acc[a][b][m][n] = (f32x4){0.f, 0.f, 0.f, 0.f};
        cur = nxt; cA = nA; cB = nB; ++ui;
        if constexpr (ALIGN_EPI) { if (wr == 1) PG8_BAR; }
    }
    PG8_WAIT_V(0);
    if constexpr (!ALIGN_EPI) { if (wr == 0) PG8_BAR; }
    PG8_BAR;
    if constexpr (Epi::AFTER_DRAIN) { E.fused(acc, cur, wr, wc, fr, fq, lds, wid, lane); S.done(cur); }
#undef PG8_SA
#undef PG8_SB
#undef PG8_STAGE
#undef PG8_LDA
#undef PG8_LDB
#undef PG8_MMA
#undef PG8_WAIT_V
#undef PG8_WAIT_L
#undef PG8_BAR
#undef PG8_SCHED
}
}
constexpr int BATCH = 2, SEQ = 16384, DM = 2048, MTOK = BATCH * SEQ;
constexpr int E_IN = 6144, O_INP = 8448  , O_LD = 8192;
constexpr int S5G = 64, S5P = 64, S5T = 128, S5NC = SEQ / S5T;
constexpr float LOG2E = 1.4426950408889634f;
constexpr float RMS_EPS = 1e-6f;
constexpr int NWAVES = 8;

#define LAS __attribute__((address_space(3)))
typedef unsigned short bf16_t;
typedef short bf16x8 __attribute__((ext_vector_type(8)));
typedef float f32x4 __attribute__((ext_vector_type(4)));
typedef float f32x2 __attribute__((ext_vector_type(2)));
typedef float f32x16 __attribute__((ext_vector_type(16)));
typedef unsigned u32x4 __attribute__((ext_vector_type(4)));
typedef unsigned u32x2 __attribute__((ext_vector_type(2)));
typedef short v4i16_t __attribute__((ext_vector_type(4)));
typedef __bf16 bf16x2_t __attribute__((ext_vector_type(2)));

constexpr size_t MiB = 1u << 20;
constexpr size_t WS_CTL = 0;
constexpr size_t WS_LAMB = 1 * MiB;
constexpr size_t WS_LAMT = 1 * MiB + 65536;
constexpr size_t WS_BBAR = 2 * MiB;
constexpr size_t WS_CMAT = 3 * MiB;
constexpr size_t WS_BIASDA = 4 * MiB;
constexpr size_t WS_BIASF = 5 * MiB;
constexpr size_t WS_FLOG = 7 * MiB;
constexpr size_t WS_S5ST = 9 * MiB;
constexpr size_t WS_WIN0 = 20 * MiB;
constexpr size_t WS_WOUT0 = 44 * MiB;
constexpr size_t WS_WGLU = 52 * MiB;
constexpr size_t WS_WIN1 = 54 * MiB;
constexpr size_t WS_WOUT1 = 87 * MiB;
constexpr size_t WS_HBUF = 96 * MiB;
constexpr size_t WS_PROJ = 224 * MiB;
constexpr size_t WS_YCAT = 736 * MiB;
constexpr size_t WS_END = 864 * MiB;
constexpr int CW_QDA = 64, CW_QFOX = 128, CW_LAM = 192, CW_THRDA = 193, CW_THRF = 194;
constexpr float ZERO_THR = 105.f;

constexpr int LDS_MISC = 135168;
constexpr int LDS_BYTES = 147456;
constexpr int AL_K = 0, AL_V = 32768, AL_B = 65536;
constexpr int LDS_STASH = 69632;

__device__ __forceinline__ float bf2f(unsigned b) { return __uint_as_float(b << 16); }
__device__ __forceinline__ unsigned pk2(float lo, float hi) { f32x2 v = {lo, hi}; bf16x2_t b = __builtin_convertvector(v, bf16x2_t); return __builtin_bit_cast(unsigned, b); }
__device__ __forceinline__ float bflo(unsigned w) { return __uint_as_float(w << 16); }
__device__ __forceinline__ float bfhi(unsigned w) { return __uint_as_float(w & 0xffff0000u); }
__device__ __forceinline__ float sigmoidf_(float x) { return 1.f / (1.f + __expf(-x)); }
__device__ __forceinline__ float siluf_(float x) { return x * sigmoidf_(x); }
__device__ __forceinline__ float gelu_tanh(float x) { const float z = 0.7978845608028654f * (x + 0.044715f * x * x * x); const float t = 1.f - 2.f / (1.f + __expf(2.f * z)); return 0.5f * x * (1.f + t); }
#define DOT2(a, b, c) __builtin_amdgcn_fdot2_f32_bf16(__builtin_bit_cast(bf16x2_t, (unsigned)(a)), __builtin_bit_cast(bf16x2_t, (unsigned)(b)), (c), false)
__device__ __forceinline__ int crow(int r, int hi) { return (r & 3) + 8 * (r >> 2) + 4 * hi; }
__device__ __forceinline__ float wave_sum(float v) {
#pragma unroll
    for (int o = 1; o < 64; o <<= 1) v += __shfl_xor(v, o);
    return v;
}

struct Args {
    const float* in[27];
    float* out; unsigned char* ws;
    int ph_lo, ph_hi;
};

namespace pg8 {
struct EpiProj1 {
    static constexpr bool PERM = true, AFTER_DRAIN = false;
    bf16_t* O; float* flog;
    __device__ __forceinline__ void operator()(const f32x4 (&acc)[2][2][4][2], const Unit& u, int wr, int wc, int fr, int fq) const {
        const int row0 = u.pm * BM + wr * 64 + fr;
        if (u.pn < 32) {
            const int col0 = u.pn * BM + wc * 32 + 8 * fq;
#pragma unroll
            for (int ai = 0; ai < 2; ++ai)
#pragma unroll
                for (int m = 0; m < 4; ++m) { bf16_t* rowp = O + (size_t)(row0 + ai * HALF + m * 16) * O_LD + col0;
#pragma unroll
                    for (int bj = 0; bj < 2; ++bj) { const f32x4 v0 = acc[ai][bj][m][0], v1 = acc[ai][bj][m][1];
                        u32x4 w; w.x = cvt_pk_bf16(v0[0], v0[1]); w.y = cvt_pk_bf16(v0[2], v0[3]); w.z = cvt_pk_bf16(v1[0], v1[1]); w.w = cvt_pk_bf16(v1[2], v1[3]);
                        *(u32x4*)(rowp + bj * HALF) = w; } }
        } else if (wc == 0 && fq < 2) {
#pragma unroll
            for (int ai = 0; ai < 2; ++ai)
#pragma unroll
                for (int m = 0; m < 4; ++m) { float* rp = flog + (size_t)(row0 + ai * HALF + m * 16) * 16 + 8 * fq;
                    *(f32x4*)(rp) = acc[ai][0][m][0]; *(f32x4*)(rp + 4) = acc[ai][0][m][1]; }
        }
    }
};
struct EpiGlu {
    static constexpr bool PERM = true, AFTER_DRAIN = false;
    bf16_t* O; const bf16_t* yg; const bf16_t* proj0; const float* bglu;
    __device__ __forceinline__ void operator()(const f32x4 (&acc)[2][2][4][2], const Unit& u, int wr, int wc, int fr, int fq) const {
        const int row0 = u.pm * BM + wr * 64 + fr; const int col0 = u.pn * BM + wc * 32 + 8 * fq;
#pragma unroll
        for (int ai = 0; ai < 2; ++ai)
#pragma unroll
            for (int m = 0; m < 4; ++m) { const size_t row = (size_t)(row0 + ai * HALF + m * 16);
#pragma unroll
                for (int bj = 0; bj < 2; ++bj) { const int c = col0 + bj * HALF;
                    const f32x4 b0 = *(const f32x4*)(bglu + c), b1 = *(const f32x4*)(bglu + c + 4);
                    const u32x4 yv = *(const u32x4*)(yg + row * 1024 + c); const u32x4 zv = *(const u32x4*)(proj0 + row * E_IN + 1024 + c);
                    const f32x4 v0 = acc[ai][bj][m][0] + b0, v1 = acc[ai][bj][m][1] + b1;
                    float r[8];
#pragma unroll
                    for (int e = 0; e < 4; ++e) { const unsigned yw = yv[e], zw = zv[e];
                        const float a0 = e < 2 ? v0[2 * e] : v1[2 * e - 4], a1 = e < 2 ? v0[2 * e + 1] : v1[2 * e - 3];
                        r[2 * e] = bflo(yw) * sigmoidf_(a0) * siluf_(bflo(zw)); r[2 * e + 1] = bfhi(yw) * sigmoidf_(a1) * siluf_(bfhi(zw)); }
                    u32x4 w; w.x = cvt_pk_bf16(r[0], r[1]); w.y = cvt_pk_bf16(r[2], r[3]); w.z = cvt_pk_bf16(r[4], r[5]); w.w = cvt_pk_bf16(r[6], r[7]);
                    *(u32x4*)(O + row * DM + c) = w; } }
    }
};
struct EpiResid {
    static constexpr bool PERM = false, AFTER_DRAIN = false;
    const float* base; float* out;
    __device__ __forceinline__ void operator()(const f32x4 (&acc)[2][2][4][2], const Unit& u, int wr, int wc, int fr, int fq) const {
        const int row0 = u.pm * BM + wr * 64 + fr; const int col0 = u.pn * BM + wc * 32 + 4 * fq;
#pragma unroll
        for (int ai = 0; ai < 2; ++ai)
#pragma unroll
            for (int m = 0; m < 4; ++m) { const size_t off = (size_t)(row0 + ai * HALF + m * 16) * DM + col0;
#pragma unroll
                for (int bj = 0; bj < 2; ++bj)
#pragma unroll
                    for (int n = 0; n < 2; ++n) { const f32x4 bs = *(const f32x4*)(base + off + bj * HALF + n * 16); *(f32x4*)(out + off + bj * HALF + n * 16) = bs + acc[ai][bj][m][n]; } }
    }
};
}

__device__ __forceinline__ void transpose_item(const float* __restrict__ W, int K, int N, bf16_t* __restrict__ WT, LAS float* scr, int item, int nblk, int lane) {
    const int kb = item / nblk, nb = item % nblk, k0 = 64 * kb, n0 = 32 * nb;
    const int nc = n0 + (lane & 31);
#pragma unroll 8
    for (int i = 0; i < 32; ++i) { const int kk = 2 * i + (lane >> 5); scr[kk * 33 + (lane & 31)] = (nc < N) ? W[(size_t)(k0 + kk) * N + nc] : 0.f; }
    asm volatile("s_waitcnt lgkmcnt(0)" ::: "memory");
    const int c = lane & 7;
#pragma unroll
    for (int j = 0; j < 4; ++j) { const int n = (lane >> 3) + 8 * j; const LAS float* s = scr + (8 * c) * 33 + n;
        u32x4 o; o.x = pk2(s[0 * 33], s[1 * 33]); o.y = pk2(s[2 * 33], s[3 * 33]); o.z = pk2(s[4 * 33], s[5 * 33]); o.w = pk2(s[6 * 33], s[7 * 33]);
        *(u32x4*)(WT + (size_t)(n0 + n) * K + k0 + 8 * c) = o; }
    asm volatile("s_waitcnt lgkmcnt(0)" ::: "memory");
}
__device__ __forceinline__ void rms_row_to_bf16(const float* __restrict__ xrow, const float* __restrict__ gain, bf16_t* __restrict__ orow, int lane) {
    const f32x4* xr = (const f32x4*)xrow + lane; const f32x4* gr = (const f32x4*)gain + lane;
    f32x4 v[8]; float s = 0.f;
#pragma unroll
    for (int j = 0; j < 8; ++j) { v[j] = xr[64 * j]; s += (v[j].x * v[j].x + v[j].y * v[j].y) + (v[j].z * v[j].z + v[j].w * v[j].w); }
    const float r = 1.f / sqrtf(wave_sum(s) * (1.f / DM) + RMS_EPS);
    u32x2* o8 = (u32x2*)orow + lane;
#pragma unroll
    for (int j = 0; j < 8; ++j) { const f32x4 g = gr[64 * j]; u32x2 w; w.x = pk2(v[j].x * r * g.x, v[j].y * r * g.y); w.y = pk2(v[j].z * r * g.z, v[j].w * r * g.w); o8[64 * j] = w; }
}
template <int LPS>
__device__ __forceinline__ void qknorm16(bf16_t* p, const float* __restrict__ gain16, float mul, float inv_n) {
    u32x4 a = *(u32x4*)p, b = *(u32x4*)(p + 8);
    float v[16];
#pragma unroll
    for (int e = 0; e < 4; ++e) { v[2 * e] = bflo(a[e]); v[2 * e + 1] = bfhi(a[e]); v[8 + 2 * e] = bflo(b[e]); v[9 + 2 * e] = bfhi(b[e]); }
    float s = 0.f;
#pragma unroll
    for (int e = 0; e < 16; ++e) s += v[e] * v[e];
#pragma unroll
    for (int o = 1; o < LPS; o <<= 1) s += __shfl_xor(s, o);
    const float r = mul / sqrtf(s * inv_n + RMS_EPS);
#pragma unroll
    for (int e = 0; e < 16; ++e) v[e] = v[e] * r * gain16[e];
#pragma unroll
    for (int e = 0; e < 4; ++e) { a[e] = pk2(v[2 * e], v[2 * e + 1]); b[e] = pk2(v[8 + 2 * e], v[9 + 2 * e]); }
    *(u32x4*)p = a; *(u32x4*)(p + 8) = b;
}

template <int DQK>
__device__ __forceinline__ void attn_pass(LAS unsigned char* lds, const bf16_t* __restrict__ Qg, const bf16_t* __restrict__ Kg, const bf16_t* __restrict__ Vg,
                                          const float* __restrict__ btab, const float bscale, const int pitch, const int q0, const int t_lo, f32x16 (&o)[4], const int wid, const int lane) {
    constexpr int NCH = DQK / 8, KS = DQK / 16, KROWB = DQK * 2, KI = NCH / 8;
    const int tid = wid * 64 + lane, r32 = lane & 31, hi = lane >> 5;
    const int NT = (q0 + 256) / 64;
    const int qrel = wid * 32 + r32;
    bf16x8 qf[KS];
#pragma unroll
    for (int s = 0; s < KS; ++s) qf[s] = *(const bf16x8*)(Qg + (size_t)(q0 + qrel) * pitch + 16 * s + 8 * hi);
    int kgo[KI], klo[KI], vgo[2], vlo[2];
#pragma unroll
    for (int i = 0; i < KI; ++i) { const int cid = tid + 512 * i, row = cid / NCH, ch = cid % NCH; const int sw = (DQK == 128) ? (row & 15) : ((row >> 1) & 7);
        kgo[i] = row * pitch + ch * 8; klo[i] = row * KROWB + ((ch ^ sw) << 4); }
#pragma unroll
    for (int i = 0; i < 2; ++i) { const int cid = tid + 512 * i, row = cid >> 4, ch = cid & 15;
        vgo[i] = row * pitch + ch * 8; vlo[i] = (ch >> 2) * 4096 + (row >> 3) * 512 + (row & 7) * 64 + (ch & 3) * 16; }
    const float bref = btab[q0];
    u32x4 kreg[KI], vreg[2]; float breg = 0.f;
#define AT_LOAD(t) do { const size_t kvb_ = (size_t)(64 * (t)) * pitch; \
        _Pragma("unroll") for (int i = 0; i < KI; ++i) kreg[i] = *(const u32x4*)(Kg + kvb_ + kgo[i]); \
        _Pragma("unroll") for (int i = 0; i < 2; ++i) vreg[i] = *(const u32x4*)(Vg + kvb_ + vgo[i]); \
        if (tid < 64) breg = (btab[64 * (t) + tid] - bref) * bscale; } while (0)
#define AT_STORE(buf) do { \
        _Pragma("unroll") for (int i = 0; i < KI; ++i) *(LAS u32x4*)(lds + AL_K + (buf) * 16384 + klo[i]) = kreg[i]; \
        _Pragma("unroll") for (int i = 0; i < 2; ++i) *(LAS u32x4*)(lds + AL_V + (buf) * 16384 + vlo[i]) = vreg[i]; \
        if (tid < 64) *(LAS float*)(lds + AL_B + (buf) * 256 + tid * 4) = breg; } while (0)
    float m_run = -INFINITY, l_run = 0.f;
#pragma unroll
    for (int b = 0; b < 4; ++b)
#pragma unroll
        for (int r = 0; r < 16; ++r) o[b][r] = 0.f;
    AT_LOAD(t_lo); AT_STORE(0); __syncthreads();
    const int ksw = (DQK == 128) ? (r32 & 15) : ((r32 >> 1) & 7);
    const int vlane = (4 * hi + ((lane & 15) >> 2)) * 64 + ((lane >> 4) & 1) * 32 + (lane & 3) * 8;
    for (int t = t_lo; t < NT; ++t) {
        const int cur = (t - t_lo) & 1;
        if (t + 1 < NT) AT_LOAD(t + 1);
        const int jb = t - (NT - 4);
        const bool skip = (jb >= 0) && (2 * jb > wid);
        if (!skip) {
            LAS const unsigned char* Kb = lds + AL_K + cur * 16384;
            f32x16 s0, s1;
            LAS const float* bl = (LAS const float*)(lds + AL_B + cur * 256);
#pragma unroll
            for (int g = 0; g < 4; ++g) { const f32x4 b0 = *(LAS const f32x4*)(bl + 8 * g + 4 * hi), b1 = *(LAS const f32x4*)(bl + 32 + 8 * g + 4 * hi);
#pragma unroll
                for (int e = 0; e < 4; ++e) { s0[4 * g + e] = b0[e]; s1[4 * g + e] = b1[e]; } }
#pragma unroll
            for (int s = 0; s < KS; ++s) { const int ch = 2 * s + hi;
                const bf16x8 a0 = *(LAS const bf16x8*)(Kb + r32 * KROWB + ((ch ^ ksw) << 4));
                const bf16x8 a1 = *(LAS const bf16x8*)(Kb + (32 + r32) * KROWB + ((ch ^ ksw) << 4));
                s0 = __builtin_amdgcn_mfma_f32_32x32x16_bf16(a0, qf[s], s0, 0, 0, 0);
                s1 = __builtin_amdgcn_mfma_f32_32x32x16_bf16(a1, qf[s], s1, 0, 0, 0); }
            if ((jb >= 0) && (2 * jb + 1 >= wid)) {
#pragma unroll
                for (int r = 0; r < 16; ++r) { const int kv = 64 * jb + crow(r, hi); if (kv > qrel) s0[r] = -INFINITY; if (kv + 32 > qrel) s1[r] = -INFINITY; }
            }
            float mx = fmaxf(s0[0], s1[0]);
#pragma unroll
            for (int r = 1; r < 16; ++r) mx = fmaxf(mx, fmaxf(s0[r], s1[r]));
            mx = fmaxf(mx, __shfl_xor(mx, 32));
            if (__any(mx > m_run + 8.f)) {
                const float m_new = fmaxf(m_run, mx);
                const float alpha = __builtin_amdgcn_exp2f(m_run - m_new);
                m_run = m_new; l_run *= alpha;
#pragma unroll
                for (int b = 0; b < 4; ++b)
#pragma unroll
                    for (int r = 0; r < 16; ++r) o[b][r] *= alpha;
            }
            float rs = 0.f;
#pragma unroll
            for (int r = 0; r < 16; ++r) { s0[r] = __builtin_amdgcn_exp2f(s0[r] - m_run); s1[r] = __builtin_amdgcn_exp2f(s1[r] - m_run); rs += s0[r] + s1[r]; }
            l_run += rs;
            u32x4 pw[4];
#pragma unroll
            for (int e = 0; e < 4; ++e) { pw[0][e] = pk2(s0[2 * e], s0[2 * e + 1]); pw[1][e] = pk2(s0[8 + 2 * e], s0[9 + 2 * e]); pw[2][e] = pk2(s1[2 * e], s1[2 * e + 1]); pw[3][e] = pk2(s1[8 + 2 * e], s1[9 + 2 * e]); }
            LAS const unsigned char* Vb = lds + AL_V + cur * 16384 + vlane;
#pragma unroll
            for (int b = 0; b < 4; ++b)
#pragma unroll
                for (int ks = 0; ks < 4; ++ks) {
                    const v4i16_t lo = __builtin_amdgcn_ds_read_tr16_b64_v4i16((LAS v4i16_t*)(Vb + b * 4096 + ks * 1024));
                    const v4i16_t hh = __builtin_amdgcn_ds_read_tr16_b64_v4i16((LAS v4i16_t*)(Vb + b * 4096 + ks * 1024 + 512));
                    const bf16x8 af = {lo[0], lo[1], lo[2], lo[3], hh[0], hh[1], hh[2], hh[3]};
                    o[b] = __builtin_amdgcn_mfma_f32_32x32x16_bf16(af, __builtin_bit_cast(bf16x8, pw[ks]), o[b], 0, 0, 0);
                }
        }
        if (t + 1 < NT) AT_STORE(cur ^ 1);
        __syncthreads();
    }
#undef AT_LOAD
#undef AT_STORE
    const float l = l_run + __shfl_xor(l_run, 32);
    const float inv = 1.f / l;
#pragma unroll
    for (int b = 0; b < 4; ++b)
#pragma unroll
        for (int r = 0; r < 16; ++r) o[b][r] *= inv;
}

__global__ void __launch_bounds__(NWAVES * 64, 2) hybrid_fwd(Args args) {
    extern __shared__ __attribute__((aligned(16))) unsigned char lds_raw[];
    LAS unsigned char* lds = (LAS unsigned char*)lds_raw;
    const int wave = __builtin_amdgcn_readfirstlane((int)threadIdx.x >> 6);
#define LANE_FRESH() int lane; asm volatile("v_mbcnt_lo_u32_b32 %0, -1, 0\n\tv_mbcnt_hi_u32_b32 %0, -1, %0" : "=v"(lane)); const int tid = wave * 64 + lane; (void)tid
    const int G = gridDim.x, bid = blockIdx.x;
    const int gw = bid * NWAVES + wave, NGW = G * NWAVES;
    typedef const Args __attribute__((address_space(4)))* KArgP;
    KArgP ka0 = (KArgP)__builtin_amdgcn_kernarg_segment_ptr();
#define KA_FRESH() KArgP ka = ka0; asm volatile("" : "+s"(ka))
#define AIN(i) (ka->in[i])
    unsigned char* ws = args.ws;
    unsigned* ctl = (unsigned*)(ws + WS_CTL);
    bf16_t* win0 = (bf16_t*)(ws + WS_WIN0); bf16_t* wout0 = (bf16_t*)(ws + WS_WOUT0); bf16_t* wglu = (bf16_t*)(ws + WS_WGLU);
    bf16_t* win1 = (bf16_t*)(ws + WS_WIN1); bf16_t* wout1 = (bf16_t*)(ws + WS_WOUT1);
    bf16_t* hbuf = (bf16_t*)(ws + WS_HBUF); bf16_t* ygelu = (bf16_t*)(ws + WS_HBUF); bf16_t* proj = (bf16_t*)(ws + WS_PROJ); bf16_t* ycat = (bf16_t*)(ws + WS_YCAT);
    f32x2* lamb = (f32x2*)(ws + WS_LAMB); f32x2* lamt = (f32x2*)(ws + WS_LAMT); unsigned* bbar = (unsigned*)(ws + WS_BBAR); bf16_t* cmat = (bf16_t*)(ws + WS_CMAT);
    float* biasda = (float*)(ws + WS_BIASDA); float* biasf = (float*)(ws + WS_BIASF); float* flog = (float*)(ws + WS_FLOG); f32x2* s5st = (f32x2*)(ws + WS_S5ST);
    cg::grid_group grid = cg::this_grid();
    const int lo = args.ph_lo, hi_ph = args.ph_hi;
#ifndef PH_MASK
#define PH_MASK 0x7ff
#endif
#define IN(k) (((PH_MASK >> (k)) & 1) && lo <= (k) && (k) < hi_ph)
#ifndef DUP_MASK
#define DUP_MASK 0
#endif
#define NREP(k) (((DUP_MASK >> (k)) & 1) ? 2 : 1)
#define SEAM(k) do { if (IN(k) && IN((k) + 1)) grid.sync(); } while (0)

    if (IN(0)) {
        KA_FRESH(); LANE_FRESH(); const float* x = AIN(0); float* out = ka->out; (void)x; (void)out;
        LAS float* scr = (LAS float*)(lds + wave * 16384);
        for (int rep = 0; rep < NREP(0); ++rep) {
        constexpr int I_IN0 = 32 * 192, I_OUT = 32 * 64, I_GLU = 16 * 32, I_IN1 = 32 * 264;
        constexpr int NITEMS = I_IN0 + 2 * I_OUT + I_GLU + I_IN1;
        for (int it = gw; it < NITEMS; it += NGW) {
            int r = it;
            if (r < I_IN0) { transpose_item(AIN(2), 2048, E_IN, win0, scr, r, 192, lane); continue; } r -= I_IN0;
            if (r < I_OUT) { transpose_item(AIN(3), 2048, 2048, wout0, scr, r, 64, lane); continue; } r -= I_OUT;
            if (r < I_GLU) { transpose_item(AIN(12), 1024, 1024, wglu, scr, r, 32, lane); continue; } r -= I_GLU;
            if (r < I_IN1) { transpose_item(AIN(22), 2048, 8208, win1, scr, r, 264, lane); continue; } r -= I_IN1;
            transpose_item(AIN(24), 2048, 2048, wout1, scr, r, 64, lane);
        }
        for (int m = gw; m < MTOK; m += NGW) rms_row_to_bf16(x + (size_t)m * DM, AIN(1), hbuf + (size_t)m * DM, lane);
        const int gt = bid * 512 + tid, NGT = G * 512;
        for (int i = gt; i < S5G * S5P; i += NGT) {
            const int g = i >> 6;
            const double dt = exp((double)AIN(6)[g]);
            const double lr = (double)AIN(4)[i], li = (double)AIN(5)[i];
            const double mag = exp(lr * dt), ar = mag * cos(li * dt), ai = mag * sin(li * dt);
            const double den = lr * lr + li * li, nr = ar - 1.0, ni = ai;
            const double kr = (nr * lr + ni * li) / den, ki = (ni * lr - nr * li) / den;
            lamb[i] = (f32x2){(float)ar, (float)ai};
            const double magT = exp(lr * dt * (double)S5T);
            lamt[i] = (f32x2){(float)(magT * cos(li * dt * (double)S5T)), (float)(magT * sin(li * dt * (double)S5T))};
#pragma unroll 2
            for (int j = 0; j < 8; ++j) { const double br0 = (double)AIN(7)[i * 16 + 2 * j], bi0 = (double)AIN(8)[i * 16 + 2 * j], br1 = (double)AIN(7)[i * 16 + 2 * j + 1], bi1 = (double)AIN(8)[i * 16 + 2 * j + 1];
                bbar[i * 16 + j] = pk2((float)(kr * br0 - ki * bi0), (float)(kr * br1 - ki * bi1));
                bbar[i * 16 + 8 + j] = pk2((float)(kr * bi0 + ki * br0), (float)(kr * bi1 + ki * br1)); }
        }
        for (int i = gt; i < S5G * 32 * 128; i += NGT) { const int k = i & 127, n = (i >> 7) & 31, g = i >> 12;
            float v = 0.f; if (n < 16) v = (k < 64) ? AIN(9)[(g * 16 + n) * 64 + k] : -AIN(10)[(g * 16 + n) * 64 + (k - 64)];
            cmat[i] = (bf16_t)(pk2(v, 0.f) & 0xffffu); }
        for (int i = gt; i < 8 * SEQ; i += NGT) { const int h = i / SEQ, j = i % SEQ; biasda[i] = exp2f(-(float)(h + 1)) * (float)j; }
        if (bid == 0 && tid == 0) {
            float d1 = 0.f, d2 = 0.f;
            for (int i = 0; i < 64; ++i) { d1 += AIN(16)[i] * AIN(17)[i]; d2 += AIN(18)[i] * AIN(19)[i]; }
            ((float*)ctl)[CW_LAM] = expf(d1) - expf(d2) + 0.2f;
            float gq = 0.f, gk = 0.f, fq_ = 0.f, fk_ = 0.f;
            for (int i = 0; i < 128; ++i) { gq = fmaxf(gq, fabsf(AIN(14)[i])); gk = fmaxf(gk, fabsf(AIN(15)[i])); fq_ = fmaxf(fq_, fabsf(AIN(25)[i])); fk_ = fmaxf(fk_, fabsf(AIN(26)[i])); }
            ((float*)ctl)[CW_THRDA] = ZERO_THR + 2.f * 8.f * gq * gk * 1.02f;
            ((float*)ctl)[CW_THRF] = ZERO_THR + 2.f * 11.3137085f * fq_ * fk_ * 1.02f;
            ctl[CW_QDA] = 0u; ctl[CW_QDA + 1] = 0u; ctl[CW_QFOX] = 0u; ctl[CW_QFOX + 1] = 0u;
        }
        }
#ifdef XSYNC
        for (int i = 0; i < XSYNC; ++i) grid.sync();
#endif
    }
    SEAM(0);
    if (IN(1)) {
        KA_FRESH(); LANE_FRESH(); const float* x = AIN(0); float* out = ka->out; (void)x; (void)out;
        pg8::Gemm g{hbuf, win0, MTOK, E_IN, DM}; pg8::StaticOrder S; S.init(MTOK, E_IN, G, bid);
        pg8::EpiBf16<0> E{proj, E_IN, nullptr, 0, 0, 1.f};
        for (int rep = 0; rep < NREP(1); ++rep) pg8::gemm_phase<pg8::EpiBf16<0>, pg8::StaticOrder, true, true>(lds, g, S, E, wave, lane);
    }
    SEAM(1);
    if (IN(2)) {
        KA_FRESH(); LANE_FRESH(); const float* x = AIN(0); float* out = ka->out; (void)x; (void)out;
        const float qmul = 0.125f * LOG2E;
        for (int m = gw; m < MTOK; m += NGW) {
#pragma unroll
            for (int it = 0; it < 2; ++it) { const int col = 2048 + it * 1024 + lane * 16;
                const float* gp = (it == 0 ? AIN(14) : AIN(15)) + (col & 127);
                float g16[16];
#pragma unroll
                for (int e = 0; e < 4; ++e) { const f32x4 gg = *(const f32x4*)(gp + 4 * e); g16[4 * e] = gg.x; g16[4 * e + 1] = gg.y; g16[4 * e + 2] = gg.z; g16[4 * e + 3] = gg.w; }
                qknorm16<4>(proj + (size_t)m * E_IN + col, g16, it == 0 ? qmul : 1.f, 1.f / 64.f); }
        }
        {
        const int r32 = lane & 31, hi = lane >> 5;
        for (int rep = 0; rep < NREP(12); ++rep)
        for (int u = gw; u < BATCH * S5G * S5NC; u += NGW) {
            const int g = u & 63, c = (u >> 6) & (S5NC - 1), b = u >> 13;
            const f32x2 la = lamb[g * 64 + lane];
            bf16x8 bre[2], bim[2];
#pragma unroll
            for (int ph = 0; ph < 2; ++ph) { const unsigned* bp = bbar + (size_t)(g * 64 + 32 * ph + r32) * 16 + 4 * hi;
                bre[ph] = __builtin_bit_cast(bf16x8, *(const u32x4*)bp); bim[ph] = __builtin_bit_cast(bf16x8, *(const u32x4*)(bp + 8)); }
            float hr = 0.f, hi_s = 0.f;
            const bf16_t* up = proj + (size_t)(b * SEQ + c * S5T + r32) * E_IN + g * 16 + 8 * hi;
            for (int sb = 0; sb < 4; ++sb) {
                const bf16x8 ua = *(const bf16x8*)(up + (size_t)(sb * 32) * E_IN);
                f32x16 z16;
#pragma unroll
                for (int r = 0; r < 16; ++r) z16[r] = 0.f;
                f32x16 xr0 = __builtin_amdgcn_mfma_f32_32x32x16_bf16(ua, bre[0], z16, 0, 0, 0), xr1 = __builtin_amdgcn_mfma_f32_32x32x16_bf16(ua, bre[1], z16, 0, 0, 0);
                f32x16 xi0 = __builtin_amdgcn_mfma_f32_32x32x16_bf16(ua, bim[0], z16, 0, 0, 0), xi1 = __builtin_amdgcn_mfma_f32_32x32x16_bf16(ua, bim[1], z16, 0, 0, 0);
#pragma unroll
                for (int r = 0; r < 16; ++r) {
                    auto sr = __builtin_amdgcn_permlane32_swap(__float_as_uint(xr0[r]), __float_as_uint(xr1[r]), false, false); xr0[r] = __uint_as_float(sr[0]); xr1[r] = __uint_as_float(sr[1]);
                    auto si = __builtin_amdgcn_permlane32_swap(__float_as_uint(xi0[r]), __float_as_uint(xi1[r]), false, false); xi0[r] = __uint_as_float(si[0]); xi1[r] = __uint_as_float(si[1]); }
#pragma unroll
                for (int t = 0; t < 32; ++t) { const int r = (t & 3) + 4 * (t >> 3); const bool odd = (t >> 2) & 1;
                    const float xr = odd ? xr1[r] : xr0[r], xi = odd ? xi1[r] : xi0[r];
                    const float nhr = la.x * hr - la.y * hi_s + xr, nhi = la.x * hi_s + la.y * hr + xi; hr = nhr; hi_s = nhi; }
            }
            s5st[((size_t)(b * S5NC + c) * 64 + g) * 64 + lane] = (f32x2){hr, hi_s};
        }
        }
    }
    SEAM(2);
    if (IN(3)) {
        KA_FRESH(); LANE_FRESH(); const float* x = AIN(0); float* out = ka->out; (void)x; (void)out;
        {
            LAS unsigned char* Ht = lds + wave * 8192;
            const int r32 = lane & 31, hi = lane >> 5;
            for (int rep = 0; rep < NREP(11); ++rep)
            for (int u = gw; u < BATCH * S5G * S5NC; u += NGW) {
                const int g = u & 63, c = (u >> 6) & (S5NC - 1), b = u >> 13;
                const int gp = g * 64 + lane;
                const f32x2 la = lamb[gp], lt = lamt[gp];
                bf16x8 bre[2], bim[2];
#pragma unroll
                for (int ph = 0; ph < 2; ++ph) { const unsigned* bp = bbar + (size_t)(g * 64 + 32 * ph + r32) * 16 + 4 * hi;
                    bre[ph] = __builtin_bit_cast(bf16x8, *(const u32x4*)bp); bim[ph] = __builtin_bit_cast(bf16x8, *(const u32x4*)(bp + 8)); }
                float hr = 0.f, hi_s = 0.f;
                for (int cc = 0; cc < c; ++cc) { const f32x2 s = s5st[((size_t)(b * S5NC + cc) * 64 + g) * 64 + lane];
                    const float nhr = lt.x * hr - lt.y * hi_s + s.x, nhi = lt.x * hi_s + lt.y * hr + s.y; hr = nhr; hi_s = nhi; }
                bf16x8 cfr[8];
#pragma unroll
                for (int s = 0; s < 8; ++s) cfr[s] = *(const bf16x8*)(cmat + (size_t)(g * 32 + r32) * 128 + 16 * s + 8 * hi);
                const float dvec = AIN(11)[g * 16 + (r32 & 15)];
                const size_t row0 = (size_t)(b * SEQ + c * S5T);
                const bf16_t* up = proj + (row0 + r32) * E_IN + g * 16 + 8 * hi;
                for (int sb = 0; sb < 4; ++sb) {
                    {
                    const bf16x8 ua = *(const bf16x8*)(up + (size_t)(sb * 32) * E_IN);
                    f32x16 z16;
#pragma unroll
                    for (int r = 0; r < 16; ++r) z16[r] = 0.f;
                    f32x16 xr0 = __builtin_amdgcn_mfma_f32_32x32x16_bf16(ua, bre[0], z16, 0, 0, 0), xr1 = __builtin_amdgcn_mfma_f32_32x32x16_bf16(ua, bre[1], z16, 0, 0, 0);
                    f32x16 xi0 = __builtin_amdgcn_mfma_f32_32x32x16_bf16(ua, bim[0], z16, 0, 0, 0), xi1 = __builtin_amdgcn_mfma_f32_32x32x16_bf16(ua, bim[1], z16, 0, 0, 0);
#pragma unroll
                    for (int r = 0; r < 16; ++r) {
                        auto sr = __builtin_amdgcn_permlane32_swap(__float_as_uint(xr0[r]), __float_as_uint(xr1[r]), false, false); xr0[r] = __uint_as_float(sr[0]); xr1[r] = __uint_as_float(sr[1]);
                        auto si = __builtin_amdgcn_permlane32_swap(__float_as_uint(xi0[r]), __float_as_uint(xi1[r]), false, false); xi0[r] = __uint_as_float(si[0]); xi1[r] = __uint_as_float(si[1]); }
#pragma unroll
                    for (int tt = 0; tt < 32; ++tt) { const int r = (tt & 3) + 4 * (tt >> 3); const bool odd = (tt >> 2) & 1;
                        const float xr = odd ? xr1[r] : xr0[r], xi = odd ? xi1[r] : xi0[r];
                        const float nhr = la.x * hr - la.y * hi_s + xr, nhi = la.x * hi_s + la.y * hr + xi; hr = nhr; hi_s = nhi;
                        const unsigned w = pk2(hr, hi_s);
                        const int sw = tt & 15;
                        *(LAS unsigned short*)(Ht + tt * 256 + ((((lane >> 3)) ^ sw) << 4) + ((lane & 7) << 1)) = (unsigned short)(w & 0xffffu);
                        *(LAS unsigned short*)(Ht + tt * 256 + ((((64 + lane) >> 3) ^ sw) << 4) + ((lane & 7) << 1)) = (unsigned short)(w >> 16);
                    }
                    }
                    asm volatile("s_waitcnt lgkmcnt(0)" ::: "memory");
                    f32x16 acc;
#pragma unroll
                    for (int r = 0; r < 16; ++r) acc[r] = 0.f;
#pragma unroll
                    for (int s = 0; s < 8; ++s) { const bf16x8 a = *(LAS const bf16x8*)(Ht + r32 * 256 + (((2 * s + hi) ^ (r32 & 15)) << 4));
                        acc = __builtin_amdgcn_mfma_f32_32x32x16_bf16(a, cfr[s], acc, 0, 0, 0); }
                    asm volatile("s_waitcnt lgkmcnt(0)" ::: "memory");
                    if (r32 < 16) {
#pragma unroll
                        for (int r = 0; r < 16; ++r) { const size_t row = row0 + sb * 32 + crow(r, hi);
                            const float uval = bf2f(proj[row * E_IN + g * 16 + r32]);
                            const float y = gelu_tanh(acc[r] + dvec * uval);
                            ygelu[row * 1024 + g * 16 + r32] = (bf16_t)(pk2(y, 0.f) & 0xffffu); }
                    }
                }
            }
        }
        __syncthreads();
        {
            LANE_FRESH();
            LAS volatile int* misc = (LAS volatile int*)(lds + LDS_MISC);
            const float lam = ((const float*)ctl)[CW_LAM]; const float thr_da = ((const float*)ctl)[CW_THRDA];
            const int r32 = lane & 31, hi = lane >> 5;
            for (int rep = 0; rep < NREP(3); ++rep)
            for (;;) {
                if (tid == 0) misc[0] = (int)atomicAdd(ctl + CW_QDA + rep, 1u);
                __syncthreads();
                const int ui = misc[0];
                __syncthreads();
                if (ui >= BATCH * 8 * 64) break;
                const int qb = 63 - (ui >> 4), bh = ui & 15, b = bh >> 3, h = bh & 7;
                const int q0 = qb * 256;
                const bf16_t* pb = proj + (size_t)b * SEQ * E_IN;
                const float dskip = thr_da * exp2f((float)(h + 1));
                const int t_lo = max(0, (int)ceilf(((float)q0 - dskip - 63.f) * (1.f / 64.f)));
                f32x16 o[4];
                LAS unsigned* stash = (LAS unsigned*)(lds + LDS_STASH) + wave * 2048 + lane;
                attn_pass<64>(lds, pb + 2048 + h * 128, pb + 3072 + h * 128, pb + 4096 + h * 128, biasda + h * SEQ, LOG2E, E_IN, q0, t_lo, o, wave, lane);
#pragma unroll
                for (int bl = 0; bl < 4; ++bl)
#pragma unroll
                    for (int e = 0; e < 8; ++e) stash[(bl * 8 + e) * 64] = pk2(o[bl][2 * e], o[bl][2 * e + 1]);
                attn_pass<64>(lds, pb + 2048 + h * 128 + 64, pb + 3072 + h * 128 + 64, pb + 4096 + h * 128, biasda + h * SEQ, LOG2E, E_IN, q0, t_lo, o, wave, lane);
                float ssq = 0.f;
#pragma unroll
                for (int bl = 0; bl < 4; ++bl)
#pragma unroll
                    for (int e = 0; e < 8; ++e) { const unsigned w0 = stash[(bl * 8 + e) * 64]; const float v0 = bflo(w0) - lam * o[bl][2 * e], v1 = bfhi(w0) - lam * o[bl][2 * e + 1];
                        o[bl][2 * e] = v0; o[bl][2 * e + 1] = v1; ssq += v0 * v0 + v1 * v1; }
                ssq += __shfl_xor(ssq, 32);
                const float rr = 0.8f / sqrtf(ssq * (1.f / 128.f) + RMS_EPS);
                const size_t tok = (size_t)b * SEQ + q0 + wave * 32 + r32;
#pragma unroll
                for (int bl = 0; bl < 4; ++bl)
#pragma unroll
                    for (int g = 0; g < 4; ++g) { const int dv0 = 32 * bl + 8 * g + 4 * hi;
                        const f32x4 gn = *(const f32x4*)(AIN(20) + dv0);
                        const u32x2 zw = *(const u32x2*)(proj + tok * E_IN + 5120 + h * 128 + dv0);
                        const float y0 = o[bl][4 * g] * rr * gn.x * siluf_(bflo(zw.x)), y1 = o[bl][4 * g + 1] * rr * gn.y * siluf_(bfhi(zw.x));
                        const float y2 = o[bl][4 * g + 2] * rr * gn.z * siluf_(bflo(zw.y)), y3 = o[bl][4 * g + 3] * rr * gn.w * siluf_(bfhi(zw.y));
                        u32x2 w; w.x = pk2(y0, y1); w.y = pk2(y2, y3);
                        *(u32x2*)(ycat + tok * DM + 1024 + h * 128 + dv0) = w; }
            }
        }
    }
    SEAM(3);
    if (IN(4)) {
        KA_FRESH(); LANE_FRESH(); const float* x = AIN(0); float* out = ka->out; (void)x; (void)out;
        pg8::Gemm g{ygelu, wglu, MTOK, 1024, 1024}; pg8::StaticOrder S; S.init(MTOK, 1024, G, bid);
        pg8::EpiGlu E{ycat, ygelu, proj, AIN(13)};
        pg8::gemm_phase<pg8::EpiGlu, pg8::StaticOrder, true, true>(lds, g, S, E, wave, lane);
    }
    SEAM(4);
    if (IN(5)) {
        KA_FRESH(); LANE_FRESH(); const float* x = AIN(0); float* out = ka->out; (void)x; (void)out;
        pg8::Gemm g{ycat, wout0, MTOK, DM, DM}; pg8::StaticOrder S; S.init(MTOK, DM, G, bid);
        pg8::EpiResid E{x, out};
        pg8::gemm_phase<pg8::EpiResid, pg8::StaticOrder, true, true>(lds, g, S, E, wave, lane);
    }
    SEAM(5);
    if (IN(6)) {
        KA_FRESH(); LANE_FRESH(); const float* x = AIN(0); float* out = ka->out; (void)x; (void)out;
        for (int rep = 0; rep < NREP(6); ++rep)
        for (int m = gw; m < MTOK; m += NGW) rms_row_to_bf16(out + (size_t)m * DM, AIN(21), hbuf + (size_t)m * DM, lane);
    }
    SEAM(6);
    if (IN(7)) {
        KA_FRESH(); LANE_FRESH(); const float* x = AIN(0); float* out = ka->out; (void)x; (void)out;
        pg8::Gemm g{hbuf, win1, MTOK, O_INP, DM}; pg8::StaticOrder S; S.init(MTOK, O_INP, G, bid);
        pg8::EpiProj1 E{proj, flog};
        for (int rep = 0; rep < NREP(7); ++rep) pg8::gemm_phase<pg8::EpiProj1, pg8::StaticOrder, true, true>(lds, g, S, E, wave, lane);
    }
    SEAM(7);
    if (IN(8)) {
        KA_FRESH(); LANE_FRESH(); const float* x = AIN(0); float* out = ka->out; (void)x; (void)out;
        if (bid < 32) {
            const int b = bid >> 4, h = bid & 15;
            LAS double* dsum = (LAS double*)lds;
            const float bf_ = AIN(23)[h];
            const float* fl = flog + ((size_t)b * SEQ + tid * 32) * 16 + h;
            double tot = 0.0;
#pragma unroll 4
            for (int i = 0; i < 32; ++i) { const float xv = fl[i * 16] + bf_; tot += (double)(fminf(xv, 0.f) - log1pf(expf(-fabsf(xv)))); }
            dsum[tid] = tot;
            __syncthreads();
            double pre = 0.0;
            for (int i = 0; i < tid; ++i) pre += dsum[i];
            float* bo = biasf + ((size_t)(b * 16 + h)) * SEQ + tid * 32;
#pragma unroll 4
            for (int i = 0; i < 32; ++i) { const float xv = fl[i * 16] + bf_; pre += (double)(fminf(xv, 0.f) - log1pf(expf(-fabsf(xv)))); bo[i] = (float)(-pre); }
            __syncthreads();
        }
        const float qmul = 0.08838834764831845f * LOG2E;
        for (int m = gw; m < MTOK; m += NGW) {
#pragma unroll
            for (int it = 0; it < 4; ++it) { const int col = it * 1024 + lane * 16;
                const float* gp = (it < 2 ? AIN(25) : AIN(26)) + (col & 127);
                float g16[16];
#pragma unroll
                for (int e = 0; e < 4; ++e) { const f32x4 gg = *(const f32x4*)(gp + 4 * e); g16[4 * e] = gg.x; g16[4 * e + 1] = gg.y; g16[4 * e + 2] = gg.z; g16[4 * e + 3] = gg.w; }
                qknorm16<8>(proj + (size_t)m * O_LD + col, g16, it < 2 ? qmul : 1.f, 1.f / 128.f); }
        }
    }
    SEAM(8);
    if (IN(9)) {
        KA_FRESH(); LANE_FRESH(); const float* x = AIN(0); float* out = ka->out; (void)x; (void)out;
        LAS volatile int* misc = (LAS volatile int*)(lds + LDS_MISC);
        const int r32 = lane & 31, hi = lane >> 5;
        const float thr_f = ((const float*)ctl)[CW_THRF];
        for (int rep = 0; rep < NREP(9); ++rep)
        for (;;) {
            if (wave == 0) {
                int u0 = 0; if (lane == 0) u0 = (int)atomicAdd(ctl + CW_QFOX + rep, 1u);
                u0 = __shfl(u0, 0);
                int tl = 0;
                if (u0 < BATCH * 16 * 64) {
                    const int qb_ = 63 - (u0 >> 5), bh_ = u0 & 31; const float* bt = biasf + (size_t)bh_ * SEQ; const float bref = bt[qb_ * 256];
#pragma unroll
                    for (int r = 0; r < 4; ++r) { const int t = lane + 64 * r; bool dead = false;
                        if (t < 4 * qb_) dead = (bt[64 * t + 63] - bref) < -thr_f;
                        tl += __popcll(__ballot(dead)); }
                }
                if (lane == 0) { misc[0] = u0; misc[1] = tl; }
            }
            __syncthreads();
            const int ui = misc[0], t_lo = misc[1];
            __syncthreads();
            if (ui >= BATCH * 16 * 64) break;
            const int qb = 63 - (ui >> 5), bh = ui & 31, b = bh >> 4, h = bh & 15;
            const int q0 = qb * 256;
            const bf16_t* pb = proj + (size_t)b * SEQ * O_LD;
            f32x16 o[4];
            attn_pass<128>(lds, pb + h * 128, pb + 2048 + h * 128, pb + 4096 + h * 128, biasf + (size_t)bh * SEQ, LOG2E, O_LD, q0, t_lo, o, wave, lane);
            const size_t tok = (size_t)b * SEQ + q0 + wave * 32 + r32;
#pragma unroll
            for (int bl = 0; bl < 4; ++bl)
#pragma unroll
                for (int g = 0; g < 4; ++g) { const int dv0 = 32 * bl + 8 * g + 4 * hi;
                    const u32x2 zw = *(const u32x2*)(proj + tok * O_LD + 6144 + h * 128 + dv0);
                    const float y0 = o[bl][4 * g] * siluf_(bflo(zw.x)), y1 = o[bl][4 * g + 1] * siluf_(bfhi(zw.x));
                    const float y2 = o[bl][4 * g + 2] * siluf_(bflo(zw.y)), y3 = o[bl][4 * g + 3] * siluf_(bfhi(zw.y));
                    u32x2 w; w.x = pk2(y0, y1); w.y = pk2(y2, y3);
                    *(u32x2*)(ycat + tok * DM + h * 128 + dv0) = w; }
        }
    }
    SEAM(9);
    if (IN(10)) {
        KA_FRESH(); LANE_FRESH(); const float* x = AIN(0); float* out = ka->out; (void)x; (void)out;
        pg8::Gemm g{ycat, wout1, MTOK, DM, DM}; pg8::StaticOrder S; S.init(MTOK, DM, G, bid);
        pg8::EpiResid E{out, out};
        pg8::gemm_phase<pg8::EpiResid, pg8::StaticOrder, true, true>(lds, g, S, E, wave, lane);
    }
#undef IN
#undef SEAM
}

#ifndef ONE_LAUNCH
#define ONE_LAUNCH 1
#endif
constexpr int NPHASE = 11;
extern "C" void kernel_launch(void* const* d_in, const int* in_sizes, int n_in, void* d_out, int out_size, void* d_ws, size_t ws_size, hipStream_t stream) {
    static int grid = 0;
    if (grid == 0) {
        if (n_in != 27 || out_size != MTOK * DM || ws_size < WS_END) { fprintf(stderr, "kernel_launch: unexpected problem (n_in %d out %d ws %zu)\n", n_in, out_size, ws_size); grid = -1; return; }
        int dev = 0, cus = 0, per_cu = 0;
        hipGetDevice(&dev);
        hipDeviceGetAttribute(&cus, hipDeviceAttributeMultiprocessorCount, dev);
        if (hipFuncSetAttribute((const void*)hybrid_fwd, hipFuncAttributeMaxDynamicSharedMemorySize, LDS_BYTES) != hipSuccess) { fprintf(stderr, "kernel_launch: hipFuncSetAttribute failed\n"); grid = -1; return; }
        if (hipOccupancyMaxActiveBlocksPerMultiprocessor(&per_cu, (const void*)hybrid_fwd, NWAVES * 64, LDS_BYTES) != hipSuccess || per_cu < 1) { fprintf(stderr, "kernel_launch: occupancy query says %d\n", per_cu); per_cu = 1; }
        (void)hipGetLastError();
        grid = cus * 1;
    }
    if (grid < 0) return;
    Args a{};
    for (int i = 0; i < 27; ++i) a.in[i] = (const float*)d_in[i];
    a.out = (float*)d_out; a.ws = (unsigned char*)d_ws;
#if ONE_LAUNCH
    a.ph_lo = 0; a.ph_hi = NPHASE;
    void* kargs[] = {&a};
    hipError_t e = hipLaunchCooperativeKernel((const void*)hybrid_fwd, dim3(grid), dim3(NWAVES * 64), kargs, LDS_BYTES, stream);
    if (e != hipSuccess) fprintf(stderr, "cooperative launch failed: %s (grid %d)\n", hipGetErrorString(e), grid);
#else
    for (int p = 0; p < NPHASE; ++p) {
        a.ph_lo = p; a.ph_hi = p + 1;
        hipLaunchKernelGGL(hybrid_fwd, dim3(grid), dim3(NWAVES * 64), LDS_BYTES, stream, a);
    }
#endif
}
```

```cpp
#include <hip/hip_runtime.h>
#include <hip/hip_cooperative_groups.h>
#include <cstdio>
#include <cstdint>
#include <cmath>
namespace cg = cooperative_groups;
#define DUP_MASK 0
namespace pg8 {
#define PG8_LAS __attribute__((address_space(3)))
typedef unsigned short bf16_t;
typedef short bf16x8 __attribute__((ext_vector_type(8)));
typedef float f32x4 __attribute__((ext_vector_type(4)));
typedef unsigned u32x4 __attribute__((ext_vector_type(4)));
constexpr int BM = 256, BK = 64, HALF = 128, HTB = HALF * BK * 2  , STAGE_BYTES = 8 * HTB, NXCD = 8, WGM = 8;

__host__ __device__ __forceinline__ int lds_byte(int r, int c) { const int st = (r >> 4) * 2 + (c >> 5), rr = r & 15, cc = c & 31, ob = rr * 64 + cc * 2; return st * 1024 + (ob ^ (((ob >> 9) & 1) << 5)); }
__host__ __device__ __forceinline__ void stage_rc(int b, int& R, int& C) { const int st = b / 1024, sb = b % 1024, swz = sb ^ (((sb >> 9) & 1) << 5); R = (st >> 1) * 16 + swz / 64; C = (st & 1) * 32 + (swz % 64) / 2; }
__host__ __device__ __forceinline__ int perm32(int rho) { const int n = rho >> 4, i = rho & 15; return 8 * (i >> 2) + 4 * n + (i & 3); }

struct Unit { int pm, pn; };
struct Gemm { const bf16_t* A; const bf16_t* Bt; int M, N, K; };

struct StaticOrder {
    int nM, nN, nwg, G, c;
    __host__ __device__ void init(int M, int N, int G_, int c_) { nM = M / BM; nN = N / BM; nwg = nM * nN; G = G_; c = c_; }
    __host__ __device__ bool next(int i, Unit& u) const {
        const long L = (long)i * G + c; if (L >= nwg) return false;
        int wgid = (int)L; { const int q = nwg / NXCD, r = nwg % NXCD, xcd = wgid % NXCD, off = wgid / NXCD; wgid = (xcd < r ? xcd * (q + 1) : r * (q + 1) + (xcd - r) * q) + off; }
        const int nig = WGM * nN, gid = wgid / nig, fm = gid * WGM, gsz = (nM - fm) < WGM ? (nM - fm) : WGM;
        u.pm = fm + ((wgid % nig) % gsz); u.pn = (wgid % nig) / gsz; return true;
    }
    __device__ __forceinline__ void a_ready(const Unit&) const {}
    __device__ __forceinline__ void done(const Unit&) const {}
};

__device__ __forceinline__ unsigned cvt_pk_bf16(float lo, float hi) { unsigned r; asm volatile("v_cvt_pk_bf16_f32 %0, %1, %2" : "=v"(r) : "v"(lo), "v"(hi)); return r; }
typedef float f32x2 __attribute__((ext_vector_type(2)));
__device__ __forceinline__ f32x2 gelu_pk(f32x2 v) {
    const f32x2 av = __builtin_elementwise_abs(v), d = av * 0.2316418882f + 1.0f;
    f32x2 t; t.x = __builtin_amdgcn_rcpf(d.x); t.y = __builtin_amdgcn_rcpf(d.y);
    f32x2 q = t * 0.5307027145f + (-0.7265760135f); q = q * t + 0.7107068705f; q = q * t + (-0.142248368f); q = q * t + 0.127414796f; q = q * t;
    const f32x2 s = (v * v) * (-0.72134752044f);
    f32x2 e; e.x = __builtin_amdgcn_exp2f(s.x); e.y = __builtin_amdgcn_exp2f(s.y);
    const f32x2 m = v * (q * e), r = v - m;
    f32x2 o; o.x = v.x < 0.f ? m.x : r.x; o.y = v.y < 0.f ? m.y : r.y; return o;
}

template <int ACT  > struct EpiBf16 {
    static constexpr bool PERM = true, AFTER_DRAIN = false; static_assert(ACT == 0 || ACT == 1, "EpiBf16: ACT is 0 (none) or 1 (gelu_pk)");
    bf16_t* O; int ldc; const float* bias; int split_cols; size_t split_stride; float scale0;
    __device__ __forceinline__ void operator()(const f32x4 (&acc)[2][2][4][2], const Unit& u, int wr, int wc, int fr, int fq) const {
        const int row0 = u.pm * BM + wr * 64 + fr; int colt = u.pn * BM; bf16_t* base = O;
        float sc = 1.f; if (split_cols) { const int t = colt / split_cols; base += (size_t)t * split_stride; colt -= t * split_cols; if (t == 0) sc = scale0; }
        const int col0 = colt + wc * 32 + 8 * fq, bcol0 = u.pn * BM + wc * 32 + 8 * fq;
        f32x4 bv[2][2];
#pragma unroll
        for (int bj = 0; bj < 2; ++bj)
#pragma unroll
            for (int n = 0; n < 2; ++n) bv[bj][n] = bias ? *(const f32x4*)(bias + bcol0 + bj * HALF + 4 * n) : (f32x4){0.f, 0.f, 0.f, 0.f};
#pragma unroll
        for (int ai = 0; ai < 2; ++ai)
#pragma unroll
            for (int m = 0; m < 4; ++m) { bf16_t* rowp = base + (size_t)(row0 + ai * HALF + m * 16) * ldc + col0;
#pragma unroll
                for (int bj = 0; bj < 2; ++bj) { f32x4 v0 = acc[ai][bj][m][0] + bv[bj][0], v1 = acc[ai][bj][m][1] + bv[bj][1];
                    if (ACT == 1) { f32x2 a = gelu_pk((f32x2){v0[0], v0[1]}), b = gelu_pk((f32x2){v0[2], v0[3]}), c = gelu_pk((f32x2){v1[0], v1[1]}), d = gelu_pk((f32x2){v1[2], v1[3]});
                        v0 = (f32x4){a.x, a.y, b.x, b.y}; v1 = (f32x4){c.x, c.y, d.x, d.y}; }
                    v0 = v0 * sc; v1 = v1 * sc; u32x4 w; w.x = cvt_pk_bf16(v0[0], v0[1]); w.y = cvt_pk_bf16(v0[2], v0[3]); w.z = cvt_pk_bf16(v1[0], v1[1]); w.w = cvt_pk_bf16(v1[2], v1[3]);
                    *(u32x4*)(rowp + bj * HALF) = w; } }
    }
};
template <class Epi, class Sched, bool ALIGN_EPI = false, bool SP2 = false>
__device__ __forceinline__ void gemm_phase(PG8_LAS unsigned char* lds, const Gemm g, const Sched& S, const Epi& E, const int wid, const int lane) {
    const int tid = wid * 64 + lane, wr = wid >> 2, wc = wid & 3, fr = lane & 15, fq = lane >> 4;
    const int K = g.K, nt = K / BK;
    unsigned voffA[2], voffB[2];
#pragma unroll
    for (int i = 0; i < 2; ++i) { int R, C; stage_rc(tid * 16 + i * 8192, R, C); const int Rb = Epi::PERM ? ((R & ~31) + perm32(R & 31)) : R;
        voffA[i] = (unsigned)(R * K + C) * 2u; voffB[i] = (unsigned)(Rb * K + C) * 2u; }
    const size_t kstep = (size_t)(BK * 2);
    const size_t hstep = (size_t)HALF * K * 2;
    const size_t tstep = 2 * hstep;
    const unsigned ldsw = (unsigned)wid * 1024u;
    const int aoff = lds_byte(wr * 64 + fr, fq * 8), boff = lds_byte(wc * 32 + fr, fq * 8);
#define PG8_SA(b, h) (((b) * 2 + (h)) * HTB)
#define PG8_SB(b, h) ((4 + (b) * 2 + (h)) * HTB)
#define PG8_STAGE(bufoff, gbase, voff) do { _Pragma("unroll") for (int _i = 0; _i < 2; ++_i) \
        __builtin_amdgcn_global_load_lds((const unsigned*)((const char*)(gbase) + (voff)[_i]), (PG8_LAS unsigned*)(lds + (bufoff) + ldsw + _i * 8192), 16, 0, 0); } while (0)
#define PG8_LDA(dst, b, h) do { _Pragma("unroll") for (int m = 0; m < 4; ++m) _Pragma("unroll") for (int k = 0; k < 2; ++k) dst[m][k] = *(const PG8_LAS bf16x8*)(lds + PG8_SA(b, h) + aoff + m * 2048 + k * 1024); } while (0)
#define PG8_LDB(dst, b, h) do { _Pragma("unroll") for (int n = 0; n < 2; ++n) _Pragma("unroll") for (int k = 0; k < 2; ++k) dst[n][k] = *(const PG8_LAS bf16x8*)(lds + PG8_SB(b, h) + boff + n * 2048 + k * 1024); } while (0)
#define PG8_MMA(ai, bj, At, Bt) do { __builtin_amdgcn_s_setprio(1); _Pragma("unroll") for (int m = 0; m < 4; ++m) _Pragma("unroll") for (int n = 0; n < 2; ++n) _Pragma("unroll") for (int k = 0; k < 2; ++k) \
        acc[ai][bj][m][n] = __builtin_amdgcn_mfma_f32_16x16x32_bf16(Bt[n][k], At[m][k], acc[ai][bj][m][n], 0, 0, 0); __builtin_amdgcn_s_setprio(0); } while (0)
#define PG8_WAIT_V(n) asm volatile("s_waitcnt vmcnt(" #n ")" ::: "memory")
#define PG8_WAIT_L(n) asm volatile("s_waitcnt lgkmcnt(" #n ")" ::: "memory")
#define PG8_BAR __builtin_amdgcn_s_barrier()
#define PG8_SCHED __builtin_amdgcn_sched_barrier(0)
    Unit cur, nxt; int ui = 0;
    if (!S.next(0, cur)) return;
    f32x4 acc[2][2][4][2];
#pragma unroll
    for (int a = 0; a < 2; ++a)
#pragma unroll
        for (int b = 0; b < 2; ++b)
#pragma unroll
            for (int m = 0; m < 4; ++m)
#pragma unroll
                for (int n = 0; n < 2; ++n) acc[a][b][m][n] = (f32x4){0.f, 0.f, 0.f, 0.f};
    bf16x8 At[4][2], B0[2][2], B1[2][2];
    const char* cA = (const char*)g.A + (size_t)cur.pm * tstep; const char* cB = (const char*)g.Bt + (size_t)cur.pn * tstep;
    S.a_ready(cur);
    if constexpr (SP2) {
        PG8_STAGE(PG8_SB(0, 0), cB, voffB); PG8_STAGE(PG8_SB(0, 1), cB + hstep, voffB); PG8_STAGE(PG8_SA(0, 0), cA, voffA); PG8_STAGE(PG8_SA(0, 1), cA + hstep, voffA);
        if (wr == 1) PG8_BAR;
        PG8_WAIT_V(2); PG8_BAR;
        PG8_STAGE(PG8_SB(1, 0), cB + kstep, voffB); PG8_STAGE(PG8_SA(1, 0), cA + kstep, voffA); PG8_STAGE(PG8_SB(1, 1), cB + hstep + kstep, voffB);
        PG8_WAIT_V(6); PG8_BAR;
    } else {
        PG8_STAGE(PG8_SB(0, 0), cB, voffB); PG8_STAGE(PG8_SA(0, 0), cA, voffA); PG8_STAGE(PG8_SB(0, 1), cB + hstep, voffB); PG8_STAGE(PG8_SA(0, 1), cA + hstep, voffA);
        if (wr == 1) PG8_BAR;
        PG8_WAIT_V(4); PG8_BAR;
        PG8_STAGE(PG8_SB(1, 0), cB + kstep, voffB); PG8_STAGE(PG8_SA(1, 0), cA + kstep, voffA); PG8_STAGE(PG8_SB(1, 1), cB + hstep + kstep, voffB);
        PG8_WAIT_V(6); PG8_BAR;
    }
    for (;;) {
        const bool has_next = S.next(ui + 1, nxt);
        const char* nA = has_next ? (const char*)g.A + (size_t)nxt.pm * tstep : cA; const char* nB = has_next ? (const char*)g.Bt + (size_t)nxt.pn * tstep : cB;
        for (int t = 0; t < nt; t += 2) {
            const bool last = (t == nt - 2);
            const char* a1 = cA + (size_t)(t + 1) * kstep;
            const char* a2 = last ? nA : cA + (size_t)(t + 2) * kstep; const char* b2 = last ? nB : cB + (size_t)(t + 2) * kstep;
            const char* a3 = a2 + kstep; const char* b3 = b2 + kstep;
            if (last && has_next) S.a_ready(nxt);
            if constexpr (SP2) {
            PG8_LDB(B0, 0, 0); PG8_LDB(B1, 0, 1); PG8_SCHED; PG8_LDA(At, 0, 0); PG8_STAGE(PG8_SA(1, 1), a1 + hstep, voffA);
            PG8_WAIT_V(8); PG8_WAIT_L(0); PG8_BAR; PG8_MMA(0, 0, At, B0); PG8_MMA(0, 1, At, B1); PG8_BAR; PG8_SCHED;
            PG8_LDA(At, 0, 1); PG8_STAGE(PG8_SB(0, 0), b2, voffB); PG8_STAGE(PG8_SB(0, 1), b2 + hstep, voffB); PG8_STAGE(PG8_SA(0, 0), a2, voffA);
            PG8_WAIT_V(8); PG8_WAIT_L(0); PG8_BAR; PG8_MMA(1, 0, At, B0); PG8_MMA(1, 1, At, B1); PG8_BAR; PG8_SCHED;
            PG8_LDB(B0, 1, 0); PG8_LDB(B1, 1, 1); PG8_SCHED; PG8_LDA(At, 1, 0); PG8_STAGE(PG8_SA(0, 1), a2 + hstep, voffA);
            PG8_WAIT_V(8); PG8_WAIT_L(0); PG8_BAR; PG8_MMA(0, 0, At, B0); PG8_MMA(0, 1, At, B1); PG8_BAR; PG8_SCHED;
            PG8_LDA(At, 1, 1); PG8_STAGE(PG8_SB(1, 0), b3, voffB); PG8_STAGE(PG8_SB(1, 1), b3 + hstep, voffB); PG8_STAGE(PG8_SA(1, 0), a3, voffA);
            PG8_WAIT_V(8); PG8_WAIT_L(0); PG8_BAR; PG8_MMA(1, 0, At, B0); PG8_MMA(1, 1, At, B1); PG8_BAR; PG8_SCHED;
            } else {
            PG8_LDB(B0, 0, 0); PG8_SCHED; PG8_LDA(At, 0, 0); PG8_STAGE(PG8_SA(1, 1), a1 + hstep, voffA);
            PG8_WAIT_L(8); PG8_BAR; PG8_WAIT_L(0); PG8_MMA(0, 0, At, B0); PG8_BAR; PG8_SCHED;
            PG8_LDB(B1, 0, 1); PG8_STAGE(PG8_SB(0, 0), b2, voffB);
            PG8_BAR; PG8_WAIT_L(0); PG8_MMA(0, 1, At, B1); PG8_BAR;
            PG8_LDA(At, 0, 1); PG8_STAGE(PG8_SA(0, 0), a2, voffA);
            PG8_BAR; PG8_WAIT_L(0); PG8_MMA(1, 0, At, B0); PG8_BAR; PG8_SCHED;
            PG8_STAGE(PG8_SB(0, 1), b2 + hstep, voffB);
            PG8_WAIT_V(6); PG8_BAR; PG8_MMA(1, 1, At, B1); PG8_BAR;
            PG8_LDB(B0, 1, 0); PG8_SCHED; PG8_LDA(At, 1, 0); PG8_STAGE(PG8_SA(0, 1), a2 + hstep, voffA);
            PG8_WAIT_L(8); PG8_BAR; PG8_WAIT_L(0); PG8_MMA(0, 0, At, B0); PG8_BAR; PG8_SCHED;
            PG8_LDB(B1, 1, 1); PG8_STAGE(PG8_SB(1, 0), b3, voffB);
            PG8_BAR; PG8_WAIT_L(0); PG8_MMA(0, 1, At, B1); PG8_BAR;
            PG8_LDA(At, 1, 1); PG8_STAGE(PG8_SA(1, 0), a3, voffA);
            PG8_BAR; PG8_WAIT_L(0); PG8_MMA(1, 0, At, B0); PG8_BAR; PG8_SCHED;
            PG8_STAGE(PG8_SB(1, 1), b3 + hstep, voffB);
            PG8_WAIT_V(6); PG8_BAR; PG8_MMA(1, 1, At, B1); PG8_BAR;
            }
        }
        if constexpr (ALIGN_EPI) { if (wr == 0) PG8_BAR; }
        if constexpr (!Epi::AFTER_DRAIN) { E(acc, cur, wr, wc, fr, fq); S.done(cur); }
        if (!has_next) break;
#pragma unroll
        for (int a = 0; a < 2; ++a)
#pragma unroll
            for (int b = 0; b < 2; ++b)
#pragma unroll
                for (int m = 0; m < 4; ++m)
#pragma unroll
                    for (int n = 0; n < 2; ++n) acc[a][b][m][n] = (f32x4){0.f, 0.f, 0.f, 0.f};
        cur = nxt; cA = nA; cB = nB; ++ui;
        if constexpr (ALIGN_EPI) { if (wr == 1) PG8_BAR; }
    }
    PG8_WAIT_V(0);
    if constexpr (!ALIGN_EPI) { if (wr == 0) PG8_BAR; }
    PG8_BAR;
    if constexpr (Epi::AFTER_DRAIN) { E.fused(acc, cur, wr, wc, fr, fq, lds, wid, lane); S.done(cur); }
#undef PG8_SA
#undef PG8_SB
#undef PG8_STAGE
#undef PG8_LDA
#undef PG8_LDB
#undef PG8_MMA
#undef PG8_WAIT_V
#undef PG8_WAIT_L
#undef PG8_BAR
#undef PG8_SCHED
}
}
#define LAS __attribute__((address_space(3)))
#define GAS __attribute__((address_space(1)))
typedef GAS unsigned gu32;
typedef GAS unsigned long long gu64;
#define RLX_AGENT __ATOMIC_RELAXED, __HIP_MEMORY_SCOPE_AGENT
#define LDS_WAIT() asm volatile("s_waitcnt lgkmcnt(0)" ::: "memory")
#define VM_WAIT() asm volatile("s_waitcnt vmcnt(0)" ::: "memory")
__device__ __forceinline__ unsigned long long rt() { return __builtin_amdgcn_s_memrealtime(); }
#define XB_TMO      128
#define XB_XCNT(j)  (256  + 64 * (j))
#define XB_XSUB(j)  (1280 + 64 * (j))
#define XB_XGEN(j)  (2304 + 64 * (j))
#define XB_TOP      3328
#define XB_TOPGEN   3392
#define XCD_BAR_WORDS 3456
#define XB_SPIN_CAP (1u << 18)

__device__ __forceinline__ unsigned xb_ld(unsigned* p)              { return __hip_atomic_load(p, __ATOMIC_RELAXED, __HIP_MEMORY_SCOPE_AGENT); }
__device__ __forceinline__ unsigned xb_add(unsigned* p, unsigned v) { return __hip_atomic_fetch_add(p, v, __ATOMIC_RELAXED, __HIP_MEMORY_SCOPE_AGENT); }
__device__ __forceinline__ unsigned xb_xcc_id() { return (unsigned)__builtin_amdgcn_s_getreg((3 << 11) | 20) & 0xFu; }
#define XB_SPIN(cond, bar) do { unsigned _sp = 0; while (cond) { __builtin_amdgcn_s_sleep(1); \
    if ((++_sp & 255u) == 0u) { if (xb_ld(&(bar)[XB_TMO])) break; if (_sp > XB_SPIN_CAP) { atomicAdd(&(bar)[XB_TMO], 1u); break; } } } } while (0)

struct XcdBarrier {
    unsigned* bar; unsigned x;
    volatile LAS unsigned* st;
};

__device__ __forceinline__ XcdBarrier xcd_barrier_post(unsigned* bar, volatile LAS unsigned* st, const bool t0) {
    XcdBarrier b; b.bar = bar; b.x = xb_xcc_id(); b.st = st;
    if (t0) (void)xb_add(&bar[XB_XCNT(b.x)], 1u);
    return b;
}
__device__ __forceinline__ void xcd_barrier_complete(unsigned* bar, unsigned x, unsigned& nloc, unsigned& nx) {
    const unsigned G = gridDim.x * gridDim.y * gridDim.z;
    unsigned sum, cnt, mine, sp = 0u;
    for (;;) {
        sum = 0u; cnt = 0u; mine = 0u;
#pragma unroll
        for (unsigned j = 0; j < 16; ++j) { const unsigned c = xb_ld(&bar[XB_XCNT(j)]); sum += c; cnt += (c > 0u) ? 1u : 0u; mine = (j == x) ? c : mine; }
        if (sum == G) break;
        __builtin_amdgcn_s_sleep(1);
        if ((++sp & 255u) == 0u) { if (xb_ld(&bar[XB_TMO])) break; if (sp > XB_SPIN_CAP) { atomicAdd(&bar[XB_TMO], 1u); break; } }
    }
    nloc = mine > 0u ? mine : 1u; nx = cnt > 0u ? cnt : 1u;
}

__device__ __forceinline__ void xcd_barrier(const XcdBarrier& b, const bool t0) {
    asm volatile("s_waitcnt vmcnt(0)" ::: "memory");
    __syncthreads();
    if (t0) {
        unsigned* bar = b.bar;
        __builtin_amdgcn_s_waitcnt(0);
        unsigned nloc = b.st[0], nx = b.st[1];
        if (nloc == 0u) { xcd_barrier_complete(bar, b.x, nloc, nx); b.st[0] = nloc; b.st[1] = nx; }
        const unsigned old = xb_add(&bar[XB_XSUB(b.x)], 1u);
        const unsigned gen = old / nloc;
        if (old + 1u == (gen + 1u) * nloc) {
            __builtin_amdgcn_fence(__ATOMIC_RELEASE, "agent");
            asm volatile("s_waitcnt vmcnt(0)" ::: "memory");
            const unsigned og = xb_add(&bar[XB_TOP], 1u);
            const unsigned tg = og / nx;
            if (og + 1u == (tg + 1u) * nx) xb_add(&bar[XB_TOPGEN], 1u);
            else XB_SPIN(xb_ld(&bar[XB_TOPGEN]) == tg, bar);
            __builtin_amdgcn_fence(__ATOMIC_ACQUIRE, "agent");
            xb_add(&bar[XB_XGEN(b.x)], 1u);
            asm volatile("s_waitcnt vmcnt(0)" ::: "memory");
        } else {
            XB_SPIN(xb_ld(&bar[XB_XGEN(b.x)]) == gen, bar);
            __builtin_amdgcn_fence(__ATOMIC_ACQUIRE, "agent");
            asm volatile("s_waitcnt vmcnt(0)" ::: "memory");
        }
    }
    __syncthreads();
}
constexpr int BATCH = 2, SEQ = 16384, DM = 2048, MTOK = BATCH * SEQ;
constexpr int E_IN = 6144, O_INP = 8448  , O_LD = 8192;
constexpr int S5G = 64, S5P = 64, S5T = 128, S5NC = SEQ / S5T;
constexpr float LOG2E = 1.4426950408889634f;
constexpr float RMS_EPS = 1e-6f;
constexpr int NWAVES = 8;

#define LAS __attribute__((address_space(3)))
typedef unsigned short bf16_t;
typedef short bf16x8 __attribute__((ext_vector_type(8)));
typedef float f32x4 __attribute__((ext_vector_type(4)));
typedef float f32x2 __attribute__((ext_vector_type(2)));
typedef float f32x16 __attribute__((ext_vector_type(16)));
typedef unsigned u32x4 __attribute__((ext_vector_type(4)));
typedef unsigned u32x2 __attribute__((ext_vector_type(2)));
typedef short v4i16_t __attribute__((ext_vector_type(4)));
typedef __bf16 bf16x2_t __attribute__((ext_vector_type(2)));

constexpr size_t MiB = 1u << 20;
constexpr size_t WS_CTL = 0;
constexpr size_t WS_LAMB = 1 * MiB;
constexpr size_t WS_LAMT = 1 * MiB + 65536;
constexpr size_t WS_BBAR = 2 * MiB;
constexpr size_t WS_CMAT = 3 * MiB;
constexpr size_t WS_BIASDA = 4 * MiB;
constexpr size_t WS_BIASF = 5 * MiB;
constexpr size_t WS_FLOG = 7 * MiB;
constexpr size_t WS_S5ST = 9 * MiB;
constexpr size_t WS_WIN0 = 20 * MiB;
constexpr size_t WS_WOUT0 = 44 * MiB;
constexpr size_t WS_WGLU = 52 * MiB;
constexpr size_t WS_WIN1 = 54 * MiB;
constexpr size_t WS_WOUT1 = 87 * MiB;
constexpr size_t WS_HBUF = 96 * MiB;
constexpr size_t WS_PROJ = 224 * MiB;
constexpr size_t WS_YCAT = 736 * MiB;
constexpr size_t WS_END = 864 * MiB;
constexpr int CW_BAR = 4096;
constexpr int CW_QDA = 64, CW_QFOX = 128, CW_LAM = 192, CW_THRDA = 193, CW_THRF = 194;
constexpr float ZERO_THR = 105.f;

constexpr int LDS_MISC = 135168;
constexpr int LDS_BYTES = 147456;
constexpr int AL_K = 0, AL_V = 32768, AL_B = 65536;
constexpr int LDS_STASH = 69632;

__device__ __forceinline__ float bf2f(unsigned b) { return __uint_as_float(b << 16); }
__device__ __forceinline__ unsigned pk2(float lo, float hi) { f32x2 v = {lo, hi}; bf16x2_t b = __builtin_convertvector(v, bf16x2_t); return __builtin_bit_cast(unsigned, b); }
__device__ __forceinline__ float bflo(unsigned w) { return __uint_as_float(w << 16); }
__device__ __forceinline__ float bfhi(unsigned w) { return __uint_as_float(w & 0xffff0000u); }
__device__ __forceinline__ float sigmoidf_(float x) { return 1.f / (1.f + __expf(-x)); }
__device__ __forceinline__ float siluf_(float x) { return x * sigmoidf_(x); }
__device__ __forceinline__ float gelu_tanh(float x) { const float z = 0.7978845608028654f * (x + 0.044715f * x * x * x); const float t = 1.f - 2.f / (1.f + __expf(2.f * z)); return 0.5f * x * (1.f + t); }
#define DOT2(a, b, c) __builtin_amdgcn_fdot2_f32_bf16(__builtin_bit_cast(bf16x2_t, (unsigned)(a)), __builtin_bit_cast(bf16x2_t, (unsigned)(b)), (c), false)
__device__ __forceinline__ int crow(int r, int hi) { return (r & 3) + 8 * (r >> 2) + 4 * hi; }
__device__ __forceinline__ float wave_sum(float v) {
#pragma unroll
    for (int o = 1; o < 64; o <<= 1) v += __shfl_xor(v, o);
    return v;
}

struct Args {
    const float* in[27];
    float* out; unsigned char* ws;
    int ph_lo, ph_hi;
};

namespace pg8 {
struct EpiProj1 {
    static constexpr bool PERM = true, AFTER_DRAIN = false;
    bf16_t* O; float* flog;
    __device__ __forceinline__ void operator()(const f32x4 (&acc)[2][2][4][2], const Unit& u, int wr, int wc, int fr, int fq) const {
        const int row0 = u.pm * BM + wr * 64 + fr;
        if (u.pn < 32) {
            const int col0 = u.pn * BM + wc * 32 + 8 * fq;
#pragma unroll
            for (int ai = 0; ai < 2; ++ai)
#pragma unroll
                for (int m = 0; m < 4; ++m) { bf16_t* rowp = O + (size_t)(row0 + ai * HALF + m * 16) * O_LD + col0;
#pragma unroll
                    for (int bj = 0; bj < 2; ++bj) { const f32x4 v0 = acc[ai][bj][m][0], v1 = acc[ai][bj][m][1];
                        u32x4 w; w.x = cvt_pk_bf16(v0[0], v0[1]); w.y = cvt_pk_bf16(v0[2], v0[3]); w.z = cvt_pk_bf16(v1[0], v1[1]); w.w = cvt_pk_bf16(v1[2], v1[3]);
                        *(u32x4*)(rowp + bj * HALF) = w; } }
        } else if (wc == 0 && fq < 2) {
#pragma unroll
            for (int ai = 0; ai < 2; ++ai)
#pragma unroll
                for (int m = 0; m < 4; ++m) { float* rp = flog + (size_t)(row0 + ai * HALF + m * 16) * 16 + 8 * fq;
                    *(f32x4*)(rp) = acc[ai][0][m][0]; *(f32x4*)(rp + 4) = acc[ai][0][m][1]; }
        }
    }
};
struct EpiGlu {
    static constexpr bool PERM = true, AFTER_DRAIN = false;
    bf16_t* O; const bf16_t* yg; const bf16_t* proj0; const float* bglu;
    __device__ __forceinline__ void operator()(const f32x4 (&acc)[2][2][4][2], const Unit& u, int wr, int wc, int fr, int fq) const {
        const int row0 = u.pm * BM + wr * 64 + fr; const int col0 = u.pn * BM + wc * 32 + 8 * fq;
#pragma unroll
        for (int ai = 0; ai < 2; ++ai)
#pragma unroll
            for (int m = 0; m < 4; ++m) { const size_t row = (size_t)(row0 + ai * HALF + m * 16);
#pragma unroll
                for (int bj = 0; bj < 2; ++bj) { const int c = col0 + bj * HALF;
                    const f32x4 b0 = *(const f32x4*)(bglu + c), b1 = *(const f32x4*)(bglu + c + 4);
                    const u32x4 yv = *(const u32x4*)(yg + row * 1024 + c); const u32x4 zv = *(const u32x4*)(proj0 + row * E_IN + 1024 + c);
                    const f32x4 v0 = acc[ai][bj][m][0] + b0, v1 = acc[ai][bj][m][1] + b1;
                    float r[8];
#pragma unroll
                    for (int e = 0; e < 4; ++e) { const unsigned yw = yv[e], zw = zv[e];
                        const float a0 = e < 2 ? v0[2 * e] : v1[2 * e - 4], a1 = e < 2 ? v0[2 * e + 1] : v1[2 * e - 3];
                        r[2 * e] = bflo(yw) * sigmoidf_(a0) * siluf_(bflo(zw)); r[2 * e + 1] = bfhi(yw) * sigmoidf_(a1) * siluf_(bfhi(zw)); }
                    u32x4 w; w.x = cvt_pk_bf16(r[0], r[1]); w.y = cvt_pk_bf16(r[2], r[3]); w.z = cvt_pk_bf16(r[4], r[5]); w.w = cvt_pk_bf16(r[6], r[7]);
                    *(u32x4*)(O + row * DM + c) = w; } }
    }
};
struct EpiResid {
    static constexpr bool PERM = false, AFTER_DRAIN = false;
    const float* base; float* out;
    __device__ __forceinline__ void operator()(const f32x4 (&acc)[2][2][4][2], const Unit& u, int wr, int wc, int fr, int fq) const {
        const int row0 = u.pm * BM + wr * 64 + fr; const int col0 = u.pn * BM + wc * 32 + 4 * fq;
#pragma unroll
        for (int ai = 0; ai < 2; ++ai)
#pragma unroll
            for (int m = 0; m < 4; ++m) { const size_t off = (size_t)(row0 + ai * HALF + m * 16) * DM + col0;
#pragma unroll
                for (int bj = 0; bj < 2; ++bj)
#pragma unroll
                    for (int n = 0; n < 2; ++n) { const f32x4 bs = *(const f32x4*)(base + off + bj * HALF + n * 16); *(f32x4*)(out + off + bj * HALF + n * 16) = bs + acc[ai][bj][m][n]; } }
    }
};
}

__device__ __forceinline__ void transpose_item(const float* __restrict__ W, int K, int N, bf16_t* __restrict__ WT, LAS float* scr, int item, int nblk, int lane) {
    const int kb = item / nblk, nb = item % nblk, k0 = 64 * kb, n0 = 32 * nb;
    const int nc = n0 + (lane & 31);
#pragma unroll 8
    for (int i = 0; i < 32; ++i) { const int kk = 2 * i + (lane >> 5); scr[kk * 33 + (lane & 31)] = (nc < N) ? W[(size_t)(k0 + kk) * N + nc] : 0.f; }
    asm volatile("s_waitcnt lgkmcnt(0)" ::: "memory");
    const int c = lane & 7;
#pragma unroll
    for (int j = 0; j < 4; ++j) { const int n = (lane >> 3) + 8 * j; const LAS float* s = scr + (8 * c) * 33 + n;
        u32x4 o; o.x = pk2(s[0 * 33], s[1 * 33]); o.y = pk2(s[2 * 33], s[3 * 33]); o.z = pk2(s[4 * 33], s[5 * 33]); o.w = pk2(s[6 * 33], s[7 * 33]);
        *(u32x4*)(WT + (size_t)(n0 + n) * K + k0 + 8 * c) = o; }
    asm volatile("s_waitcnt lgkmcnt(0)" ::: "memory");
}
__device__ __forceinline__ void rms_row_to_bf16(const float* __restrict__ xrow, const float* __restrict__ gain, bf16_t* __restrict__ orow, int lane) {
    const f32x4* xr = (const f32x4*)xrow + lane; const f32x4* gr = (const f32x4*)gain + lane;
    f32x4 v[8]; float s = 0.f;
#pragma unroll
    for (int j = 0; j < 8; ++j) { v[j] = xr[64 * j]; s += (v[j].x * v[j].x + v[j].y * v[j].y) + (v[j].z * v[j].z + v[j].w * v[j].w); }
    const float r = 1.f / sqrtf(wave_sum(s) * (1.f / DM) + RMS_EPS);
    u32x2* o8 = (u32x2*)orow + lane;
#pragma unroll
    for (int j = 0; j < 8; ++j) { const f32x4 g = gr[64 * j]; u32x2 w; w.x = pk2(v[j].x * r * g.x, v[j].y * r * g.y); w.y = pk2(v[j].z * r * g.z, v[j].w * r * g.w); o8[64 * j] = w; }
}
template <int LPS>
__device__ __forceinline__ void qknorm16(bf16_t* p, const float* __restrict__ gain16, float mul, float inv_n) {
    u32x4 a = *(u32x4*)p, b = *(u32x4*)(p + 8);
    float v[16];
#pragma unroll
    for (int e = 0; e < 4; ++e) { v[2 * e] = bflo(a[e]); v[2 * e + 1] = bfhi(a[e]); v[8 + 2 * e] = bflo(b[e]); v[9 + 2 * e] = bfhi(b[e]); }
    float s = 0.f;
#pragma unroll
    for (int e = 0; e < 16; ++e) s += v[e] * v[e];
#pragma unroll
    for (int o = 1; o < LPS; o <<= 1) s += __shfl_xor(s, o);
    const float r = mul / sqrtf(s * inv_n + RMS_EPS);
#pragma unroll
    for (int e = 0; e < 16; ++e) v[e] = v[e] * r * gain16[e];
#pragma unroll
    for (int e = 0; e < 4; ++e) { a[e] = pk2(v[2 * e], v[2 * e + 1]); b[e] = pk2(v[8 + 2 * e], v[9 + 2 * e]); }
    *(u32x4*)p = a; *(u32x4*)(p + 8) = b;
}
__device__ __forceinline__ void rms_rows2_to_bf16(const float* __restrict__ x0, const float* __restrict__ x1, const bool has1, const float* __restrict__ gain, bf16_t* __restrict__ o0, bf16_t* __restrict__ o1, int lane) {
    const f32x4* xr0 = (const f32x4*)x0 + lane; const f32x4* xr1 = (const f32x4*)x1 + lane; const f32x4* gr = (const f32x4*)gain + lane;
    f32x4 v[8], w[8]; float s0 = 0.f, s1 = 0.f;
#pragma unroll
    for (int j = 0; j < 8; ++j) v[j] = xr0[64 * j];
    if (has1) {
#pragma unroll
        for (int j = 0; j < 8; ++j) w[j] = xr1[64 * j];
    }
#pragma unroll
    for (int j = 0; j < 8; ++j) s0 += (v[j].x * v[j].x + v[j].y * v[j].y) + (v[j].z * v[j].z + v[j].w * v[j].w);
    const float r0 = 1.f / sqrtf(wave_sum(s0) * (1.f / DM) + RMS_EPS);
    u32x2* p0 = (u32x2*)o0 + lane;
#pragma unroll
    for (int j = 0; j < 8; ++j) { const f32x4 g = gr[64 * j]; u32x2 q; q.x = pk2(v[j].x * r0 * g.x, v[j].y * r0 * g.y); q.y = pk2(v[j].z * r0 * g.z, v[j].w * r0 * g.w); p0[64 * j] = q; }
    if (has1) {
#pragma unroll
        for (int j = 0; j < 8; ++j) s1 += (w[j].x * w[j].x + w[j].y * w[j].y) + (w[j].z * w[j].z + w[j].w * w[j].w);
        const float r1 = 1.f / sqrtf(wave_sum(s1) * (1.f / DM) + RMS_EPS);
        u32x2* p1 = (u32x2*)o1 + lane;
#pragma unroll
        for (int j = 0; j < 8; ++j) { const f32x4 g = gr[64 * j]; u32x2 q; q.x = pk2(w[j].x * r1 * g.x, w[j].y * r1 * g.y); q.y = pk2(w[j].z * r1 * g.z, w[j].w * r1 * g.w); p1[64 * j] = q; }
    }
}
template <int LPS>
__device__ __forceinline__ void qknorm_regs(u32x4& a, u32x4& b, const float* __restrict__ gp, float mul, float inv_n) {
    float v[16];
#pragma unroll
    for (int e = 0; e < 4; ++e) { v[2 * e] = bflo(a[e]); v[2 * e + 1] = bfhi(a[e]); v[8 + 2 * e] = bflo(b[e]); v[9 + 2 * e] = bfhi(b[e]); }
    float s = 0.f;
#pragma unroll
    for (int e = 0; e < 16; ++e) s += v[e] * v[e];
#pragma unroll
    for (int o = 1; o < LPS; o <<= 1) s += __shfl_xor(s, o);
    const float r = mul / sqrtf(s * inv_n + RMS_EPS);
#pragma unroll
    for (int e = 0; e < 4; ++e) { const f32x4 gg = *(const f32x4*)(gp + 4 * e);
        v[4 * e] *= r * gg.x; v[4 * e + 1] *= r * gg.y; v[4 * e + 2] *= r * gg.z; v[4 * e + 3] *= r * gg.w; }
#pragma unroll
    for (int e = 0; e < 4; ++e) { a[e] = pk2(v[2 * e], v[2 * e + 1]); b[e] = pk2(v[8 + 2 * e], v[9 + 2 * e]); }
}
template <int NIT, int NQ, int LPS>
__device__ __forceinline__ void qknorm_rows2(bf16_t* p0, bf16_t* p1, const bool has1, const float* __restrict__ gq, const float* __restrict__ gk, const float qmul, const float inv_n, const int lane) {
    u32x4 a0[NIT], b0[NIT], a1[NIT], b1[NIT];
#pragma unroll
    for (int it = 0; it < NIT; ++it) { a0[it] = *(const u32x4*)(p0 + it * 1024 + lane * 16); b0[it] = *(const u32x4*)(p0 + it * 1024 + lane * 16 + 8); }
    if (has1) {
#pragma unroll
        for (int it = 0; it < NIT; ++it) { a1[it] = *(const u32x4*)(p1 + it * 1024 + lane * 16); b1[it] = *(const u32x4*)(p1 + it * 1024 + lane * 16 + 8); }
    }
#pragma unroll
    for (int it = 0; it < NIT; ++it) { const float* gp = (it < NQ ? gq : gk) + ((lane * 16) & 127);
        qknorm_regs<LPS>(a0[it], b0[it], gp, it < NQ ? qmul : 1.f, inv_n);
        *(u32x4*)(p0 + it * 1024 + lane * 16) = a0[it]; *(u32x4*)(p0 + it * 1024 + lane * 16 + 8) = b0[it]; }
    if (has1) {
#pragma unroll
        for (int it = 0; it < NIT; ++it) { const float* gp = (it < NQ ? gq : gk) + ((lane * 16) & 127);
            qknorm_regs<LPS>(a1[it], b1[it], gp, it < NQ ? qmul : 1.f, inv_n);
            *(u32x4*)(p1 + it * 1024 + lane * 16) = a1[it]; *(u32x4*)(p1 + it * 1024 + lane * 16 + 8) = b1[it]; }
    }
}

template <int DQK>
__device__ __forceinline__ void attn_pass(LAS unsigned char* lds, const bf16_t* __restrict__ Qg, const bf16_t* __restrict__ Kg, const bf16_t* __restrict__ Vg,
                                          const float* __restrict__ btab, const float bscale, const int pitch, const int q0, const int t_lo, f32x16 (&o)[4], const int wid, const int lane) {
    constexpr int NCH = DQK / 8, KS = DQK / 16, KROWB = DQK * 2, KI = NCH / 8;
    const int tid = wid * 64 + lane, r32 = lane & 31, hi = lane >> 5;
    const int NT = (q0 + 256) / 64;
    const int qrel = wid * 32 + r32;
    bf16x8 qf[KS];
#pragma unroll
    for (int s = 0; s < KS; ++s) qf[s] = *(const bf16x8*)(Qg + (size_t)(q0 + qrel) * pitch + 16 * s + 8 * hi);
    int kgo[KI], klo[KI], vgo[2], vlo[2];
#pragma unroll
    for (int i = 0; i < KI; ++i) { const int cid = tid + 512 * i, row = cid / NCH, ch = cid % NCH; const int sw = (DQK == 128) ? (row & 15) : ((row >> 1) & 7);
        kgo[i] = row * pitch + ch * 8; klo[i] = row * KROWB + ((ch ^ sw) << 4); }
#pragma unroll
    for (int i = 0; i < 2; ++i) { const int cid = tid + 512 * i, row = cid >> 4, ch = cid & 15;
        vgo[i] = row * pitch + ch * 8; vlo[i] = (ch >> 2) * 4096 + (row >> 3) * 512 + (row & 7) * 64 + (ch & 3) * 16; }
    const float bref = btab[q0];
    u32x4 kreg[KI], vreg[2]; float breg = 0.f;
#define AT_LOAD(t) do { const size_t kvb_ = (size_t)(64 * (t)) * pitch; \
        _Pragma("unroll") for (int i = 0; i < KI; ++i) kreg[i] = *(const u32x4*)(Kg + kvb_ + kgo[i]); \
        _Pragma("unroll") for (int i = 0; i < 2; ++i) vreg[i] = *(const u32x4*)(Vg + kvb_ + vgo[i]); \
        if (tid < 64) breg = (btab[64 * (t) + tid] - bref) * bscale; } while (0)
#define AT_STORE(buf) do { \
        _Pragma("unroll") for (int i = 0; i < KI; ++i) *(LAS u32x4*)(lds + AL_K + (buf) * 16384 + klo[i]) = kreg[i]; \
        _Pragma("unroll") for (int i = 0; i < 2; ++i) *(LAS u32x4*)(lds + AL_V + (buf) * 16384 + vlo[i]) = vreg[i]; \
        if (tid < 64) *(LAS float*)(lds + AL_B + (buf) * 256 + tid * 4) = breg; } while (0)
    float m_run = -INFINITY, l_run = 0.f;
#pragma unroll
    for (int b = 0; b < 4; ++b)
#pragma unroll
        for (int r = 0; r < 16; ++r) o[b][r] = 0.f;
    AT_LOAD(t_lo); AT_STORE(0); __syncthreads();
    const int ksw = (DQK == 128) ? (r32 & 15) : ((r32 >> 1) & 7);
    const int vlane = (4 * hi + ((lane & 15) >> 2)) * 64 + ((lane >> 4) & 1) * 32 + (lane & 3) * 8;
    for (int t = t_lo; t < NT; ++t) {
        const int cur = (t - t_lo) & 1;
        if (t + 1 < NT) AT_LOAD(t + 1);
        const int jb = t - (NT - 4);
        const bool skip = (jb >= 0) && (2 * jb > wid);
        if (!skip) {
            LAS const unsigned char* Kb = lds + AL_K + cur * 16384;
            f32x16 s0, s1;
            LAS const float* bl = (LAS const float*)(lds + AL_B + cur * 256);
#pragma unroll
            for (int g = 0; g < 4; ++g) { const f32x4 b0 = *(LAS const f32x4*)(bl + 8 * g + 4 * hi), b1 = *(LAS const f32x4*)(bl + 32 + 8 * g + 4 * hi);
#pragma unroll
                for (int e = 0; e < 4; ++e) { s0[4 * g + e] = b0[e]; s1[4 * g + e] = b1[e]; } }
#pragma unroll
            for (int s = 0; s < KS; ++s) { const int ch = 2 * s + hi;
                const bf16x8 a0 = *(LAS const bf16x8*)(Kb + r32 * KROWB + ((ch ^ ksw) << 4));
                const bf16x8 a1 = *(LAS const bf16x8*)(Kb + (32 + r32) * KROWB + ((ch ^ ksw) << 4));
                s0 = __builtin_amdgcn_mfma_f32_32x32x16_bf16(a0, qf[s], s0, 0, 0, 0);
                s1 = __builtin_amdgcn_mfma_f32_32x32x16_bf16(a1, qf[s], s1, 0, 0, 0); }
            if ((jb >= 0) && (2 * jb + 1 >= wid)) {
#pragma unroll
                for (int r = 0; r < 16; ++r) { const int kv = 64 * jb + crow(r, hi); if (kv > qrel) s0[r] = -INFINITY; if (kv + 32 > qrel) s1[r] = -INFINITY; }
            }
            float mx = fmaxf(s0[0], s1[0]);
#pragma unroll
            for (int r = 1; r < 16; ++r) mx = fmaxf(mx, fmaxf(s0[r], s1[r]));
            mx = fmaxf(mx, __shfl_xor(mx, 32));
            if (__any(mx > m_run + 8.f)) {
                const float m_new = fmaxf(m_run, mx);
                const float alpha = __builtin_amdgcn_exp2f(m_run - m_new);
                m_run = m_new; l_run *= alpha;
#pragma unroll
                for (int b = 0; b < 4; ++b)
#pragma unroll
                    for (int r = 0; r < 16; ++r) o[b][r] *= alpha;
            }
            float rs = 0.f;
#pragma unroll
            for (int r = 0; r < 16; ++r) { s0[r] = __builtin_amdgcn_exp2f(s0[r] - m_run); s1[r] = __builtin_amdgcn_exp2f(s1[r] - m_run); rs += s0[r] + s1[r]; }
            l_run += rs;
            u32x4 pw[4];
#pragma unroll
            for (int e = 0; e < 4; ++e) { pw[0][e] = pk2(s0[2 * e], s0[2 * e + 1]); pw[1][e] = pk2(s0[8 + 2 * e], s0[9 + 2 * e]); pw[2][e] = pk2(s1[2 * e], s1[2 * e + 1]); pw[3][e] = pk2(s1[8 + 2 * e], s1[9 + 2 * e]); }
            LAS const unsigned char* Vb = lds + AL_V + cur * 16384 + vlane;
#pragma unroll
            for (int b = 0; b < 4; ++b)
#pragma unroll
                for (int ks = 0; ks < 4; ++ks) {
                    const v4i16_t lo = __builtin_amdgcn_ds_read_tr16_b64_v4i16((LAS v4i16_t*)(Vb + b * 4096 + ks * 1024));
                    const v4i16_t hh = __builtin_amdgcn_ds_read_tr16_b64_v4i16((LAS v4i16_t*)(Vb + b * 4096 + ks * 1024 + 512));
                    const bf16x8 af = {lo[0], lo[1], lo[2], lo[3], hh[0], hh[1], hh[2], hh[3]};
                    o[b] = __builtin_amdgcn_mfma_f32_32x32x16_bf16(af, __builtin_bit_cast(bf16x8, pw[ks]), o[b], 0, 0, 0);
                }
        }
        if (t + 1 < NT) AT_STORE(cur ^ 1);
        __syncthreads();
    }
#undef AT_LOAD
#undef AT_STORE
    const float l = l_run + __shfl_xor(l_run, 32);
    const float inv = 1.f / l;
#pragma unroll
    for (int b = 0; b < 4; ++b)
#pragma unroll
        for (int r = 0; r < 16; ++r) o[b][r] *= inv;
}

template <int DQK>
__device__ __forceinline__ void qk_tile(LAS const unsigned char* Kb, LAS const float* bl, const bf16x8* qf, const int ksw, const int r32, const int hi, f32x16& s0, f32x16& s1) {
    constexpr int KS = DQK / 16, KROWB = DQK * 2;
#pragma unroll
    for (int g = 0; g < 4; ++g) { const f32x4 b0 = *(LAS const f32x4*)(bl + 8 * g + 4 * hi), b1 = *(LAS const f32x4*)(bl + 32 + 8 * g + 4 * hi);
#pragma unroll
        for (int e = 0; e < 4; ++e) { s0[4 * g + e] = b0[e]; s1[4 * g + e] = b1[e]; } }
#pragma unroll
    for (int s = 0; s < KS; ++s) { const int ch = 2 * s + hi;
        const bf16x8 a0 = *(LAS const bf16x8*)(Kb + r32 * KROWB + ((ch ^ ksw) << 4));
        const bf16x8 a1 = *(LAS const bf16x8*)(Kb + (32 + r32) * KROWB + ((ch ^ ksw) << 4));
        s0 = __builtin_amdgcn_mfma_f32_32x32x16_bf16(a0, qf[s], s0, 0, 0, 0);
        s1 = __builtin_amdgcn_mfma_f32_32x32x16_bf16(a1, qf[s], s1, 0, 0, 0); }
}
__device__ __forceinline__ void pv_tile(LAS const unsigned char* Vb, const u32x4* pw, f32x16 (&o)[4]) {
#pragma unroll
    for (int ks = 0; ks < 4; ++ks)
#pragma unroll
        for (int b = 0; b < 4; ++b) {
            const v4i16_t lo = __builtin_amdgcn_ds_read_tr16_b64_v4i16((LAS v4i16_t*)(Vb + b * 4096 + ks * 1024));
            const v4i16_t hh = __builtin_amdgcn_ds_read_tr16_b64_v4i16((LAS v4i16_t*)(Vb + b * 4096 + ks * 1024 + 512));
            const bf16x8 af = {lo[0], lo[1], lo[2], lo[3], hh[0], hh[1], hh[2], hh[3]};
            o[b] = __builtin_amdgcn_mfma_f32_32x32x16_bf16(af, __builtin_bit_cast(bf16x8, pw[ks]), o[b], 0, 0, 0);
        }
}
__device__ __forceinline__ void softmax_tile(f32x16& s0, f32x16& s1, float& m_run, float& l_run, float& alpha, bool& resc, u32x4* pw) {
    float mxa = __builtin_fmaxf(s0[0], s1[0]), mxb = __builtin_fmaxf(s0[1], s1[1]);
#pragma unroll
    for (int r = 2; r < 16; r += 2) { mxa = __builtin_fmaxf(__builtin_fmaxf(mxa, s0[r]), s1[r]); mxb = __builtin_fmaxf(__builtin_fmaxf(mxb, s0[r + 1]), s1[r + 1]); }
    float mx = __builtin_fmaxf(mxa, mxb);
    { auto rr = __builtin_amdgcn_permlane32_swap(__float_as_uint(mx), __float_as_uint(mx), false, false); mx = fmaxf(__uint_as_float(rr[0]), __uint_as_float(rr[1])); }
    resc = __any(mx > m_run + 8.f);
    alpha = 1.f;
    if (resc) { const float m_new = fmaxf(m_run, mx); alpha = __builtin_amdgcn_exp2f(m_run - m_new); m_run = m_new; l_run *= alpha; }
    float rs = 0.f;
#pragma unroll
    for (int r = 0; r < 16; ++r) { s0[r] = __builtin_amdgcn_exp2f(s0[r] - m_run); s1[r] = __builtin_amdgcn_exp2f(s1[r] - m_run); rs += s0[r] + s1[r]; }
    l_run += rs;
#pragma unroll
    for (int e = 0; e < 4; ++e) { pw[0][e] = pk2(s0[2 * e], s0[2 * e + 1]); pw[1][e] = pk2(s0[8 + 2 * e], s0[9 + 2 * e]); pw[2][e] = pk2(s1[2 * e], s1[2 * e + 1]); pw[3][e] = pk2(s1[8 + 2 * e], s1[9 + 2 * e]); }
}
__device__ __forceinline__ void softmax_tile_sm(f32x16& s0, f32x16& s1, float& m_run, float& l_run, float& alpha, bool& resc, u32x4* pw, const bool skipmax) {
    resc = false; alpha = 1.f;
    if (!skipmax) {
    float mxa = __builtin_fmaxf(s0[0], s1[0]), mxb = __builtin_fmaxf(s0[1], s1[1]);
#pragma unroll
    for (int r = 2; r < 16; r += 2) { mxa = __builtin_fmaxf(__builtin_fmaxf(mxa, s0[r]), s1[r]); mxb = __builtin_fmaxf(__builtin_fmaxf(mxb, s0[r + 1]), s1[r + 1]); }
    float mx = __builtin_fmaxf(mxa, mxb);
    { auto rr = __builtin_amdgcn_permlane32_swap(__float_as_uint(mx), __float_as_uint(mx), false, false); mx = fmaxf(__uint_as_float(rr[0]), __uint_as_float(rr[1])); }
    resc = __any(mx > m_run + 8.f);
    alpha = 1.f;
    if (resc) { const float m_new = fmaxf(m_run, mx); alpha = __builtin_amdgcn_exp2f(m_run - m_new); m_run = m_new; l_run *= alpha; }
    }
    float rs = 0.f;
#pragma unroll
    for (int r = 0; r < 16; ++r) { s0[r] = __builtin_amdgcn_exp2f(s0[r] - m_run); s1[r] = __builtin_amdgcn_exp2f(s1[r] - m_run); rs += s0[r] + s1[r]; }
    l_run += rs;
#pragma unroll
    for (int e = 0; e < 4; ++e) { pw[0][e] = pk2(s0[2 * e], s0[2 * e + 1]); pw[1][e] = pk2(s0[8 + 2 * e], s0[9 + 2 * e]); pw[2][e] = pk2(s1[2 * e], s1[2 * e + 1]); pw[3][e] = pk2(s1[8 + 2 * e], s1[9 + 2 * e]); }
}
template <int DQK>
__device__ __forceinline__ void attn_pass2(LAS unsigned char* lds, const bf16_t* __restrict__ Qg, const bf16_t* __restrict__ Kg, const bf16_t* __restrict__ Vg,
                                           const float* __restrict__ btab, const float bscale, const int pitch, const int q0, const int t_lo, f32x16 (&o)[4], const int wid, const int lane) {
    constexpr int NCH = DQK / 8, KS = DQK / 16, KROWB = DQK * 2, KI = NCH / 8;
    const int tid = wid * 64 + lane, r32 = lane & 31, hi = lane >> 5;
    const int NT = (q0 + 256) / 64;
    const int T_w = NT - 4 + (wid >> 1);
    const int qrel = wid * 32 + r32;
    bf16x8 qf[KS];
#pragma unroll
    for (int s = 0; s < KS; ++s) qf[s] = *(const bf16x8*)(Qg + (size_t)(q0 + qrel) * pitch + 16 * s + 8 * hi);
    int kgo[KI], klo[KI], vgo[2], vlo[2];
#pragma unroll
    for (int i = 0; i < KI; ++i) { const int cid = tid + 512 * i, row = cid / NCH, ch = cid % NCH; const int sw = (DQK == 128) ? (row & 15) : ((row >> 1) & 7);
        kgo[i] = row * pitch + ch * 8; klo[i] = row * KROWB + ((ch ^ sw) << 4); }
#pragma unroll
    for (int i = 0; i < 2; ++i) { const int cid = tid + 512 * i, row = cid >> 4, ch = cid & 15;
        vgo[i] = row * pitch + ch * 8; vlo[i] = (ch >> 2) * 4096 + (row >> 3) * 512 + (row & 7) * 64 + (ch & 3) * 16; }
    const float bref = btab[q0];
    u32x4 kreg[KI], vreg[2]; float breg = 0.f;
#define AT_LOADK(t) do { const size_t kvb_ = (size_t)(64 * (t)) * pitch; \
        _Pragma("unroll") for (int i = 0; i < KI; ++i) kreg[i] = *(const u32x4*)(Kg + kvb_ + kgo[i]); \
        if (tid < 64) breg = (btab[64 * (t) + tid] - bref) * bscale; } while (0)
#define AT_LOADV(t) do { const size_t kvb_ = (size_t)(64 * (t)) * pitch; \
        _Pragma("unroll") for (int i = 0; i < 2; ++i) vreg[i] = *(const u32x4*)(Vg + kvb_ + vgo[i]); } while (0)
#define AT_STOREK(buf) do { \
        _Pragma("unroll") for (int i = 0; i < KI; ++i) *(LAS u32x4*)(lds + AL_K + (buf) * 16384 + klo[i]) = kreg[i]; \
        if (tid < 64) *(LAS float*)(lds + AL_B + (buf) * 256 + tid * 4) = breg; } while (0)
#define AT_STOREV(buf) do { \
        _Pragma("unroll") for (int i = 0; i < 2; ++i) *(LAS u32x4*)(lds + AL_V + (buf) * 16384 + vlo[i]) = vreg[i]; } while (0)
    float m_run = -INFINITY, l_run = 0.f;
#pragma unroll
    for (int b = 0; b < 4; ++b)
#pragma unroll
        for (int r = 0; r < 16; ++r) o[b][r] = 0.f;
    const int ksw = (DQK == 128) ? (r32 & 15) : ((r32 >> 1) & 7);
    const int vlane = (4 * hi + ((lane & 15) >> 2)) * 64 + ((lane >> 4) & 1) * 32 + (lane & 3) * 8;
    AT_LOADK(t_lo); AT_STOREK(t_lo & 1);
    AT_LOADK(t_lo + 1); AT_STOREK((t_lo + 1) & 1);
    __syncthreads();
    f32x16 sc0, sc1, sn0, sn1;
    u32x4 pprev[4], pnew[4];
#pragma unroll
    for (int k = 0; k < 4; ++k) { pprev[k] = (u32x4){0u, 0u, 0u, 0u}; pnew[k] = (u32x4){0u, 0u, 0u, 0u}; }
    qk_tile<DQK>(lds + AL_K + (t_lo & 1) * 16384, (LAS const float*)(lds + AL_B + (t_lo & 1) * 256), qf, ksw, r32, hi, sc0, sc1);
#pragma unroll
    for (int r = 0; r < 16; ++r) { sn0[r] = 0.f; sn1[r] = 0.f; }
    for (int t = t_lo; t < NT; ++t) {
        const int pn = (t + 1) & 1, pc = t & 1;
        if (t + 2 < NT) AT_LOADK(t + 2);
        AT_LOADV(t);
        float alpha = 1.f; bool resc = false;
        if ((t > t_lo) && (t < NT - 4)) {
            qk_tile<DQK>(lds + AL_K + pn * 16384, (LAS const float*)(lds + AL_B + pn * 256), qf, ksw, r32, hi, sn0, sn1);
            pv_tile(lds + AL_V + pn * 16384 + vlane, pprev, o);
            softmax_tile(sc0, sc1, m_run, l_run, alpha, resc, pnew);
        } else {
            if (t + 1 <= T_w) qk_tile<DQK>(lds + AL_K + pn * 16384, (LAS const float*)(lds + AL_B + pn * 256), qf, ksw, r32, hi, sn0, sn1);
            if (t > t_lo && t - 1 <= T_w) pv_tile(lds + AL_V + pn * 16384 + vlane, pprev, o);
            if (t <= T_w) {
                const int jb = t - (NT - 4);
                if ((jb >= 0) && (2 * jb + 1 >= wid)) {
#pragma unroll
                    for (int r = 0; r < 16; ++r) { const int kv = 64 * jb + crow(r, hi); if (kv > qrel) sc0[r] = -INFINITY; if (kv + 32 > qrel) sc1[r] = -INFINITY; }
                }
                softmax_tile(sc0, sc1, m_run, l_run, alpha, resc, pnew);
            }
        }
        if (resc) {
#pragma unroll
            for (int b = 0; b < 4; ++b)
#pragma unroll
                for (int r = 0; r < 16; ++r) o[b][r] *= alpha;
        }
        if (t + 2 < NT) AT_STOREK(pc);
        AT_STOREV(pc);
        __syncthreads();
#pragma unroll
        for (int k = 0; k < 4; ++k) pprev[k] = pnew[k];
        sc0 = sn0; sc1 = sn1;
    }
    if (NT - 1 <= T_w) pv_tile(lds + AL_V + ((NT - 1) & 1) * 16384 + vlane, pprev, o);
    __syncthreads();
#undef AT_LOADK
#undef AT_LOADV
#undef AT_STOREK
#undef AT_STOREV
    const float l = l_run + __shfl_xor(l_run, 32);
    const float inv = 1.f / l;
#pragma unroll
    for (int b = 0; b < 4; ++b)
#pragma unroll
        for (int r = 0; r < 16; ++r) o[b][r] *= inv;
}

template <int DQK>
__device__ __forceinline__ void qk_tile_pf(LAS const unsigned char* Kb, LAS const float* bl, const bf16x8* qf, const int ksw, const int r32, const int hi, f32x16& s0, f32x16& s1) {
    constexpr int KS = DQK / 16, KROWB = DQK * 2;
    LAS const unsigned char* k0 = Kb + r32 * KROWB; LAS const unsigned char* k1 = Kb + (32 + r32) * KROWB;
    bf16x8 fa[2][2];
    { const int ch_ = hi; fa[0][0] = *(LAS const bf16x8*)(k0 + ((ch_ ^ ksw) << 4)); fa[0][1] = *(LAS const bf16x8*)(k1 + ((ch_ ^ ksw) << 4)); }
#pragma unroll
    for (int g = 0; g < 4; ++g) { const f32x4 b0 = *(LAS const f32x4*)(bl + 8 * g + 4 * hi), b1 = *(LAS const f32x4*)(bl + 32 + 8 * g + 4 * hi);
#pragma unroll
        for (int e = 0; e < 4; ++e) { s0[4 * g + e] = b0[e]; s1[4 * g + e] = b1[e]; } }
    __builtin_amdgcn_sched_barrier(0);
#pragma unroll
    for (int s = 0; s < KS; ++s) {
        if (s + 1 < KS) { const int ch_ = 2 * (s + 1) + hi; fa[(s + 1) & 1][0] = *(LAS const bf16x8*)(k0 + ((ch_ ^ ksw) << 4)); fa[(s + 1) & 1][1] = *(LAS const bf16x8*)(k1 + ((ch_ ^ ksw) << 4)); }
        s0 = __builtin_amdgcn_mfma_f32_32x32x16_bf16(fa[s & 1][0], qf[s], s0, 0, 0, 0);
        s1 = __builtin_amdgcn_mfma_f32_32x32x16_bf16(fa[s & 1][1], qf[s], s1, 0, 0, 0);
        __builtin_amdgcn_sched_barrier(0);
    }
}
__device__ __forceinline__ bool attn_static_ok(const float* __restrict__ btab, const float bscale, const float bq2, const int q0) {
    const float a = __uint_as_float(__builtin_amdgcn_readfirstlane(__float_as_uint(btab[q0]))), b = __uint_as_float(__builtin_amdgcn_readfirstlane(__float_as_uint(btab[q0 + 255])));
    return ((b - a) * bscale + bq2) <= 90.f;
}
template <int DQK, bool FASTM>
__device__ __forceinline__ void attn_pass3(LAS unsigned char* lds, const bf16_t* __restrict__ Qg, const bf16_t* __restrict__ Kg, const bf16_t* __restrict__ Vg,
                                           const float* __restrict__ btab, const float bscale, const float bq2, const int pitch, const int q0, const int t_lo, f32x16 (&o)[4], const int wid, const int lane_in) {
    constexpr int NCH = DQK / 8, KS = DQK / 16, KI = NCH / 8;
    int lane_l = lane_in; asm volatile("" : "+v"(lane_l));
    const int lane = lane_l, tid = wid * 64 + lane, r32 = lane & 31, hi = lane >> 5;
    const int NT = (q0 + 256) / 64;
    const int T_w = NT - 4 + (wid >> 1);
    const int qrel = wid * 32 + r32;
    bf16x8 qf[KS];
#pragma unroll
    for (int s = 0; s < KS; ++s) qf[s] = *(const bf16x8*)(Qg + (size_t)(q0 + qrel) * pitch + 16 * s + 8 * hi);
    int kgo0, vgo0;
    { const int p = wid * 64 + lane, row = p / NCH, cp = p % NCH; const int sw = (DQK == 128) ? (row & 15) : ((row >> 1) & 7); kgo0 = row * pitch + (cp ^ sw) * 8; }
    { const int p = wid * 64 + lane; const int row = ((p >> 5) & 7) * 8 + ((p >> 2) & 7), ch = (p >> 8) * 4 + (p & 3); vgo0 = row * pitch + ch * 8; }
    const float bref = __uint_as_float(__builtin_amdgcn_readfirstlane(__float_as_uint(btab[q0])));
    float breg = 0.f;
#define AT_DMAK(t, buf) do { const bf16_t* kp_ = Kg + (size_t)(64 * (t)) * pitch; \
        _Pragma("unroll") for (int i = 0; i < KI; ++i) __builtin_amdgcn_global_load_lds((const unsigned*)(kp_ + kgo0 + i * 32 * pitch), (LAS unsigned*)(lds + AL_K + (buf) * 16384 + (wid + 8 * i) * 1024), 16, 0, 0); } while (0)
#define AT_DMAV(t, buf) do { const bf16_t* vp_ = Vg + (size_t)(64 * (t)) * pitch; \
        _Pragma("unroll") for (int i = 0; i < 2; ++i) __builtin_amdgcn_global_load_lds((const unsigned*)(vp_ + vgo0 + i * 64), (LAS unsigned*)(lds + AL_V + (buf) * 16384 + (wid + 8 * i) * 1024), 16, 0, 0); } while (0)
    const float brm = (__uint_as_float(__builtin_amdgcn_readfirstlane(__float_as_uint(btab[q0 + 255]))) - bref) * bscale;
    constexpr bool fastm = FASTM;
    const float cshift = fastm ? (brm + 0.5f * bq2) : 0.f;
#define AT_LOADB(t) do { if (wid == 0) breg = btab[64 * (t) + lane]; } while (0)
#define AT_STOREB(buf) do { if (wid == 0) *(LAS float*)(lds + AL_B + (buf) * 256 + lane * 4) = (breg - bref) * bscale - cshift; } while (0)
    float m_run = fastm ? 0.f : -INFINITY, l_run = 0.f;
#pragma unroll
    for (int b = 0; b < 4; ++b)
#pragma unroll
        for (int r = 0; r < 16; ++r) o[b][r] = 0.f;
    const int ksw = (DQK == 128) ? (r32 & 15) : ((r32 >> 1) & 7);
    const int vlane = (4 * hi + ((lane & 15) >> 2)) * 64 + ((lane >> 4) & 1) * 32 + (lane & 3) * 8;
    const int t0 = t_lo & ~1;
    AT_DMAK(t0, 0); AT_DMAK(t0 + 1, 1); AT_DMAV(t0, 0);
    AT_LOADB(t0); AT_STOREB(0); AT_LOADB(t0 + 1); AT_STOREB(1);
    asm volatile("s_waitcnt vmcnt(0)" ::: "memory");
    __syncthreads();
    f32x16 sc0, sc1, sn0, sn1;
    u32x4 pw[4];
    qk_tile<DQK>(lds + AL_K, (LAS const float*)(lds + AL_B), qf, ksw, r32, hi, sc0, sc1);
#define P3_STEP(t, pc, pn, C0, C1, N0, N1) do { \
        if ((t) + 2 < NT) { AT_DMAK((t) + 2, pc); AT_LOADB((t) + 2); } \
        if ((t) + 1 < NT) AT_DMAV((t) + 1, pn); \
        float alpha = 1.f; bool resc = false; \
        if ((t) <= T_w) { \
            if ((t) < T_w) { \
                qk_tile<DQK>(lds + AL_K + (pn) * 16384, (LAS const float*)(lds + AL_B + (pn) * 256), qf, ksw, r32, hi, N0, N1); \
            } else { \
                const int jb = (t) - (NT - 4); \
                _Pragma("unroll") for (int r = 0; r < 16; ++r) { const int kv = 64 * jb + crow(r, hi); if (kv > qrel) C0[r] = -INFINITY; if (kv + 32 > qrel) C1[r] = -INFINITY; } \
            } \
            softmax_tile_sm(C0, C1, m_run, l_run, alpha, resc, pw, fastm); \
            if (resc) { \
                _Pragma("unroll") for (int b = 0; b < 4; ++b) _Pragma("unroll") for (int r = 0; r < 16; ++r) o[b][r] *= alpha; \
            } \
            pv_tile(lds + AL_V + (pc) * 16384 + vlane, pw, o); \
        } \
        if ((t) + 2 < NT) AT_STOREB(pc); \
        asm volatile("s_waitcnt vmcnt(0)" ::: "memory"); \
        __syncthreads(); } while (0)
#define P3_MAIN(t, pc, pn, C0, C1, N0, N1) do { \
        AT_DMAK((t) + 2, pc); AT_LOADB((t) + 2); AT_DMAV((t) + 1, pn); \
        float alpha = 1.f; bool resc = false; \
        qk_tile_pf<DQK>(lds + AL_K + (pn) * 16384, (LAS const float*)(lds + AL_B + (pn) * 256), qf, ksw, r32, hi, N0, N1); \
        softmax_tile_sm(C0, C1, m_run, l_run, alpha, resc, pw, fastm); \
        if (resc) { \
            _Pragma("unroll") for (int b = 0; b < 4; ++b) _Pragma("unroll") for (int r = 0; r < 16; ++r) o[b][r] *= alpha; \
        } \
        pv_tile(lds + AL_V + (pc) * 16384 + vlane, pw, o); \
        AT_STOREB(pc); \
        asm volatile("s_waitcnt vmcnt(0)" ::: "memory"); \
        __syncthreads(); } while (0)
    int opq_ = 0; asm volatile("s_mov_b32 %0, 0" : "=s"(opq_));
#define P3_FAST(t, pc, pn, C0, C1, N0, N1) do { \
        AT_DMAK((t) + 2, pc); AT_LOADB((t) + 2); AT_DMAV((t) + 1, pn); \
        qk_tile_pf<DQK>(lds + AL_K + (pn) * 16384, (LAS const float*)(lds + AL_B + (pn) * 256), qf, ksw, r32, hi, N0, N1); \
        if (__builtin_expect(opq_ != 0, 0)) { asm volatile("s_nop 0" ::: "memory"); } \
        { float rs_ = 0.f; \
          _Pragma("unroll") for (int r = 0; r < 16; ++r) { C0[r] = __builtin_amdgcn_exp2f(C0[r]); C1[r] = __builtin_amdgcn_exp2f(C1[r]); rs_ += C0[r] + C1[r]; } \
          l_run += rs_; \
          _Pragma("unroll") for (int e = 0; e < 4; ++e) { pw[0][e] = pk2(C0[2 * e], C0[2 * e + 1]); pw[1][e] = pk2(C0[8 + 2 * e], C0[9 + 2 * e]); pw[2][e] = pk2(C1[2 * e], C1[2 * e + 1]); pw[3][e] = pk2(C1[8 + 2 * e], C1[9 + 2 * e]); } } \
        pv_tile(lds + AL_V + (pc) * 16384 + vlane, pw, o); \
        AT_STOREB(pc); \
        asm volatile("s_waitcnt vmcnt(0)" ::: "memory"); \
        __syncthreads(); } while (0)
    int t = t0;
    if constexpr (fastm) {
        for (; t < NT - 4; t += 2) {
            P3_FAST(t, 0, 1, sc0, sc1, sn0, sn1);
            P3_FAST(t + 1, 1, 0, sn0, sn1, sc0, sc1);
        }
    } else {
        for (; t < NT - 4; t += 2) {
            P3_MAIN(t, 0, 1, sc0, sc1, sn0, sn1);
            P3_MAIN(t + 1, 1, 0, sn0, sn1, sc0, sc1);
        }
    }
#undef P3_FAST
    for (; t < NT; t += 2) {
        P3_STEP(t, 0, 1, sc0, sc1, sn0, sn1);
        P3_STEP(t + 1, 1, 0, sn0, sn1, sc0, sc1);
    }
#undef P3_MAIN
#undef P3_STEP
#undef AT_DMAK
#undef AT_DMAV
#undef AT_LOADB
#undef AT_STOREB
    const float l = l_run + __shfl_xor(l_run, 32);
    const float inv = 1.f / l;
#pragma unroll
    for (int b = 0; b < 4; ++b)
#pragma unroll
        for (int r = 0; r < 16; ++r) o[b][r] *= inv;
}

__global__ void __launch_bounds__(NWAVES * 64, 2) hybrid_fwd(Args args) {
    extern __shared__ __attribute__((aligned(16))) unsigned char lds_raw[];
    LAS unsigned char* lds = (LAS unsigned char*)lds_raw;
    const int wave = __builtin_amdgcn_readfirstlane((int)threadIdx.x >> 6);
#define LANE_FRESH() int lane; asm volatile("v_mbcnt_lo_u32_b32 %0, -1, 0\n\tv_mbcnt_hi_u32_b32 %0, -1, %0" : "=v"(lane)); const int tid = wave * 64 + lane; (void)tid
    const int G = gridDim.x, bid = blockIdx.x;
    const int gw = bid * NWAVES + wave, NGW = G * NWAVES;
    typedef const Args __attribute__((address_space(4)))* KArgP;
    KArgP ka0 = (KArgP)__builtin_amdgcn_kernarg_segment_ptr();
#define KA_FRESH() KArgP ka = ka0; asm volatile("" : "+s"(ka))
#define AIN(i) (ka->in[i])
#define WS_FRESH() unsigned char* ws = ka->ws; unsigned* ctl = (unsigned*)(ws + WS_CTL); bf16_t* win0 = (bf16_t*)(ws + WS_WIN0); bf16_t* wout0 = (bf16_t*)(ws + WS_WOUT0); bf16_t* wglu = (bf16_t*)(ws + WS_WGLU); bf16_t* win1 = (bf16_t*)(ws + WS_WIN1); bf16_t* wout1 = (bf16_t*)(ws + WS_WOUT1); bf16_t* hbuf = (bf16_t*)(ws + WS_HBUF); bf16_t* ygelu = (bf16_t*)(ws + WS_HBUF); bf16_t* proj = (bf16_t*)(ws + WS_PROJ); bf16_t* ycat = (bf16_t*)(ws + WS_YCAT); f32x2* lamb = (f32x2*)(ws + WS_LAMB); f32x2* lamt = (f32x2*)(ws + WS_LAMT); unsigned* bbar = (unsigned*)(ws + WS_BBAR); bf16_t* cmat = (bf16_t*)(ws + WS_CMAT); float* biasda = (float*)(ws + WS_BIASDA); float* biasf = (float*)(ws + WS_BIASF); float* flog = (float*)(ws + WS_FLOG); f32x2* s5st = (f32x2*)(ws + WS_S5ST); (void)ctl; (void)win0; (void)wout0; (void)wglu; (void)win1; (void)wout1; (void)hbuf; (void)ygelu; (void)proj; (void)ycat; (void)lamb; (void)lamt; (void)bbar; (void)cmat; (void)biasda; (void)biasf; (void)flog; (void)s5st
    cg::grid_group grid = cg::this_grid();
    XcdBarrier xbar;
    {
        int l0; asm volatile("v_mbcnt_lo_u32_b32 %0, -1, 0\n\tv_mbcnt_hi_u32_b32 %0, -1, %0" : "=v"(l0));
        if (wave == 0 && l0 < 32) ((LAS unsigned*)(lds + LDS_MISC))[l0] = 0u;
        __syncthreads();
        xbar = xcd_barrier_post((unsigned*)(args.ws + WS_CTL) + CW_BAR, (volatile LAS unsigned*)(lds + LDS_MISC) + 8, wave == 0 && l0 == 0);
    }
    const int lo = args.ph_lo, hi_ph = args.ph_hi;
#ifndef PH_MASK
#define PH_MASK 0x7ff
#endif
#define IN(k) (((PH_MASK >> (k)) & 1) && lo <= (k) && (k) < hi_ph)
#ifndef DUP_MASK
#define DUP_MASK 0
#endif
#define NREP(k) (((DUP_MASK >> (k)) & 1) ? 2 : 1)
#define SEAM(k) do { if (IN(k) && IN((k) + 1)) { if ((k) == 0) grid.sync(); else { int l0; asm volatile("v_mbcnt_lo_u32_b32 %0, -1, 0\n\tv_mbcnt_hi_u32_b32 %0, -1, %0" : "=v"(l0)); xcd_barrier(xbar, wave == 0 && l0 == 0); } } } while (0)

    if (IN(0)) {
        KA_FRESH(); LANE_FRESH(); WS_FRESH(); const float* x = AIN(0); float* out = ka->out; (void)x; (void)out;
        LAS float* scr = (LAS float*)(lds + wave * 16384);
        for (int rep = 0; rep < NREP(0); ++rep) {
        constexpr int I_IN0 = 32 * 192, I_OUT = 32 * 64, I_GLU = 16 * 32, I_IN1 = 32 * 264;
        constexpr int NITEMS = I_IN0 + 2 * I_OUT + I_GLU + I_IN1;
        for (int it = gw; it < NITEMS; it += NGW) {
            int r = it;
            if (r < I_IN0) { transpose_item(AIN(2), 2048, E_IN, win0, scr, r, 192, lane); continue; } r -= I_IN0;
            if (r < I_OUT) { transpose_item(AIN(3), 2048, 2048, wout0, scr, r, 64, lane); continue; } r -= I_OUT;
            if (r < I_GLU) { transpose_item(AIN(12), 1024, 1024, wglu, scr, r, 32, lane); continue; } r -= I_GLU;
            if (r < I_IN1) { transpose_item(AIN(22), 2048, 8208, win1, scr, r, 264, lane); continue; } r -= I_IN1;
            transpose_item(AIN(24), 2048, 2048, wout1, scr, r, 64, lane);
        }
        for (int m = gw; m < MTOK; m += 2 * NGW) { const int m1 = m + NGW; const bool h1 = m1 < MTOK; const int mm = h1 ? m1 : m;
            rms_rows2_to_bf16(x + (size_t)m * DM, x + (size_t)mm * DM, h1, AIN(1), hbuf + (size_t)m * DM, hbuf + (size_t)mm * DM, lane); }
        const int gt = bid * 512 + tid, NGT = G * 512;
        for (int i = gt; i < S5G * S5P; i += NGT) {
            const int g = i >> 6;
            const double dt = exp((double)AIN(6)[g]);
            const double lr = (double)AIN(4)[i], li = (double)AIN(5)[i];
            const double mag = exp(lr * dt), ar = mag * cos(li * dt), ai = mag * sin(li * dt);
            const double den = lr * lr + li * li, nr = ar - 1.0, ni = ai;
            const double kr = (nr * lr + ni * li) / den, ki = (ni * lr - nr * li) / den;
            lamb[i] = (f32x2){(float)ar, (float)ai};
            const double magT = exp(lr * dt * (double)S5T);
            lamt[i] = (f32x2){(float)(magT * cos(li * dt * (double)S5T)), (float)(magT * sin(li * dt * (double)S5T))};
#pragma unroll 2
            for (int j = 0; j < 8; ++j) { const double br0 = (double)AIN(7)[i * 16 + 2 * j], bi0 = (double)AIN(8)[i * 16 + 2 * j], br1 = (double)AIN(7)[i * 16 + 2 * j + 1], bi1 = (double)AIN(8)[i * 16 + 2 * j + 1];
                bbar[i * 16 + j] = pk2((float)(kr * br0 - ki * bi0), (float)(kr * br1 - ki * bi1));
                bbar[i * 16 + 8 + j] = pk2((float)(kr * bi0 + ki * br0), (float)(kr * bi1 + ki * br1)); }
        }
        for (int i = gt; i < S5G * 32 * 128; i += NGT) { const int k = i & 127, n = (i >> 7) & 31, g = i >> 12;
            float v = 0.f; if (n < 16) v = (k < 64) ? AIN(9)[(g * 16 + n) * 64 + k] : -AIN(10)[(g * 16 + n) * 64 + (k - 64)];
            cmat[i] = (bf16_t)(pk2(v, 0.f) & 0xffffu); }
        for (int i = gt; i < 8 * SEQ; i += NGT) { const int h = i / SEQ, j = i % SEQ; biasda[i] = exp2f(-(float)(h + 1)) * (float)j; }
        if (bid == 0 && tid == 0) {
            float d1 = 0.f, d2 = 0.f;
            for (int i = 0; i < 64; ++i) { d1 += AIN(16)[i] * AIN(17)[i]; d2 += AIN(18)[i] * AIN(19)[i]; }
            ((float*)ctl)[CW_LAM] = expf(d1) - expf(d2) + 0.2f;
            float gq = 0.f, gk = 0.f, fq_ = 0.f, fk_ = 0.f;
            for (int i = 0; i < 128; ++i) { gq = fmaxf(gq, fabsf(AIN(14)[i])); gk = fmaxf(gk, fabsf(AIN(15)[i])); fq_ = fmaxf(fq_, fabsf(AIN(25)[i])); fk_ = fmaxf(fk_, fabsf(AIN(26)[i])); }
            ((float*)ctl)[CW_THRDA] = ZERO_THR + 2.f * 8.f * gq * gk * 1.02f;
            ((float*)ctl)[CW_THRF] = ZERO_THR + 2.f * 11.3137085f * fq_ * fk_ * 1.02f;
            ctl[CW_QDA] = 0u; ctl[CW_QDA + 1] = 0u; ctl[CW_QFOX] = 0u; ctl[CW_QFOX + 1] = 0u;
        }
        }
#ifdef XSYNC
        for (int i = 0; i < XSYNC; ++i) grid.sync();
#endif
    }
    SEAM(0);
    if (IN(1)) {
        KA_FRESH(); LANE_FRESH(); WS_FRESH(); const float* x = AIN(0); float* out = ka->out; (void)x; (void)out;
        pg8::Gemm g{hbuf, win0, MTOK, E_IN, DM}; pg8::StaticOrder S; S.init(MTOK, E_IN, G, bid);
        pg8::EpiBf16<0> E{proj, E_IN, nullptr, 0, 0, 1.f};
        for (int rep = 0; rep < NREP(1); ++rep) pg8::gemm_phase<pg8::EpiBf16<0>, pg8::StaticOrder, true, true>(lds, g, S, E, wave, lane);
    }
    SEAM(1);
    if (IN(2)) {
        KA_FRESH(); LANE_FRESH(); WS_FRESH(); const float* x = AIN(0); float* out = ka->out; (void)x; (void)out;
        const float qmul = 0.125f * LOG2E;
        for (int m = gw; m < MTOK; m += 2 * NGW) { const int m1 = m + NGW; const bool h1 = m1 < MTOK; const int mm = h1 ? m1 : m;
            qknorm_rows2<2, 1, 4>(proj + (size_t)m * E_IN + 2048, proj + (size_t)mm * E_IN + 2048, h1, AIN(14), AIN(15), qmul, 1.f / 64.f, lane); }
        {
        const int r32 = lane & 31, hi = lane >> 5;
        for (int rep = 0; rep < NREP(12); ++rep)
        for (int u = gw; u < BATCH * S5G * S5NC; u += NGW) {
            const int g = u & 63, c = (u >> 6) & (S5NC - 1), b = u >> 13;
            const f32x2 la = lamb[g * 64 + lane];
            bf16x8 bre[2], bim[2];
#pragma unroll
            for (int ph = 0; ph < 2; ++ph) { const unsigned* bp = bbar + (size_t)(g * 64 + 32 * ph + r32) * 16 + 4 * hi;
                bre[ph] = __builtin_bit_cast(bf16x8, *(const u32x4*)bp); bim[ph] = __builtin_bit_cast(bf16x8, *(const u32x4*)(bp + 8)); }
            float hr = 0.f, hi_s = 0.f;
            const bf16_t* up = proj + (size_t)(b * SEQ + c * S5T + r32) * E_IN + g * 16 + 8 * hi;
            for (int sb = 0; sb < 4; ++sb) {
                const bf16x8 ua = *(const bf16x8*)(up + (size_t)(sb * 32) * E_IN);
                f32x16 z16;
#pragma unroll
                for (int r = 0; r < 16; ++r) z16[r] = 0.f;
                f32x16 xr0 = __builtin_amdgcn_mfma_f32_32x32x16_bf16(ua, bre[0], z16, 0, 0, 0), xr1 = __builtin_amdgcn_mfma_f32_32x32x16_bf16(ua, bre[1], z16, 0, 0, 0);
                f32x16 xi0 = __builtin_amdgcn_mfma_f32_32x32x16_bf16(ua, bim[0], z16, 0, 0, 0), xi1 = __builtin_amdgcn_mfma_f32_32x32x16_bf16(ua, bim[1], z16, 0, 0, 0);
#pragma unroll
                for (int r = 0; r < 16; ++r) {
                    auto sr = __builtin_amdgcn_permlane32_swap(__float_as_uint(xr0[r]), __float_as_uint(xr1[r]), false, false); xr0[r] = __uint_as_float(sr[0]); xr1[r] = __uint_as_float(sr[1]);
                    auto si = __builtin_amdgcn_permlane32_swap(__float_as_uint(xi0[r]), __float_as_uint(xi1[r]), false, false); xi0[r] = __uint_as_float(si[0]); xi1[r] = __uint_as_float(si[1]); }
#pragma unroll
                for (int t = 0; t < 32; ++t) { const int r = (t & 3) + 4 * (t >> 3); const bool odd = (t >> 2) & 1;
                    const float xr = odd ? xr1[r] : xr0[r], xi = odd ? xi1[r] : xi0[r];
                    const float nhr = la.x * hr - la.y * hi_s + xr, nhi = la.x * hi_s + la.y * hr + xi; hr = nhr; hi_s = nhi; }
            }
            s5st[((size_t)(b * S5NC + c) * 64 + g) * 64 + lane] = (f32x2){hr, hi_s};
        }
        }
    }
    SEAM(2);
    if (IN(3)) {
        KA_FRESH(); LANE_FRESH(); WS_FRESH(); const float* x = AIN(0); float* out = ka->out; (void)x; (void)out;
        {
            LAS unsigned char* Ht = lds + wave * 8192;
            const int r32 = lane & 31, hi = lane >> 5;
            for (int rep = 0; rep < NREP(11); ++rep)
            for (int u = gw; u < BATCH * S5G * (S5NC / 8); u += NGW) {
                const int g = u & 63, c0 = ((u >> 6) & 15) * 8, b = u >> 10;
                const int gp = g * 64 + lane;
                const f32x2 la = lamb[gp], lt = lamt[gp];
                bf16x8 bre[2], bim[2];
#pragma unroll
                for (int ph = 0; ph < 2; ++ph) { const unsigned* bp = bbar + (size_t)(g * 64 + 32 * ph + r32) * 16 + 4 * hi;
                    bre[ph] = __builtin_bit_cast(bf16x8, *(const u32x4*)bp); bim[ph] = __builtin_bit_cast(bf16x8, *(const u32x4*)(bp + 8)); }
                float hr = 0.f, hi_s = 0.f;
#pragma unroll 8
                for (int cc = 0; cc < c0; ++cc) { const f32x2 s = s5st[((size_t)(b * S5NC + cc) * 64 + g) * 64 + lane];
                    const float nhr = lt.x * hr - lt.y * hi_s + s.x, nhi = lt.x * hi_s + lt.y * hr + s.y; hr = nhr; hi_s = nhi; }
                bf16x8 cfr[8];
#pragma unroll
                for (int s = 0; s < 8; ++s) cfr[s] = *(const bf16x8*)(cmat + (size_t)(g * 32 + r32) * 128 + 16 * s + 8 * hi);
                const float dvec = AIN(11)[g * 16 + (r32 & 15)];
                for (int c = c0; c < c0 + 8; ++c) {
                const size_t row0 = (size_t)(b * SEQ + c * S5T);
                const bf16_t* up = proj + (row0 + r32) * E_IN + g * 16 + 8 * hi;
                for (int sb = 0; sb < 4; ++sb) {
                    unsigned short uv16[16];
                    if (r32 < 16) {
#pragma unroll
                        for (int r = 0; r < 16; ++r) uv16[r] = proj[(row0 + sb * 32 + crow(r, hi)) * E_IN + g * 16 + r32];
                    }
                    {
                    const bf16x8 ua = *(const bf16x8*)(up + (size_t)(sb * 32) * E_IN);
                    f32x16 z16;
#pragma unroll
                    for (int r = 0; r < 16; ++r) z16[r] = 0.f;
                    f32x16 xr0 = __builtin_amdgcn_mfma_f32_32x32x16_bf16(ua, bre[0], z16, 0, 0, 0), xr1 = __builtin_amdgcn_mfma_f32_32x32x16_bf16(ua, bre[1], z16, 0, 0, 0);
                    f32x16 xi0 = __builtin_amdgcn_mfma_f32_32x32x16_bf16(ua, bim[0], z16, 0, 0, 0), xi1 = __builtin_amdgcn_mfma_f32_32x32x16_bf16(ua, bim[1], z16, 0, 0, 0);
#pragma unroll
                    for (int r = 0; r < 16; ++r) {
                        auto sr = __builtin_amdgcn_permlane32_swap(__float_as_uint(xr0[r]), __float_as_uint(xr1[r]), false, false); xr0[r] = __uint_as_float(sr[0]); xr1[r] = __uint_as_float(sr[1]);
                        auto si = __builtin_amdgcn_permlane32_swap(__float_as_uint(xi0[r]), __float_as_uint(xi1[r]), false, false); xi0[r] = __uint_as_float(si[0]); xi1[r] = __uint_as_float(si[1]); }
#pragma unroll
                    for (int tt = 0; tt < 32; ++tt) { const int r = (tt & 3) + 4 * (tt >> 3); const bool odd = (tt >> 2) & 1;
                        const float xr = odd ? xr1[r] : xr0[r], xi = odd ? xi1[r] : xi0[r];
                        const float nhr = la.x * hr - la.y * hi_s + xr, nhi = la.x * hi_s + la.y * hr + xi; hr = nhr; hi_s = nhi;
                        const unsigned w = pk2(hr, hi_s);
                        const int sw = tt & 15;
                        *(LAS unsigned short*)(Ht + tt * 256 + ((((lane >> 3)) ^ sw) << 4) + ((lane & 7) << 1)) = (unsigned short)(w & 0xffffu);
                        *(LAS unsigned short*)(Ht + tt * 256 + ((((64 + lane) >> 3) ^ sw) << 4) + ((lane & 7) << 1)) = (unsigned short)(w >> 16);
                    }
                    }
                    asm volatile("s_waitcnt lgkmcnt(0)" ::: "memory");
                    f32x16 acc;
#pragma unroll
                    for (int r = 0; r < 16; ++r) acc[r] = 0.f;
#pragma unroll
                    for (int s = 0; s < 8; ++s) { const bf16x8 a = *(LAS const bf16x8*)(Ht + r32 * 256 + (((2 * s + hi) ^ (r32 & 15)) << 4));
                        acc = __builtin_amdgcn_mfma_f32_32x32x16_bf16(a, cfr[s], acc, 0, 0, 0); }
                    asm volatile("s_waitcnt lgkmcnt(0)" ::: "memory");
                    if (r32 < 16) {
#pragma unroll
                        for (int r = 0; r < 16; ++r) { const size_t row = row0 + sb * 32 + crow(r, hi);
                            const float uval = bf2f(uv16[r]);
                            const float y = gelu_tanh(acc[r] + dvec * uval);
                            ygelu[row * 1024 + g * 16 + r32] = (bf16_t)(pk2(y, 0.f) & 0xffffu); }
                    }
                }
                }
            }
        }
        __syncthreads();
        {
            LANE_FRESH();
            LAS volatile int* misc = (LAS volatile int*)(lds + LDS_MISC);
            const float lam = ((const float*)ctl)[CW_LAM]; const float thr_da = ((const float*)ctl)[CW_THRDA];
            const int r32 = lane & 31, hi = lane >> 5;
            for (int rep = 0; rep < NREP(3); ++rep)
            for (;;) {
                if (tid == 0) misc[0] = (int)atomicAdd(ctl + CW_QDA + rep, 1u);
                __syncthreads();
                const int ui = misc[0];
                __syncthreads();
                if (ui >= BATCH * 8 * 64) break;
                const int qb = 63 - (ui >> 4), bh = ui & 15, b = bh >> 3, h = bh & 7;
                const int q0 = qb * 256;
                const bf16_t* pb = proj + (size_t)b * SEQ * E_IN;
                const float dskip = thr_da * exp2f((float)(h + 1));
                const int t_lo = max(0, (int)ceilf(((float)q0 - dskip - 63.f) * (1.f / 64.f)));
                f32x16 o[4];
                LAS unsigned* stash = (LAS unsigned*)(lds + LDS_STASH) + wave * 2048 + lane;
                const float bq2 = (thr_da - ZERO_THR) * LOG2E;
                const bool fm = attn_static_ok(biasda + h * SEQ, LOG2E, bq2, q0);
                if (fm) attn_pass3<64, true>(lds, pb + 2048 + h * 128, pb + 3072 + h * 128, pb + 4096 + h * 128, biasda + h * SEQ, LOG2E, bq2, E_IN, q0, t_lo, o, wave, lane);
                else attn_pass3<64, false>(lds, pb + 2048 + h * 128, pb + 3072 + h * 128, pb + 4096 + h * 128, biasda + h * SEQ, LOG2E, bq2, E_IN, q0, t_lo, o, wave, lane);
#pragma unroll
                for (int bl = 0; bl < 4; ++bl)
#pragma unroll
                    for (int e = 0; e < 8; ++e) stash[(bl * 8 + e) * 64] = pk2(o[bl][2 * e], o[bl][2 * e + 1]);
                if (fm) attn_pass3<64, true>(lds, pb + 2048 + h * 128 + 64, pb + 3072 + h * 128 + 64, pb + 4096 + h * 128, biasda + h * SEQ, LOG2E, bq2, E_IN, q0, t_lo, o, wave, lane);
                else attn_pass3<64, false>(lds, pb + 2048 + h * 128 + 64, pb + 3072 + h * 128 + 64, pb + 4096 + h * 128, biasda + h * SEQ, LOG2E, bq2, E_IN, q0, t_lo, o, wave, lane);
                int hi_e = hi, r32_e = r32; asm volatile("" : "+v"(hi_e), "+v"(r32_e));
                float ssq = 0.f;
#pragma unroll
                for (int bl = 0; bl < 4; ++bl)
#pragma unroll
                    for (int e = 0; e < 8; ++e) { const unsigned w0 = stash[(bl * 8 + e) * 64]; const float v0 = bflo(w0) - lam * o[bl][2 * e], v1 = bfhi(w0) - lam * o[bl][2 * e + 1];
                        o[bl][2 * e] = v0; o[bl][2 * e + 1] = v1; ssq += v0 * v0 + v1 * v1; }
                ssq += __shfl_xor(ssq, 32);
                const float rr = 0.8f / sqrtf(ssq * (1.f / 128.f) + RMS_EPS);
                const size_t tok = (size_t)b * SEQ + q0 + wave * 32 + r32_e;
#pragma unroll
                for (int bl = 0; bl < 4; ++bl)
#pragma unroll
                    for (int g = 0; g < 4; ++g) { const int dv0 = 32 * bl + 8 * g + 4 * hi_e;
                        const f32x4 gn = *(const f32x4*)(AIN(20) + dv0);
                        const u32x2 zw = *(const u32x2*)(proj + tok * E_IN + 5120 + h * 128 + dv0);
                        const float y0 = o[bl][4 * g] * rr * gn.x * siluf_(bflo(zw.x)), y1 = o[bl][4 * g + 1] * rr * gn.y * siluf_(bfhi(zw.x));
                        const float y2 = o[bl][4 * g + 2] * rr * gn.z * siluf_(bflo(zw.y)), y3 = o[bl][4 * g + 3] * rr * gn.w * siluf_(bfhi(zw.y));
                        u32x2 w; w.x = pk2(y0, y1); w.y = pk2(y2, y3);
                        *(u32x2*)(ycat + tok * DM + 1024 + h * 128 + dv0) = w; }
            }
        }
    }
    SEAM(3);
    if (IN(4)) {
        KA_FRESH(); LANE_FRESH(); WS_FRESH(); const float* x = AIN(0); float* out = ka->out; (void)x; (void)out;
        pg8::Gemm g{ygelu, wglu, MTOK, 1024, 1024}; pg8::StaticOrder S; S.init(MTOK, 1024, G, bid);
        pg8::EpiGlu E{ycat, ygelu, proj, AIN(13)};
        pg8::gemm_phase<pg8::EpiGlu, pg8::StaticOrder, true, true>(lds, g, S, E, wave, lane);
    }
    SEAM(4);
    if (IN(5)) {
        KA_FRESH(); LANE_FRESH(); WS_FRESH(); const float* x = AIN(0); float* out = ka->out; (void)x; (void)out;
        pg8::Gemm g{ycat, wout0, MTOK, DM, DM}; pg8::StaticOrder S; S.init(MTOK, DM, G, bid);
        pg8::EpiResid E{x, out};
        pg8::gemm_phase<pg8::EpiResid, pg8::StaticOrder, true, true>(lds, g, S, E, wave, lane);
    }
    SEAM(5);
    if (IN(6)) {
        KA_FRESH(); LANE_FRESH(); WS_FRESH(); const float* x = AIN(0); float* out = ka->out; (void)x; (void)out;
        for (int rep = 0; rep < NREP(6); ++rep)
        for (int m = gw; m < MTOK; m += 2 * NGW) { const int m1 = m + NGW; const bool h1 = m1 < MTOK; const int mm = h1 ? m1 : m;
            rms_rows2_to_bf16(out + (size_t)m * DM, out + (size_t)mm * DM, h1, AIN(21), hbuf + (size_t)m * DM, hbuf + (size_t)mm * DM, lane); }
    }
    SEAM(6);
    if (IN(7)) {
        KA_FRESH(); LANE_FRESH(); WS_FRESH(); const float* x = AIN(0); float* out = ka->out; (void)x; (void)out;
        pg8::Gemm g{hbuf, win1, MTOK, O_INP, DM}; pg8::StaticOrder S; S.init(MTOK, O_INP, G, bid);
        pg8::EpiProj1 E{proj, flog};
        for (int rep = 0; rep < NREP(7); ++rep) pg8::gemm_phase<pg8::EpiProj1, pg8::StaticOrder, true, true>(lds, g, S, E, wave, lane);
    }
    SEAM(7);
    if (IN(8)) {
        KA_FRESH(); LANE_FRESH(); WS_FRESH(); const float* x = AIN(0); float* out = ka->out; (void)x; (void)out;
        if (bid < 32) {
            const int b = bid >> 4, h = bid & 15;
            LAS double* dsum = (LAS double*)lds;
            const float bf_ = AIN(23)[h];
            const float* fl = flog + ((size_t)b * SEQ + tid * 32) * 16 + h;
            double tot = 0.0;
#pragma unroll 4
            for (int i = 0; i < 32; ++i) { const float xv = fl[i * 16] + bf_; tot += (double)(fminf(xv, 0.f) - log1pf(expf(-fabsf(xv)))); }
            dsum[tid] = tot;
            __syncthreads();
            double pre = 0.0;
            for (int i = 0; i < tid; ++i) pre += dsum[i];
            float* bo = biasf + ((size_t)(b * 16 + h)) * SEQ + tid * 32;
#pragma unroll 4
            for (int i = 0; i < 32; ++i) { const float xv = fl[i * 16] + bf_; pre += (double)(fminf(xv, 0.f) - log1pf(expf(-fabsf(xv)))); bo[i] = (float)(-pre); }
            __syncthreads();
        }
        const float qmul = 0.08838834764831845f * LOG2E;
        for (int m = gw; m < MTOK; m += 2 * NGW) { const int m1 = m + NGW; const bool h1 = m1 < MTOK; const int mm = h1 ? m1 : m;
            qknorm_rows2<4, 2, 8>(proj + (size_t)m * O_LD, proj + (size_t)mm * O_LD, h1, AIN(25), AIN(26), qmul, 1.f / 128.f, lane); }
    }
    SEAM(8);
    if (IN(9)) {
        KA_FRESH(); LANE_FRESH(); WS_FRESH(); const float* x = AIN(0); float* out = ka->out; (void)x; (void)out;
        LAS volatile int* misc = (LAS volatile int*)(lds + LDS_MISC);
        const int r32 = lane & 31, hi = lane >> 5;
        const float thr_f = ((const float*)ctl)[CW_THRF];
        for (int rep = 0; rep < NREP(9); ++rep)
        for (;;) {
            if (wave == 0) {
                int u0 = 0; if (lane == 0) u0 = (int)atomicAdd(ctl + CW_QFOX + rep, 1u);
                u0 = __shfl(u0, 0);
                int tl = 0;
                if (u0 < BATCH * 16 * 64) {
                    const int qb_ = 63 - (u0 >> 5), bh_ = u0 & 31; const float* bt = biasf + (size_t)bh_ * SEQ; const float bref = bt[qb_ * 256];
                    int ln = lane; asm volatile("" : "+v"(ln));
#pragma unroll
                    for (int r = 0; r < 4; ++r) { const int t = ln + 64 * r; bool dead = false;
                        if (t < 4 * qb_) dead = (bt[64 * t + 63] - bref) < -thr_f;
                        tl += __popcll(__ballot(dead)); }
                }
                if (lane == 0) { misc[0] = u0; misc[1] = tl; }
            }
            __syncthreads();
            const int ui = misc[0], t_lo = misc[1];
            __syncthreads();
            if (ui >= BATCH * 16 * 64) break;
            const int qb = 63 - (ui >> 5), bh = ui & 31, b = bh >> 4, h = bh & 15;
            const int q0 = qb * 256;
            const bf16_t* pb = proj + (size_t)b * SEQ * O_LD;
            f32x16 o[4];
            const float bq2 = (thr_f - ZERO_THR) * LOG2E;
            if (attn_static_ok(biasf + (size_t)bh * SEQ, LOG2E, bq2, q0)) attn_pass3<128, true>(lds, pb + h * 128, pb + 2048 + h * 128, pb + 4096 + h * 128, biasf + (size_t)bh * SEQ, LOG2E, bq2, O_LD, q0, t_lo, o, wave, lane);
            else attn_pass3<128, false>(lds, pb + h * 128, pb + 2048 + h * 128, pb + 4096 + h * 128, biasf + (size_t)bh * SEQ, LOG2E, bq2, O_LD, q0, t_lo, o, wave, lane);
            int hi_e = hi, r32_e = r32; asm volatile("" : "+v"(hi_e), "+v"(r32_e));
            const size_t tok = (size_t)b * SEQ + q0 + wave * 32 + r32_e;
#pragma unroll
            for (int bl = 0; bl < 4; ++bl)
#pragma unroll
                for (int g = 0; g < 4; ++g) { const int dv0 = 32 * bl + 8 * g + 4 * hi_e;
                    const u32x2 zw = *(const u32x2*)(proj + tok * O_LD + 6144 + h * 128 + dv0);
                    const float y0 = o[bl][4 * g] * siluf_(bflo(zw.x)), y1 = o[bl][4 * g + 1] * siluf_(bfhi(zw.x));
                    const float y2 = o[bl][4 * g + 2] * siluf_(bflo(zw.y)), y3 = o[bl][4 * g + 3] * siluf_(bfhi(zw.y));
                    u32x2 w; w.x = pk2(y0, y1); w.y = pk2(y2, y3);
                    *(u32x2*)(ycat + tok * DM + h * 128 + dv0) = w; }
        }
    }
    SEAM(9);
    if (IN(10)) {
        KA_FRESH(); LANE_FRESH(); WS_FRESH(); const float* x = AIN(0); float* out = ka->out; (void)x; (void)out;
        pg8::Gemm g{ycat, wout1, MTOK, DM, DM}; pg8::StaticOrder S; S.init(MTOK, DM, G, bid);
        pg8::EpiResid E{out, out};
        pg8::gemm_phase<pg8::EpiResid, pg8::StaticOrder, true, true>(lds, g, S, E, wave, lane);
    }
#undef IN
#undef SEAM
}

#ifndef ONE_LAUNCH
#define ONE_LAUNCH 1
#endif
constexpr int NPHASE = 11;
extern "C" void kernel_launch(void* const* d_in, const int* in_sizes, int n_in, void* d_out, int out_size, void* d_ws, size_t ws_size, hipStream_t stream) {
    static int grid = 0;
    if (grid == 0) {
        if (n_in != 27 || out_size != MTOK * DM || ws_size < WS_END) { fprintf(stderr, "kernel_launch: unexpected problem (n_in %d out %d ws %zu)\n", n_in, out_size, ws_size); grid = -1; return; }
        int dev = 0, cus = 0, per_cu = 0;
        hipGetDevice(&dev);
        hipDeviceGetAttribute(&cus, hipDeviceAttributeMultiprocessorCount, dev);
        if (hipFuncSetAttribute((const void*)hybrid_fwd, hipFuncAttributeMaxDynamicSharedMemorySize, LDS_BYTES) != hipSuccess) { fprintf(stderr, "kernel_launch: hipFuncSetAttribute failed\n"); grid = -1; return; }
        if (hipOccupancyMaxActiveBlocksPerMultiprocessor(&per_cu, (const void*)hybrid_fwd, NWAVES * 64, LDS_BYTES) != hipSuccess || per_cu < 1) { fprintf(stderr, "kernel_launch: occupancy query says %d\n", per_cu); per_cu = 1; }
        (void)hipGetLastError();
        grid = cus * 1;
    }
    if (grid < 0) return;
    if (hipMemsetAsync(d_ws, 0, 65536, stream) != hipSuccess) { fprintf(stderr, "kernel_launch: memset failed\n"); return; }
    Args a{};
    for (int i = 0; i < 27; ++i) a.in[i] = (const float*)d_in[i];
    a.out = (float*)d_out; a.ws = (unsigned char*)d_ws;
#if ONE_LAUNCH
    a.ph_lo = 0; a.ph_hi = NPHASE;
    void* kargs[] = {&a};
    hipError_t e = hipLaunchCooperativeKernel((const void*)hybrid_fwd, dim3(grid), dim3(NWAVES * 64), kargs, LDS_BYTES, stream);
    if (e != hipSuccess) fprintf(stderr, "cooperative launch failed: %s (grid %d)\n", hipGetErrorString(e), grid);
#else
    for (int p = 0; p < NPHASE; ++p) {
        a.ph_lo = p; a.ph_hi = p + 1;
        hipLaunchKernelGGL(hybrid_fwd, dim3(grid), dim3(NWAVES * 64), LDS_BYTES, stream, a);
    }
#endif
}
```

```cpp
#include <hip/hip_runtime.h>
#include <hip/hip_cooperative_groups.h>
#include <cstdio>
#include <cstdint>
#include <cmath>
namespace cg = cooperative_groups;
#define DUP_MASK 0
namespace pg8 {
#define PG8_LAS __attribute__((address_space(3)))
typedef unsigned short bf16_t;
typedef short bf16x8 __attribute__((ext_vector_type(8)));
typedef float f32x4 __attribute__((ext_vector_type(4)));
typedef unsigned u32x4 __attribute__((ext_vector_type(4)));
constexpr int BM = 256, BK = 64, HALF = 128, HTB = HALF * BK * 2  , STAGE_BYTES = 8 * HTB, NXCD = 8, WGM = 8;

__host__ __device__ __forceinline__ int lds_byte(int r, int c) { const int st = (r >> 4) * 2 + (c >> 5), rr = r & 15, cc = c & 31, ob = rr * 64 + cc * 2; return st * 1024 + (ob ^ (((ob >> 9) & 1) << 5)); }
__host__ __device__ __forceinline__ void stage_rc(int b, int& R, int& C) { const int st = b / 1024, sb = b % 1024, swz = sb ^ (((sb >> 9) & 1) << 5); R = (st >> 1) * 16 + swz / 64; C = (st & 1) * 32 + (swz % 64) / 2; }
__host__ __device__ __forceinline__ int perm32(int rho) { const int n = rho >> 4, i = rho & 15; return 8 * (i >> 2) + 4 * n + (i & 3); }

struct Unit { int pm, pn; };
struct Gemm { const bf16_t* A; const bf16_t* Bt; int M, N, K; };

struct StaticOrder {
    int nM, nN, nwg, G, c;
    __host__ __device__ void init(int M, int N, int G_, int c_) { nM = M / BM; nN = N / BM; nwg = nM * nN; G = G_; c = c_; }
    __host__ __device__ bool next(int i, Unit& u) const {
        const long L = (long)i * G + c; if (L >= nwg) return false;
        int wgid = (int)L; { const int q = nwg / NXCD, r = nwg % NXCD, xcd = wgid % NXCD, off = wgid / NXCD; wgid = (xcd < r ? xcd * (q + 1) : r * (q + 1) + (xcd - r) * q) + off; }
        const int nig = WGM * nN, gid = wgid / nig, fm = gid * WGM, gsz = (nM - fm) < WGM ? (nM - fm) : WGM;
        u.pm = fm + ((wgid % nig) % gsz); u.pn = (wgid % nig) / gsz; return true;
    }
    __device__ __forceinline__ void a_ready(const Unit&) const {}
    __device__ __forceinline__ void done(const Unit&) const {}
};

__device__ __forceinline__ unsigned cvt_pk_bf16(float lo, float hi) { unsigned r; asm volatile("v_cvt_pk_bf16_f32 %0, %1, %2" : "=v"(r) : "v"(lo), "v"(hi)); return r; }
typedef float f32x2 __attribute__((ext_vector_type(2)));
__device__ __forceinline__ f32x2 gelu_pk(f32x2 v) {
    const f32x2 av = __builtin_elementwise_abs(v), d = av * 0.2316418882f + 1.0f;
    f32x2 t; t.x = __builtin_amdgcn_rcpf(d.x); t.y = __builtin_amdgcn_rcpf(d.y);
    f32x2 q = t * 0.5307027145f + (-0.7265760135f); q = q * t + 0.7107068705f; q = q * t + (-0.142248368f); q = q * t + 0.127414796f; q = q * t;
    const f32x2 s = (v * v) * (-0.72134752044f);
    f32x2 e; e.x = __builtin_amdgcn_exp2f(s.x); e.y = __builtin_amdgcn_exp2f(s.y);
    const f32x2 m = v * (q * e), r = v - m;
    f32x2 o; o.x = v.x < 0.f ? m.x : r.x; o.y = v.y < 0.f ? m.y : r.y; return o;
}

template <int ACT  > struct EpiBf16 {
    static constexpr bool PERM = true, AFTER_DRAIN = false; static_assert(ACT == 0 || ACT == 1, "EpiBf16: ACT is 0 (none) or 1 (gelu_pk)");
    bf16_t* O; int ldc; const float* bias; int split_cols; size_t split_stride; float scale0;
    __device__ __forceinline__ void operator()(const f32x4 (&acc)[2][2][4][2], const Unit& u, int wr, int wc, int fr, int fq) const {
        const int row0 = u.pm * BM + wr * 64 + fr; int colt = u.pn * BM; bf16_t* base = O;
        float sc = 1.f; if (split_cols) { const int t = colt / split_cols; base += (size_t)t * split_stride; colt -= t * split_cols; if (t == 0) sc = scale0; }
        const int col0 = colt + wc * 32 + 8 * fq, bcol0 = u.pn * BM + wc * 32 + 8 * fq;
        f32x4 bv[2][2];
#pragma unroll
        for (int bj = 0; bj < 2; ++bj)
#pragma unroll
            for (int n = 0; n < 2; ++n) bv[bj][n] = bias ? *(const f32x4*)(bias + bcol0 + bj * HALF + 4 * n) : (f32x4){0.f, 0.f, 0.f, 0.f};
#pragma unroll
        for (int ai = 0; ai < 2; ++ai)
#pragma unroll
            for (int m = 0; m < 4; ++m) { bf16_t* rowp = base + (size_t)(row0 + ai * HALF + m * 16) * ldc + col0;
#pragma unroll
                for (int bj = 0; bj < 2; ++bj) { f32x4 v0 = acc[ai][bj][m][0] + bv[bj][0], v1 = acc[ai][bj][m][1] + bv[bj][1];
                    if (ACT == 1) { f32x2 a = gelu_pk((f32x2){v0[0], v0[1]}), b = gelu_pk((f32x2){v0[2], v0[3]}), c = gelu_pk((f32x2){v1[0], v1[1]}), d = gelu_pk((f32x2){v1[2], v1[3]});
                        v0 = (f32x4){a.x, a.y, b.x, b.y}; v1 = (f32x4){c.x, c.y, d.x, d.y}; }
                    v0 = v0 * sc; v1 = v1 * sc; u32x4 w; w.x = cvt_pk_bf16(v0[0], v0[1]); w.y = cvt_pk_bf16(v0[2], v0[3]); w.z = cvt_pk_bf16(v1[0], v1[1]); w.w = cvt_pk_bf16(v1[2], v1[3]);
                    *(u32x4*)(rowp + bj * HALF) = w; } }
    }
};
template <class Epi, class Sched, bool ALIGN_EPI = false, bool SP2 = false>
__device__ __forceinline__ void gemm_phase(PG8_LAS unsigned char* lds, const Gemm g, const Sched& S, const Epi& E, const int wid, const int lane) {
    const int tid = wid * 64 + lane, wr = wid >> 2, wc = wid & 3, fr = lane & 15, fq = lane >> 4;
    const int K = g.K, nt = K / BK;
    unsigned voffA[2], voffB[2];
#pragma unroll
    for (int i = 0; i < 2; ++i) { int R, C; stage_rc(tid * 16 + i * 8192, R, C); const int Rb = Epi::PERM ? ((R & ~31) + perm32(R & 31)) : R;
        voffA[i] = (unsigned)(R * K + C) * 2u; voffB[i] = (unsigned)(Rb * K + C) * 2u; }
    const size_t kstep = (size_t)(BK * 2);
    const size_t hstep = (size_t)HALF * K * 2;
    const size_t tstep = 2 * hstep;
    const unsigned ldsw = (unsigned)wid * 1024u;
    const int aoff = lds_byte(wr * 64 + fr, fq * 8), boff = lds_byte(wc * 32 + fr, fq * 8);
#define PG8_SA(b, h) (((b) * 2 + (h)) * HTB)
#define PG8_SB(b, h) ((4 + (b) * 2 + (h)) * HTB)
#define PG8_STAGE(bufoff, gbase, voff) do { _Pragma("unroll") for (int _i = 0; _i < 2; ++_i) \
        __builtin_amdgcn_global_load_lds((const unsigned*)((const char*)(gbase) + (voff)[_i]), (PG8_LAS unsigned*)(lds + (bufoff) + ldsw + _i * 8192), 16, 0, 0); } while (0)
#define PG8_LDA(dst, b, h) do { _Pragma("unroll") for (int m = 0; m < 4; ++m) _Pragma("unroll") for (int k = 0; k < 2; ++k) dst[m][k] = *(const PG8_LAS bf16x8*)(lds + PG8_SA(b, h) + aoff + m * 2048 + k * 1024); } while (0)
#define PG8_LDB(dst, b, h) do { _Pragma("unroll") for (int n = 0; n < 2; ++n) _Pragma("unroll") for (int k = 0; k < 2; ++k) dst[n][k] = *(const PG8_LAS bf16x8*)(lds + PG8_SB(b, h) + boff + n * 2048 + k * 1024); } while (0)
#define PG8_MMA(ai, bj, At, Bt) do { __builtin_amdgcn_s_setprio(1); _Pragma("unroll") for (int m = 0; m < 4; ++m) _Pragma("unroll") for (int n = 0; n < 2; ++n) _Pragma("unroll") for (int k = 0; k < 2; ++k) \
        acc[ai][bj][m][n] = __builtin_amdgcn_mfma_f32_16x16x32_bf16(Bt[n][k], At[m][k], acc[ai][bj][m][n], 0, 0, 0); __builtin_amdgcn_s_setprio(0); } while (0)
#define PG8_WAIT_V(n) asm volatile("s_waitcnt vmcnt(" #n ")" ::: "memory")
#define PG8_WAIT_L(n) asm volatile("s_waitcnt lgkmcnt(" #n ")" ::: "memory")
#define PG8_BAR __builtin_amdgcn_s_barrier()
#define PG8_SCHED __builtin_amdgcn_sched_barrier(0)
    Unit cur, nxt; int ui = 0;
    if (!S.next(0, cur)) return;
    f32x4 acc[2][2][4][2];
#pragma unroll
    for (int a = 0; a < 2; ++a)
#pragma unroll
        for (int b = 0; b < 2; ++b)
#pragma unroll
            for (int m = 0; m < 4; ++m)
#pragma unroll
                for (int n = 0; n < 2; ++n) acc[a][b][m][n] = (f32x4){0.f, 0.f, 0.f, 0.f};
    bf16x8 At[4][2], B0[2][2], B1[2][2];
    const char* cA = (const char*)g.A + (size_t)cur.pm * tstep; const char* cB = (const char*)g.Bt + (size_t)cur.pn * tstep;
    S.a_ready(cur);
    if constexpr (SP2) {
        PG8_STAGE(PG8_SB(0, 0), cB, voffB); PG8_STAGE(PG8_SB(0, 1), cB + hstep, voffB); PG8_STAGE(PG8_SA(0, 0), cA, voffA); PG8_STAGE(PG8_SA(0, 1), cA + hstep, voffA);
        if (wr == 1) PG8_BAR;
        PG8_WAIT_V(2); PG8_BAR;
        PG8_STAGE(PG8_SB(1, 0), cB + kstep, voffB); PG8_STAGE(PG8_SA(1, 0), cA + kstep, voffA); PG8_STAGE(PG8_SB(1, 1), cB + hstep + kstep, voffB);
        PG8_WAIT_V(6); PG8_BAR;
    } else {
        PG8_STAGE(PG8_SB(0, 0), cB, voffB); PG8_STAGE(PG8_SA(0, 0), cA, voffA); PG8_STAGE(PG8_SB(0, 1), cB + hstep, voffB); PG8_STAGE(PG8_SA(0, 1), cA + hstep, voffA);
        if (wr == 1) PG8_BAR;
        PG8_WAIT_V(4); PG8_BAR;
        PG8_STAGE(PG8_SB(1, 0), cB + kstep, voffB); PG8_STAGE(PG8_SA(1, 0), cA + kstep, voffA); PG8_STAGE(PG8_SB(1, 1), cB + hstep + kstep, voffB);
        PG8_WAIT_V(6); PG8_BAR;
    }
    for (;;) {
        const bool has_next = S.next(ui + 1, nxt);
        const char* nA = has_next ? (const char*)g.A + (size_t)nxt.pm * tstep : cA; const char* nB = has_next ? (const char*)g.Bt + (size_t)nxt.pn * tstep : cB;
        for (int t = 0; t < nt; t += 2) {
            const bool last = (t == nt - 2);
            const char* a1 = cA + (size_t)(t + 1) * kstep;
            const char* a2 = last ? nA : cA + (size_t)(t + 2) * kstep; const char* b2 = last ? nB : cB + (size_t)(t + 2) * kstep;
            const char* a3 = a2 + kstep; const char* b3 = b2 + kstep;
            if (last && has_next) S.a_ready(nxt);
            if constexpr (SP2) {
            PG8_LDB(B0, 0, 0); PG8_LDB(B1, 0, 1); PG8_SCHED; PG8_LDA(At, 0, 0); PG8_STAGE(PG8_SA(1, 1), a1 + hstep, voffA);
            PG8_WAIT_V(8); PG8_WAIT_L(0); PG8_BAR; PG8_MMA(0, 0, At, B0); PG8_MMA(0, 1, At, B1); PG8_BAR; PG8_SCHED;
            PG8_LDA(At, 0, 1); PG8_STAGE(PG8_SB(0, 0), b2, voffB); PG8_STAGE(PG8_SB(0, 1), b2 + hstep, voffB); PG8_STAGE(PG8_SA(0, 0), a2, voffA);
            PG8_WAIT_V(8); PG8_WAIT_L(0); PG8_BAR; PG8_MMA(1, 0, At, B0); PG8_MMA(1, 1, At, B1); PG8_BAR; PG8_SCHED;
            PG8_LDB(B0, 1, 0); PG8_LDB(B1, 1, 1); PG8_SCHED; PG8_LDA(At, 1, 0); PG8_STAGE(PG8_SA(0, 1), a2 + hstep, voffA);
            PG8_WAIT_V(8); PG8_WAIT_L(0); PG8_BAR; PG8_MMA(0, 0, At, B0); PG8_MMA(0, 1, At, B1); PG8_BAR; PG8_SCHED;
            PG8_LDA(At, 1, 1); PG8_STAGE(PG8_SB(1, 0), b3, voffB); PG8_STAGE(PG8_SB(1, 1), b3 + hstep, voffB); PG8_STAGE(PG8_SA(1, 0), a3, voffA);
            PG8_WAIT_V(8); PG8_WAIT_L(0); PG8_BAR; PG8_MMA(1, 0, At, B0); PG8_MMA(1, 1, At, B1); PG8_BAR; PG8_SCHED;
            } else {
            PG8_LDB(B0, 0, 0); PG8_SCHED; PG8_LDA(At, 0, 0); PG8_STAGE(PG8_SA(1, 1), a1 + hstep, voffA);
            PG8_WAIT_L(8); PG8_BAR; PG8_WAIT_L(0); PG8_MMA(0, 0, At, B0); PG8_BAR; PG8_SCHED;
            PG8_LDB(B1, 0, 1); PG8_STAGE(PG8_SB(0, 0), b2, voffB);
            PG8_BAR; PG8_WAIT_L(0); PG8_MMA(0, 1, At, B1); PG8_BAR;
            PG8_LDA(At, 0, 1); PG8_STAGE(PG8_SA(0, 0), a2, voffA);
            PG8_BAR; PG8_WAIT_L(0); PG8_MMA(1, 0, At, B0); PG8_BAR; PG8_SCHED;
            PG8_STAGE(PG8_SB(0, 1), b2 + hstep, voffB);
            PG8_WAIT_V(6); PG8_BAR; PG8_MMA(1, 1, At, B1); PG8_BAR;
            PG8_LDB(B0, 1, 0); PG8_SCHED; PG8_LDA(At, 1, 0); PG8_STAGE(PG8_SA(0, 1), a2 + hstep, voffA);
            PG8_WAIT_L(8); PG8_BAR; PG8_WAIT_L(0); PG8_MMA(0, 0, At, B0); PG8_BAR; PG8_SCHED;
            PG8_LDB(B1, 1, 1); PG8_STAGE(PG8_SB(1, 0), b3, voffB);
            PG8_BAR; PG8_WAIT_L(0); PG8_MMA(0, 1, At, B1); PG8_BAR;
            PG8_LDA(At, 1, 1); PG8_STAGE(PG8_SA(1, 0), a3, voffA);
            PG8_BAR; PG8_WAIT_L(0); PG8_MMA(1, 0, At, B0); PG8_BAR; PG8_SCHED;
            PG8_STAGE(PG8_SB(1, 1), b3 + hstep, voffB);
            PG8_WAIT_V(6); PG8_BAR; PG8_MMA(1, 1, At, B1); PG8_BAR;
            }
        }
        if constexpr (ALIGN_EPI) { if (wr == 0) PG8_BAR; }
        if constexpr (!Epi::AFTER_DRAIN) { E(acc, cur, wr, wc, fr, fq); S.done(cur); }
        if (!has_next) break;
#pragma unroll
        for (int a = 0; a < 2; ++a)
#pragma unroll
            for (int b = 0; b < 2; ++b)
#pragma unroll
                for (int m = 0; m < 4; ++m)
#pragma unroll
                    for (int n = 0; n < 2; ++n) acc[a][b][m][n] = (f32x4){0.f, 0.f, 0.f, 0.f};
        cur = nxt; cA = nA; cB = nB; ++ui;
        if constexpr (ALIGN_EPI) { if (wr == 1) PG8_BAR; }
    }
    PG8_WAIT_V(0);
    if constexpr (!ALIGN_EPI) { if (wr == 0) PG8_BAR; }
    PG8_BAR;
    if constexpr (Epi::AFTER_DRAIN) { E.fused(acc, cur, wr, wc, fr, fq, lds, wid, lane); S.done(cur); }
#undef PG8_SA
#undef PG8_SB
#undef PG8_STAGE
#undef PG8_LDA
#undef PG8_LDB
#undef PG8_MMA
#undef PG8_WAIT_V
#undef PG8_WAIT_L
#undef PG8_BAR
#undef PG8_SCHED
}
}
#define LAS __attribute__((address_space(3)))
#define GAS __attribute__((address_space(1)))
typedef GAS unsigned gu32;
typedef GAS unsigned long long gu64;
#define RLX_AGENT __ATOMIC_RELAXED, __HIP_MEMORY_SCOPE_AGENT
#define LDS_WAIT() asm volatile("s_waitcnt lgkmcnt(0)" ::: "memory")
#define VM_WAIT() asm volatile("s_waitcnt vmcnt(0)" ::: "memory")
__device__ __forceinline__ unsigned long long rt() { return __builtin_amdgcn_s_memrealtime(); }
#define XB_TMO      128
#define XB_XCNT(j)  (256  + 64 * (j))
#define XB_XSUB(j)  (1280 + 64 * (j))
#define XB_XGEN(j)  (2304 + 64 * (j))
#define XB_TOP      3328
#define XB_TOPGEN   3392
#define XCD_BAR_WORDS 3456
#define XB_SPIN_CAP (1u << 18)

__device__ __forceinline__ unsigned xb_ld(unsigned* p)              { return __hip_atomic_load(p, __ATOMIC_RELAXED, __HIP_MEMORY_SCOPE_AGENT); }
__device__ __forceinline__ unsigned xb_add(unsigned* p, unsigned v) { return __hip_atomic_fetch_add(p, v, __ATOMIC_RELAXED, __HIP_MEMORY_SCOPE_AGENT); }
__device__ __forceinline__ unsigned xb_xcc_id() { return (unsigned)__builtin_amdgcn_s_getreg((3 << 11) | 20) & 0xFu; }
#define XB_SPIN(cond, bar) do { unsigned _sp = 0; while (cond) { __builtin_amdgcn_s_sleep(1); \
    if ((++_sp & 255u) == 0u) { if (xb_ld(&(bar)[XB_TMO])) break; if (_sp > XB_SPIN_CAP) { atomicAdd(&(bar)[XB_TMO], 1u); break; } } } } while (0)

struct XcdBarrier {
    unsigned* bar; unsigned x;
    volatile LAS unsigned* st;
};

__device__ __forceinline__ XcdBarrier xcd_barrier_post(unsigned* bar, volatile LAS unsigned* st, const bool t0) {
    XcdBarrier b; b.bar = bar; b.x = xb_xcc_id(); b.st = st;
    if (t0) (void)xb_add(&bar[XB_XCNT(b.x)], 1u);
    return b;
}
__device__ __forceinline__ void xcd_barrier_complete(unsigned* bar, unsigned x, unsigned& nloc, unsigned& nx) {
    const unsigned G = gridDim.x * gridDim.y * gridDim.z;
    unsigned sum, cnt, mine, sp = 0u;
    for (;;) {
        sum = 0u; cnt = 0u; mine = 0u;
#pragma unroll
        for (unsigned j = 0; j < 16; ++j) { const unsigned c = xb_ld(&bar[XB_XCNT(j)]); sum += c; cnt += (c > 0u) ? 1u : 0u; mine = (j == x) ? c : mine; }
        if (sum == G) break;
        __builtin_amdgcn_s_sleep(1);
        if ((++sp & 255u) == 0u) { if (xb_ld(&bar[XB_TMO])) break; if (sp > XB_SPIN_CAP) { atomicAdd(&bar[XB_TMO], 1u); break; } }
    }
    nloc = mine > 0u ? mine : 1u; nx = cnt > 0u ? cnt : 1u;
}

__device__ __forceinline__ void xcd_barrier(const XcdBarrier& b, const bool t0) {
    asm volatile("s_waitcnt vmcnt(0)" ::: "memory");
    __syncthreads();
    if (t0) {
        unsigned* bar = b.bar;
        __builtin_amdgcn_s_waitcnt(0);
        unsigned nloc = b.st[0], nx = b.st[1];
        if (nloc == 0u) { xcd_barrier_complete(bar, b.x, nloc, nx); b.st[0] = nloc; b.st[1] = nx; }
        const unsigned old = xb_add(&bar[XB_XSUB(b.x)], 1u);
        const unsigned gen = old / nloc;
        if (old + 1u == (gen + 1u) * nloc) {
            __builtin_amdgcn_fence(__ATOMIC_RELEASE, "agent");
            asm volatile("s_waitcnt vmcnt(0)" ::: "memory");
            const unsigned og = xb_add(&bar[XB_TOP], 1u);
            const unsigned tg = og / nx;
            if (og + 1u == (tg + 1u) * nx) xb_add(&bar[XB_TOPGEN], 1u);
            else XB_SPIN(xb_ld(&bar[XB_TOPGEN]) == tg, bar);
            __builtin_amdgcn_fence(__ATOMIC_ACQUIRE, "agent");
            xb_add(&bar[XB_XGEN(b.x)], 1u);
            asm volatile("s_waitcnt vmcnt(0)" ::: "memory");
        } else {
            XB_SPIN(xb_ld(&bar[XB_XGEN(b.x)]) == gen, bar);
            __builtin_amdgcn_fence(__ATOMIC_ACQUIRE, "agent");
            asm volatile("s_waitcnt vmcnt(0)" ::: "memory");
        }
    }
    __syncthreads();
}
constexpr int BATCH = 2, SEQ = 16384, DM = 2048, MTOK = BATCH * SEQ;
constexpr int E_IN = 6144, O_INP = 8448  , O_LD = 8192;
constexpr int S5G = 64, S5P = 64, S5T = 128, S5NC = SEQ / S5T;
constexpr float LOG2E = 1.4426950408889634f;
constexpr float RMS_EPS = 1e-6f;
constexpr int NWAVES = 8;

#define LAS __attribute__((address_space(3)))
typedef unsigned short bf16_t;
typedef short bf16x8 __attribute__((ext_vector_type(8)));
typedef float f32x4 __attribute__((ext_vector_type(4)));
typedef float f32x2 __attribute__((ext_vector_type(2)));
typedef float f32x16 __attribute__((ext_vector_type(16)));
typedef unsigned u32x4 __attribute__((ext_vector_type(4)));
typedef unsigned u32x2 __attribute__((ext_vector_type(2)));
typedef short v4i16_t __attribute__((ext_vector_type(4)));
typedef __bf16 bf16x2_t __attribute__((ext_vector_type(2)));

constexpr size_t MiB = 1u << 20;
constexpr size_t WS_CTL = 0;
constexpr size_t WS_LAMB = 1 * MiB;
constexpr size_t WS_LAMT = 1 * MiB + 65536;
constexpr size_t WS_BBAR = 2 * MiB;
constexpr size_t WS_CMAT = 3 * MiB;
constexpr size_t WS_BIASDA = 4 * MiB;
constexpr size_t WS_BIASF = 5 * MiB;
constexpr size_t WS_FLOG = 7 * MiB;
constexpr size_t WS_S5ST = 9 * MiB;
constexpr size_t WS_WIN0 = 20 * MiB;
constexpr size_t WS_WOUT0 = 44 * MiB;
constexpr size_t WS_WGLU = 52 * MiB;
constexpr size_t WS_WIN1 = 54 * MiB;
constexpr size_t WS_WOUT1 = 87 * MiB;
constexpr size_t WS_HBUF = 96 * MiB;
constexpr size_t WS_PROJ = 224 * MiB;
constexpr size_t WS_YCAT = 736 * MiB;
constexpr size_t WS_END = 864 * MiB;
constexpr int CW_BAR = 4096;
constexpr int CW_QDA = 64, CW_QFOX = 128, CW_LAM = 192, CW_THRDA = 193, CW_THRF = 194;
constexpr float ZERO_THR = 105.f;

constexpr int LDS_MISC = 135168;
constexpr int LDS_BYTES = 147456;
constexpr int AL_K = 0, AL_V = 32768, AL_B = 65536;
constexpr int LDS_STASH = 69632;

__device__ __forceinline__ float bf2f(unsigned b) { return __uint_as_float(b << 16); }
__device__ __forceinline__ unsigned pk2(float lo, float hi) { f32x2 v = {lo, hi}; bf16x2_t b = __builtin_convertvector(v, bf16x2_t); return __builtin_bit_cast(unsigned, b); }
__device__ __forceinline__ float bflo(unsigned w) { return __uint_as_float(w << 16); }
__device__ __forceinline__ float bfhi(unsigned w) { return __uint_as_float(w & 0xffff0000u); }
__device__ __forceinline__ float sigmoidf_(float x) { return 1.f / (1.f + __expf(-x)); }
__device__ __forceinline__ float siluf_(float x) { return x * sigmoidf_(x); }
__device__ __forceinline__ float gelu_tanh(float x) { const float z = 0.7978845608028654f * (x + 0.044715f * x * x * x); const float t = 1.f - 2.f / (1.f + __expf(2.f * z)); return 0.5f * x * (1.f + t); }
#define DOT2(a, b, c) __builtin_amdgcn_fdot2_f32_bf16(__builtin_bit_cast(bf16x2_t, (unsigned)(a)), __builtin_bit_cast(bf16x2_t, (unsigned)(b)), (c), false)
__device__ __forceinline__ int crow(int r, int hi) { return (r & 3) + 8 * (r >> 2) + 4 * hi; }
__device__ __forceinline__ float wave_sum(float v) {
#pragma unroll
    for (int o = 1; o < 64; o <<= 1) v += __shfl_xor(v, o);
    return v;
}

struct Args {
    const float* in[27];
    float* out; unsigned char* ws;
    int ph_lo, ph_hi;
};

namespace pg8 {
struct EpiProj1 {
    static constexpr bool PERM = true, AFTER_DRAIN = false;
    bf16_t* O; float* flog;
    __device__ __forceinline__ void operator()(const f32x4 (&acc)[2][2][4][2], const Unit& u, int wr, int wc, int fr, int fq) const {
        const int row0 = u.pm * BM + wr * 64 + fr;
        if (u.pn < 32) {
            const int col0 = u.pn * BM + wc * 32 + 8 * fq;
#pragma unroll
            for (int ai = 0; ai < 2; ++ai)
#pragma unroll
                for (int m = 0; m < 4; ++m) { bf16_t* rowp = O + (size_t)(row0 + ai * HALF + m * 16) * O_LD + col0;
#pragma unroll
                    for (int bj = 0; bj < 2; ++bj) { const f32x4 v0 = acc[ai][bj][m][0], v1 = acc[ai][bj][m][1];
                        u32x4 w; w.x = cvt_pk_bf16(v0[0], v0[1]); w.y = cvt_pk_bf16(v0[2], v0[3]); w.z = cvt_pk_bf16(v1[0], v1[1]); w.w = cvt_pk_bf16(v1[2], v1[3]);
                        *(u32x4*)(rowp + bj * HALF) = w; } }
        } else if (wc == 0 && fq < 2) {
#pragma unroll
            for (int ai = 0; ai < 2; ++ai)
#pragma unroll
                for (int m = 0; m < 4; ++m) { float* rp = flog + (size_t)(row0 + ai * HALF + m * 16) * 16 + 8 * fq;
                    *(f32x4*)(rp) = acc[ai][0][m][0]; *(f32x4*)(rp + 4) = acc[ai][0][m][1]; }
        }
    }
};
struct EpiGlu {
    static constexpr bool PERM = true, AFTER_DRAIN = false;
    bf16_t* O; const bf16_t* yg; const bf16_t* proj0; const float* bglu;
    __device__ __forceinline__ void operator()(const f32x4 (&acc)[2][2][4][2], const Unit& u, int wr, int wc, int fr, int fq) const {
        const int row0 = u.pm * BM + wr * 64 + fr; const int col0 = u.pn * BM + wc * 32 + 8 * fq;
#pragma unroll
        for (int ai = 0; ai < 2; ++ai)
#pragma unroll
            for (int m = 0; m < 4; ++m) { const size_t row = (size_t)(row0 + ai * HALF + m * 16);
#pragma unroll
                for (int bj = 0; bj < 2; ++bj) { const int c = col0 + bj * HALF;
                    const f32x4 b0 = *(const f32x4*)(bglu + c), b1 = *(const f32x4*)(bglu + c + 4);
                    const u32x4 yv = *(const u32x4*)(yg + row * 1024 + c); const u32x4 zv = *(const u32x4*)(proj0 + row * E_IN + 1024 + c);
                    const f32x4 v0 = acc[ai][bj][m][0] + b0, v1 = acc[ai][bj][m][1] + b1;
                    float r[8];
#pragma unroll
                    for (int e = 0; e < 4; ++e) { const unsigned yw = yv[e], zw = zv[e];
                        const float a0 = e < 2 ? v0[2 * e] : v1[2 * e - 4], a1 = e < 2 ? v0[2 * e + 1] : v1[2 * e - 3];
                        r[2 * e] = bflo(yw) * sigmoidf_(a0) * siluf_(bflo(zw)); r[2 * e + 1] = bfhi(yw) * sigmoidf_(a1) * siluf_(bfhi(zw)); }
                    u32x4 w; w.x = cvt_pk_bf16(r[0], r[1]); w.y = cvt_pk_bf16(r[2], r[3]); w.z = cvt_pk_bf16(r[4], r[5]); w.w = cvt_pk_bf16(r[6], r[7]);
                    *(u32x4*)(O + row * DM + c) = w; } }
    }
};
struct EpiResid {
    static constexpr bool PERM = false, AFTER_DRAIN = false;
    const float* base; float* out;
    __device__ __forceinline__ void operator()(const f32x4 (&acc)[2][2][4][2], const Unit& u, int wr, int wc, int fr, int fq) const {
        const int row0 = u.pm * BM + wr * 64 + fr; const int col0 = u.pn * BM + wc * 32 + 4 * fq;
#pragma unroll
        for (int ai = 0; ai < 2; ++ai)
#pragma unroll
            for (int m = 0; m < 4; ++m) { const size_t off = (size_t)(row0 + ai * HALF + m * 16) * DM + col0;
#pragma unroll
                for (int bj = 0; bj < 2; ++bj)
#pragma unroll
                    for (int n = 0; n < 2; ++n) { const f32x4 bs = *(const f32x4*)(base + off + bj * HALF + n * 16); *(f32x4*)(out + off + bj * HALF + n * 16) = bs + acc[ai][bj][m][n]; } }
    }
};
}

__device__ __forceinline__ void transpose_item(const float* __restrict__ W, int K, int N, bf16_t* __restrict__ WT, LAS float* scr, int item, int nblk, int lane) {
    const int kb = item / nblk, nb = item % nblk, k0 = 64 * kb, n0 = 32 * nb;
    const int nc = n0 + (lane & 31);
#pragma unroll 8
    for (int i = 0; i < 32; ++i) { const int kk = 2 * i + (lane >> 5); scr[kk * 33 + (lane & 31)] = (nc < N) ? W[(size_t)(k0 + kk) * N + nc] : 0.f; }
    asm volatile("s_waitcnt lgkmcnt(0)" ::: "memory");
    const int c = lane & 7;
#pragma unroll
    for (int j = 0; j < 4; ++j) { const int n = (lane >> 3) + 8 * j; const LAS float* s = scr + (8 * c) * 33 + n;
        u32x4 o; o.x = pk2(s[0 * 33], s[1 * 33]); o.y = pk2(s[2 * 33], s[3 * 33]); o.z = pk2(s[4 * 33], s[5 * 33]); o.w = pk2(s[6 * 33], s[7 * 33]);
        *(u32x4*)(WT + (size_t)(n0 + n) * K + k0 + 8 * c) = o; }
    asm volatile("s_waitcnt lgkmcnt(0)" ::: "memory");
}
__device__ __forceinline__ void rms_row_to_bf16(const float* __restrict__ xrow, const float* __restrict__ gain, bf16_t* __restrict__ orow, int lane) {
    const f32x4* xr = (const f32x4*)xrow + lane; const f32x4* gr = (const f32x4*)gain + lane;
    f32x4 v[8]; float s = 0.f;
#pragma unroll
    for (int j = 0; j < 8; ++j) { v[j] = xr[64 * j]; s += (v[j].x * v[j].x + v[j].y * v[j].y) + (v[j].z * v[j].z + v[j].w * v[j].w); }
    const float r = 1.f / sqrtf(wave_sum(s) * (1.f / DM) + RMS_EPS);
    u32x2* o8 = (u32x2*)orow + lane;
#pragma unroll
    for (int j = 0; j < 8; ++j) { const f32x4 g = gr[64 * j]; u32x2 w; w.x = pk2(v[j].x * r * g.x, v[j].y * r * g.y); w.y = pk2(v[j].z * r * g.z, v[j].w * r * g.w); o8[64 * j] = w; }
}
template <int LPS>
__device__ __forceinline__ void qknorm16(bf16_t* p, const float* __restrict__ gain16, float mul, float inv_n) {
    u32x4 a = *(u32x4*)p, b = *(u32x4*)(p + 8);
    float v[16];
#pragma unroll
    for (int e = 0; e < 4; ++e) { v[2 * e] = bflo(a[e]); v[2 * e + 1] = bfhi(a[e]); v[8 + 2 * e] = bflo(b[e]); v[9 + 2 * e] = bfhi(b[e]); }
    float s = 0.f;
#pragma unroll
    for (int e = 0; e < 16; ++e) s += v[e] * v[e];
#pragma unroll
    for (int o = 1; o < LPS; o <<= 1) s += __shfl_xor(s, o);
    const float r = mul / sqrtf(s * inv_n + RMS_EPS);
#pragma unroll
    for (int e = 0; e < 16; ++e) v[e] = v[e] * r * gain16[e];
#pragma unroll
    for (int e = 0; e < 4; ++e) { a[e] = pk2(v[2 * e], v[2 * e + 1]); b[e] = pk2(v[8 + 2 * e], v[9 + 2 * e]); }
    *(u32x4*)p = a; *(u32x4*)(p + 8) = b;
}
__device__ __forceinline__ void rms_rows2_to_bf16(const float* __restrict__ x0, const float* __restrict__ x1, const bool has1, const float* __restrict__ gain, bf16_t* __restrict__ o0, bf16_t* __restrict__ o1, int lane) {
    const f32x4* xr0 = (const f32x4*)x0 + lane; const f32x4* xr1 = (const f32x4*)x1 + lane; const f32x4* gr = (const f32x4*)gain + lane;
    f32x4 v[8], w[8]; float s0 = 0.f, s1 = 0.f;
#pragma unroll
    for (int j = 0; j < 8; ++j) v[j] = xr0[64 * j];
    if (has1) {
#pragma unroll
        for (int j = 0; j < 8; ++j) w[j] = xr1[64 * j];
    }
#pragma unroll
    for (int j = 0; j < 8; ++j) s0 += (v[j].x * v[j].x + v[j].y * v[j].y) + (v[j].z * v[j].z + v[j].w * v[j].w);
    const float r0 = 1.f / sqrtf(wave_sum(s0) * (1.f / DM) + RMS_EPS);
    u32x2* p0 = (u32x2*)o0 + lane;
#pragma unroll
    for (int j = 0; j < 8; ++j) { const f32x4 g = gr[64 * j]; u32x2 q; q.x = pk2(v[j].x * r0 * g.x, v[j].y * r0 * g.y); q.y = pk2(v[j].z * r0 * g.z, v[j].w * r0 * g.w); p0[64 * j] = q; }
    if (has1) {
#pragma unroll
        for (int j = 0; j < 8; ++j) s1 += (w[j].x * w[j].x + w[j].y * w[j].y) + (w[j].z * w[j].z + w[j].w * w[j].w);
        const float r1 = 1.f / sqrtf(wave_sum(s1) * (1.f / DM) + RMS_EPS);
        u32x2* p1 = (u32x2*)o1 + lane;
#pragma unroll
        for (int j = 0; j < 8; ++j) { const f32x4 g = gr[64 * j]; u32x2 q; q.x = pk2(w[j].x * r1 * g.x, w[j].y * r1 * g.y); q.y = pk2(w[j].z * r1 * g.z, w[j].w * r1 * g.w); p1[64 * j] = q; }
    }
}
template <int LPS>
__device__ __forceinline__ void qknorm_regs(u32x4& a, u32x4& b, const float* __restrict__ gp, float mul, float inv_n) {
    float v[16];
#pragma unroll
    for (int e = 0; e < 4; ++e) { v[2 * e] = bflo(a[e]); v[2 * e + 1] = bfhi(a[e]); v[8 + 2 * e] = bflo(b[e]); v[9 + 2 * e] = bfhi(b[e]); }
    float s = 0.f;
#pragma unroll
    for (int e = 0; e < 16; ++e) s += v[e] * v[e];
#pragma unroll
    for (int o = 1; o < LPS; o <<= 1) s += __shfl_xor(s, o);
    const float r = mul / sqrtf(s * inv_n + RMS_EPS);
#pragma unroll
    for (int e = 0; e < 4; ++e) { const f32x4 gg = *(const f32x4*)(gp + 4 * e);
        v[4 * e] *= r * gg.x; v[4 * e + 1] *= r * gg.y; v[4 * e + 2] *= r * gg.z; v[4 * e + 3] *= r * gg.w; }
#pragma unroll
    for (int e = 0; e < 4; ++e) { a[e] = pk2(v[2 * e], v[2 * e + 1]); b[e] = pk2(v[8 + 2 * e], v[9 + 2 * e]); }
}
template <int NIT, int NQ, int LPS>
__device__ __forceinline__ void qknorm_rows2(bf16_t* p0, bf16_t* p1, const bool has1, const float* __restrict__ gq, const float* __restrict__ gk, const float qmul, const float inv_n, const int lane) {
    u32x4 a0[NIT], b0[NIT], a1[NIT], b1[NIT];
#pragma unroll
    for (int it = 0; it < NIT; ++it) { a0[it] = *(const u32x4*)(p0 + it * 1024 + lane * 16); b0[it] = *(const u32x4*)(p0 + it * 1024 + lane * 16 + 8); }
    if (has1) {
#pragma unroll
        for (int it = 0; it < NIT; ++it) { a1[it] = *(const u32x4*)(p1 + it * 1024 + lane * 16); b1[it] = *(const u32x4*)(p1 + it * 1024 + lane * 16 + 8); }
    }
#pragma unroll
    for (int it = 0; it < NIT; ++it) { const float* gp = (it < NQ ? gq : gk) + ((lane * 16) & 127);
        qknorm_regs<LPS>(a0[it], b0[it], gp, it < NQ ? qmul : 1.f, inv_n);
        *(u32x4*)(p0 + it * 1024 + lane * 16) = a0[it]; *(u32x4*)(p0 + it * 1024 + lane * 16 + 8) = b0[it]; }
    if (has1) {
#pragma unroll
        for (int it = 0; it < NIT; ++it) { const float* gp = (it < NQ ? gq : gk) + ((lane * 16) & 127);
            qknorm_regs<LPS>(a1[it], b1[it], gp, it < NQ ? qmul : 1.f, inv_n);
            *(u32x4*)(p1 + it * 1024 + lane * 16) = a1[it]; *(u32x4*)(p1 + it * 1024 + lane * 16 + 8) = b1[it]; }
    }
}

template <int DQK>
__device__ __forceinline__ void attn_pass(LAS unsigned char* lds, const bf16_t* __restrict__ Qg, const bf16_t* __restrict__ Kg, const bf16_t* __restrict__ Vg,
                                          const float* __restrict__ btab, const float bscale, const int pitch, const int q0, const int t_lo, f32x16 (&o)[4], const int wid, const int lane) {
    constexpr int NCH = DQK / 8, KS = DQK / 16, KROWB = DQK * 2, KI = NCH / 8;
    const int tid = wid * 64 + lane, r32 = lane & 31, hi = lane >> 5;
    const int NT = (q0 + 256) / 64;
    const int qrel = wid * 32 + r32;
    bf16x8 qf[KS];
#pragma unroll
    for (int s = 0; s < KS; ++s) qf[s] = *(const bf16x8*)(Qg + (size_t)(q0 + qrel) * pitch + 16 * s + 8 * hi);
    int kgo[KI], klo[KI], vgo[2], vlo[2];
#pragma unroll
    for (int i = 0; i < KI; ++i) { const int cid = tid + 512 * i, row = cid / NCH, ch = cid % NCH; const int sw = (DQK == 128) ? (row & 15) : ((row >> 1) & 7);
        kgo[i] = row * pitch + ch * 8; klo[i] = row * KROWB + ((ch ^ sw) << 4); }
#pragma unroll
    for (int i = 0; i < 2; ++i) { const int cid = tid + 512 * i, row = cid >> 4, ch = cid & 15;
        vgo[i] = row * pitch + ch * 8; vlo[i] = (ch >> 2) * 4096 + (row >> 3) * 512 + (row & 7) * 64 + (ch & 3) * 16; }
    const float bref = btab[q0];
    u32x4 kreg[KI], vreg[2]; float breg = 0.f;
#define AT_LOAD(t) do { const size_t kvb_ = (size_t)(64 * (t)) * pitch; \
        _Pragma("unroll") for (int i = 0; i < KI; ++i) kreg[i] = *(const u32x4*)(Kg + kvb_ + kgo[i]); \
        _Pragma("unroll") for (int i = 0; i < 2; ++i) vreg[i] = *(const u32x4*)(Vg + kvb_ + vgo[i]); \
        if (tid < 64) breg = (btab[64 * (t) + tid] - bref) * bscale; } while (0)
#define AT_STORE(buf) do { \
        _Pragma("unroll") for (int i = 0; i < KI; ++i) *(LAS u32x4*)(lds + AL_K + (buf) * 16384 + klo[i]) = kreg[i]; \
        _Pragma("unroll") for (int i = 0; i < 2; ++i) *(LAS u32x4*)(lds + AL_V + (buf) * 16384 + vlo[i]) = vreg[i]; \
        if (tid < 64) *(LAS float*)(lds + AL_B + (buf) * 256 + tid * 4) = breg; } while (0)
    float m_run = -INFINITY, l_run = 0.f;
#pragma unroll
    for (int b = 0; b < 4; ++b)
#pragma unroll
        for (int r = 0; r < 16; ++r) o[b][r] = 0.f;
    AT_LOAD(t_lo); AT_STORE(0); __syncthreads();
    const int ksw = (DQK == 128) ? (r32 & 15) : ((r32 >> 1) & 7);
    const int vlane = (4 * hi + ((lane & 15) >> 2)) * 64 + ((lane >> 4) & 1) * 32 + (lane & 3) * 8;
    for (int t = t_lo; t < NT; ++t) {
        const int cur = (t - t_lo) & 1;
        if (t + 1 < NT) AT_LOAD(t + 1);
        const int jb = t - (NT - 4);
        const bool skip = (jb >= 0) && (2 * jb > wid);
        if (!skip) {
            LAS const unsigned char* Kb = lds + AL_K + cur * 16384;
            f32x16 s0, s1;
            LAS const float* bl = (LAS const float*)(lds + AL_B + cur * 256);
#pragma unroll
            for (int g = 0; g < 4; ++g) { const f32x4 b0 = *(LAS const f32x4*)(bl + 8 * g + 4 * hi), b1 = *(LAS const f32x4*)(bl + 32 + 8 * g + 4 * hi);
#pragma unroll
                for (int e = 0; e < 4; ++e) { s0[4 * g + e] = b0[e]; s1[4 * g + e] = b1[e]; } }
#pragma unroll
            for (int s = 0; s < KS; ++s) { const int ch = 2 * s + hi;
                const bf16x8 a0 = *(LAS const bf16x8*)(Kb + r32 * KROWB + ((ch ^ ksw) << 4));
                const bf16x8 a1 = *(LAS const bf16x8*)(Kb + (32 + r32) * KROWB + ((ch ^ ksw) << 4));
                s0 = __builtin_amdgcn_mfma_f32_32x32x16_bf16(a0, qf[s], s0, 0, 0, 0);
                s1 = __builtin_amdgcn_mfma_f32_32x32x16_bf16(a1, qf[s], s1, 0, 0, 0); }
            if ((jb >= 0) && (2 * jb + 1 >= wid)) {
#pragma unroll
                for (int r = 0; r < 16; ++r) { const int kv = 64 * jb + crow(r, hi); if (kv > qrel) s0[r] = -INFINITY; if (kv + 32 > qrel) s1[r] = -INFINITY; }
            }
            float mx = fmaxf(s0[0], s1[0]);
#pragma unroll
            for (int r = 1; r < 16; ++r) mx = fmaxf(mx, fmaxf(s0[r], s1[r]));
            mx = fmaxf(mx, __shfl_xor(mx, 32));
            if (__any(mx > m_run + 8.f)) {
                const float m_new = fmaxf(m_run, mx);
                const float alpha = __builtin_amdgcn_exp2f(m_run - m_new);
                m_run = m_new; l_run *= alpha;
#pragma unroll
                for (int b = 0; b < 4; ++b)
#pragma unroll
                    for (int r = 0; r < 16; ++r) o[b][r] *= alpha;
            }
            float rs = 0.f;
#pragma unroll
            for (int r = 0; r < 16; ++r) { s0[r] = __builtin_amdgcn_exp2f(s0[r] - m_run); s1[r] = __builtin_amdgcn_exp2f(s1[r] - m_run); rs += s0[r] + s1[r]; }
            l_run += rs;
            u32x4 pw[4];
#pragma unroll
            for (int e = 0; e < 4; ++e) { pw[0][e] = pk2(s0[2 * e], s0[2 * e + 1]); pw[1][e] = pk2(s0[8 + 2 * e], s0[9 + 2 * e]); pw[2][e] = pk2(s1[2 * e], s1[2 * e + 1]); pw[3][e] = pk2(s1[8 + 2 * e], s1[9 + 2 * e]); }
            LAS const unsigned char* Vb = lds + AL_V + cur * 16384 + vlane;
#pragma unroll
            for (int b = 0; b < 4; ++b)
#pragma unroll
                for (int ks = 0; ks < 4; ++ks) {
                    const v4i16_t lo = __builtin_amdgcn_ds_read_tr16_b64_v4i16((LAS v4i16_t*)(Vb + b * 4096 + ks * 1024));
                    const v4i16_t hh = __builtin_amdgcn_ds_read_tr16_b64_v4i16((LAS v4i16_t*)(Vb + b * 4096 + ks * 1024 + 512));
                    const bf16x8 af = {lo[0], lo[1], lo[2], lo[3], hh[0], hh[1], hh[2], hh[3]};
                    o[b] = __builtin_amdgcn_mfma_f32_32x32x16_bf16(af, __builtin_bit_cast(bf16x8, pw[ks]), o[b], 0, 0, 0);
                }
        }
        if (t + 1 < NT) AT_STORE(cur ^ 1);
        __syncthreads();
    }
#undef AT_LOAD
#undef AT_STORE
    const float l = l_run + __shfl_xor(l_run, 32);
    const float inv = 1.f / l;
#pragma unroll
    for (int b = 0; b < 4; ++b)
#pragma unroll
        for (int r = 0; r < 16; ++r) o[b][r] *= inv;
}

template <int DQK>
__device__ __forceinline__ void qk_tile(LAS const unsigned char* Kb, LAS const float* bl, const bf16x8* qf, const int ksw, const int r32, const int hi, f32x16& s0, f32x16& s1) {
    constexpr int KS = DQK / 16, KROWB = DQK * 2;
#pragma unroll
    for (int g = 0; g < 4; ++g) { const f32x4 b0 = *(LAS const f32x4*)(bl + 8 * g + 4 * hi), b1 = *(LAS const f32x4*)(bl + 32 + 8 * g + 4 * hi);
#pragma unroll
        for (int e = 0; e < 4; ++e) { s0[4 * g + e] = b0[e]; s1[4 * g + e] = b1[e]; } }
#pragma unroll
    for (int s = 0; s < KS; ++s) { const int ch = 2 * s + hi;
        const bf16x8 a0 = *(LAS const bf16x8*)(Kb + r32 * KROWB + ((ch ^ ksw) << 4));
        const bf16x8 a1 = *(LAS const bf16x8*)(Kb + (32 + r32) * KROWB + ((ch ^ ksw) << 4));
        s0 = __builtin_amdgcn_mfma_f32_32x32x16_bf16(a0, qf[s], s0, 0, 0, 0);
        s1 = __builtin_amdgcn_mfma_f32_32x32x16_bf16(a1, qf[s], s1, 0, 0, 0); }
}
__device__ __forceinline__ void pv_tile(LAS const unsigned char* Vb, const u32x4* pw, f32x16 (&o)[4]) {
#pragma unroll
    for (int ks = 0; ks < 4; ++ks)
#pragma unroll
        for (int b = 0; b < 4; ++b) {
            const v4i16_t lo = __builtin_amdgcn_ds_read_tr16_b64_v4i16((LAS v4i16_t*)(Vb + b * 4096 + ks * 1024));
            const v4i16_t hh = __builtin_amdgcn_ds_read_tr16_b64_v4i16((LAS v4i16_t*)(Vb + b * 4096 + ks * 1024 + 512));
            const bf16x8 af = {lo[0], lo[1], lo[2], lo[3], hh[0], hh[1], hh[2], hh[3]};
            o[b] = __builtin_amdgcn_mfma_f32_32x32x16_bf16(af, __builtin_bit_cast(bf16x8, pw[ks]), o[b], 0, 0, 0);
        }
}
__device__ __forceinline__ void softmax_tile(f32x16& s0, f32x16& s1, float& m_run, float& l_run, float& alpha, bool& resc, u32x4* pw) {
    float mxa = __builtin_fmaxf(s0[0], s1[0]), mxb = __builtin_fmaxf(s0[1], s1[1]);
#pragma unroll
    for (int r = 2; r < 16; r += 2) { mxa = __builtin_fmaxf(__builtin_fmaxf(mxa, s0[r]), s1[r]); mxb = __builtin_fmaxf(__builtin_fmaxf(mxb, s0[r + 1]), s1[r + 1]); }
    float mx = __builtin_fmaxf(mxa, mxb);
    { auto rr = __builtin_amdgcn_permlane32_swap(__float_as_uint(mx), __float_as_uint(mx), false, false); mx = fmaxf(__uint_as_float(rr[0]), __uint_as_float(rr[1])); }
    resc = __any(mx > m_run + 8.f);
    alpha = 1.f;
    if (resc) { const float m_new = fmaxf(m_run, mx); alpha = __builtin_amdgcn_exp2f(m_run - m_new); m_run = m_new; l_run *= alpha; }
    float rs = 0.f;
#pragma unroll
    for (int r = 0; r < 16; ++r) { s0[r] = __builtin_amdgcn_exp2f(s0[r] - m_run); s1[r] = __builtin_amdgcn_exp2f(s1[r] - m_run); rs += s0[r] + s1[r]; }
    l_run += rs;
#pragma unroll
    for (int e = 0; e < 4; ++e) { pw[0][e] = pk2(s0[2 * e], s0[2 * e + 1]); pw[1][e] = pk2(s0[8 + 2 * e], s0[9 + 2 * e]); pw[2][e] = pk2(s1[2 * e], s1[2 * e + 1]); pw[3][e] = pk2(s1[8 + 2 * e], s1[9 + 2 * e]); }
}
__device__ __forceinline__ void softmax_tile_sm(f32x16& s0, f32x16& s1, float& m_run, float& l_run, float& alpha, bool& resc, u32x4* pw, const bool skipmax) {
    resc = false; alpha = 1.f;
    if (!skipmax) {
    float mxa = __builtin_fmaxf(s0[0], s1[0]), mxb = __builtin_fmaxf(s0[1], s1[1]);
#pragma unroll
    for (int r = 2; r < 16; r += 2) { mxa = __builtin_fmaxf(__builtin_fmaxf(mxa, s0[r]), s1[r]); mxb = __builtin_fmaxf(__builtin_fmaxf(mxb, s0[r + 1]), s1[r + 1]); }
    float mx = __builtin_fmaxf(mxa, mxb);
    { auto rr = __builtin_amdgcn_permlane32_swap(__float_as_uint(mx), __float_as_uint(mx), false, false); mx = fmaxf(__uint_as_float(rr[0]), __uint_as_float(rr[1])); }
    resc = __any(mx > m_run + 8.f);
    alpha = 1.f;
    if (resc) { const float m_new = fmaxf(m_run, mx); alpha = __builtin_amdgcn_exp2f(m_run - m_new); m_run = m_new; l_run *= alpha; }
    }
    float rs = 0.f;
#pragma unroll
    for (int r = 0; r < 16; ++r) { s0[r] = __builtin_amdgcn_exp2f(s0[r] - m_run); s1[r] = __builtin_amdgcn_exp2f(s1[r] - m_run); rs += s0[r] + s1[r]; }
    l_run += rs;
#pragma unroll
    for (int e = 0; e < 4; ++e) { pw[0][e] = pk2(s0[2 * e], s0[2 * e + 1]); pw[1][e] = pk2(s0[8 + 2 * e], s0[9 + 2 * e]); pw[2][e] = pk2(s1[2 * e], s1[2 * e + 1]); pw[3][e] = pk2(s1[8 + 2 * e], s1[9 + 2 * e]); }
}
template <int DQK>
__device__ __forceinline__ void attn_pass2(LAS unsigned char* lds, const bf16_t* __restrict__ Qg, const bf16_t* __restrict__ Kg, const bf16_t* __restrict__ Vg,
                                           const float* __restrict__ btab, const float bscale, const int pitch, const int q0, const int t_lo, f32x16 (&o)[4], const int wid, const int lane) {
    constexpr int NCH = DQK / 8, KS = DQK / 16, KROWB = DQK * 2, KI = NCH / 8;
    const int tid = wid * 64 + lane, r32 = lane & 31, hi = lane >> 5;
    const int NT = (q0 + 256) / 64;
    const int T_w = NT - 4 + (wid >> 1);
    const int qrel = wid * 32 + r32;
    bf16x8 qf[KS];
#pragma unroll
    for (int s = 0; s < KS; ++s) qf[s] = *(const bf16x8*)(Qg + (size_t)(q0 + qrel) * pitch + 16 * s + 8 * hi);
    int kgo[KI], klo[KI], vgo[2], vlo[2];
#pragma unroll
    for (int i = 0; i < KI; ++i) { const int cid = tid + 512 * i, row = cid / NCH, ch = cid % NCH; const int sw = (DQK == 128) ? (row & 15) : ((row >> 1) & 7);
        kgo[i] = row * pitch + ch * 8; klo[i] = row * KROWB + ((ch ^ sw) << 4); }
#pragma unroll
    for (int i = 0; i < 2; ++i) { const int cid = tid + 512 * i, row = cid >> 4, ch = cid & 15;
        vgo[i] = row * pitch + ch * 8; vlo[i] = (ch >> 2) * 4096 + (row >> 3) * 512 + (row & 7) * 64 + (ch & 3) * 16; }
    const float bref = btab[q0];
    u32x4 kreg[KI], vreg[2]; float breg = 0.f;
#define AT_LOADK(t) do { const size_t kvb_ = (size_t)(64 * (t)) * pitch; \
        _Pragma("unroll") for (int i = 0; i < KI; ++i) kreg[i] = *(const u32x4*)(Kg + kvb_ + kgo[i]); \
        if (tid < 64) breg = (btab[64 * (t) + tid] - bref) * bscale; } while (0)
#define AT_LOADV(t) do { const size_t kvb_ = (size_t)(64 * (t)) * pitch; \
        _Pragma("unroll") for (int i = 0; i < 2; ++i) vreg[i] = *(const u32x4*)(Vg + kvb_ + vgo[i]); } while (0)
#define AT_STOREK(buf) do { \
        _Pragma("unroll") for (int i = 0; i < KI; ++i) *(LAS u32x4*)(lds + AL_K + (buf) * 16384 + klo[i]) = kreg[i]; \
        if (tid < 64) *(LAS float*)(lds + AL_B + (buf) * 256 + tid * 4) = breg; } while (0)
#define AT_STOREV(buf) do { \
        _Pragma("unroll") for (int i = 0; i < 2; ++i) *(LAS u32x4*)(lds + AL_V + (buf) * 16384 + vlo[i]) = vreg[i]; } while (0)
    float m_run = -INFINITY, l_run = 0.f;
#pragma unroll
    for (int b = 0; b < 4; ++b)
#pragma unroll
        for (int r = 0; r < 16; ++r) o[b][r] = 0.f;
    const int ksw = (DQK == 128) ? (r32 & 15) : ((r32 >> 1) & 7);
    const int vlane = (4 * hi + ((lane & 15) >> 2)) * 64 + ((lane >> 4) & 1) * 32 + (lane & 3) * 8;
    AT_LOADK(t_lo); AT_STOREK(t_lo & 1);
    AT_LOADK(t_lo + 1); AT_STOREK((t_lo + 1) & 1);
    __syncthreads();
    f32x16 sc0, sc1, sn0, sn1;
    u32x4 pprev[4], pnew[4];
#pragma unroll
    for (int k = 0; k < 4; ++k) { pprev[k] = (u32x4){0u, 0u, 0u, 0u}; pnew[k] = (u32x4){0u, 0u, 0u, 0u}; }
    qk_tile<DQK>(lds + AL_K + (t_lo & 1) * 16384, (LAS const float*)(lds + AL_B + (t_lo & 1) * 256), qf, ksw, r32, hi, sc0, sc1);
#pragma unroll
    for (int r = 0; r < 16; ++r) { sn0[r] = 0.f; sn1[r] = 0.f; }
    for (int t = t_lo; t < NT; ++t) {
        const int pn = (t + 1) & 1, pc = t & 1;
        if (t + 2 < NT) AT_LOADK(t + 2);
        AT_LOADV(t);
        float alpha = 1.f; bool resc = false;
        if ((t > t_lo) && (t < NT - 4)) {
            qk_tile<DQK>(lds + AL_K + pn * 16384, (LAS const float*)(lds + AL_B + pn * 256), qf, ksw, r32, hi, sn0, sn1);
            pv_tile(lds + AL_V + pn * 16384 + vlane, pprev, o);
            softmax_tile(sc0, sc1, m_run, l_run, alpha, resc, pnew);
        } else {
            if (t + 1 <= T_w) qk_tile<DQK>(lds + AL_K + pn * 16384, (LAS const float*)(lds + AL_B + pn * 256), qf, ksw, r32, hi, sn0, sn1);
            if (t > t_lo && t - 1 <= T_w) pv_tile(lds + AL_V + pn * 16384 + vlane, pprev, o);
            if (t <= T_w) {
                const int jb = t - (NT - 4);
                if ((jb >= 0) && (2 * jb + 1 >= wid)) {
#pragma unroll
                    for (int r = 0; r < 16; ++r) { const int kv = 64 * jb + crow(r, hi); if (kv > qrel) sc0[r] = -INFINITY; if (kv + 32 > qrel) sc1[r] = -INFINITY; }
                }
                softmax_tile(sc0, sc1, m_run, l_run, alpha, resc, pnew);
            }
        }
        if (resc) {
#pragma unroll
            for (int b = 0; b < 4; ++b)
#pragma unroll
                for (int r = 0; r < 16; ++r) o[b][r] *= alpha;
        }
        if (t + 2 < NT) AT_STOREK(pc);
        AT_STOREV(pc);
        __syncthreads();
#pragma unroll
        for (int k = 0; k < 4; ++k) pprev[k] = pnew[k];
        sc0 = sn0; sc1 = sn1;
    }
    if (NT - 1 <= T_w) pv_tile(lds + AL_V + ((NT - 1) & 1) * 16384 + vlane, pprev, o);
    __syncthreads();
#undef AT_LOADK
#undef AT_LOADV
#undef AT_STOREK
#undef AT_STOREV
    const float l = l_run + __shfl_xor(l_run, 32);
    const float inv = 1.f / l;
#pragma unroll
    for (int b = 0; b < 4; ++b)
#pragma unroll
        for (int r = 0; r < 16; ++r) o[b][r] *= inv;
}

template <int DQK>
__device__ __forceinline__ void qk_tile_pf(LAS const unsigned char* Kb, LAS const float* bl, const bf16x8* qf, const int ksw, const int r32, const int hi, f32x16& s0, f32x16& s1) {
    constexpr int KS = DQK / 16, KROWB = DQK * 2;
    LAS const unsigned char* k0 = Kb + r32 * KROWB; LAS const unsigned char* k1 = Kb + (32 + r32) * KROWB;
    bf16x8 fa[2][2];
    { const int ch_ = hi; fa[0][0] = *(LAS const bf16x8*)(k0 + ((ch_ ^ ksw) << 4)); fa[0][1] = *(LAS const bf16x8*)(k1 + ((ch_ ^ ksw) << 4)); }
#pragma unroll
    for (int g = 0; g < 4; ++g) { const f32x4 b0 = *(LAS const f32x4*)(bl + 8 * g + 4 * hi), b1 = *(LAS const f32x4*)(bl + 32 + 8 * g + 4 * hi);
#pragma unroll
        for (int e = 0; e < 4; ++e) { s0[4 * g + e] = b0[e]; s1[4 * g + e] = b1[e]; } }
    __builtin_amdgcn_sched_barrier(0);
#pragma unroll
    for (int s = 0; s < KS; ++s) {
        if (s + 1 < KS) { const int ch_ = 2 * (s + 1) + hi; fa[(s + 1) & 1][0] = *(LAS const bf16x8*)(k0 + ((ch_ ^ ksw) << 4)); fa[(s + 1) & 1][1] = *(LAS const bf16x8*)(k1 + ((ch_ ^ ksw) << 4)); }
        s0 = __builtin_amdgcn_mfma_f32_32x32x16_bf16(fa[s & 1][0], qf[s], s0, 0, 0, 0);
        s1 = __builtin_amdgcn_mfma_f32_32x32x16_bf16(fa[s & 1][1], qf[s], s1, 0, 0, 0);
        __builtin_amdgcn_sched_barrier(0);
    }
}
__device__ __forceinline__ bool attn_static_ok(const float* __restrict__ btab, const float bscale, const float bq2, const int q0) {
    const float a = __uint_as_float(__builtin_amdgcn_readfirstlane(__float_as_uint(btab[q0]))), b = __uint_as_float(__builtin_amdgcn_readfirstlane(__float_as_uint(btab[q0 + 255])));
    return ((b - a) * bscale + bq2) <= 90.f;
}
template <int DQK, bool FASTM>
__device__ __forceinline__ void attn_pass3(LAS unsigned char* lds, const bf16_t* __restrict__ Qg, const bf16_t* __restrict__ Kg, const bf16_t* __restrict__ Vg,
                                           const float* __restrict__ btab, const float bscale, const float bq2, const int pitch, const int q0, const int t_lo, f32x16 (&o)[4], const int wid, const int lane_in) {
    constexpr int NCH = DQK / 8, KS = DQK / 16, KI = NCH / 8;
    int lane_l = lane_in; asm volatile("" : "+v"(lane_l));
    const int lane = lane_l, tid = wid * 64 + lane, r32 = lane & 31, hi = lane >> 5;
    const int NT = (q0 + 256) / 64;
    const int T_w = NT - 4 + (wid >> 1);
    const int qrel = wid * 32 + r32;
    bf16x8 qf[KS];
#pragma unroll
    for (int s = 0; s < KS; ++s) qf[s] = *(const bf16x8*)(Qg + (size_t)(q0 + qrel) * pitch + 16 * s + 8 * hi);
    int kgo0, vgo0;
    { const int p = wid * 64 + lane, row = p / NCH, cp = p % NCH; const int sw = (DQK == 128) ? (row & 15) : ((row >> 1) & 7); kgo0 = row * pitch + (cp ^ sw) * 8; }
    { const int p = wid * 64 + lane; const int row = ((p >> 5) & 7) * 8 + ((p >> 2) & 7), ch = (p >> 8) * 4 + (p & 3); vgo0 = row * pitch + ch * 8; }
    const float bref = __uint_as_float(__builtin_amdgcn_readfirstlane(__float_as_uint(btab[q0])));
    float breg = 0.f;
#define AT_DMAK(t, buf) do { const bf16_t* kp_ = Kg + (size_t)(64 * (t)) * pitch; \
        _Pragma("unroll") for (int i = 0; i < KI; ++i) __builtin_amdgcn_global_load_lds((const unsigned*)(kp_ + kgo0 + i * 32 * pitch), (LAS unsigned*)(lds + AL_K + (buf) * 16384 + (wid + 8 * i) * 1024), 16, 0, 0); } while (0)
#define AT_DMAV(t, buf) do { const bf16_t* vp_ = Vg + (size_t)(64 * (t)) * pitch; \
        _Pragma("unroll") for (int i = 0; i < 2; ++i) __builtin_amdgcn_global_load_lds((const unsigned*)(vp_ + vgo0 + i * 64), (LAS unsigned*)(lds + AL_V + (buf) * 16384 + (wid + 8 * i) * 1024), 16, 0, 0); } while (0)
    const float brm = (__uint_as_float(__builtin_amdgcn_readfirstlane(__float_as_uint(btab[q0 + 255]))) - bref) * bscale;
    constexpr bool fastm = FASTM;
    const float cshift = fastm ? (brm + 0.5f * bq2) : 0.f;
#define AT_LOADB(t) do { if (wid == 0) breg = btab[64 * (t) + lane]; } while (0)
#define AT_STOREB(buf) do { if (wid == 0) *(LAS float*)(lds + AL_B + (buf) * 256 + lane * 4) = (breg - bref) * bscale - cshift; } while (0)
    float m_run = fastm ? 0.f : -INFINITY, l_run = 0.f;
#pragma unroll
    for (int b = 0; b < 4; ++b)
#pragma unroll
        for (int r = 0; r < 16; ++r) o[b][r] = 0.f;
    const int ksw = (DQK == 128) ? (r32 & 15) : ((r32 >> 1) & 7);
    const int vlane = (4 * hi + ((lane & 15) >> 2)) * 64 + ((lane >> 4) & 1) * 32 + (lane & 3) * 8;
    const int t0 = t_lo & ~1;
    AT_DMAK(t0, 0); AT_DMAK(t0 + 1, 1); AT_DMAV(t0, 0);
    AT_LOADB(t0); AT_STOREB(0); AT_LOADB(t0 + 1); AT_STOREB(1);
    asm volatile("s_waitcnt vmcnt(0)" ::: "memory");
    __syncthreads();
    f32x16 sc0, sc1, sn0, sn1;
    u32x4 pw[4];
    qk_tile<DQK>(lds + AL_K, (LAS const float*)(lds + AL_B), qf, ksw, r32, hi, sc0, sc1);
#define P3_STEP(t, pc, pn, C0, C1, N0, N1) do { \
        if ((t) + 2 < NT) { AT_DMAK((t) + 2, pc); AT_LOADB((t) + 2); } \
        if ((t) + 1 < NT) AT_DMAV((t) + 1, pn); \
        float alpha = 1.f; bool resc = false; \
        if ((t) <= T_w) { \
            if ((t) < T_w) { \
                qk_tile<DQK>(lds + AL_K + (pn) * 16384, (LAS const float*)(lds + AL_B + (pn) * 256), qf, ksw, r32, hi, N0, N1); \
            } else { \
                const int jb = (t) - (NT - 4); \
                _Pragma("unroll") for (int r = 0; r < 16; ++r) { const int kv = 64 * jb + crow(r, hi); if (kv > qrel) C0[r] = -INFINITY; if (kv + 32 > qrel) C1[r] = -INFINITY; } \
            } \
            softmax_tile_sm(C0, C1, m_run, l_run, alpha, resc, pw, fastm); \
            if (resc) { \
                _Pragma("unroll") for (int b = 0; b < 4; ++b) _Pragma("unroll") for (int r = 0; r < 16; ++r) o[b][r] *= alpha; \
            } \
            pv_tile(lds + AL_V + (pc) * 16384 + vlane, pw, o); \
        } \
        if ((t) + 2 < NT) AT_STOREB(pc); \
        asm volatile("s_waitcnt vmcnt(0)" ::: "memory"); \
        __syncthreads(); } while (0)
#define P3_MAIN(t, pc, pn, C0, C1, N0, N1) do { \
        AT_DMAK((t) + 2, pc); AT_LOADB((t) + 2); AT_DMAV((t) + 1, pn); \
        float alpha = 1.f; bool resc = false; \
        qk_tile_pf<DQK>(lds + AL_K + (pn) * 16384, (LAS const float*)(lds + AL_B + (pn) * 256), qf, ksw, r32, hi, N0, N1); \
        softmax_tile_sm(C0, C1, m_run, l_run, alpha, resc, pw, fastm); \
        if (resc) { \
            _Pragma("unroll") for (int b = 0; b < 4; ++b) _Pragma("unroll") for (int r = 0; r < 16; ++r) o[b][r] *= alpha; \
        } \
        pv_tile(lds + AL_V + (pc) * 16384 + vlane, pw, o); \
        AT_STOREB(pc); \
        asm volatile("s_waitcnt vmcnt(0)" ::: "memory"); \
        __syncthreads(); } while (0)
    int opq_ = 0; asm volatile("s_mov_b32 %0, 0" : "=s"(opq_));
#define P3_FAST(t, pc, pn, C0, C1, N0, N1) do { \
        AT_DMAK((t) + 2, pc); AT_LOADB((t) + 2); AT_DMAV((t) + 1, pn); \
        qk_tile_pf<DQK>(lds + AL_K + (pn) * 16384, (LAS const float*)(lds + AL_B + (pn) * 256), qf, ksw, r32, hi, N0, N1); \
        if (__builtin_expect(opq_ != 0, 0)) { asm volatile("s_nop 0" ::: "memory"); } \
        { f32x2 rs2_ = {0.f, 0.f}; \
          _Pragma("unroll") for (int r = 0; r < 16; ++r) { C0[r] = __builtin_amdgcn_exp2f(C0[r]); C1[r] = __builtin_amdgcn_exp2f(C1[r]); } \
          _Pragma("unroll") for (int r = 0; r < 16; r += 2) { rs2_ += (f32x2){C0[r], C0[r + 1]}; rs2_ += (f32x2){C1[r], C1[r + 1]}; } \
          l_run += rs2_.x + rs2_.y; \
          _Pragma("unroll") for (int e = 0; e < 4; ++e) { pw[0][e] = pk2(C0[2 * e], C0[2 * e + 1]); pw[1][e] = pk2(C0[8 + 2 * e], C0[9 + 2 * e]); pw[2][e] = pk2(C1[2 * e], C1[2 * e + 1]); pw[3][e] = pk2(C1[8 + 2 * e], C1[9 + 2 * e]); } } \
        pv_tile(lds + AL_V + (pc) * 16384 + vlane, pw, o); \
        AT_STOREB(pc); \
        asm volatile("s_waitcnt vmcnt(0)" ::: "memory"); \
        __syncthreads(); } while (0)
    int t = t0;
    if constexpr (fastm) {
        for (; t < NT - 4; t += 2) {
            P3_FAST(t, 0, 1, sc0, sc1, sn0, sn1);
            P3_FAST(t + 1, 1, 0, sn0, sn1, sc0, sc1);
        }
    } else {
        for (; t < NT - 4; t += 2) {
            P3_MAIN(t, 0, 1, sc0, sc1, sn0, sn1);
            P3_MAIN(t + 1, 1, 0, sn0, sn1, sc0, sc1);
        }
    }
#undef P3_FAST
    for (; t < NT; t += 2) {
        P3_STEP(t, 0, 1, sc0, sc1, sn0, sn1);
        P3_STEP(t + 1, 1, 0, sn0, sn1, sc0, sc1);
    }
#undef P3_MAIN
#undef P3_STEP
#undef AT_DMAK
#undef AT_DMAV
#undef AT_LOADB
#undef AT_STOREB
    const float l = l_run + __shfl_xor(l_run, 32);
    const float inv = 1.f / l;
#pragma unroll
    for (int b = 0; b < 4; ++b)
#pragma unroll
        for (int r = 0; r < 16; ++r) o[b][r] *= inv;
}

__global__ void __launch_bounds__(NWAVES * 64, 2) hybrid_fwd(Args args) {
    extern __shared__ __attribute__((aligned(16))) unsigned char lds_raw[];
    LAS unsigned char* lds = (LAS unsigned char*)lds_raw;
    const int wave = __builtin_amdgcn_readfirstlane((int)threadIdx.x >> 6);
#define LANE_FRESH() int lane; asm volatile("v_mbcnt_lo_u32_b32 %0, -1, 0\n\tv_mbcnt_hi_u32_b32 %0, -1, %0" : "=v"(lane)); const int tid = wave * 64 + lane; (void)tid
    const int G = gridDim.x, bid = blockIdx.x;
    const int gw = bid * NWAVES + wave, NGW = G * NWAVES;
    typedef const Args __attribute__((address_space(4)))* KArgP;
    KArgP ka0 = (KArgP)__builtin_amdgcn_kernarg_segment_ptr();
#define KA_FRESH() KArgP ka = ka0; asm volatile("" : "+s"(ka))
#define AIN(i) (ka->in[i])
#define WS_FRESH() unsigned char* ws = ka->ws; unsigned* ctl = (unsigned*)(ws + WS_CTL); bf16_t* win0 = (bf16_t*)(ws + WS_WIN0); bf16_t* wout0 = (bf16_t*)(ws + WS_WOUT0); bf16_t* wglu = (bf16_t*)(ws + WS_WGLU); bf16_t* win1 = (bf16_t*)(ws + WS_WIN1); bf16_t* wout1 = (bf16_t*)(ws + WS_WOUT1); bf16_t* hbuf = (bf16_t*)(ws + WS_HBUF); bf16_t* ygelu = (bf16_t*)(ws + WS_HBUF); bf16_t* proj = (bf16_t*)(ws + WS_PROJ); bf16_t* ycat = (bf16_t*)(ws + WS_YCAT); f32x2* lamb = (f32x2*)(ws + WS_LAMB); f32x2* lamt = (f32x2*)(ws + WS_LAMT); unsigned* bbar = (unsigned*)(ws + WS_BBAR); bf16_t* cmat = (bf16_t*)(ws + WS_CMAT); float* biasda = (float*)(ws + WS_BIASDA); float* biasf = (float*)(ws + WS_BIASF); float* flog = (float*)(ws + WS_FLOG); f32x2* s5st = (f32x2*)(ws + WS_S5ST); (void)ctl; (void)win0; (void)wout0; (void)wglu; (void)win1; (void)wout1; (void)hbuf; (void)ygelu; (void)proj; (void)ycat; (void)lamb; (void)lamt; (void)bbar; (void)cmat; (void)biasda; (void)biasf; (void)flog; (void)s5st
    cg::grid_group grid = cg::this_grid();
    XcdBarrier xbar;
    {
        int l0; asm volatile("v_mbcnt_lo_u32_b32 %0, -1, 0\n\tv_mbcnt_hi_u32_b32 %0, -1, %0" : "=v"(l0));
        if (wave == 0 && l0 < 32) ((LAS unsigned*)(lds + LDS_MISC))[l0] = 0u;
        __syncthreads();
        xbar = xcd_barrier_post((unsigned*)(args.ws + WS_CTL) + CW_BAR, (volatile LAS unsigned*)(lds + LDS_MISC) + 8, wave == 0 && l0 == 0);
    }
    const int lo = args.ph_lo, hi_ph = args.ph_hi;
#ifndef PH_MASK
#define PH_MASK 0x7ff
#endif
#define IN(k) (((PH_MASK >> (k)) & 1) && lo <= (k) && (k) < hi_ph)
#ifndef DUP_MASK
#define DUP_MASK 0
#endif
#define NREP(k) (((DUP_MASK >> (k)) & 1) ? 2 : 1)
#define SEAM(k) do { if (IN(k) && IN((k) + 1)) { if ((k) == 0) grid.sync(); else { int l0; asm volatile("v_mbcnt_lo_u32_b32 %0, -1, 0\n\tv_mbcnt_hi_u32_b32 %0, -1, %0" : "=v"(l0)); xcd_barrier(xbar, wave == 0 && l0 == 0); } } } while (0)

    if (IN(0)) {
        KA_FRESH(); LANE_FRESH(); WS_FRESH(); const float* x = AIN(0); float* out = ka->out; (void)x; (void)out;
        LAS float* scr = (LAS float*)(lds + wave * 16384);
        for (int rep = 0; rep < NREP(0); ++rep) {
        constexpr int I_IN0 = 32 * 192, I_OUT = 32 * 64, I_GLU = 16 * 32, I_IN1 = 32 * 264;
        constexpr int NITEMS = I_IN0 + 2 * I_OUT + I_GLU + I_IN1;
        for (int it = gw; it < NITEMS; it += NGW) {
            int r = it;
            if (r < I_IN0) { transpose_item(AIN(2), 2048, E_IN, win0, scr, r, 192, lane); continue; } r -= I_IN0;
            if (r < I_OUT) { transpose_item(AIN(3), 2048, 2048, wout0, scr, r, 64, lane); continue; } r -= I_OUT;
            if (r < I_GLU) { transpose_item(AIN(12), 1024, 1024, wglu, scr, r, 32, lane); continue; } r -= I_GLU;
            if (r < I_IN1) { transpose_item(AIN(22), 2048, 8208, win1, scr, r, 264, lane); continue; } r -= I_IN1;
            transpose_item(AIN(24), 2048, 2048, wout1, scr, r, 64, lane);
        }
        for (int m = gw; m < MTOK; m += 2 * NGW) { const int m1 = m + NGW; const bool h1 = m1 < MTOK; const int mm = h1 ? m1 : m;
            rms_rows2_to_bf16(x + (size_t)m * DM, x + (size_t)mm * DM, h1, AIN(1), hbuf + (size_t)m * DM, hbuf + (size_t)mm * DM, lane); }
        const int gt = bid * 512 + tid, NGT = G * 512;
        for (int i = gt; i < S5G * S5P; i += NGT) {
            const int g = i >> 6;
            const double dt = exp((double)AIN(6)[g]);
            const double lr = (double)AIN(4)[i], li = (double)AIN(5)[i];
            const double mag = exp(lr * dt), ar = mag * cos(li * dt), ai = mag * sin(li * dt);
            const double den = lr * lr + li * li, nr = ar - 1.0, ni = ai;
            const double kr = (nr * lr + ni * li) / den, ki = (ni * lr - nr * li) / den;
            lamb[i] = (f32x2){(float)ar, (float)ai};
            const double magT = exp(lr * dt * (double)S5T);
            lamt[i] = (f32x2){(float)(magT * cos(li * dt * (double)S5T)), (float)(magT * sin(li * dt * (double)S5T))};
#pragma unroll 2
            for (int j = 0; j < 8; ++j) { const double br0 = (double)AIN(7)[i * 16 + 2 * j], bi0 = (double)AIN(8)[i * 16 + 2 * j], br1 = (double)AIN(7)[i * 16 + 2 * j + 1], bi1 = (double)AIN(8)[i * 16 + 2 * j + 1];
                bbar[i * 16 + j] = pk2((float)(kr * br0 - ki * bi0), (float)(kr * br1 - ki * bi1));
                bbar[i * 16 + 8 + j] = pk2((float)(kr * bi0 + ki * br0), (float)(kr * bi1 + ki * br1)); }
        }
        for (int i = gt; i < S5G * 32 * 128; i += NGT) { const int k = i & 127, n = (i >> 7) & 31, g = i >> 12;
            float v = 0.f; if (n < 16) v = (k < 64) ? AIN(9)[(g * 16 + n) * 64 + k] : -AIN(10)[(g * 16 + n) * 64 + (k - 64)];
            cmat[i] = (bf16_t)(pk2(v, 0.f) & 0xffffu); }
        for (int i = gt; i < 8 * SEQ; i += NGT) { const int h = i / SEQ, j = i % SEQ; biasda[i] = exp2f(-(float)(h + 1)) * (float)j; }
        if (bid == 0 && tid == 0) {
            float d1 = 0.f, d2 = 0.f;
            for (int i = 0; i < 64; ++i) { d1 += AIN(16)[i] * AIN(17)[i]; d2 += AIN(18)[i] * AIN(19)[i]; }
            ((float*)ctl)[CW_LAM] = expf(d1) - expf(d2) + 0.2f;
            float gq = 0.f, gk = 0.f, fq_ = 0.f, fk_ = 0.f;
            for (int i = 0; i < 128; ++i) { gq = fmaxf(gq, fabsf(AIN(14)[i])); gk = fmaxf(gk, fabsf(AIN(15)[i])); fq_ = fmaxf(fq_, fabsf(AIN(25)[i])); fk_ = fmaxf(fk_, fabsf(AIN(26)[i])); }
            ((float*)ctl)[CW_THRDA] = ZERO_THR + 2.f * 8.f * gq * gk * 1.02f;
            ((float*)ctl)[CW_THRF] = ZERO_THR + 2.f * 11.3137085f * fq_ * fk_ * 1.02f;
            ctl[CW_QDA] = 0u; ctl[CW_QDA + 1] = 0u; ctl[CW_QFOX] = 0u; ctl[CW_QFOX + 1] = 0u;
        }
        }
#ifdef XSYNC
        for (int i = 0; i < XSYNC; ++i) grid.sync();
#endif
    }
    SEAM(0);
    if (IN(1)) {
        KA_FRESH(); LANE_FRESH(); WS_FRESH(); const float* x = AIN(0); float* out = ka->out; (void)x; (void)out;
        pg8::Gemm g{hbuf, win0, MTOK, E_IN, DM}; pg8::StaticOrder S; S.init(MTOK, E_IN, G, bid);
        pg8::EpiBf16<0> E{proj, E_IN, nullptr, 0, 0, 1.f};
        for (int rep = 0; rep < NREP(1); ++rep) pg8::gemm_phase<pg8::EpiBf16<0>, pg8::StaticOrder, true, true>(lds, g, S, E, wave, lane);
    }
    SEAM(1);
    if (IN(2)) {
        KA_FRESH(); LANE_FRESH(); WS_FRESH(); const float* x = AIN(0); float* out = ka->out; (void)x; (void)out;
        const float qmul = 0.125f * LOG2E;
        for (int m = gw; m < MTOK; m += 2 * NGW) { const int m1 = m + NGW; const bool h1 = m1 < MTOK; const int mm = h1 ? m1 : m;
            qknorm_rows2<2, 1, 4>(proj + (size_t)m * E_IN + 2048, proj + (size_t)mm * E_IN + 2048, h1, AIN(14), AIN(15), qmul, 1.f / 64.f, lane); }
        {
        const int r32 = lane & 31, hi = lane >> 5;
        for (int rep = 0; rep < NREP(12); ++rep)
        for (int u = gw; u < BATCH * S5G * S5NC; u += NGW) {
            const int g = u & 63, c = (u >> 6) & (S5NC - 1), b = u >> 13;
            const f32x2 la = lamb[g * 64 + lane];
            bf16x8 bre[2], bim[2];
#pragma unroll
            for (int ph = 0; ph < 2; ++ph) { const unsigned* bp = bbar + (size_t)(g * 64 + 32 * ph + r32) * 16 + 4 * hi;
                bre[ph] = __builtin_bit_cast(bf16x8, *(const u32x4*)bp); bim[ph] = __builtin_bit_cast(bf16x8, *(const u32x4*)(bp + 8)); }
            float hr = 0.f, hi_s = 0.f;
            const bf16_t* up = proj + (size_t)(b * SEQ + c * S5T + r32) * E_IN + g * 16 + 8 * hi;
            for (int sb = 0; sb < 4; ++sb) {
                const bf16x8 ua = *(const bf16x8*)(up + (size_t)(sb * 32) * E_IN);
                f32x16 z16;
#pragma unroll
                for (int r = 0; r < 16; ++r) z16[r] = 0.f;
                f32x16 xr0 = __builtin_amdgcn_mfma_f32_32x32x16_bf16(ua, bre[0], z16, 0, 0, 0), xr1 = __builtin_amdgcn_mfma_f32_32x32x16_bf16(ua, bre[1], z16, 0, 0, 0);
                f32x16 xi0 = __builtin_amdgcn_mfma_f32_32x32x16_bf16(ua, bim[0], z16, 0, 0, 0), xi1 = __builtin_amdgcn_mfma_f32_32x32x16_bf16(ua, bim[1], z16, 0, 0, 0);
#pragma unroll
                for (int r = 0; r < 16; ++r) {
                    auto sr = __builtin_amdgcn_permlane32_swap(__float_as_uint(xr0[r]), __float_as_uint(xr1[r]), false, false); xr0[r] = __uint_as_float(sr[0]); xr1[r] = __uint_as_float(sr[1]);
                    auto si = __builtin_amdgcn_permlane32_swap(__float_as_uint(xi0[r]), __float_as_uint(xi1[r]), false, false); xi0[r] = __uint_as_float(si[0]); xi1[r] = __uint_as_float(si[1]); }
#pragma unroll
                for (int t = 0; t < 32; ++t) { const int r = (t & 3) + 4 * (t >> 3); const bool odd = (t >> 2) & 1;
                    const float xr = odd ? xr1[r] : xr0[r], xi = odd ? xi1[r] : xi0[r];
                    const float nhr = la.x * hr - la.y * hi_s + xr, nhi = la.x * hi_s + la.y * hr + xi; hr = nhr; hi_s = nhi; }
            }
            s5st[((size_t)(b * S5NC + c) * 64 + g) * 64 + lane] = (f32x2){hr, hi_s};
        }
        }
    }
    SEAM(2);
    if (IN(3)) {
        KA_FRESH(); LANE_FRESH(); WS_FRESH(); const float* x = AIN(0); float* out = ka->out; (void)x; (void)out;
        {
            LAS unsigned char* Ht = lds + wave * 8192;
            const int r32 = lane & 31, hi = lane >> 5;
            for (int rep = 0; rep < NREP(11); ++rep)
            for (int u = gw; u < BATCH * S5G * (S5NC / 8); u += NGW) {
                const int g = u & 63, c0 = ((u >> 6) & 15) * 8, b = u >> 10;
                const int gp = g * 64 + lane;
                const f32x2 la = lamb[gp], lt = lamt[gp];
                bf16x8 bre[2], bim[2];
#pragma unroll
                for (int ph = 0; ph < 2; ++ph) { const unsigned* bp = bbar + (size_t)(g * 64 + 32 * ph + r32) * 16 + 4 * hi;
                    bre[ph] = __builtin_bit_cast(bf16x8, *(const u32x4*)bp); bim[ph] = __builtin_bit_cast(bf16x8, *(const u32x4*)(bp + 8)); }
                float hr = 0.f, hi_s = 0.f;
#pragma unroll 8
                for (int cc = 0; cc < c0; ++cc) { const f32x2 s = s5st[((size_t)(b * S5NC + cc) * 64 + g) * 64 + lane];
                    const float nhr = lt.x * hr - lt.y * hi_s + s.x, nhi = lt.x * hi_s + lt.y * hr + s.y; hr = nhr; hi_s = nhi; }
                bf16x8 cfr[8];
#pragma unroll
                for (int s = 0; s < 8; ++s) cfr[s] = *(const bf16x8*)(cmat + (size_t)(g * 32 + r32) * 128 + 16 * s + 8 * hi);
                const float dvec = AIN(11)[g * 16 + (r32 & 15)];
                for (int c = c0; c < c0 + 8; ++c) {
                const size_t row0 = (size_t)(b * SEQ + c * S5T);
                const bf16_t* up = proj + (row0 + r32) * E_IN + g * 16 + 8 * hi;
                for (int sb = 0; sb < 4; ++sb) {
                    unsigned short uv16[16];
                    if (r32 < 16) {
#pragma unroll
                        for (int r = 0; r < 16; ++r) uv16[r] = proj[(row0 + sb * 32 + crow(r, hi)) * E_IN + g * 16 + r32];
                    }
                    {
                    const bf16x8 ua = *(const bf16x8*)(up + (size_t)(sb * 32) * E_IN);
                    f32x16 z16;
#pragma unroll
                    for (int r = 0; r < 16; ++r) z16[r] = 0.f;
                    f32x16 xr0 = __builtin_amdgcn_mfma_f32_32x32x16_bf16(ua, bre[0], z16, 0, 0, 0), xr1 = __builtin_amdgcn_mfma_f32_32x32x16_bf16(ua, bre[1], z16, 0, 0, 0);
                    f32x16 xi0 = __builtin_amdgcn_mfma_f32_32x32x16_bf16(ua, bim[0], z16, 0, 0, 0), xi1 = __builtin_amdgcn_mfma_f32_32x32x16_bf16(ua, bim[1], z16, 0, 0, 0);
#pragma unroll
                    for (int r = 0; r < 16; ++r) {
                        auto sr = __builtin_amdgcn_permlane32_swap(__float_as_uint(xr0[r]), __float_as_uint(xr1[r]), false, false); xr0[r] = __uint_as_float(sr[0]); xr1[r] = __uint_as_float(sr[1]);
                        auto si = __builtin_amdgcn_permlane32_swap(__float_as_uint(xi0[r]), __float_as_uint(xi1[r]), false, false); xi0[r] = __uint_as_float(si[0]); xi1[r] = __uint_as_float(si[1]); }
#pragma unroll
                    for (int tt = 0; tt < 32; ++tt) { const int r = (tt & 3) + 4 * (tt >> 3); const bool odd = (tt >> 2) & 1;
                        const float xr = odd ? xr1[r] : xr0[r], xi = odd ? xi1[r] : xi0[r];
                        const float nhr = la.x * hr - la.y * hi_s + xr, nhi = la.x * hi_s + la.y * hr + xi; hr = nhr; hi_s = nhi;
                        const unsigned w = pk2(hr, hi_s);
                        const int sw = tt & 15;
                        *(LAS unsigned short*)(Ht + tt * 256 + ((((lane >> 3)) ^ sw) << 4) + ((lane & 7) << 1)) = (unsigned short)(w & 0xffffu);
                        *(LAS unsigned short*)(Ht + tt * 256 + ((((64 + lane) >> 3) ^ sw) << 4) + ((lane & 7) << 1)) = (unsigned short)(w >> 16);
                    }
                    }
                    asm volatile("s_waitcnt lgkmcnt(0)" ::: "memory");
                    f32x16 acc;
#pragma unroll
                    for (int r = 0; r < 16; ++r) acc[r] = 0.f;
#pragma unroll
                    for (int s = 0; s < 8; ++s) { const bf16x8 a = *(LAS const bf16x8*)(Ht + r32 * 256 + (((2 * s + hi) ^ (r32 & 15)) << 4));
                        acc = __builtin_amdgcn_mfma_f32_32x32x16_bf16(a, cfr[s], acc, 0, 0, 0); }
                    asm volatile("s_waitcnt lgkmcnt(0)" ::: "memory");
                    if (r32 < 16) {
#pragma unroll
                        for (int r = 0; r < 16; ++r) { const size_t row = row0 + sb * 32 + crow(r, hi);
                            const float uval = bf2f(uv16[r]);
                            const float y = gelu_tanh(acc[r] + dvec * uval);
                            ygelu[row * 1024 + g * 16 + r32] = (bf16_t)(pk2(y, 0.f) & 0xffffu); }
                    }
                }
                }
            }
        }
        __syncthreads();
        {
            LANE_FRESH();
            LAS volatile int* misc = (LAS volatile int*)(lds + LDS_MISC);
            const float lam = ((const float*)ctl)[CW_LAM]; const float thr_da = ((const float*)ctl)[CW_THRDA];
            const int r32 = lane & 31, hi = lane >> 5;
            for (int rep = 0; rep < NREP(3); ++rep)
            for (;;) {
                if (tid == 0) misc[0] = (int)atomicAdd(ctl + CW_QDA + rep, 1u);
                __syncthreads();
                const int ui = misc[0];
                __syncthreads();
                if (ui >= BATCH * 8 * 64) break;
                const int qb = 63 - (ui >> 4), bh = ui & 15, b = bh >> 3, h = bh & 7;
                const int q0 = qb * 256;
                const bf16_t* pb = proj + (size_t)b * SEQ * E_IN;
                const float dskip = thr_da * exp2f((float)(h + 1));
                const int t_lo = max(0, (int)ceilf(((float)q0 - dskip - 63.f) * (1.f / 64.f)));
                f32x16 o[4];
                LAS unsigned* stash = (LAS unsigned*)(lds + LDS_STASH) + wave * 2048 + lane;
                const float bq2 = (thr_da - ZERO_THR) * LOG2E;
                const bool fm = attn_static_ok(biasda + h * SEQ, LOG2E, bq2, q0);
                if (fm) attn_pass3<64, true>(lds, pb + 2048 + h * 128, pb + 3072 + h * 128, pb + 4096 + h * 128, biasda + h * SEQ, LOG2E, bq2, E_IN, q0, t_lo, o, wave, lane);
                else attn_pass3<64, false>(lds, pb + 2048 + h * 128, pb + 3072 + h * 128, pb + 4096 + h * 128, biasda + h * SEQ, LOG2E, bq2, E_IN, q0, t_lo, o, wave, lane);
#pragma unroll
                for (int bl = 0; bl < 4; ++bl)
#pragma unroll
                    for (int e = 0; e < 8; ++e) stash[(bl * 8 + e) * 64] = pk2(o[bl][2 * e], o[bl][2 * e + 1]);
                if (fm) attn_pass3<64, true>(lds, pb + 2048 + h * 128 + 64, pb + 3072 + h * 128 + 64, pb + 4096 + h * 128, biasda + h * SEQ, LOG2E, bq2, E_IN, q0, t_lo, o, wave, lane);
                else attn_pass3<64, false>(lds, pb + 2048 + h * 128 + 64, pb + 3072 + h * 128 + 64, pb + 4096 + h * 128, biasda + h * SEQ, LOG2E, bq2, E_IN, q0, t_lo, o, wave, lane);
                int hi_e = hi, r32_e = r32; asm volatile("" : "+v"(hi_e), "+v"(r32_e));
                float ssq = 0.f;
#pragma unroll
                for (int bl = 0; bl < 4; ++bl)
#pragma unroll
                    for (int e = 0; e < 8; ++e) { const unsigned w0 = stash[(bl * 8 + e) * 64]; const float v0 = bflo(w0) - lam * o[bl][2 * e], v1 = bfhi(w0) - lam * o[bl][2 * e + 1];
                        o[bl][2 * e] = v0; o[bl][2 * e + 1] = v1; ssq += v0 * v0 + v1 * v1; }
                ssq += __shfl_xor(ssq, 32);
                const float rr = 0.8f / sqrtf(ssq * (1.f / 128.f) + RMS_EPS);
                const size_t tok = (size_t)b * SEQ + q0 + wave * 32 + r32_e;
#pragma unroll
                for (int bl = 0; bl < 4; ++bl)
#pragma unroll
                    for (int g = 0; g < 4; ++g) { const int dv0 = 32 * bl + 8 * g + 4 * hi_e;
                        const f32x4 gn = *(const f32x4*)(AIN(20) + dv0);
                        const u32x2 zw = *(const u32x2*)(proj + tok * E_IN + 5120 + h * 128 + dv0);
                        const float y0 = o[bl][4 * g] * rr * gn.x * siluf_(bflo(zw.x)), y1 = o[bl][4 * g + 1] * rr * gn.y * siluf_(bfhi(zw.x));
                        const float y2 = o[bl][4 * g + 2] * rr * gn.z * siluf_(bflo(zw.y)), y3 = o[bl][4 * g + 3] * rr * gn.w * siluf_(bfhi(zw.y));
                        u32x2 w; w.x = pk2(y0, y1); w.y = pk2(y2, y3);
                        *(u32x2*)(ycat + tok * DM + 1024 + h * 128 + dv0) = w; }
            }
        }
    }
    SEAM(3);
    if (IN(4)) {
        KA_FRESH(); LANE_FRESH(); WS_FRESH(); const float* x = AIN(0); float* out = ka->out; (void)x; (void)out;
        pg8::Gemm g{ygelu, wglu, MTOK, 1024, 1024}; pg8::StaticOrder S; S.init(MTOK, 1024, G, bid);
        pg8::EpiGlu E{ycat, ygelu, proj, AIN(13)};
        pg8::gemm_phase<pg8::EpiGlu, pg8::StaticOrder, true, true>(lds, g, S, E, wave, lane);
    }
    SEAM(4);
    if (IN(5)) {
        KA_FRESH(); LANE_FRESH(); WS_FRESH(); const float* x = AIN(0); float* out = ka->out; (void)x; (void)out;
        pg8::Gemm g{ycat, wout0, MTOK, DM, DM}; pg8::StaticOrder S; S.init(MTOK, DM, G, bid);
        pg8::EpiResid E{x, out};
        pg8::gemm_phase<pg8::EpiResid, pg8::StaticOrder, true, true>(lds, g, S, E, wave, lane);
    }
    SEAM(5);
    if (IN(6)) {
        KA_FRESH(); LANE_FRESH(); WS_FRESH(); const float* x = AIN(0); float* out = ka->out; (void)x; (void)out;
        for (int rep = 0; rep < NREP(6); ++rep)
        for (int m = gw; m < MTOK; m += 2 * NGW) { const int m1 = m + NGW; const bool h1 = m1 < MTOK; const int mm = h1 ? m1 : m;
            rms_rows2_to_bf16(out + (size_t)m * DM, out + (size_t)mm * DM, h1, AIN(21), hbuf + (size_t)m * DM, hbuf + (size_t)mm * DM, lane); }
    }
    SEAM(6);
    if (IN(7)) {
        KA_FRESH(); LANE_FRESH(); WS_FRESH(); const float* x = AIN(0); float* out = ka->out; (void)x; (void)out;
        pg8::Gemm g{hbuf, win1, MTOK, O_INP, DM}; pg8::StaticOrder S; S.init(MTOK, O_INP, G, bid);
        pg8::EpiProj1 E{proj, flog};
        for (int rep = 0; rep < NREP(7); ++rep) pg8::gemm_phase<pg8::EpiProj1, pg8::StaticOrder, true, true>(lds, g, S, E, wave, lane);
    }
    SEAM(7);
    if (IN(8)) {
        KA_FRESH(); LANE_FRESH(); WS_FRESH(); const float* x = AIN(0); float* out = ka->out; (void)x; (void)out;
        if (bid < 32) {
            const int b = bid >> 4, h = bid & 15;
            LAS double* dsum = (LAS double*)lds;
            const float bf_ = AIN(23)[h];
            const float* fl = flog + ((size_t)b * SEQ + tid * 32) * 16 + h;
            double tot = 0.0;
#pragma unroll 4
            for (int i = 0; i < 32; ++i) { const float xv = fl[i * 16] + bf_; tot += (double)(fminf(xv, 0.f) - log1pf(expf(-fabsf(xv)))); }
            dsum[tid] = tot;
            __syncthreads();
            double pre = 0.0;
            for (int i = 0; i < tid; ++i) pre += dsum[i];
            float* bo = biasf + ((size_t)(b * 16 + h)) * SEQ + tid * 32;
#pragma unroll 4
            for (int i = 0; i < 32; ++i) { const float xv = fl[i * 16] + bf_; pre += (double)(fminf(xv, 0.f) - log1pf(expf(-fabsf(xv)))); bo[i] = (float)(-pre); }
            __syncthreads();
        }
        const float qmul = 0.08838834764831845f * LOG2E;
        for (int m = gw; m < MTOK; m += 2 * NGW) { const int m1 = m + NGW; const bool h1 = m1 < MTOK; const int mm = h1 ? m1 : m;
            qknorm_rows2<4, 2, 8>(proj + (size_t)m * O_LD, proj + (size_t)mm * O_LD, h1, AIN(25), AIN(26), qmul, 1.f / 128.f, lane); }
    }
    SEAM(8);
    if (IN(9)) {
        KA_FRESH(); LANE_FRESH(); WS_FRESH(); const float* x = AIN(0); float* out = ka->out; (void)x; (void)out;
        LAS volatile int* misc = (LAS volatile int*)(lds + LDS_MISC);
        const int r32 = lane & 31, hi = lane >> 5;
        const float thr_f = ((const float*)ctl)[CW_THRF];
        for (int rep = 0; rep < NREP(9); ++rep)
        for (;;) {
            if (wave == 0) {
                int u0 = 0; if (lane == 0) u0 = (int)atomicAdd(ctl + CW_QFOX + rep, 1u);
                u0 = __shfl(u0, 0);
                int tl = 0;
                if (u0 < BATCH * 16 * 64) {
                    const int qb_ = 63 - (u0 >> 5), bh_ = u0 & 31; const float* bt = biasf + (size_t)bh_ * SEQ; const float bref = bt[qb_ * 256];
                    int ln = lane; asm volatile("" : "+v"(ln));
#pragma unroll
                    for (int r = 0; r < 4; ++r) { const int t = ln + 64 * r; bool dead = false;
                        if (t < 4 * qb_) dead = (bt[64 * t + 63] - bref) < -thr_f;
                        tl += __popcll(__ballot(dead)); }
                }
                if (lane == 0) { misc[0] = u0; misc[1] = tl; }
            }
            __syncthreads();
            const int ui = misc[0], t_lo = misc[1];
            __syncthreads();
            if (ui >= BATCH * 16 * 64) break;
            const int qb = 63 - (ui >> 5), bh = ui & 31, b = bh >> 4, h = bh & 15;
            const int q0 = qb * 256;
            const bf16_t* pb = proj + (size_t)b * SEQ * O_LD;
            f32x16 o[4];
            const float bq2 = (thr_f - ZERO_THR) * LOG2E;
            if (attn_static_ok(biasf + (size_t)bh * SEQ, LOG2E, bq2, q0)) attn_pass3<128, true>(lds, pb + h * 128, pb + 2048 + h * 128, pb + 4096 + h * 128, biasf + (size_t)bh * SEQ, LOG2E, bq2, O_LD, q0, t_lo, o, wave, lane);
            else attn_pass3<128, false>(lds, pb + h * 128, pb + 2048 + h * 128, pb + 4096 + h * 128, biasf + (size_t)bh * SEQ, LOG2E, bq2, O_LD, q0, t_lo, o, wave, lane);
            int hi_e = hi, r32_e = r32; asm volatile("" : "+v"(hi_e), "+v"(r32_e));
            const size_t tok = (size_t)b * SEQ + q0 + wave * 32 + r32_e;
#pragma unroll
            for (int bl = 0; bl < 4; ++bl)
#pragma unroll
                for (int g = 0; g < 4; ++g) { const int dv0 = 32 * bl + 8 * g + 4 * hi_e;
                    const u32x2 zw = *(const u32x2*)(proj + tok * O_LD + 6144 + h * 128 + dv0);
                    const float y0 = o[bl][4 * g] * siluf_(bflo(zw.x)), y1 = o[bl][4 * g + 1] * siluf_(bfhi(zw.x));
                    const float y2 = o[bl][4 * g + 2] * siluf_(bflo(zw.y)), y3 = o[bl][4 * g + 3] * siluf_(bfhi(zw.y));
                    u32x2 w; w.x = pk2(y0, y1); w.y = pk2(y2, y3);
                    *(u32x2*)(ycat + tok * DM + h * 128 + dv0) = w; }
        }
    }
    SEAM(9);
    if (IN(10)) {
        KA_FRESH(); LANE_FRESH(); WS_FRESH(); const float* x = AIN(0); float* out = ka->out; (void)x; (void)out;
        pg8::Gemm g{ycat, wout1, MTOK, DM, DM}; pg8::StaticOrder S; S.init(MTOK, DM, G, bid);
        pg8::EpiResid E{out, out};
        pg8::gemm_phase<pg8::EpiResid, pg8::StaticOrder, true, true>(lds, g, S, E, wave, lane);
    }
#undef IN
#undef SEAM
}

#ifndef ONE_LAUNCH
#define ONE_LAUNCH 1
#endif
constexpr int NPHASE = 11;
extern "C" void kernel_launch(void* const* d_in, const int* in_sizes, int n_in, void* d_out, int out_size, void* d_ws, size_t ws_size, hipStream_t stream) {
    static int grid = 0;
    if (grid == 0) {
        if (n_in != 27 || out_size != MTOK * DM || ws_size < WS_END) { fprintf(stderr, "kernel_launch: unexpected problem (n_in %d out %d ws %zu)\n", n_in, out_size, ws_size); grid = -1; return; }
        int dev = 0, cus = 0, per_cu = 0;
        hipGetDevice(&dev);
        hipDeviceGetAttribute(&cus, hipDeviceAttributeMultiprocessorCount, dev);
        if (hipFuncSetAttribute((const void*)hybrid_fwd, hipFuncAttributeMaxDynamicSharedMemorySize, LDS_BYTES) != hipSuccess) { fprintf(stderr, "kernel_launch: hipFuncSetAttribute failed\n"); grid = -1; return; }
        if (hipOccupancyMaxActiveBlocksPerMultiprocessor(&per_cu, (const void*)hybrid_fwd, NWAVES * 64, LDS_BYTES) != hipSuccess || per_cu < 1) { fprintf(stderr, "kernel_launch: occupancy query says %d\n", per_cu); per_cu = 1; }
        (void)hipGetLastError();
        grid = cus * 1;
    }
    if (grid < 0) return;
    if (hipMemsetAsync(d_ws, 0, 65536, stream) != hipSuccess) { fprintf(stderr, "kernel_launch: memset failed\n"); return; }
    Args a{};
    for (int i = 0; i < 27; ++i) a.in[i] = (const float*)d_in[i];
    a.out = (float*)d_out; a.ws = (unsigned char*)d_ws;
#if ONE_LAUNCH
    a.ph_lo = 0; a.ph_hi = NPHASE;
    void* kargs[] = {&a};
    hipError_t e = hipLaunchCooperativeKernel((const void*)hybrid_fwd, dim3(grid), dim3(NWAVES * 64), kargs, LDS_BYTES, stream);
    if (e != hipSuccess) fprintf(stderr, "cooperative launch failed: %s (grid %d)\n", hipGetErrorString(e), grid);
#else
    for (int p = 0; p < NPHASE; ++p) {
        a.ph_lo = p; a.ph_hi = p + 1;
        hipLaunchKernelGGL(hybrid_fwd, dim3(grid), dim3(NWAVES * 64), LDS_BYTES, stream, a);
    }
#endif
}
```

```cpp
#include <hip/hip_runtime.h>
#include <hip/hip_cooperative_groups.h>
#include <cstdio>
#include <cstdint>
#include <cmath>
namespace cg = cooperative_groups;
#define DUP_MASK 0
namespace pg8 {
#define PG8_LAS __attribute__((address_space(3)))
typedef unsigned short bf16_t;
typedef short bf16x8 __attribute__((ext_vector_type(8)));
typedef float f32x4 __attribute__((ext_vector_type(4)));
typedef unsigned u32x4 __attribute__((ext_vector_type(4)));
constexpr int BM = 256, BK = 64, HALF = 128, HTB = HALF * BK * 2  , STAGE_BYTES = 8 * HTB, NXCD = 8, WGM = 8;

__host__ __device__ __forceinline__ int lds_byte(int r, int c) { const int st = (r >> 4) * 2 + (c >> 5), rr = r & 15, cc = c & 31, ob = rr * 64 + cc * 2; return st * 1024 + (ob ^ (((ob >> 9) & 1) << 5)); }
__host__ __device__ __forceinline__ void stage_rc(int b, int& R, int& C) { const int st = b / 1024, sb = b % 1024, swz = sb ^ (((sb >> 9) & 1) << 5); R = (st >> 1) * 16 + swz / 64; C = (st & 1) * 32 + (swz % 64) / 2; }
__host__ __device__ __forceinline__ int perm32(int rho) { const int n = rho >> 4, i = rho & 15; return 8 * (i >> 2) + 4 * n + (i & 3); }

struct Unit { int pm, pn; };
struct Gemm { const bf16_t* A; const bf16_t* Bt; int M, N, K; };

struct StaticOrder {
    int nM, nN, nwg, G, c;
    __host__ __device__ void init(int M, int N, int G_, int c_) { nM = M / BM; nN = N / BM; nwg = nM * nN; G = G_; c = c_; }
    __host__ __device__ bool next(int i, Unit& u) const {
        const long L = (long)i * G + c; if (L >= nwg) return false;
        int wgid = (int)L; { const int q = nwg / NXCD, r = nwg % NXCD, xcd = wgid % NXCD, off = wgid / NXCD; wgid = (xcd < r ? xcd * (q + 1) : r * (q + 1) + (xcd - r) * q) + off; }
        const int nig = WGM * nN, gid = wgid / nig, fm = gid * WGM, gsz = (nM - fm) < WGM ? (nM - fm) : WGM;
        u.pm = fm + ((wgid % nig) % gsz); u.pn = (wgid % nig) / gsz; return true;
    }
    __device__ __forceinline__ void a_ready(const Unit&) const {}
    __device__ __forceinline__ void done(const Unit&) const {}
};

__device__ __forceinline__ unsigned cvt_pk_bf16(float lo, float hi) { unsigned r; asm volatile("v_cvt_pk_bf16_f32 %0, %1, %2" : "=v"(r) : "v"(lo), "v"(hi)); return r; }
typedef float f32x2 __attribute__((ext_vector_type(2)));
__device__ __forceinline__ f32x2 gelu_pk(f32x2 v) {
    const f32x2 av = __builtin_elementwise_abs(v), d = av * 0.2316418882f + 1.0f;
    f32x2 t; t.x = __builtin_amdgcn_rcpf(d.x); t.y = __builtin_amdgcn_rcpf(d.y);
    f32x2 q = t * 0.5307027145f + (-0.7265760135f); q = q * t + 0.7107068705f; q = q * t + (-0.142248368f); q = q * t + 0.127414796f; q = q * t;
    const f32x2 s = (v * v) * (-0.72134752044f);
    f32x2 e; e.x = __builtin_amdgcn_exp2f(s.x); e.y = __builtin_amdgcn_exp2f(s.y);
    const f32x2 m = v * (q * e), r = v - m;
    f32x2 o; o.x = v.x < 0.f ? m.x : r.x; o.y = v.y < 0.f ? m.y : r.y; return o;
}

template <int ACT  > struct EpiBf16 {
    static constexpr bool PERM = true, AFTER_DRAIN = false; static_assert(ACT == 0 || ACT == 1, "EpiBf16: ACT is 0 (none) or 1 (gelu_pk)");
    bf16_t* O; int ldc; const float* bias; int split_cols; size_t split_stride; float scale0;
    __device__ __forceinline__ void operator()(const f32x4 (&acc)[2][2][4][2], const Unit& u, int wr, int wc, int fr, int fq) const {
        const int row0 = u.pm * BM + wr * 64 + fr; int colt = u.pn * BM; bf16_t* base = O;
        float sc = 1.f; if (split_cols) { const int t = colt / split_cols; base += (size_t)t * split_stride; colt -= t * split_cols; if (t == 0) sc = scale0; }
        const int col0 = colt + wc * 32 + 8 * fq, bcol0 = u.pn * BM + wc * 32 + 8 * fq;
        f32x4 bv[2][2];
#pragma unroll
        for (int bj = 0; bj < 2; ++bj)
#pragma unroll
            for (int n = 0; n < 2; ++n) bv[bj][n] = bias ? *(const f32x4*)(bias + bcol0 + bj * HALF + 4 * n) : (f32x4){0.f, 0.f, 0.f, 0.f};
#pragma unroll
        for (int ai = 0; ai < 2; ++ai)
#pragma unroll
            for (int m = 0; m < 4; ++m) { bf16_t* rowp = base + (size_t)(row0 + ai * HALF + m * 16) * ldc + col0;
#pragma unroll
                for (int bj = 0; bj < 2; ++bj) { f32x4 v0 = acc[ai][bj][m][0] + bv[bj][0], v1 = acc[ai][bj][m][1] + bv[bj][1];
                    if (ACT == 1) { f32x2 a = gelu_pk((f32x2){v0[0], v0[1]}), b = gelu_pk((f32x2){v0[2], v0[3]}), c = gelu_pk((f32x2){v1[0], v1[1]}), d = gelu_pk((f32x2){v1[2], v1[3]});
                        v0 = (f32x4){a.x, a.y, b.x, b.y}; v1 = (f32x4){c.x, c.y, d.x, d.y}; }
                    v0 = v0 * sc; v1 = v1 * sc; u32x4 w; w.x = cvt_pk_bf16(v0[0], v0[1]); w.y = cvt_pk_bf16(v0[2], v0[3]); w.z = cvt_pk_bf16(v1[0], v1[1]); w.w = cvt_pk_bf16(v1[2], v1[3]);
                    *(u32x4*)(rowp + bj * HALF) = w; } }
    }
};
template <class Epi, class Sched, bool ALIGN_EPI = false, bool SP2 = false>
__device__ __forceinline__ void gemm_phase(PG8_LAS unsigned char* lds, const Gemm g, const Sched& S, const Epi& E, const int wid, const int lane) {
    const int tid = wid * 64 + lane, wr = wid >> 2, wc = wid & 3, fr = lane & 15, fq = lane >> 4;
    const int K = g.K, nt = K / BK;
    unsigned voffA[2], voffB[2];
#pragma unroll
    for (int i = 0; i < 2; ++i) { int R, C; stage_rc(tid * 16 + i * 8192, R, C); const int Rb = Epi::PERM ? ((R & ~31) + perm32(R & 31)) : R;
        voffA[i] = (unsigned)(R * K + C) * 2u; voffB[i] = (unsigned)(Rb * K + C) * 2u; }
    const size_t kstep = (size_t)(BK * 2);
    const size_t hstep = (size_t)HALF * K * 2;
    const size_t tstep = 2 * hstep;
    const unsigned ldsw = (unsigned)wid * 1024u;
    const int aoff = lds_byte(wr * 64 + fr, fq * 8), boff = lds_byte(wc * 32 + fr, fq * 8);
#define PG8_SA(b, h) (((b) * 2 + (h)) * HTB)
#define PG8_SB(b, h) ((4 + (b) * 2 + (h)) * HTB)
#define PG8_STAGE(bufoff, gbase, voff) do { _Pragma("unroll") for (int _i = 0; _i < 2; ++_i) \
        __builtin_amdgcn_global_load_lds((const unsigned*)((const char*)(gbase) + (voff)[_i]), (PG8_LAS unsigned*)(lds + (bufoff) + ldsw + _i * 8192), 16, 0, 0); } while (0)
#define PG8_LDA(dst, b, h) do { _Pragma("unroll") for (int m = 0; m < 4; ++m) _Pragma("unroll") for (int k = 0; k < 2; ++k) dst[m][k] = *(const PG8_LAS bf16x8*)(lds + PG8_SA(b, h) + aoff + m * 2048 + k * 1024); } while (0)
#define PG8_LDB(dst, b, h) do { _Pragma("unroll") for (int n = 0; n < 2; ++n) _Pragma("unroll") for (int k = 0; k < 2; ++k) dst[n][k] = *(const PG8_LAS bf16x8*)(lds + PG8_SB(b, h) + boff + n * 2048 + k * 1024); } while (0)
#define PG8_MMA(ai, bj, At, Bt) do { __builtin_amdgcn_s_setprio(1); _Pragma("unroll") for (int m = 0; m < 4; ++m) _Pragma("unroll") for (int n = 0; n < 2; ++n) _Pragma("unroll") for (int k = 0; k < 2; ++k) \
        acc[ai][bj][m][n] = __builtin_amdgcn_mfma_f32_16x16x32_bf16(Bt[n][k], At[m][k], acc[ai][bj][m][n], 0, 0, 0); __builtin_amdgcn_s_setprio(0); } while (0)
#define PG8_WAIT_V(n) asm volatile("s_waitcnt vmcnt(" #n ")" ::: "memory")
#define PG8_WAIT_L(n) asm volatile("s_waitcnt lgkmcnt(" #n ")" ::: "memory")
#define PG8_BAR __builtin_amdgcn_s_barrier()
#define PG8_SCHED __builtin_amdgcn_sched_barrier(0)
    Unit cur, nxt; int ui = 0;
    if (!S.next(0, cur)) return;
    f32x4 acc[2][2][4][2];
#pragma unroll
    for (int a = 0; a < 2; ++a)
#pragma unroll
        for (int b = 0; b < 2; ++b)
#pragma unroll
            for (int m = 0; m < 4; ++m)
#pragma unroll
                for (int n = 0; n < 2; ++n) acc[a][b][m][n] = (f32x4){0.f, 0.f, 0.f, 0.f};
    bf16x8 At[4][2], B0[2][2], B1[2][2];
    const char* cA = (const char*)g.A + (size_t)cur.pm * tstep; const char* cB = (const char*)g.Bt + (size_t)cur.pn * tstep;
    S.a_ready(cur);
    if constexpr (SP2) {
        PG8_STAGE(PG8_SB(0, 0), cB, voffB); PG8_STAGE(PG8_SB(0, 1), cB + hstep, voffB); PG8_STAGE(PG8_SA(0, 0), cA, voffA); PG8_STAGE(PG8_SA(0, 1), cA + hstep, voffA);
        if (wr == 1) PG8_BAR;
        PG8_WAIT_V(2); PG8_BAR;
        PG8_STAGE(PG8_SB(1, 0), cB + kstep, voffB); PG8_STAGE(PG8_SA(1, 0), cA + kstep, voffA); PG8_STAGE(PG8_SB(1, 1), cB + hstep + kstep, voffB);
        PG8_WAIT_V(6); PG8_BAR;
    } else {
        PG8_STAGE(PG8_SB(0, 0), cB, voffB); PG8_STAGE(PG8_SA(0, 0), cA, voffA); PG8_STAGE(PG8_SB(0, 1), cB + hstep, voffB); PG8_STAGE(PG8_SA(0, 1), cA + hstep, voffA);
        if (wr == 1) PG8_BAR;
        PG8_WAIT_V(4); PG8_BAR;
        PG8_STAGE(PG8_SB(1, 0), cB + kstep, voffB); PG8_STAGE(PG8_SA(1, 0), cA + kstep, voffA); PG8_STAGE(PG8_SB(1, 1), cB + hstep + kstep, voffB);
        PG8_WAIT_V(6); PG8_BAR;
    }
    for (;;) {
        const bool has_next = S.next(ui + 1, nxt);
        const char* nA = has_next ? (const char*)g.A + (size_t)nxt.pm * tstep : cA; const char* nB = has_next ? (const char*)g.Bt + (size_t)nxt.pn * tstep : cB;
        for (int t = 0; t < nt; t += 2) {
            const bool last = (t == nt - 2);
            const char* a1 = cA + (size_t)(t + 1) * kstep;
            const char* a2 = last ? nA : cA + (size_t)(t + 2) * kstep; const char* b2 = last ? nB : cB + (size_t)(t + 2) * kstep;
            const char* a3 = a2 + kstep; const char* b3 = b2 + kstep;
            if (last && has_next) S.a_ready(nxt);
            if constexpr (SP2) {
            PG8_LDB(B0, 0, 0); PG8_LDB(B1, 0, 1); PG8_SCHED; PG8_LDA(At, 0, 0); PG8_STAGE(PG8_SA(1, 1), a1 + hstep, voffA);
            PG8_WAIT_V(8); PG8_WAIT_L(0); PG8_BAR; PG8_MMA(0, 0, At, B0); PG8_MMA(0, 1, At, B1); PG8_BAR; PG8_SCHED;
            PG8_LDA(At, 0, 1); PG8_STAGE(PG8_SB(0, 0), b2, voffB); PG8_STAGE(PG8_SB(0, 1), b2 + hstep, voffB); PG8_STAGE(PG8_SA(0, 0), a2, voffA);
            PG8_WAIT_V(8); PG8_WAIT_L(0); PG8_BAR; PG8_MMA(1, 0, At, B0); PG8_MMA(1, 1, At, B1); PG8_BAR; PG8_SCHED;
            PG8_LDB(B0, 1, 0); PG8_LDB(B1, 1, 1); PG8_SCHED; PG8_LDA(At, 1, 0); PG8_STAGE(PG8_SA(0, 1), a2 + hstep, voffA);
            PG8_WAIT_V(8); PG8_WAIT_L(0); PG8_BAR; PG8_MMA(0, 0, At, B0); PG8_MMA(0, 1, At, B1); PG8_BAR; PG8_SCHED;
            PG8_LDA(At, 1, 1); PG8_STAGE(PG8_SB(1, 0), b3, voffB); PG8_STAGE(PG8_SB(1, 1), b3 + hstep, voffB); PG8_STAGE(PG8_SA(1, 0), a3, voffA);
            PG8_WAIT_V(8); PG8_WAIT_L(0); PG8_BAR; PG8_MMA(1, 0, At, B0); PG8_MMA(1, 1, At, B1); PG8_BAR; PG8_SCHED;
            } else {
            PG8_LDB(B0, 0, 0); PG8_SCHED; PG8_LDA(At, 0, 0); PG8_STAGE(PG8_SA(1, 1), a1 + hstep, voffA);
            PG8_WAIT_L(8); PG8_BAR; PG8_WAIT_L(0); PG8_MMA(0, 0, At, B0); PG8_BAR; PG8_SCHED;
            PG8_LDB(B1, 0, 1); PG8_STAGE(PG8_SB(0, 0), b2, voffB);
            PG8_BAR; PG8_WAIT_L(0); PG8_MMA(0, 1, At, B1); PG8_BAR;
            PG8_LDA(At, 0, 1); PG8_STAGE(PG8_SA(0, 0), a2, voffA);
            PG8_BAR; PG8_WAIT_L(0); PG8_MMA(1, 0, At, B0); PG8_BAR; PG8_SCHED;
            PG8_STAGE(PG8_SB(0, 1), b2 + hstep, voffB);
            PG8_WAIT_V(6); PG8_BAR; PG8_MMA(1, 1, At, B1); PG8_BAR;
            PG8_LDB(B0, 1, 0); PG8_SCHED; PG8_LDA(At, 1, 0); PG8_STAGE(PG8_SA(0, 1), a2 + hstep, voffA);
            PG8_WAIT_L(8); PG8_BAR; PG8_WAIT_L(0); PG8_MMA(0, 0, At, B0); PG8_BAR; PG8_SCHED;
            PG8_LDB(B1, 1, 1); PG8_STAGE(PG8_SB(1, 0), b3, voffB);
            PG8_BAR; PG8_WAIT_L(0); PG8_MMA(0, 1, At, B1); PG8_BAR;
            PG8_LDA(At, 1, 1); PG8_STAGE(PG8_SA(1, 0), a3, voffA);
            PG8_BAR; PG8_WAIT_L(0); PG8_MMA(1, 0, At, B0); PG8_BAR; PG8_SCHED;
            PG8_STAGE(PG8_SB(1, 1), b3 + hstep, voffB);
            PG8_WAIT_V(6); PG8_BAR; PG8_MMA(1, 1, At, B1); PG8_BAR;
            }
        }
        if constexpr (ALIGN_EPI) { if (wr == 0) PG8_BAR; }
        if constexpr (!Epi::AFTER_DRAIN) { E(acc, cur, wr, wc, fr, fq); S.done(cur); }
        if (!has_next) break;
#pragma unroll
        for (int a = 0; a < 2; ++a)
#pragma unroll
            for (int b = 0; b < 2; ++b)
#pragma unroll
                for (int m = 0; m < 4; ++m)
#pragma unroll
                    for (int n = 0; n < 2; ++n) acc[a][b][m][n] = (f32x4){0.f, 0.f, 0.f, 0.f};
        cur = nxt; cA = nA; cB = nB; ++ui;
        if constexpr (ALIGN_EPI) { if (wr == 1) PG8_BAR; }
    }
    PG8_WAIT_V(0);
    if constexpr (!ALIGN_EPI) { if (wr == 0) PG8_BAR; }
    PG8_BAR;
    if constexpr (Epi::AFTER_DRAIN) { E.fused(acc, cur, wr, wc, fr, fq, lds, wid, lane); S.done(cur); }
#undef PG8_SA
#undef PG8_SB
#undef PG8_STAGE
#undef PG8_LDA
#undef PG8_LDB
#undef PG8_MMA
#undef PG8_WAIT_V
#undef PG8_WAIT_L
#undef PG8_BAR
#undef PG8_SCHED
}
}
#define LAS __attribute__((address_space(3)))
#define GAS __attribute__((address_space(1)))
typedef GAS unsigned gu32;
typedef GAS unsigned long long gu64;
#define RLX_AGENT __ATOMIC_RELAXED, __HIP_MEMORY_SCOPE_AGENT
#define LDS_WAIT() asm volatile("s_waitcnt lgkmcnt(0)" ::: "memory")
#define VM_WAIT() asm volatile("s_waitcnt vmcnt(0)" ::: "memory")
__device__ __forceinline__ unsigned long long rt() { return __builtin_amdgcn_s_memrealtime(); }
#define XB_TMO      128
#define XB_XCNT(j)  (256  + 64 * (j))
#define XB_XSUB(j)  (1280 + 64 * (j))
#define XB_XGEN(j)  (2304 + 64 * (j))
#define XB_TOP      3328
#define XB_TOPGEN   3392
#define XCD_BAR_WORDS 3456
#define XB_SPIN_CAP (1u << 18)

__device__ __forceinline__ unsigned xb_ld(unsigned* p)              { return __hip_atomic_load(p, __ATOMIC_RELAXED, __HIP_MEMORY_SCOPE_AGENT); }
__device__ __forceinline__ unsigned xb_add(unsigned* p, unsigned v) { return __hip_atomic_fetch_add(p, v, __ATOMIC_RELAXED, __HIP_MEMORY_SCOPE_AGENT); }
__device__ __forceinline__ unsigned xb_xcc_id() { return (unsigned)__builtin_amdgcn_s_getreg((3 << 11) | 20) & 0xFu; }
#define XB_SPIN(cond, bar) do { unsigned _sp = 0; while (cond) { __builtin_amdgcn_s_sleep(1); \
    if ((++_sp & 255u) == 0u) { if (xb_ld(&(bar)[XB_TMO])) break; if (_sp > XB_SPIN_CAP) { atomicAdd(&(bar)[XB_TMO], 1u); break; } } } } while (0)

struct XcdBarrier {
    unsigned* bar; unsigned x;
    volatile LAS unsigned* st;
};

__device__ __forceinline__ XcdBarrier xcd_barrier_post(unsigned* bar, volatile LAS unsigned* st, const bool t0) {
    XcdBarrier b; b.bar = bar; b.x = xb_xcc_id(); b.st = st;
    if (t0) (void)xb_add(&bar[XB_XCNT(b.x)], 1u);
    return b;
}
__device__ __forceinline__ void xcd_barrier_complete(unsigned* bar, unsigned x, unsigned& nloc, unsigned& nx) {
    const unsigned G = gridDim.x * gridDim.y * gridDim.z;
    unsigned sum, cnt, mine, sp = 0u;
    for (;;) {
        sum = 0u; cnt = 0u; mine = 0u;
#pragma unroll
        for (unsigned j = 0; j < 16; ++j) { const unsigned c = xb_ld(&bar[XB_XCNT(j)]); sum += c; cnt += (c > 0u) ? 1u : 0u; mine = (j == x) ? c : mine; }
        if (sum == G) break;
        __builtin_amdgcn_s_sleep(1);
        if ((++sp & 255u) == 0u) { if (xb_ld(&bar[XB_TMO])) break; if (sp > XB_SPIN_CAP) { atomicAdd(&bar[XB_TMO], 1u); break; } }
    }
    nloc = mine > 0u ? mine : 1u; nx = cnt > 0u ? cnt : 1u;
}

__device__ __forceinline__ void xcd_barrier(const XcdBarrier& b, const bool t0) {
    asm volatile("s_waitcnt vmcnt(0)" ::: "memory");
    __syncthreads();
    if (t0) {
        unsigned* bar = b.bar;
        __builtin_amdgcn_s_waitcnt(0);
        unsigned nloc = b.st[0], nx = b.st[1];
        if (nloc == 0u) { xcd_barrier_complete(bar, b.x, nloc, nx); b.st[0] = nloc; b.st[1] = nx; }
        const unsigned old = xb_add(&bar[XB_XSUB(b.x)], 1u);
        const unsigned gen = old / nloc;
        if (old + 1u == (gen + 1u) * nloc) {
            __builtin_amdgcn_fence(__ATOMIC_RELEASE, "agent");
            asm volatile("s_waitcnt vmcnt(0)" ::: "memory");
            const unsigned og = xb_add(&bar[XB_TOP], 1u);
            const unsigned tg = og / nx;
            if (og + 1u == (tg + 1u) * nx) xb_add(&bar[XB_TOPGEN], 1u);
            else XB_SPIN(xb_ld(&bar[XB_TOPGEN]) == tg, bar);
            __builtin_amdgcn_fence(__ATOMIC_ACQUIRE, "agent");
            xb_add(&bar[XB_XGEN(b.x)], 1u);
            asm volatile("s_waitcnt vmcnt(0)" ::: "memory");
        } else {
            XB_SPIN(xb_ld(&bar[XB_XGEN(b.x)]) == gen, bar);
            __builtin_amdgcn_fence(__ATOMIC_ACQUIRE, "agent");
            asm volatile("s_waitcnt vmcnt(0)" ::: "memory");
        }
    }
    __syncthreads();
}
constexpr int BATCH = 2, SEQ = 16384, DM = 2048, MTOK = BATCH * SEQ;
constexpr int E_IN = 6144, O_INP = 8448  , O_LD = 8192;
constexpr int S5G = 64, S5P = 64, S5T = 128, S5NC = SEQ / S5T;
constexpr float LOG2E = 1.4426950408889634f;
constexpr float RMS_EPS = 1e-6f;
constexpr int NWAVES = 8;

#define LAS __attribute__((address_space(3)))
typedef unsigned short bf16_t;
typedef short bf16x8 __attribute__((ext_vector_type(8)));
typedef float f32x4 __attribute__((ext_vector_type(4)));
typedef float f32x2 __attribute__((ext_vector_type(2)));
typedef float f32x16 __attribute__((ext_vector_type(16)));
typedef unsigned u32x4 __attribute__((ext_vector_type(4)));
typedef unsigned u32x2 __attribute__((ext_vector_type(2)));
typedef short v4i16_t __attribute__((ext_vector_type(4)));
typedef __bf16 bf16x2_t __attribute__((ext_vector_type(2)));

constexpr size_t MiB = 1u << 20;
constexpr size_t WS_CTL = 0;
constexpr size_t WS_LAMB = 1 * MiB;
constexpr size_t WS_LAMT = 1 * MiB + 65536;
constexpr size_t WS_BBAR = 2 * MiB;
constexpr size_t WS_CMAT = 3 * MiB;
constexpr size_t WS_BIASDA = 4 * MiB;
constexpr size_t WS_BIASF = 5 * MiB;
constexpr size_t WS_FLOG = 7 * MiB;
constexpr size_t WS_S5ST = 9 * MiB;
constexpr size_t WS_WIN0 = 20 * MiB;
constexpr size_t WS_WOUT0 = 44 * MiB;
constexpr size_t WS_WGLU = 52 * MiB;
constexpr size_t WS_WIN1 = 54 * MiB;
constexpr size_t WS_WOUT1 = 87 * MiB;
constexpr size_t WS_HBUF = 96 * MiB;
constexpr size_t WS_PROJ = 224 * MiB;
constexpr size_t WS_YCAT = 736 * MiB;
constexpr size_t WS_END = 864 * MiB;
constexpr int CW_BAR = 4096;
constexpr int CW_QDA = 64, CW_QFOX = 128, CW_LAM = 192, CW_THRDA = 193, CW_THRF = 194;
constexpr float ZERO_THR = 105.f;

constexpr int LDS_MISC = 135168;
constexpr int LDS_BYTES = 147456;
constexpr int AL_K = 0, AL_V = 32768, AL_B = 65536;
constexpr int LDS_STASH = 69632;

__device__ __forceinline__ float bf2f(unsigned b) { return __uint_as_float(b << 16); }
__device__ __forceinline__ unsigned pk2(float lo, float hi) { f32x2 v = {lo, hi}; bf16x2_t b = __builtin_convertvector(v, bf16x2_t); return __builtin_bit_cast(unsigned, b); }
__device__ __forceinline__ float bflo(unsigned w) { return __uint_as_float(w << 16); }
__device__ __forceinline__ float bfhi(unsigned w) { return __uint_as_float(w & 0xffff0000u); }
__device__ __forceinline__ float sigmoidf_(float x) { return 1.f / (1.f + __expf(-x)); }
__device__ __forceinline__ float siluf_(float x) { return x * sigmoidf_(x); }
__device__ __forceinline__ float gelu_tanh(float x) { const float z = 0.7978845608028654f * (x + 0.044715f * x * x * x); const float t = 1.f - 2.f / (1.f + __expf(2.f * z)); return 0.5f * x * (1.f + t); }
#define DOT2(a, b, c) __builtin_amdgcn_fdot2_f32_bf16(__builtin_bit_cast(bf16x2_t, (unsigned)(a)), __builtin_bit_cast(bf16x2_t, (unsigned)(b)), (c), false)
__device__ __forceinline__ int crow(int r, int hi) { return (r & 3) + 8 * (r >> 2) + 4 * hi; }
__device__ __forceinline__ float wave_sum(float v) {
#pragma unroll
    for (int o = 1; o < 64; o <<= 1) v += __shfl_xor(v, o);
    return v;
}

struct Args {
    const float* in[27];
    float* out; unsigned char* ws;
    int ph_lo, ph_hi;
};

namespace pg8 {
struct EpiProj1 {
    static constexpr bool PERM = true, AFTER_DRAIN = false;
    bf16_t* O; float* flog;
    __device__ __forceinline__ void operator()(const f32x4 (&acc)[2][2][4][2], const Unit& u, int wr, int wc, int fr, int fq) const {
        const int row0 = u.pm * BM + wr * 64 + fr;
        if (u.pn < 32) {
            const int col0 = u.pn * BM + wc * 32 + 8 * fq;
#pragma unroll
            for (int ai = 0; ai < 2; ++ai)
#pragma unroll
                for (int m = 0; m < 4; ++m) { bf16_t* rowp = O + (size_t)(row0 + ai * HALF + m * 16) * O_LD + col0;
#pragma unroll
                    for (int bj = 0; bj < 2; ++bj) { const f32x4 v0 = acc[ai][bj][m][0], v1 = acc[ai][bj][m][1];
                        u32x4 w; w.x = cvt_pk_bf16(v0[0], v0[1]); w.y = cvt_pk_bf16(v0[2], v0[3]); w.z = cvt_pk_bf16(v1[0], v1[1]); w.w = cvt_pk_bf16(v1[2], v1[3]);
                        *(u32x4*)(rowp + bj * HALF) = w; } }
        } else if (wc == 0 && fq < 2) {
#pragma unroll
            for (int ai = 0; ai < 2; ++ai)
#pragma unroll
                for (int m = 0; m < 4; ++m) { float* rp = flog + (size_t)(row0 + ai * HALF + m * 16) * 16 + 8 * fq;
                    *(f32x4*)(rp) = acc[ai][0][m][0]; *(f32x4*)(rp + 4) = acc[ai][0][m][1]; }
        }
    }
};
struct EpiGlu {
    static constexpr bool PERM = true, AFTER_DRAIN = false;
    bf16_t* O; const bf16_t* yg; const bf16_t* proj0; const float* bglu;
    __device__ __forceinline__ void operator()(const f32x4 (&acc)[2][2][4][2], const Unit& u, int wr, int wc, int fr, int fq) const {
        const int row0 = u.pm * BM + wr * 64 + fr; const int col0 = u.pn * BM + wc * 32 + 8 * fq;
#pragma unroll
        for (int ai = 0; ai < 2; ++ai)
#pragma unroll
            for (int m = 0; m < 4; ++m) { const size_t row = (size_t)(row0 + ai * HALF + m * 16);
#pragma unroll
                for (int bj = 0; bj < 2; ++bj) { const int c = col0 + bj * HALF;
                    const f32x4 b0 = *(const f32x4*)(bglu + c), b1 = *(const f32x4*)(bglu + c + 4);
                    const u32x4 yv = *(const u32x4*)(yg + row * 1024 + c); const u32x4 zv = *(const u32x4*)(proj0 + row * E_IN + 1024 + c);
                    const f32x4 v0 = acc[ai][bj][m][0] + b0, v1 = acc[ai][bj][m][1] + b1;
                    float r[8];
#pragma unroll
                    for (int e = 0; e < 4; ++e) { const unsigned yw = yv[e], zw = zv[e];
                        const float a0 = e < 2 ? v0[2 * e] : v1[2 * e - 4], a1 = e < 2 ? v0[2 * e + 1] : v1[2 * e - 3];
                        r[2 * e] = bflo(yw) * sigmoidf_(a0) * siluf_(bflo(zw)); r[2 * e + 1] = bfhi(yw) * sigmoidf_(a1) * siluf_(bfhi(zw)); }
                    u32x4 w; w.x = cvt_pk_bf16(r[0], r[1]); w.y = cvt_pk_bf16(r[2], r[3]); w.z = cvt_pk_bf16(r[4], r[5]); w.w = cvt_pk_bf16(r[6], r[7]);
                    *(u32x4*)(O + row * DM + c) = w; } }
    }
};
struct EpiResid {
    static constexpr bool PERM = false, AFTER_DRAIN = false;
    const float* base; float* out;
    __device__ __forceinline__ void operator()(const f32x4 (&acc)[2][2][4][2], const Unit& u, int wr, int wc, int fr, int fq) const {
        const int row0 = u.pm * BM + wr * 64 + fr; const int col0 = u.pn * BM + wc * 32 + 4 * fq;
#pragma unroll
        for (int ai = 0; ai < 2; ++ai)
#pragma unroll
            for (int m = 0; m < 4; ++m) { const size_t off = (size_t)(row0 + ai * HALF + m * 16) * DM + col0;
#pragma unroll
                for (int bj = 0; bj < 2; ++bj)
#pragma unroll
                    for (int n = 0; n < 2; ++n) { const f32x4 bs = *(const f32x4*)(base + off + bj * HALF + n * 16); *(f32x4*)(out + off + bj * HALF + n * 16) = bs + acc[ai][bj][m][n]; } }
    }
};
}

__device__ __forceinline__ void transpose_item(const float* __restrict__ W, int K, int N, bf16_t* __restrict__ WT, LAS float* scr, int item, int nblk, int lane) {
    const int kb = item / nblk, nb = item % nblk, k0 = 64 * kb, n0 = 32 * nb;
    const int nc = n0 + (lane & 31);
#pragma unroll 8
    for (int i = 0; i < 32; ++i) { const int kk = 2 * i + (lane >> 5); scr[kk * 33 + (lane & 31)] = (nc < N) ? W[(size_t)(k0 + kk) * N + nc] : 0.f; }
    asm volatile("s_waitcnt lgkmcnt(0)" ::: "memory");
    const int c = lane & 7;
#pragma unroll
    for (int j = 0; j < 4; ++j) { const int n = (lane >> 3) + 8 * j; const LAS float* s = scr + (8 * c) * 33 + n;
        u32x4 o; o.x = pk2(s[0 * 33], s[1 * 33]); o.y = pk2(s[2 * 33], s[3 * 33]); o.z = pk2(s[4 * 33], s[5 * 33]); o.w = pk2(s[6 * 33], s[7 * 33]);
        *(u32x4*)(WT + (size_t)(n0 + n) * K + k0 + 8 * c) = o; }
    asm volatile("s_waitcnt lgkmcnt(0)" ::: "memory");
}
__device__ __forceinline__ void rms_row_to_bf16(const float* __restrict__ xrow, const float* __restrict__ gain, bf16_t* __restrict__ orow, int lane) {
    const f32x4* xr = (const f32x4*)xrow + lane; const f32x4* gr = (const f32x4*)gain + lane;
    f32x4 v[8]; float s = 0.f;
#pragma unroll
    for (int j = 0; j < 8; ++j) { v[j] = xr[64 * j]; s += (v[j].x * v[j].x + v[j].y * v[j].y) + (v[j].z * v[j].z + v[j].w * v[j].w); }
    const float r = 1.f / sqrtf(wave_sum(s) * (1.f / DM) + RMS_EPS);
    u32x2* o8 = (u32x2*)orow + lane;
#pragma unroll
    for (int j = 0; j < 8; ++j) { const f32x4 g = gr[64 * j]; u32x2 w; w.x = pk2(v[j].x * r * g.x, v[j].y * r * g.y); w.y = pk2(v[j].z * r * g.z, v[j].w * r * g.w); o8[64 * j] = w; }
}
template <int LPS>
__device__ __forceinline__ void qknorm16(bf16_t* p, const float* __restrict__ gain16, float mul, float inv_n) {
    u32x4 a = *(u32x4*)p, b = *(u32x4*)(p + 8);
    float v[16];
#pragma unroll
    for (int e = 0; e < 4; ++e) { v[2 * e] = bflo(a[e]); v[2 * e + 1] = bfhi(a[e]); v[8 + 2 * e] = bflo(b[e]); v[9 + 2 * e] = bfhi(b[e]); }
    float s = 0.f;
#pragma unroll
    for (int e = 0; e < 16; ++e) s += v[e] * v[e];
#pragma unroll
    for (int o = 1; o < LPS; o <<= 1) s += __shfl_xor(s, o);
    const float r = mul / sqrtf(s * inv_n + RMS_EPS);
#pragma unroll
    for (int e = 0; e < 16; ++e) v[e] = v[e] * r * gain16[e];
#pragma unroll
    for (int e = 0; e < 4; ++e) { a[e] = pk2(v[2 * e], v[2 * e + 1]); b[e] = pk2(v[8 + 2 * e], v[9 + 2 * e]); }
    *(u32x4*)p = a; *(u32x4*)(p + 8) = b;
}
__device__ __forceinline__ void rms_rows2_to_bf16(const float* __restrict__ x0, const float* __restrict__ x1, const bool has1, const float* __restrict__ gain, bf16_t* __restrict__ o0, bf16_t* __restrict__ o1, int lane) {
    const f32x4* xr0 = (const f32x4*)x0 + lane; const f32x4* xr1 = (const f32x4*)x1 + lane; const f32x4* gr = (const f32x4*)gain + lane;
    f32x4 v[8], w[8]; float s0 = 0.f, s1 = 0.f;
#pragma unroll
    for (int j = 0; j < 8; ++j) v[j] = xr0[64 * j];
    if (has1) {
#pragma unroll
        for (int j = 0; j < 8; ++j) w[j] = xr1[64 * j];
    }
#pragma unroll
    for (int j = 0; j < 8; ++j) s0 += (v[j].x * v[j].x + v[j].y * v[j].y) + (v[j].z * v[j].z + v[j].w * v[j].w);
    const float r0 = 1.f / sqrtf(wave_sum(s0) * (1.f / DM) + RMS_EPS);
    u32x2* p0 = (u32x2*)o0 + lane;
#pragma unroll
    for (int j = 0; j < 8; ++j) { const f32x4 g = gr[64 * j]; u32x2 q; q.x = pk2(v[j].x * r0 * g.x, v[j].y * r0 * g.y); q.y = pk2(v[j].z * r0 * g.z, v[j].w * r0 * g.w); p0[64 * j] = q; }
    if (has1) {
#pragma unroll
        for (int j = 0; j < 8; ++j) s1 += (w[j].x * w[j].x + w[j].y * w[j].y) + (w[j].z * w[j].z + w[j].w * w[j].w);
        const float r1 = 1.f / sqrtf(wave_sum(s1) * (1.f / DM) + RMS_EPS);
        u32x2* p1 = (u32x2*)o1 + lane;
#pragma unroll
        for (int j = 0; j < 8; ++j) { const f32x4 g = gr[64 * j]; u32x2 q; q.x = pk2(w[j].x * r1 * g.x, w[j].y * r1 * g.y); q.y = pk2(w[j].z * r1 * g.z, w[j].w * r1 * g.w); p1[64 * j] = q; }
    }
}
template <int LPS>
__device__ __forceinline__ void qknorm_regs(u32x4& a, u32x4& b, const float* __restrict__ gp, float mul, float inv_n) {
    float v[16];
#pragma unroll
    for (int e = 0; e < 4; ++e) { v[2 * e] = bflo(a[e]); v[2 * e + 1] = bfhi(a[e]); v[8 + 2 * e] = bflo(b[e]); v[9 + 2 * e] = bfhi(b[e]); }
    float s = 0.f;
#pragma unroll
    for (int e = 0; e < 16; ++e) s += v[e] * v[e];
#pragma unroll
    for (int o = 1; o < LPS; o <<= 1) s += __shfl_xor(s, o);
    const float r = mul / sqrtf(s * inv_n + RMS_EPS);
#pragma unroll
    for (int e = 0; e < 4; ++e) { const f32x4 gg = *(const f32x4*)(gp + 4 * e);
        v[4 * e] *= r * gg.x; v[4 * e + 1] *= r * gg.y; v[4 * e + 2] *= r * gg.z; v[4 * e + 3] *= r * gg.w; }
#pragma unroll
    for (int e = 0; e < 4; ++e) { a[e] = pk2(v[2 * e], v[2 * e + 1]); b[e] = pk2(v[8 + 2 * e], v[9 + 2 * e]); }
}
template <int NIT, int NQ, int LPS>
__device__ __forceinline__ void qknorm_rows2(bf16_t* p0, bf16_t* p1, const bool has1, const float* __restrict__ gq, const float* __restrict__ gk, const float qmul, const float inv_n, const int lane) {
    u32x4 a0[NIT], b0[NIT], a1[NIT], b1[NIT];
#pragma unroll
    for (int it = 0; it < NIT; ++it) { a0[it] = *(const u32x4*)(p0 + it * 1024 + lane * 16); b0[it] = *(const u32x4*)(p0 + it * 1024 + lane * 16 + 8); }
    if (has1) {
#pragma unroll
        for (int it = 0; it < NIT; ++it) { a1[it] = *(const u32x4*)(p1 + it * 1024 + lane * 16); b1[it] = *(const u32x4*)(p1 + it * 1024 + lane * 16 + 8); }
    }
#pragma unroll
    for (int it = 0; it < NIT; ++it) { const float* gp = (it < NQ ? gq : gk) + ((lane * 16) & 127);
        qknorm_regs<LPS>(a0[it], b0[it], gp, it < NQ ? qmul : 1.f, inv_n);
        *(u32x4*)(p0 + it * 1024 + lane * 16) = a0[it]; *(u32x4*)(p0 + it * 1024 + lane * 16 + 8) = b0[it]; }
    if (has1) {
#pragma unroll
        for (int it = 0; it < NIT; ++it) { const float* gp = (it < NQ ? gq : gk) + ((lane * 16) & 127);
            qknorm_regs<LPS>(a1[it], b1[it], gp, it < NQ ? qmul : 1.f, inv_n);
            *(u32x4*)(p1 + it * 1024 + lane * 16) = a1[it]; *(u32x4*)(p1 + it * 1024 + lane * 16 + 8) = b1[it]; }
    }
}

template <int DQK>
__device__ __forceinline__ void attn_pass(LAS unsigned char* lds, const bf16_t* __restrict__ Qg, const bf16_t* __restrict__ Kg, const bf16_t* __restrict__ Vg,
                                          const float* __restrict__ btab, const float bscale, const int pitch, const int q0, const int t_lo, f32x16 (&o)[4], const int wid, const int lane) {
    constexpr int NCH = DQK / 8, KS = DQK / 16, KROWB = DQK * 2, KI = NCH / 8;
    const int tid = wid * 64 + lane, r32 = lane & 31, hi = lane >> 5;
    const int NT = (q0 + 256) / 64;
    const int qrel = wid * 32 + r32;
    bf16x8 qf[KS];
#pragma unroll
    for (int s = 0; s < KS; ++s) qf[s] = *(const bf16x8*)(Qg + (size_t)(q0 + qrel) * pitch + 16 * s + 8 * hi);
    int kgo[KI], klo[KI], vgo[2], vlo[2];
#pragma unroll
    for (int i = 0; i < KI; ++i) { const int cid = tid + 512 * i, row = cid / NCH, ch = cid % NCH; const int sw = (DQK == 128) ? (row & 15) : ((row >> 1) & 7);
        kgo[i] = row * pitch + ch * 8; klo[i] = row * KROWB + ((ch ^ sw) << 4); }
#pragma unroll
    for (int i = 0; i < 2; ++i) { const int cid = tid + 512 * i, row = cid >> 4, ch = cid & 15;
        vgo[i] = row * pitch + ch * 8; vlo[i] = (ch >> 2) * 4096 + (row >> 3) * 512 + (row & 7) * 64 + (ch & 3) * 16; }
    const float bref = btab[q0];
    u32x4 kreg[KI], vreg[2]; float breg = 0.f;
#define AT_LOAD(t) do { const size_t kvb_ = (size_t)(64 * (t)) * pitch; \
        _Pragma("unroll") for (int i = 0; i < KI; ++i) kreg[i] = *(const u32x4*)(Kg + kvb_ + kgo[i]); \
        _Pragma("unroll") for (int i = 0; i < 2; ++i) vreg[i] = *(const u32x4*)(Vg + kvb_ + vgo[i]); \
        if (tid < 64) breg = (btab[64 * (t) + tid] - bref) * bscale; } while (0)
#define AT_STORE(buf) do { \
        _Pragma("unroll") for (int i = 0; i < KI; ++i) *(LAS u32x4*)(lds + AL_K + (buf) * 16384 + klo[i]) = kreg[i]; \
        _Pragma("unroll") for (int i = 0; i < 2; ++i) *(LAS u32x4*)(lds + AL_V + (buf) * 16384 + vlo[i]) = vreg[i]; \
        if (tid < 64) *(LAS float*)(lds + AL_B + (buf) * 256 + tid * 4) = breg; } while (0)
    float m_run = -INFINITY, l_run = 0.f;
#pragma unroll
    for (int b = 0; b < 4; ++b)
#pragma unroll
        for (int r = 0; r < 16; ++r) o[b][r] = 0.f;
    AT_LOAD(t_lo); AT_STORE(0); __syncthreads();
    const int ksw = (DQK == 128) ? (r32 & 15) : ((r32 >> 1) & 7);
    const int vlane = (4 * hi + ((lane & 15) >> 2)) * 64 + ((lane >> 4) & 1) * 32 + (lane & 3) * 8;
    for (int t = t_lo; t < NT; ++t) {
        const int cur = (t - t_lo) & 1;
        if (t + 1 < NT) AT_LOAD(t + 1);
        const int jb = t - (NT - 4);
        const bool skip = (jb >= 0) && (2 * jb > wid);
        if (!skip) {
            LAS const unsigned char* Kb = lds + AL_K + cur * 16384;
            f32x16 s0, s1;
            LAS const float* bl = (LAS const float*)(lds + AL_B + cur * 256);
#pragma unroll
            for (int g = 0; g < 4; ++g) { const f32x4 b0 = *(LAS const f32x4*)(bl + 8 * g + 4 * hi), b1 = *(LAS const f32x4*)(bl + 32 + 8 * g + 4 * hi);
#pragma unroll
                for (int e = 0; e < 4; ++e) { s0[4 * g + e] = b0[e]; s1[4 * g + e] = b1[e]; } }
#pragma unroll
            for (int s = 0; s < KS; ++s) { const int ch = 2 * s + hi;
                const bf16x8 a0 = *(LAS const bf16x8*)(Kb + r32 * KROWB + ((ch ^ ksw) << 4));
                const bf16x8 a1 = *(LAS const bf16x8*)(Kb + (32 + r32) * KROWB + ((ch ^ ksw) << 4));
                s0 = __builtin_amdgcn_mfma_f32_32x32x16_bf16(a0, qf[s], s0, 0, 0, 0);
                s1 = __builtin_amdgcn_mfma_f32_32x32x16_bf16(a1, qf[s], s1, 0, 0, 0); }
            if ((jb >= 0) && (2 * jb + 1 >= wid)) {
#pragma unroll
                for (int r = 0; r < 16; ++r) { const int kv = 64 * jb + crow(r, hi); if (kv > qrel) s0[r] = -INFINITY; if (kv + 32 > qrel) s1[r] = -INFINITY; }
            }
            float mx = fmaxf(s0[0], s1[0]);
#pragma unroll
            for (int r = 1; r < 16; ++r) mx = fmaxf(mx, fmaxf(s0[r], s1[r]));
            mx = fmaxf(mx, __shfl_xor(mx, 32));
            if (__any(mx > m_run + 8.f)) {
                const float m_new = fmaxf(m_run, mx);
                const float alpha = __builtin_amdgcn_exp2f(m_run - m_new);
                m_run = m_new; l_run *= alpha;
#pragma unroll
                for (int b = 0; b < 4; ++b)
#pragma unroll
                    for (int r = 0; r < 16; ++r) o[b][r] *= alpha;
            }
            float rs = 0.f;
#pragma unroll
            for (int r = 0; r < 16; ++r) { s0[r] = __builtin_amdgcn_exp2f(s0[r] - m_run); s1[r] = __builtin_amdgcn_exp2f(s1[r] - m_run); rs += s0[r] + s1[r]; }
            l_run += rs;
            u32x4 pw[4];
#pragma unroll
            for (int e = 0; e < 4; ++e) { pw[0][e] = pk2(s0[2 * e], s0[2 * e + 1]); pw[1][e] = pk2(s0[8 + 2 * e], s0[9 + 2 * e]); pw[2][e] = pk2(s1[2 * e], s1[2 * e + 1]); pw[3][e] = pk2(s1[8 + 2 * e], s1[9 + 2 * e]); }
            LAS const unsigned char* Vb = lds + AL_V + cur * 16384 + vlane;
#pragma unroll
            for (int b = 0; b < 4; ++b)
#pragma unroll
                for (int ks = 0; ks < 4; ++ks) {
                    const v4i16_t lo = __builtin_amdgcn_ds_read_tr16_b64_v4i16((LAS v4i16_t*)(Vb + b * 4096 + ks * 1024));
                    const v4i16_t hh = __builtin_amdgcn_ds_read_tr16_b64_v4i16((LAS v4i16_t*)(Vb + b * 4096 + ks * 1024 + 512));
                    const bf16x8 af = {lo[0], lo[1], lo[2], lo[3], hh[0], hh[1], hh[2], hh[3]};
                    o[b] = __builtin_amdgcn_mfma_f32_32x32x16_bf16(af, __builtin_bit_cast(bf16x8, pw[ks]), o[b], 0, 0, 0);
                }
        }
        if (t + 1 < NT) AT_STORE(cur ^ 1);
        __syncthreads();
    }
#undef AT_LOAD
#undef AT_STORE
    const float l = l_run + __shfl_xor(l_run, 32);
    const float inv = 1.f / l;
#pragma unroll
    for (int b = 0; b < 4; ++b)
#pragma unroll
        for (int r = 0; r < 16; ++r) o[b][r] *= inv;
}

template <int DQK>
__device__ __forceinline__ void qk_tile(LAS const unsigned char* Kb, LAS const float* bl, const bf16x8* qf, const int ksw, const int r32, const int hi, f32x16& s0, f32x16& s1) {
    constexpr int KS = DQK / 16, KROWB = DQK * 2;
#pragma unroll
    for (int g = 0; g < 4; ++g) { const f32x4 b0 = *(LAS const f32x4*)(bl + 8 * g + 4 * hi), b1 = *(LAS const f32x4*)(bl + 32 + 8 * g + 4 * hi);
#pragma unroll
        for (int e = 0; e < 4; ++e) { s0[4 * g + e] = b0[e]; s1[4 * g + e] = b1[e]; } }
#pragma unroll
    for (int s = 0; s < KS; ++s) { const int ch = 2 * s + hi;
        const bf16x8 a0 = *(LAS const bf16x8*)(Kb + r32 * KROWB + ((ch ^ ksw) << 4));
        const bf16x8 a1 = *(LAS const bf16x8*)(Kb + (32 + r32) * KROWB + ((ch ^ ksw) << 4));
        s0 = __builtin_amdgcn_mfma_f32_32x32x16_bf16(a0, qf[s], s0, 0, 0, 0);
        s1 = __builtin_amdgcn_mfma_f32_32x32x16_bf16(a1, qf[s], s1, 0, 0, 0); }
}
__device__ __forceinline__ void pv_tile(LAS const unsigned char* Vb, const u32x4* pw, f32x16 (&o)[4]) {
#pragma unroll
    for (int ks = 0; ks < 4; ++ks)
#pragma unroll
        for (int b = 0; b < 4; ++b) {
            const v4i16_t lo = __builtin_amdgcn_ds_read_tr16_b64_v4i16((LAS v4i16_t*)(Vb + b * 4096 + ks * 1024));
            const v4i16_t hh = __builtin_amdgcn_ds_read_tr16_b64_v4i16((LAS v4i16_t*)(Vb + b * 4096 + ks * 1024 + 512));
            const bf16x8 af = {lo[0], lo[1], lo[2], lo[3], hh[0], hh[1], hh[2], hh[3]};
            o[b] = __builtin_amdgcn_mfma_f32_32x32x16_bf16(af, __builtin_bit_cast(bf16x8, pw[ks]), o[b], 0, 0, 0);
        }
}
__device__ __forceinline__ void softmax_tile(f32x16& s0, f32x16& s1, float& m_run, float& l_run, float& alpha, bool& resc, u32x4* pw) {
    float mxa = __builtin_fmaxf(s0[0], s1[0]), mxb = __builtin_fmaxf(s0[1], s1[1]);
#pragma unroll
    for (int r = 2; r < 16; r += 2) { mxa = __builtin_fmaxf(__builtin_fmaxf(mxa, s0[r]), s1[r]); mxb = __builtin_fmaxf(__builtin_fmaxf(mxb, s0[r + 1]), s1[r + 1]); }
    float mx = __builtin_fmaxf(mxa, mxb);
    { auto rr = __builtin_amdgcn_permlane32_swap(__float_as_uint(mx), __float_as_uint(mx), false, false); mx = fmaxf(__uint_as_float(rr[0]), __uint_as_float(rr[1])); }
    resc = __any(mx > m_run + 8.f);
    alpha = 1.f;
    if (resc) { const float m_new = fmaxf(m_run, mx); alpha = __builtin_amdgcn_exp2f(m_run - m_new); m_run = m_new; l_run *= alpha; }
    float rs = 0.f;
#pragma unroll
    for (int r = 0; r < 16; ++r) { s0[r] = __builtin_amdgcn_exp2f(s0[r] - m_run); s1[r] = __builtin_amdgcn_exp2f(s1[r] - m_run); rs += s0[r] + s1[r]; }
    l_run += rs;
#pragma unroll
    for (int e = 0; e < 4; ++e) { pw[0][e] = pk2(s0[2 * e], s0[2 * e + 1]); pw[1][e] = pk2(s0[8 + 2 * e], s0[9 + 2 * e]); pw[2][e] = pk2(s1[2 * e], s1[2 * e + 1]); pw[3][e] = pk2(s1[8 + 2 * e], s1[9 + 2 * e]); }
}
__device__ __forceinline__ void softmax_tile_sm(f32x16& s0, f32x16& s1, float& m_run, float& l_run, float& alpha, bool& resc, u32x4* pw, const bool skipmax) {
    resc = false; alpha = 1.f;
    if (!skipmax) {
    float mxa = __builtin_fmaxf(s0[0], s1[0]), mxb = __builtin_fmaxf(s0[1], s1[1]);
#pragma unroll
    for (int r = 2; r < 16; r += 2) { mxa = __builtin_fmaxf(__builtin_fmaxf(mxa, s0[r]), s1[r]); mxb = __builtin_fmaxf(__builtin_fmaxf(mxb, s0[r + 1]), s1[r + 1]); }
    float mx = __builtin_fmaxf(mxa, mxb);
    { auto rr = __builtin_amdgcn_permlane32_swap(__float_as_uint(mx), __float_as_uint(mx), false, false); mx = fmaxf(__uint_as_float(rr[0]), __uint_as_float(rr[1])); }
    resc = __any(mx > m_run + 8.f);
    alpha = 1.f;
    if (resc) { const float m_new = fmaxf(m_run, mx); alpha = __builtin_amdgcn_exp2f(m_run - m_new); m_run = m_new; l_run *= alpha; }
    }
    float rs = 0.f;
#pragma unroll
    for (int r = 0; r < 16; ++r) { s0[r] = __builtin_amdgcn_exp2f(s0[r] - m_run); s1[r] = __builtin_amdgcn_exp2f(s1[r] - m_run); rs += s0[r] + s1[r]; }
    l_run += rs;
#pragma unroll
    for (int e = 0; e < 4; ++e) { pw[0][e] = pk2(s0[2 * e], s0[2 * e + 1]); pw[1][e] = pk2(s0[8 + 2 * e], s0[9 + 2 * e]); pw[2][e] = pk2(s1[2 * e], s1[2 * e + 1]); pw[3][e] = pk2(s1[8 + 2 * e], s1[9 + 2 * e]); }
}
template <int DQK>
__device__ __forceinline__ void attn_pass2(LAS unsigned char* lds, const bf16_t* __restrict__ Qg, const bf16_t* __restrict__ Kg, const bf16_t* __restrict__ Vg,
                                           const float* __restrict__ btab, const float bscale, const int pitch, const int q0, const int t_lo, f32x16 (&o)[4], const int wid, const int lane) {
    constexpr int NCH = DQK / 8, KS = DQK / 16, KROWB = DQK * 2, KI = NCH / 8;
    const int tid = wid * 64 + lane, r32 = lane & 31, hi = lane >> 5;
    const int NT = (q0 + 256) / 64;
    const int T_w = NT - 4 + (wid >> 1);
    const int qrel = wid * 32 + r32;
    bf16x8 qf[KS];
#pragma unroll
    for (int s = 0; s < KS; ++s) qf[s] = *(const bf16x8*)(Qg + (size_t)(q0 + qrel) * pitch + 16 * s + 8 * hi);
    int kgo[KI], klo[KI], vgo[2], vlo[2];
#pragma unroll
    for (int i = 0; i < KI; ++i) { const int cid = tid + 512 * i, row = cid / NCH, ch = cid % NCH; const int sw = (DQK == 128) ? (row & 15) : ((row >> 1) & 7);
        kgo[i] = row * pitch + ch * 8; klo[i] = row * KROWB + ((ch ^ sw) << 4); }
#pragma unroll
    for (int i = 0; i < 2; ++i) { const int cid = tid + 512 * i, row = cid >> 4, ch = cid & 15;
        vgo[i] = row * pitch + ch * 8; vlo[i] = (ch >> 2) * 4096 + (row >> 3) * 512 + (row & 7) * 64 + (ch & 3) * 16; }
    const float bref = btab[q0];
    u32x4 kreg[KI], vreg[2]; float breg = 0.f;
#define AT_LOADK(t) do { const size_t kvb_ = (size_t)(64 * (t)) * pitch; \
        _Pragma("unroll") for (int i = 0; i < KI; ++i) kreg[i] = *(const u32x4*)(Kg + kvb_ + kgo[i]); \
        if (tid < 64) breg = (btab[64 * (t) + tid] - bref) * bscale; } while (0)
#define AT_LOADV(t) do { const size_t kvb_ = (size_t)(64 * (t)) * pitch; \
        _Pragma("unroll") for (int i = 0; i < 2; ++i) vreg[i] = *(const u32x4*)(Vg + kvb_ + vgo[i]); } while (0)
#define AT_STOREK(buf) do { \
        _Pragma("unroll") for (int i = 0; i < KI; ++i) *(LAS u32x4*)(lds + AL_K + (buf) * 16384 + klo[i]) = kreg[i]; \
        if (tid < 64) *(LAS float*)(lds + AL_B + (buf) * 256 + tid * 4) = breg; } while (0)
#define AT_STOREV(buf) do { \
        _Pragma("unroll") for (int i = 0; i < 2; ++i) *(LAS u32x4*)(lds + AL_V + (buf) * 16384 + vlo[i]) = vreg[i]; } while (0)
    float m_run = -INFINITY, l_run = 0.f;
#pragma unroll
    for (int b = 0; b < 4; ++b)
#pragma unroll
        for (int r = 0; r < 16; ++r) o[b][r] = 0.f;
    const int ksw = (DQK == 128) ? (r32 & 15) : ((r32 >> 1) & 7);
    const int vlane = (4 * hi + ((lane & 15) >> 2)) * 64 + ((lane >> 4) & 1) * 32 + (lane & 3) * 8;
    AT_LOADK(t_lo); AT_STOREK(t_lo & 1);
    AT_LOADK(t_lo + 1); AT_STOREK((t_lo + 1) & 1);
    __syncthreads();
    f32x16 sc0, sc1, sn0, sn1;
    u32x4 pprev[4], pnew[4];
#pragma unroll
    for (int k = 0; k < 4; ++k) { pprev[k] = (u32x4){0u, 0u, 0u, 0u}; pnew[k] = (u32x4){0u, 0u, 0u, 0u}; }
    qk_tile<DQK>(lds + AL_K + (t_lo & 1) * 16384, (LAS const float*)(lds + AL_B + (t_lo & 1) * 256), qf, ksw, r32, hi, sc0, sc1);
#pragma unroll
    for (int r = 0; r < 16; ++r) { sn0[r] = 0.f; sn1[r] = 0.f; }
    for (int t = t_lo; t < NT; ++t) {
        const int pn = (t + 1) & 1, pc = t & 1;
        if (t + 2 < NT) AT_LOADK(t + 2);
        AT_LOADV(t);
        float alpha = 1.f; bool resc = false;
        if ((t > t_lo) && (t < NT - 4)) {
            qk_tile<DQK>(lds + AL_K + pn * 16384, (LAS const float*)(lds + AL_B + pn * 256), qf, ksw, r32, hi, sn0, sn1);
            pv_tile(lds + AL_V + pn * 16384 + vlane, pprev, o);
            softmax_tile(sc0, sc1, m_run, l_run, alpha, resc, pnew);
        } else {
            if (t + 1 <= T_w) qk_tile<DQK>(lds + AL_K + pn * 16384, (LAS const float*)(lds + AL_B + pn * 256), qf, ksw, r32, hi, sn0, sn1);
            if (t > t_lo && t - 1 <= T_w) pv_tile(lds + AL_V + pn * 16384 + vlane, pprev, o);
            if (t <= T_w) {
                const int jb = t - (NT - 4);
                if ((jb >= 0) && (2 * jb + 1 >= wid)) {
#pragma unroll
                    for (int r = 0; r < 16; ++r) { const int kv = 64 * jb + crow(r, hi); if (kv > qrel) sc0[r] = -INFINITY; if (kv + 32 > qrel) sc1[r] = -INFINITY; }
                }
                softmax_tile(sc0, sc1, m_run, l_run, alpha, resc, pnew);
            }
        }
        if (resc) {
#pragma unroll
            for (int b = 0; b < 4; ++b)
#pragma unroll
                for (int r = 0; r < 16; ++r) o[b][r] *= alpha;
        }
        if (t + 2 < NT) AT_STOREK(pc);
        AT_STOREV(pc);
        __syncthreads();
#pragma unroll
        for (int k = 0; k < 4; ++k) pprev[k] = pnew[k];
        sc0 = sn0; sc1 = sn1;
    }
    if (NT - 1 <= T_w) pv_tile(lds + AL_V + ((NT - 1) & 1) * 16384 + vlane, pprev, o);
    __syncthreads();
#undef AT_LOADK
#undef AT_LOADV
#undef AT_STOREK
#undef AT_STOREV
    const float l = l_run + __shfl_xor(l_run, 32);
    const float inv = 1.f / l;
#pragma unroll
    for (int b = 0; b < 4; ++b)
#pragma unroll
        for (int r = 0; r < 16; ++r) o[b][r] *= inv;
}

template <int DQK>
__device__ __forceinline__ void qk_tile_pf(LAS const unsigned char* Kb, LAS const float* bl, const bf16x8* qf, const int ksw, const int r32, const int hi, f32x16& s0, f32x16& s1) {
    constexpr int KS = DQK / 16, KROWB = DQK * 2;
    LAS const unsigned char* k0 = Kb + r32 * KROWB; LAS const unsigned char* k1 = Kb + (32 + r32) * KROWB;
    bf16x8 fa[2][2];
    { const int ch_ = hi; fa[0][0] = *(LAS const bf16x8*)(k0 + ((ch_ ^ ksw) << 4)); fa[0][1] = *(LAS const bf16x8*)(k1 + ((ch_ ^ ksw) << 4)); }
#pragma unroll
    for (int g = 0; g < 4; ++g) { const f32x4 b0 = *(LAS const f32x4*)(bl + 8 * g + 4 * hi), b1 = *(LAS const f32x4*)(bl + 32 + 8 * g + 4 * hi);
#pragma unroll
        for (int e = 0; e < 4; ++e) { s0[4 * g + e] = b0[e]; s1[4 * g + e] = b1[e]; } }
    __builtin_amdgcn_sched_barrier(0);
#pragma unroll
    for (int s = 0; s < KS; ++s) {
        if (s + 1 < KS) { const int ch_ = 2 * (s + 1) + hi; fa[(s + 1) & 1][0] = *(LAS const bf16x8*)(k0 + ((ch_ ^ ksw) << 4)); fa[(s + 1) & 1][1] = *(LAS const bf16x8*)(k1 + ((ch_ ^ ksw) << 4)); }
        s0 = __builtin_amdgcn_mfma_f32_32x32x16_bf16(fa[s & 1][0], qf[s], s0, 0, 0, 0);
        s1 = __builtin_amdgcn_mfma_f32_32x32x16_bf16(fa[s & 1][1], qf[s], s1, 0, 0, 0);
        __builtin_amdgcn_sched_barrier(0);
    }
}
__device__ __forceinline__ bool attn_static_ok(const float* __restrict__ btab, const float bscale, const float bq2, const int q0) {
    const float a = __uint_as_float(__builtin_amdgcn_readfirstlane(__float_as_uint(btab[q0]))), b = __uint_as_float(__builtin_amdgcn_readfirstlane(__float_as_uint(btab[q0 + 255])));
    return ((b - a) * bscale + bq2) <= 90.f;
}
template <int DQK, bool FASTM>
__device__ __forceinline__ void attn_pass3(LAS unsigned char* lds, const bf16_t* __restrict__ Qg, const bf16_t* __restrict__ Kg, const bf16_t* __restrict__ Vg,
                                           const float* __restrict__ btab, const float bscale, const float bq2, const int pitch, const int q0, const int t_lo, f32x16 (&o)[4], const int wid, const int lane_in) {
    constexpr int NCH = DQK / 8, KS = DQK / 16, KI = NCH / 8;
    int lane_l = lane_in; asm volatile("" : "+v"(lane_l));
    const int lane = lane_l, tid = wid * 64 + lane, r32 = lane & 31, hi = lane >> 5;
    const int NT = (q0 + 256) / 64;
    const int T_w = NT - 4 + (wid >> 1);
    const int qrel = wid * 32 + r32;
    bf16x8 qf[KS];
#pragma unroll
    for (int s = 0; s < KS; ++s) qf[s] = *(const bf16x8*)(Qg + (size_t)(q0 + qrel) * pitch + 16 * s + 8 * hi);
    int kgo0, vgo0;
    { const int p = wid * 64 + lane, row = p / NCH, cp = p % NCH; const int sw = (DQK == 128) ? (row & 15) : ((row >> 1) & 7); kgo0 = row * pitch + (cp ^ sw) * 8; }
    { const int p = wid * 64 + lane; const int row = ((p >> 5) & 7) * 8 + ((p >> 2) & 7), ch = (p >> 8) * 4 + (p & 3); vgo0 = row * pitch + ch * 8; }
    const float bref = __uint_as_float(__builtin_amdgcn_readfirstlane(__float_as_uint(btab[q0])));
    float breg = 0.f;
#define AT_DMAK(t, buf) do { const bf16_t* kp_ = Kg + (size_t)(64 * (t)) * pitch; \
        _Pragma("unroll") for (int i = 0; i < KI; ++i) __builtin_amdgcn_global_load_lds((const unsigned*)(kp_ + kgo0 + i * 32 * pitch), (LAS unsigned*)(lds + AL_K + (buf) * 16384 + (wid + 8 * i) * 1024), 16, 0, 0); } while (0)
#define AT_DMAV(t, buf) do { const bf16_t* vp_ = Vg + (size_t)(64 * (t)) * pitch; \
        _Pragma("unroll") for (int i = 0; i < 2; ++i) __builtin_amdgcn_global_load_lds((const unsigned*)(vp_ + vgo0 + i * 64), (LAS unsigned*)(lds + AL_V + (buf) * 16384 + (wid + 8 * i) * 1024), 16, 0, 0); } while (0)
    const float brm = (__uint_as_float(__builtin_amdgcn_readfirstlane(__float_as_uint(btab[q0 + 255]))) - bref) * bscale;
    constexpr bool fastm = FASTM;
    const float cshift = fastm ? (brm + 0.5f * bq2) : 0.f;
#define AT_LOADB(t) do { if (wid == 0) breg = btab[64 * (t) + lane]; } while (0)
#define AT_STOREB(buf) do { if (wid == 0) *(LAS float*)(lds + AL_B + (buf) * 256 + lane * 4) = (breg - bref) * bscale - cshift; } while (0)
    float m_run = fastm ? 0.f : -INFINITY, l_run = 0.f;
#pragma unroll
    for (int b = 0; b < 4; ++b)
#pragma unroll
        for (int r = 0; r < 16; ++r) o[b][r] = 0.f;
    const int ksw = (DQK == 128) ? (r32 & 15) : ((r32 >> 1) & 7);
    const int vlane = (4 * hi + ((lane & 15) >> 2)) * 64 + ((lane >> 4) & 1) * 32 + (lane & 3) * 8;
    const int t0 = t_lo & ~1;
    AT_DMAK(t0, 0); AT_DMAK(t0 + 1, 1); AT_DMAV(t0, 0);
    AT_LOADB(t0); AT_STOREB(0); AT_LOADB(t0 + 1); AT_STOREB(1);
    asm volatile("s_waitcnt vmcnt(0)" ::: "memory");
    __syncthreads();
    f32x16 sc0, sc1, sn0, sn1;
    u32x4 pw[4];
    qk_tile<DQK>(lds + AL_K, (LAS const float*)(lds + AL_B), qf, ksw, r32, hi, sc0, sc1);
#define P3_STEP(t, pc, pn, C0, C1, N0, N1) do { \
        if ((t) + 2 < NT) { AT_DMAK((t) + 2, pc); AT_LOADB((t) + 2); } \
        if ((t) + 1 < NT) AT_DMAV((t) + 1, pn); \
        float alpha = 1.f; bool resc = false; \
        if ((t) <= T_w) { \
            if ((t) < T_w) { \
                qk_tile<DQK>(lds + AL_K + (pn) * 16384, (LAS const float*)(lds + AL_B + (pn) * 256), qf, ksw, r32, hi, N0, N1); \
            } else { \
                const int jb = (t) - (NT - 4); \
                _Pragma("unroll") for (int r = 0; r < 16; ++r) { const int kv = 64 * jb + crow(r, hi); if (kv > qrel) C0[r] = -INFINITY; if (kv + 32 > qrel) C1[r] = -INFINITY; } \
            } \
            softmax_tile_sm(C0, C1, m_run, l_run, alpha, resc, pw, fastm); \
            if (resc) { \
                _Pragma("unroll") for (int b = 0; b < 4; ++b) _Pragma("unroll") for (int r = 0; r < 16; ++r) o[b][r] *= alpha; \
            } \
            pv_tile(lds + AL_V + (pc) * 16384 + vlane, pw, o); \
        } \
        if ((t) + 2 < NT) AT_STOREB(pc); \
        asm volatile("s_waitcnt vmcnt(0)" ::: "memory"); \
        __syncthreads(); } while (0)
#define P3_MAIN(t, pc, pn, C0, C1, N0, N1) do { \
        AT_DMAK((t) + 2, pc); AT_LOADB((t) + 2); AT_DMAV((t) + 1, pn); \
        float alpha = 1.f; bool resc = false; \
        qk_tile_pf<DQK>(lds + AL_K + (pn) * 16384, (LAS const float*)(lds + AL_B + (pn) * 256), qf, ksw, r32, hi, N0, N1); \
        softmax_tile_sm(C0, C1, m_run, l_run, alpha, resc, pw, fastm); \
        if (resc) { \
            _Pragma("unroll") for (int b = 0; b < 4; ++b) _Pragma("unroll") for (int r = 0; r < 16; ++r) o[b][r] *= alpha; \
        } \
        pv_tile(lds + AL_V + (pc) * 16384 + vlane, pw, o); \
        AT_STOREB(pc); \
        asm volatile("s_waitcnt vmcnt(0)" ::: "memory"); \
        __syncthreads(); } while (0)
    int opq_ = 0; asm volatile("s_mov_b32 %0, 0" : "=s"(opq_));
#define P3_FAST(t, pc, pn, C0, C1, N0, N1) do { \
        AT_DMAK((t) + 2, pc); AT_LOADB((t) + 2); AT_DMAV((t) + 1, pn); \
        qk_tile_pf<DQK>(lds + AL_K + (pn) * 16384, (LAS const float*)(lds + AL_B + (pn) * 256), qf, ksw, r32, hi, N0, N1); \
        if (__builtin_expect(opq_ != 0, 0)) { asm volatile("s_nop 0" ::: "memory"); } \
        { f32x2 rs2_ = {0.f, 0.f}; \
          _Pragma("unroll") for (int r = 0; r < 16; ++r) { C0[r] = __builtin_amdgcn_exp2f(C0[r]); C1[r] = __builtin_amdgcn_exp2f(C1[r]); } \
          _Pragma("unroll") for (int r = 0; r < 16; r += 2) { rs2_ += (f32x2){C0[r], C0[r + 1]}; rs2_ += (f32x2){C1[r], C1[r + 1]}; } \
          l_run += rs2_.x + rs2_.y; \
          _Pragma("unroll") for (int e = 0; e < 4; ++e) { pw[0][e] = pk2(C0[2 * e], C0[2 * e + 1]); pw[1][e] = pk2(C0[8 + 2 * e], C0[9 + 2 * e]); pw[2][e] = pk2(C1[2 * e], C1[2 * e + 1]); pw[3][e] = pk2(C1[8 + 2 * e], C1[9 + 2 * e]); } } \
        pv_tile(lds + AL_V + (pc) * 16384 + vlane, pw, o); \
        AT_STOREB(pc); \
        asm volatile("s_waitcnt vmcnt(0)" ::: "memory"); \
        __syncthreads(); } while (0)
    int t = t0;
    if constexpr (fastm) {
        for (; t < NT - 4; t += 2) {
            P3_FAST(t, 0, 1, sc0, sc1, sn0, sn1);
            P3_FAST(t + 1, 1, 0, sn0, sn1, sc0, sc1);
        }
    } else {
        for (; t < NT - 4; t += 2) {
            P3_MAIN(t, 0, 1, sc0, sc1, sn0, sn1);
            P3_MAIN(t + 1, 1, 0, sn0, sn1, sc0, sc1);
        }
    }
#undef P3_FAST
    for (; t < NT; t += 2) {
        P3_STEP(t, 0, 1, sc0, sc1, sn0, sn1);
        P3_STEP(t + 1, 1, 0, sn0, sn1, sc0, sc1);
    }
#undef P3_MAIN
#undef P3_STEP
#undef AT_DMAK
#undef AT_DMAV
#undef AT_LOADB
#undef AT_STOREB
    const float l = l_run + __shfl_xor(l_run, 32);
    const float inv = 1.f / l;
#pragma unroll
    for (int b = 0; b < 4; ++b)
#pragma unroll
        for (int r = 0; r < 16; ++r) o[b][r] *= inv;
}

__global__ void __launch_bounds__(NWAVES * 64, 2) hybrid_fwd(Args args) {
    extern __shared__ __attribute__((aligned(16))) unsigned char lds_raw[];
    LAS unsigned char* lds = (LAS unsigned char*)lds_raw;
    const int wave = __builtin_amdgcn_readfirstlane((int)threadIdx.x >> 6);
#define LANE_FRESH() int lane; asm volatile("v_mbcnt_lo_u32_b32 %0, -1, 0\n\tv_mbcnt_hi_u32_b32 %0, -1, %0" : "=v"(lane)); const int tid = wave * 64 + lane; (void)tid
    const int G = gridDim.x, bid = blockIdx.x;
    const int gw = bid * NWAVES + wave, NGW = G * NWAVES;
    typedef const Args __attribute__((address_space(4)))* KArgP;
    KArgP ka0 = (KArgP)__builtin_amdgcn_kernarg_segment_ptr();
#define KA_FRESH() KArgP ka = ka0; asm volatile("" : "+s"(ka))
#define AIN(i) (ka->in[i])
#define WS_FRESH() unsigned char* ws = ka->ws; unsigned* ctl = (unsigned*)(ws + WS_CTL); bf16_t* win0 = (bf16_t*)(ws + WS_WIN0); bf16_t* wout0 = (bf16_t*)(ws + WS_WOUT0); bf16_t* wglu = (bf16_t*)(ws + WS_WGLU); bf16_t* win1 = (bf16_t*)(ws + WS_WIN1); bf16_t* wout1 = (bf16_t*)(ws + WS_WOUT1); bf16_t* hbuf = (bf16_t*)(ws + WS_HBUF); bf16_t* ygelu = (bf16_t*)(ws + WS_HBUF); bf16_t* proj = (bf16_t*)(ws + WS_PROJ); bf16_t* ycat = (bf16_t*)(ws + WS_YCAT); f32x2* lamb = (f32x2*)(ws + WS_LAMB); f32x2* lamt = (f32x2*)(ws + WS_LAMT); unsigned* bbar = (unsigned*)(ws + WS_BBAR); bf16_t* cmat = (bf16_t*)(ws + WS_CMAT); float* biasda = (float*)(ws + WS_BIASDA); float* biasf = (float*)(ws + WS_BIASF); float* flog = (float*)(ws + WS_FLOG); f32x2* s5st = (f32x2*)(ws + WS_S5ST); (void)ctl; (void)win0; (void)wout0; (void)wglu; (void)win1; (void)wout1; (void)hbuf; (void)ygelu; (void)proj; (void)ycat; (void)lamb; (void)lamt; (void)bbar; (void)cmat; (void)biasda; (void)biasf; (void)flog; (void)s5st
    cg::grid_group grid = cg::this_grid();
    XcdBarrier xbar;
    {
        int l0; asm volatile("v_mbcnt_lo_u32_b32 %0, -1, 0\n\tv_mbcnt_hi_u32_b32 %0, -1, %0" : "=v"(l0));
        if (wave == 0 && l0 < 32) ((LAS unsigned*)(lds + LDS_MISC))[l0] = 0u;
        __syncthreads();
        xbar = xcd_barrier_post((unsigned*)(args.ws + WS_CTL) + CW_BAR, (volatile LAS unsigned*)(lds + LDS_MISC) + 8, wave == 0 && l0 == 0);
    }
    const int lo = args.ph_lo, hi_ph = args.ph_hi;
#ifndef PH_MASK
#define PH_MASK 0x7ff
#endif
#define IN(k) (((PH_MASK >> (k)) & 1) && lo <= (k) && (k) < hi_ph)
#ifndef DUP_MASK
#define DUP_MASK 0
#endif
#define NREP(k) (((DUP_MASK >> (k)) & 1) ? 2 : 1)
#define SEAM(k) do { if (IN(k) && IN((k) + 1)) { if ((k) == 0) grid.sync(); else { int l0; asm volatile("v_mbcnt_lo_u32_b32 %0, -1, 0\n\tv_mbcnt_hi_u32_b32 %0, -1, %0" : "=v"(l0)); xcd_barrier(xbar, wave == 0 && l0 == 0); } } } while (0)

    if (IN(0)) {
        KA_FRESH(); LANE_FRESH(); WS_FRESH(); const float* x = AIN(0); float* out = ka->out; (void)x; (void)out;
        LAS float* scr = (LAS float*)(lds + wave * 16384);
        for (int rep = 0; rep < NREP(0); ++rep) {
        constexpr int I_IN0 = 32 * 192, I_OUT = 32 * 64, I_GLU = 16 * 32, I_IN1 = 32 * 264;
        constexpr int NITEMS = I_IN0 + 2 * I_OUT + I_GLU + I_IN1;
        for (int it = gw; it < NITEMS; it += NGW) {
            int r = it;
            if (r < I_IN0) { transpose_item(AIN(2), 2048, E_IN, win0, scr, r, 192, lane); continue; } r -= I_IN0;
            if (r < I_OUT) { transpose_item(AIN(3), 2048, 2048, wout0, scr, r, 64, lane); continue; } r -= I_OUT;
            if (r < I_GLU) { transpose_item(AIN(12), 1024, 1024, wglu, scr, r, 32, lane); continue; } r -= I_GLU;
            if (r < I_IN1) { transpose_item(AIN(22), 2048, 8208, win1, scr, r, 264, lane); continue; } r -= I_IN1;
            transpose_item(AIN(24), 2048, 2048, wout1, scr, r, 64, lane);
        }
        for (int m = gw; m < MTOK; m += 2 * NGW) { const int m1 = m + NGW; const bool h1 = m1 < MTOK; const int mm = h1 ? m1 : m;
            rms_rows2_to_bf16(x + (size_t)m * DM, x + (size_t)mm * DM, h1, AIN(1), hbuf + (size_t)m * DM, hbuf + (size_t)mm * DM, lane); }
        const int gt = bid * 512 + tid, NGT = G * 512;
        for (int i = gt; i < S5G * S5P; i += NGT) {
            const int g = i >> 6;
            const double dt = exp((double)AIN(6)[g]);
            const double lr = (double)AIN(4)[i], li = (double)AIN(5)[i];
            const double mag = exp(lr * dt), ar = mag * cos(li * dt), ai = mag * sin(li * dt);
            const double den = lr * lr + li * li, nr = ar - 1.0, ni = ai;
            const double kr = (nr * lr + ni * li) / den, ki = (ni * lr - nr * li) / den;
            lamb[i] = (f32x2){(float)ar, (float)ai};
            const double magT = exp(lr * dt * (double)S5T);
            lamt[i] = (f32x2){(float)(magT * cos(li * dt * (double)S5T)), (float)(magT * sin(li * dt * (double)S5T))};
#pragma unroll 2
            for (int j = 0; j < 8; ++j) { const double br0 = (double)AIN(7)[i * 16 + 2 * j], bi0 = (double)AIN(8)[i * 16 + 2 * j], br1 = (double)AIN(7)[i * 16 + 2 * j + 1], bi1 = (double)AIN(8)[i * 16 + 2 * j + 1];
                bbar[i * 16 + j] = pk2((float)(kr * br0 - ki * bi0), (float)(kr * br1 - ki * bi1));
                bbar[i * 16 + 8 + j] = pk2((float)(kr * bi0 + ki * br0), (float)(kr * bi1 + ki * br1)); }
        }
        for (int i = gt; i < S5G * 32 * 128; i += NGT) { const int k = i & 127, n = (i >> 7) & 31, g = i >> 12;
            float v = 0.f; if (n < 16) v = (k < 64) ? AIN(9)[(g * 16 + n) * 64 + k] : -AIN(10)[(g * 16 + n) * 64 + (k - 64)];
            cmat[i] = (bf16_t)(pk2(v, 0.f) & 0xffffu); }
        for (int i = gt; i < 8 * SEQ; i += NGT) { const int h = i / SEQ, j = i % SEQ; biasda[i] = exp2f(-(float)(h + 1)) * (float)j; }
        if (bid == 0 && tid == 0) {
            float d1 = 0.f, d2 = 0.f;
            for (int i = 0; i < 64; ++i) { d1 += AIN(16)[i] * AIN(17)[i]; d2 += AIN(18)[i] * AIN(19)[i]; }
            ((float*)ctl)[CW_LAM] = expf(d1) - expf(d2) + 0.2f;
            float gq = 0.f, gk = 0.f, fq_ = 0.f, fk_ = 0.f;
            for (int i = 0; i < 128; ++i) { gq = fmaxf(gq, fabsf(AIN(14)[i])); gk = fmaxf(gk, fabsf(AIN(15)[i])); fq_ = fmaxf(fq_, fabsf(AIN(25)[i])); fk_ = fmaxf(fk_, fabsf(AIN(26)[i])); }
            ((float*)ctl)[CW_THRDA] = ZERO_THR + 2.f * 8.f * gq * gk * 1.02f;
            ((float*)ctl)[CW_THRF] = ZERO_THR + 2.f * 11.3137085f * fq_ * fk_ * 1.02f;
            ctl[CW_QDA] = 0u; ctl[CW_QDA + 1] = 0u; ctl[CW_QFOX] = 0u; ctl[CW_QFOX + 1] = 0u;
        }
        }
#ifdef XSYNC
        for (int i = 0; i < XSYNC; ++i) grid.sync();
#endif
    }
    SEAM(0);
    if (IN(1)) {
        KA_FRESH(); LANE_FRESH(); WS_FRESH(); const float* x = AIN(0); float* out = ka->out; (void)x; (void)out;
        pg8::Gemm g{hbuf, win0, MTOK, E_IN, DM}; pg8::StaticOrder S; S.init(MTOK, E_IN, G, bid);
        pg8::EpiBf16<0> E{proj, E_IN, nullptr, 0, 0, 1.f};
        for (int rep = 0; rep < NREP(1); ++rep) pg8::gemm_phase<pg8::EpiBf16<0>, pg8::StaticOrder, true, true>(lds, g, S, E, wave, lane);
    }
    SEAM(1);
    if (IN(2)) {
        KA_FRESH(); LANE_FRESH(); WS_FRESH(); const float* x = AIN(0); float* out = ka->out; (void)x; (void)out;
        const float qmul = 0.125f * LOG2E;
        for (int m = gw; m < MTOK; m += 2 * NGW) { const int m1 = m + NGW; const bool h1 = m1 < MTOK; const int mm = h1 ? m1 : m;
            qknorm_rows2<2, 1, 4>(proj + (size_t)m * E_IN + 2048, proj + (size_t)mm * E_IN + 2048, h1, AIN(14), AIN(15), qmul, 1.f / 64.f, lane); }
        {
        const int r32 = lane & 31, hi = lane >> 5;
        for (int rep = 0; rep < NREP(12); ++rep)
        for (int u = gw; u < BATCH * S5G * S5NC; u += NGW) {
            const int g = u & 63, c = (u >> 6) & (S5NC - 1), b = u >> 13;
            const f32x2 la = lamb[g * 64 + lane];
            bf16x8 bre[2], bim[2];
#pragma unroll
            for (int ph = 0; ph < 2; ++ph) { const unsigned* bp = bbar + (size_t)(g * 64 + 32 * ph + r32) * 16 + 4 * hi;
                bre[ph] = __builtin_bit_cast(bf16x8, *(const u32x4*)bp); bim[ph] = __builtin_bit_cast(bf16x8, *(const u32x4*)(bp + 8)); }
            float hr = 0.f, hi_s = 0.f;
            const bf16_t* up = proj + (size_t)(b * SEQ + c * S5T + r32) * E_IN + g * 16 + 8 * hi;
            for (int sb = 0; sb < 4; ++sb) {
                const bf16x8 ua = *(const bf16x8*)(up + (size_t)(sb * 32) * E_IN);
                f32x16 z16;
#pragma unroll
                for (int r = 0; r < 16; ++r) z16[r] = 0.f;
                f32x16 xr0 = __builtin_amdgcn_mfma_f32_32x32x16_bf16(ua, bre[0], z16, 0, 0, 0), xr1 = __builtin_amdgcn_mfma_f32_32x32x16_bf16(ua, bre[1], z16, 0, 0, 0);
                f32x16 xi0 = __builtin_amdgcn_mfma_f32_32x32x16_bf16(ua, bim[0], z16, 0, 0, 0), xi1 = __builtin_amdgcn_mfma_f32_32x32x16_bf16(ua, bim[1], z16, 0, 0, 0);
#pragma unroll
                for (int r = 0; r < 16; ++r) {
                    auto sr = __builtin_amdgcn_permlane32_swap(__float_as_uint(xr0[r]), __float_as_uint(xr1[r]), false, false); xr0[r] = __uint_as_float(sr[0]); xr1[r] = __uint_as_float(sr[1]);
                    auto si = __builtin_amdgcn_permlane32_swap(__float_as_uint(xi0[r]), __float_as_uint(xi1[r]), false, false); xi0[r] = __uint_as_float(si[0]); xi1[r] = __uint_as_float(si[1]); }
#pragma unroll
                for (int t = 0; t < 32; ++t) { const int r = (t & 3) + 4 * (t >> 3); const bool odd = (t >> 2) & 1;
                    const float xr = odd ? xr1[r] : xr0[r], xi = odd ? xi1[r] : xi0[r];
                    const float nhr = la.x * hr - la.y * hi_s + xr, nhi = la.x * hi_s + la.y * hr + xi; hr = nhr; hi_s = nhi; }
            }
            s5st[((size_t)(b * S5NC + c) * 64 + g) * 64 + lane] = (f32x2){hr, hi_s};
        }
        }
    }
    SEAM(2);
    if (IN(3)) {
        KA_FRESH(); LANE_FRESH(); WS_FRESH(); const float* x = AIN(0); float* out = ka->out; (void)x; (void)out;
        {
            LAS unsigned char* Ht = lds + wave * 8192;
            const int r32 = lane & 31, hi = lane >> 5;
            for (int rep = 0; rep < NREP(11); ++rep)
            for (int u = gw; u < BATCH * S5G * (S5NC / 8); u += NGW) {
                const int g = u & 63, c0 = ((u >> 6) & 15) * 8, b = u >> 10;
                const int gp = g * 64 + lane;
                const f32x2 la = lamb[gp], lt = lamt[gp];
                bf16x8 bre[2], bim[2];
#pragma unroll
                for (int ph = 0; ph < 2; ++ph) { const unsigned* bp = bbar + (size_t)(g * 64 + 32 * ph + r32) * 16 + 4 * hi;
                    bre[ph] = __builtin_bit_cast(bf16x8, *(const u32x4*)bp); bim[ph] = __builtin_bit_cast(bf16x8, *(const u32x4*)(bp + 8)); }
                float hr = 0.f, hi_s = 0.f;
#pragma unroll 8
                for (int cc = 0; cc < c0; ++cc) { const f32x2 s = s5st[((size_t)(b * S5NC + cc) * 64 + g) * 64 + lane];
                    const float nhr = lt.x * hr - lt.y * hi_s + s.x, nhi = lt.x * hi_s + lt.y * hr + s.y; hr = nhr; hi_s = nhi; }
                bf16x8 cfr[8];
#pragma unroll
                for (int s = 0; s < 8; ++s) cfr[s] = *(const bf16x8*)(cmat + (size_t)(g * 32 + r32) * 128 + 16 * s + 8 * hi);
                const f32x4 dv0 = *(const f32x4*)(AIN(11) + g * 16 + 4 * hi), dv1 = *(const f32x4*)(AIN(11) + g * 16 + 8 + 4 * hi);
                for (int c = c0; c < c0 + 8; ++c) {
                const size_t row0 = (size_t)(b * SEQ + c * S5T);
                const bf16_t* up = proj + (row0 + r32) * E_IN + g * 16 + 8 * hi;
                for (int sb = 0; sb < 4; ++sb) {
                    const size_t orow = row0 + sb * 32 + r32;
                    const u32x2 uvA = *(const u32x2*)(proj + orow * E_IN + g * 16 + 4 * hi), uvB = *(const u32x2*)(proj + orow * E_IN + g * 16 + 8 + 4 * hi);
                    {
                    const bf16x8 ua = *(const bf16x8*)(up + (size_t)(sb * 32) * E_IN);
                    f32x16 z16;
#pragma unroll
                    for (int r = 0; r < 16; ++r) z16[r] = 0.f;
                    f32x16 xr0 = __builtin_amdgcn_mfma_f32_32x32x16_bf16(ua, bre[0], z16, 0, 0, 0), xr1 = __builtin_amdgcn_mfma_f32_32x32x16_bf16(ua, bre[1], z16, 0, 0, 0);
                    f32x16 xi0 = __builtin_amdgcn_mfma_f32_32x32x16_bf16(ua, bim[0], z16, 0, 0, 0), xi1 = __builtin_amdgcn_mfma_f32_32x32x16_bf16(ua, bim[1], z16, 0, 0, 0);
#pragma unroll
                    for (int r = 0; r < 16; ++r) {
                        auto sr = __builtin_amdgcn_permlane32_swap(__float_as_uint(xr0[r]), __float_as_uint(xr1[r]), false, false); xr0[r] = __uint_as_float(sr[0]); xr1[r] = __uint_as_float(sr[1]);
                        auto si = __builtin_amdgcn_permlane32_swap(__float_as_uint(xi0[r]), __float_as_uint(xi1[r]), false, false); xi0[r] = __uint_as_float(si[0]); xi1[r] = __uint_as_float(si[1]); }
#pragma unroll
                    for (int tt = 0; tt < 32; ++tt) { const int r = (tt & 3) + 4 * (tt >> 3); const bool odd = (tt >> 2) & 1;
                        const float xr = odd ? xr1[r] : xr0[r], xi = odd ? xi1[r] : xi0[r];
                        const float nhr = la.x * hr - la.y * hi_s + xr, nhi = la.x * hi_s + la.y * hr + xi; hr = nhr; hi_s = nhi;
                        const unsigned w = pk2(hr, hi_s);
                        const int sw = tt & 15;
                        *(LAS unsigned short*)(Ht + tt * 256 + ((((lane >> 3)) ^ sw) << 4) + ((lane & 7) << 1)) = (unsigned short)(w & 0xffffu);
                        *(LAS unsigned short*)(Ht + tt * 256 + ((((64 + lane) >> 3) ^ sw) << 4) + ((lane & 7) << 1)) = (unsigned short)(w >> 16);
                    }
                    }
                    asm volatile("s_waitcnt lgkmcnt(0)" ::: "memory");
                    f32x16 acc;
#pragma unroll
                    for (int r = 0; r < 16; ++r) acc[r] = 0.f;
#pragma unroll
                    for (int s = 0; s < 8; ++s) { const bf16x8 a = *(LAS const bf16x8*)(Ht + r32 * 256 + (((2 * s + hi) ^ (r32 & 15)) << 4));
                        acc = __builtin_amdgcn_mfma_f32_32x32x16_bf16(cfr[s], a, acc, 0, 0, 0); }
                    asm volatile("s_waitcnt lgkmcnt(0)" ::: "memory");
                    {
                        const float y0 = gelu_tanh(acc[0] + dv0.x * bflo(uvA.x)), y1 = gelu_tanh(acc[1] + dv0.y * bfhi(uvA.x)), y2 = gelu_tanh(acc[2] + dv0.z * bflo(uvA.y)), y3 = gelu_tanh(acc[3] + dv0.w * bfhi(uvA.y));
                        const float y4 = gelu_tanh(acc[4] + dv1.x * bflo(uvB.x)), y5 = gelu_tanh(acc[5] + dv1.y * bfhi(uvB.x)), y6 = gelu_tanh(acc[6] + dv1.z * bflo(uvB.y)), y7 = gelu_tanh(acc[7] + dv1.w * bfhi(uvB.y));
                        u32x2 wA, wB; wA.x = pk2(y0, y1); wA.y = pk2(y2, y3); wB.x = pk2(y4, y5); wB.y = pk2(y6, y7);
                        *(u32x2*)(ygelu + orow * 1024 + g * 16 + 4 * hi) = wA; *(u32x2*)(ygelu + orow * 1024 + g * 16 + 8 + 4 * hi) = wB;
                    }
                }
                }
            }
        }
        __syncthreads();
        {
            LANE_FRESH();
            LAS volatile int* misc = (LAS volatile int*)(lds + LDS_MISC);
            const float lam = ((const float*)ctl)[CW_LAM]; const float thr_da = ((const float*)ctl)[CW_THRDA];
            const int r32 = lane & 31, hi = lane >> 5;
            for (int rep = 0; rep < NREP(3); ++rep)
            for (;;) {
                if (tid == 0) misc[0] = (int)atomicAdd(ctl + CW_QDA + rep, 1u);
                __syncthreads();
                const int ui = misc[0];
                __syncthreads();
                if (ui >= BATCH * 8 * 64) break;
                const int qb = 63 - (ui >> 4), bh = ui & 15, b = bh >> 3, h = bh & 7;
                const int q0 = qb * 256;
                const bf16_t* pb = proj + (size_t)b * SEQ * E_IN;
                const float dskip = thr_da * exp2f((float)(h + 1));
                const int t_lo = max(0, (int)ceilf(((float)q0 - dskip - 63.f) * (1.f / 64.f)));
                f32x16 o[4];
                LAS unsigned* stash = (LAS unsigned*)(lds + LDS_STASH) + wave * 2048 + lane;
                const float bq2 = (thr_da - ZERO_THR) * LOG2E;
                const bool fm = attn_static_ok(biasda + h * SEQ, LOG2E, bq2, q0);
                if (fm) attn_pass3<64, true>(lds, pb + 2048 + h * 128, pb + 3072 + h * 128, pb + 4096 + h * 128, biasda + h * SEQ, LOG2E, bq2, E_IN, q0, t_lo, o, wave, lane);
                else attn_pass3<64, false>(lds, pb + 2048 + h * 128, pb + 3072 + h * 128, pb + 4096 + h * 128, biasda + h * SEQ, LOG2E, bq2, E_IN, q0, t_lo, o, wave, lane);
#pragma unroll
                for (int bl = 0; bl < 4; ++bl)
#pragma unroll
                    for (int e = 0; e < 8; ++e) stash[(bl * 8 + e) * 64] = pk2(o[bl][2 * e], o[bl][2 * e + 1]);
                if (fm) attn_pass3<64, true>(lds, pb + 2048 + h * 128 + 64, pb + 3072 + h * 128 + 64, pb + 4096 + h * 128, biasda + h * SEQ, LOG2E, bq2, E_IN, q0, t_lo, o, wave, lane);
                else attn_pass3<64, false>(lds, pb + 2048 + h * 128 + 64, pb + 3072 + h * 128 + 64, pb + 4096 + h * 128, biasda + h * SEQ, LOG2E, bq2, E_IN, q0, t_lo, o, wave, lane);
                int hi_e = hi, r32_e = r32; asm volatile("" : "+v"(hi_e), "+v"(r32_e));
                float ssq = 0.f;
#pragma unroll
                for (int bl = 0; bl < 4; ++bl)
#pragma unroll
                    for (int e = 0; e < 8; ++e) { const unsigned w0 = stash[(bl * 8 + e) * 64]; const float v0 = bflo(w0) - lam * o[bl][2 * e], v1 = bfhi(w0) - lam * o[bl][2 * e + 1];
                        o[bl][2 * e] = v0; o[bl][2 * e + 1] = v1; ssq += v0 * v0 + v1 * v1; }
                ssq += __shfl_xor(ssq, 32);
                const float rr = 0.8f / sqrtf(ssq * (1.f / 128.f) + RMS_EPS);
                const size_t tok = (size_t)b * SEQ + q0 + wave * 32 + r32_e;
#pragma unroll
                for (int bl = 0; bl < 4; ++bl)
#pragma unroll
                    for (int g = 0; g < 4; ++g) { const int dv0 = 32 * bl + 8 * g + 4 * hi_e;
                        const f32x4 gn = *(const f32x4*)(AIN(20) + dv0);
                        const u32x2 zw = *(const u32x2*)(proj + tok * E_IN + 5120 + h * 128 + dv0);
                        const float y0 = o[bl][4 * g] * rr * gn.x * siluf_(bflo(zw.x)), y1 = o[bl][4 * g + 1] * rr * gn.y * siluf_(bfhi(zw.x));
                        const float y2 = o[bl][4 * g + 2] * rr * gn.z * siluf_(bflo(zw.y)), y3 = o[bl][4 * g + 3] * rr * gn.w * siluf_(bfhi(zw.y));
                        u32x2 w; w.x = pk2(y0, y1); w.y = pk2(y2, y3);
                        *(u32x2*)(ycat + tok * DM + 1024 + h * 128 + dv0) = w; }
            }
        }
    }
    SEAM(3);
    if (IN(4)) {
        KA_FRESH(); LANE_FRESH(); WS_FRESH(); const float* x = AIN(0); float* out = ka->out; (void)x; (void)out;
        pg8::Gemm g{ygelu, wglu, MTOK, 1024, 1024}; pg8::StaticOrder S; S.init(MTOK, 1024, G, bid);
        pg8::EpiGlu E{ycat, ygelu, proj, AIN(13)};
        pg8::gemm_phase<pg8::EpiGlu, pg8::StaticOrder, true, true>(lds, g, S, E, wave, lane);
    }
    SEAM(4);
    if (IN(5)) {
        KA_FRESH(); LANE_FRESH(); WS_FRESH(); const float* x = AIN(0); float* out = ka->out; (void)x; (void)out;
        pg8::Gemm g{ycat, wout0, MTOK, DM, DM}; pg8::StaticOrder S; S.init(MTOK, DM, G, bid);
        pg8::EpiResid E{x, out};
        pg8::gemm_phase<pg8::EpiResid, pg8::StaticOrder, true, true>(lds, g, S, E, wave, lane);
    }
    SEAM(5);
    if (IN(6)) {
        KA_FRESH(); LANE_FRESH(); WS_FRESH(); const float* x = AIN(0); float* out = ka->out; (void)x; (void)out;
        for (int rep = 0; rep < NREP(6); ++rep)
        for (int m = gw; m < MTOK; m += 2 * NGW) { const int m1 = m + NGW; const bool h1 = m1 < MTOK; const int mm = h1 ? m1 : m;
            rms_rows2_to_bf16(out + (size_t)m * DM, out + (size_t)mm * DM, h1, AIN(21), hbuf + (size_t)m * DM, hbuf + (size_t)mm * DM, lane); }
    }
    SEAM(6);
    if (IN(7)) {
        KA_FRESH(); LANE_FRESH(); WS_FRESH(); const float* x = AIN(0); float* out = ka->out; (void)x; (void)out;
        pg8::Gemm g{hbuf, win1, MTOK, O_INP, DM}; pg8::StaticOrder S; S.init(MTOK, O_INP, G, bid);
        pg8::EpiProj1 E{proj, flog};
        for (int rep = 0; rep < NREP(7); ++rep) pg8::gemm_phase<pg8::EpiProj1, pg8::StaticOrder, true, true>(lds, g, S, E, wave, lane);
    }
    SEAM(7);
    if (IN(8)) {
        KA_FRESH(); LANE_FRESH(); WS_FRESH(); const float* x = AIN(0); float* out = ka->out; (void)x; (void)out;
        if (bid < 32) {
            const int b = bid >> 4, h = bid & 15;
            LAS double* dsum = (LAS double*)lds;
            const float bf_ = AIN(23)[h];
            const float* fl = flog + ((size_t)b * SEQ + tid * 32) * 16 + h;
            float lf[32];
#pragma unroll
            for (int i = 0; i < 32; ++i) lf[i] = fl[i * 16];
            double tot = 0.0;
#pragma unroll
            for (int i = 0; i < 32; ++i) { const float xv = lf[i] + bf_; lf[i] = fminf(xv, 0.f) - __logf(1.f + __expf(-fabsf(xv))); tot += (double)lf[i]; }
            dsum[tid] = tot;
            __syncthreads();
            double pre = 0.0;
#pragma unroll 8
            for (int i = 0; i < tid; ++i) pre += dsum[i];
            float* bo = biasf + ((size_t)(b * 16 + h)) * SEQ + tid * 32;
#pragma unroll
            for (int i = 0; i < 32; i += 4) { f32x4 w;
                pre += (double)lf[i]; w.x = (float)(-pre); pre += (double)lf[i + 1]; w.y = (float)(-pre); pre += (double)lf[i + 2]; w.z = (float)(-pre); pre += (double)lf[i + 3]; w.w = (float)(-pre);
                *(f32x4*)(bo + i) = w; }
            __syncthreads();
        }
        const float qmul = 0.08838834764831845f * LOG2E;
        for (int m = gw; m < MTOK; m += 2 * NGW) { const int m1 = m + NGW; const bool h1 = m1 < MTOK; const int mm = h1 ? m1 : m;
            qknorm_rows2<4, 2, 8>(proj + (size_t)m * O_LD, proj + (size_t)mm * O_LD, h1, AIN(25), AIN(26), qmul, 1.f / 128.f, lane); }
    }
    SEAM(8);
    if (IN(9)) {
        KA_FRESH(); LANE_FRESH(); WS_FRESH(); const float* x = AIN(0); float* out = ka->out; (void)x; (void)out;
        LAS volatile int* misc = (LAS volatile int*)(lds + LDS_MISC);
        const int r32 = lane & 31, hi = lane >> 5;
        const float thr_f = ((const float*)ctl)[CW_THRF];
        for (int rep = 0; rep < NREP(9); ++rep)
        for (;;) {
            if (wave == 0) {
                int u0 = 0; if (lane == 0) u0 = (int)atomicAdd(ctl + CW_QFOX + rep, 1u);
                u0 = __shfl(u0, 0);
                int tl = 0;
                if (u0 < BATCH * 16 * 64) {
                    const int qb_ = 63 - (u0 >> 5), bh_ = u0 & 31; const float* bt = biasf + (size_t)bh_ * SEQ; const float bref = bt[qb_ * 256];
                    int ln = lane; asm volatile("" : "+v"(ln));
#pragma unroll
                    for (int r = 0; r < 4; ++r) { const int t = ln + 64 * r; bool dead = false;
                        if (t < 4 * qb_) dead = (bt[64 * t + 63] - bref) < -thr_f;
                        tl += __popcll(__ballot(dead)); }
                }
                if (lane == 0) { misc[0] = u0; misc[1] = tl; }
            }
            __syncthreads();
            const int ui = misc[0], t_lo = misc[1];
            __syncthreads();
            if (ui >= BATCH * 16 * 64) break;
            const int qb = 63 - (ui >> 5), bh = ui & 31, b = bh >> 4, h = bh & 15;
            const int q0 = qb * 256;
            const bf16_t* pb = proj + (size_t)b * SEQ * O_LD;
            f32x16 o[4];
            const float bq2 = (thr_f - ZERO_THR) * LOG2E;
            if (attn_static_ok(biasf + (size_t)bh * SEQ, LOG2E, bq2, q0)) attn_pass3<128, true>(lds, pb + h * 128, pb + 2048 + h * 128, pb + 4096 + h * 128, biasf + (size_t)bh * SEQ, LOG2E, bq2, O_LD, q0, t_lo, o, wave, lane);
            else attn_pass3<128, false>(lds, pb + h * 128, pb + 2048 + h * 128, pb + 4096 + h * 128, biasf + (size_t)bh * SEQ, LOG2E, bq2, O_LD, q0, t_lo, o, wave, lane);
            int hi_e = hi, r32_e = r32; asm volatile("" : "+v"(hi_e), "+v"(r32_e));
            const size_t tok = (size_t)b * SEQ + q0 + wave * 32 + r32_e;
#pragma unroll
            for (int bl = 0; bl < 4; ++bl)
#pragma unroll
                for (int g = 0; g < 4; ++g) { const int dv0 = 32 * bl + 8 * g + 4 * hi_e;
                    const u32x2 zw = *(const u32x2*)(proj + tok * O_LD + 6144 + h * 128 + dv0);
                    const float y0 = o[bl][4 * g] * siluf_(bflo(zw.x)), y1 = o[bl][4 * g + 1] * siluf_(bfhi(zw.x));
                    const float y2 = o[bl][4 * g + 2] * siluf_(bflo(zw.y)), y3 = o[bl][4 * g + 3] * siluf_(bfhi(zw.y));
                    u32x2 w; w.x = pk2(y0, y1); w.y = pk2(y2, y3);
                    *(u32x2*)(ycat + tok * DM + h * 128 + dv0) = w; }
        }
    }
    SEAM(9);
    if (IN(10)) {
        KA_FRESH(); LANE_FRESH(); WS_FRESH(); const float* x = AIN(0); float* out = ka->out; (void)x; (void)out;
        pg8::Gemm g{ycat, wout1, MTOK, DM, DM}; pg8::StaticOrder S; S.init(MTOK, DM, G, bid);
        pg8::EpiResid E{out, out};
        pg8::gemm_phase<pg8::EpiResid, pg8::StaticOrder, true, true>(lds, g, S, E, wave, lane);
    }
#undef IN
#undef SEAM
}

#ifndef ONE_LAUNCH
#define ONE_LAUNCH 1
#endif
constexpr int NPHASE = 11;
extern "C" void kernel_launch(void* const* d_in, const int* in_sizes, int n_in, void* d_out, int out_size, void* d_ws, size_t ws_size, hipStream_t stream) {
    static int grid = 0;
    if (grid == 0) {
        if (n_in != 27 || out_size != MTOK * DM || ws_size < WS_END) { fprintf(stderr, "kernel_launch: unexpected problem (n_in %d out %d ws %zu)\n", n_in, out_size, ws_size); grid = -1; return; }
        int dev = 0, cus = 0, per_cu = 0;
        hipGetDevice(&dev);
        hipDeviceGetAttribute(&cus, hipDeviceAttributeMultiprocessorCount, dev);
        if (hipFuncSetAttribute((const void*)hybrid_fwd, hipFuncAttributeMaxDynamicSharedMemorySize, LDS_BYTES) != hipSuccess) { fprintf(stderr, "kernel_launch: hipFuncSetAttribute failed\n"); grid = -1; return; }
        if (hipOccupancyMaxActiveBlocksPerMultiprocessor(&per_cu, (const void*)hybrid_fwd, NWAVES * 64, LDS_BYTES) != hipSuccess || per_cu < 1) { fprintf(stderr, "kernel_launch: occupancy query says %d\n", per_cu); per_cu = 1; }
        (void)hipGetLastError();
        grid = cus * 1;
    }
    if (grid < 0) return;
    if (hipMemsetAsync(d_ws, 0, 65536, stream) != hipSuccess) { fprintf(stderr, "kernel_launch: memset failed\n"); return; }
    Args a{};
    for (int i = 0; i < 27; ++i) a.in[i] = (const float*)d_in[i];
    a.out = (float*)d_out; a.ws = (unsigned char*)d_ws;
#if ONE_LAUNCH
    a.ph_lo = 0; a.ph_hi = NPHASE;
    void* kargs[] = {&a};
    hipError_t e = hipLaunchCooperativeKernel((const void*)hybrid_fwd, dim3(grid), dim3(NWAVES * 64), kargs, LDS_BYTES, stream);
    if (e != hipSuccess) fprintf(stderr, "cooperative launch failed: %s (grid %d)\n", hipGetErrorString(e), grid);
#else
    for (int p = 0; p < NPHASE; ++p) {
        a.ph_lo = p; a.ph_hi = p + 1;
        hipLaunchKernelGGL(hybrid_fwd, dim3(grid), dim3(NWAVES * 64), LDS_BYTES, stream, a);
    }
#endif
}
```

```cpp
#include <hip/hip_runtime.h>
#include <hip/hip_cooperative_groups.h>
#include <cstdio>
#include <cstdint>
#include <cmath>
namespace cg = cooperative_groups;
#define DUP_MASK 0
namespace pg8 {
#define PG8_LAS __attribute__((address_space(3)))
typedef unsigned short bf16_t;
typedef short bf16x8 __attribute__((ext_vector_type(8)));
typedef float f32x4 __attribute__((ext_vector_type(4)));
typedef unsigned u32x4 __attribute__((ext_vector_type(4)));
constexpr int BM = 256, BK = 64, HALF = 128, HTB = HALF * BK * 2  , STAGE_BYTES = 8 * HTB, NXCD = 8, WGM = 8;

__host__ __device__ __forceinline__ int lds_byte(int r, int c) { const int st = (r >> 4) * 2 + (c >> 5), rr = r & 15, cc = c & 31, ob = rr * 64 + cc * 2; return st * 1024 + (ob ^ (((ob >> 9) & 1) << 5)); }
__host__ __device__ __forceinline__ void stage_rc(int b, int& R, int& C) { const int st = b / 1024, sb = b % 1024, swz = sb ^ (((sb >> 9) & 1) << 5); R = (st >> 1) * 16 + swz / 64; C = (st & 1) * 32 + (swz % 64) / 2; }
__host__ __device__ __forceinline__ int perm32(int rho) { const int n = rho >> 4, i = rho & 15; return 8 * (i >> 2) + 4 * n + (i & 3); }

struct Unit { int pm, pn; };
struct Gemm { const bf16_t* A; const bf16_t* Bt; int M, N, K; };

struct StaticOrder {
    int nM, nN, nwg, G, c;
    __host__ __device__ void init(int M, int N, int G_, int c_) { nM = M / BM; nN = N / BM; nwg = nM * nN; G = G_; c = c_; }
    __host__ __device__ bool next(int i, Unit& u) const {
        const long L = (long)i * G + c; if (L >= nwg) return false;
        int wgid = (int)L; { const int q = nwg / NXCD, r = nwg % NXCD, xcd = wgid % NXCD, off = wgid / NXCD; wgid = (xcd < r ? xcd * (q + 1) : r * (q + 1) + (xcd - r) * q) + off; }
        const int nig = WGM * nN, gid = wgid / nig, fm = gid * WGM, gsz = (nM - fm) < WGM ? (nM - fm) : WGM;
        u.pm = fm + ((wgid % nig) % gsz); u.pn = (wgid % nig) / gsz; return true;
    }
    __device__ __forceinline__ void a_ready(const Unit&) const {}
    __device__ __forceinline__ void done(const Unit&) const {}
};

__device__ __forceinline__ unsigned cvt_pk_bf16(float lo, float hi) { unsigned r; asm volatile("v_cvt_pk_bf16_f32 %0, %1, %2" : "=v"(r) : "v"(lo), "v"(hi)); return r; }
typedef float f32x2 __attribute__((ext_vector_type(2)));
__device__ __forceinline__ f32x2 gelu_pk(f32x2 v) {
    const f32x2 av = __builtin_elementwise_abs(v), d = av * 0.2316418882f + 1.0f;
    f32x2 t; t.x = __builtin_amdgcn_rcpf(d.x); t.y = __builtin_amdgcn_rcpf(d.y);
    f32x2 q = t * 0.5307027145f + (-0.7265760135f); q = q * t + 0.7107068705f; q = q * t + (-0.142248368f); q = q * t + 0.127414796f; q = q * t;
    const f32x2 s = (v * v) * (-0.72134752044f);
    f32x2 e; e.x = __builtin_amdgcn_exp2f(s.x); e.y = __builtin_amdgcn_exp2f(s.y);
    const f32x2 m = v * (q * e), r = v - m;
    f32x2 o; o.x = v.x < 0.f ? m.x : r.x; o.y = v.y < 0.f ? m.y : r.y; return o;
}

template <int ACT  > struct EpiBf16 {
    static constexpr bool PERM = true, AFTER_DRAIN = false; static_assert(ACT == 0 || ACT == 1, "EpiBf16: ACT is 0 (none) or 1 (gelu_pk)");
    bf16_t* O; int ldc; const float* bias; int split_cols; size_t split_stride; float scale0;
    __device__ __forceinline__ void operator()(const f32x4 (&acc)[2][2][4][2], const Unit& u, int wr, int wc, int fr, int fq) const {
        const int row0 = u.pm * BM + wr * 64 + fr; int colt = u.pn * BM; bf16_t* base = O;
        float sc = 1.f; if (split_cols) { const int t = colt / split_cols; base += (size_t)t * split_stride; colt -= t * split_cols; if (t == 0) sc = scale0; }
        const int col0 = colt + wc * 32 + 8 * fq, bcol0 = u.pn * BM + wc * 32 + 8 * fq;
        f32x4 bv[2][2];
#pragma unroll
        for (int bj = 0; bj < 2; ++bj)
#pragma unroll
            for (int n = 0; n < 2; ++n) bv[bj][n] = bias ? *(const f32x4*)(bias + bcol0 + bj * HALF + 4 * n) : (f32x4){0.f, 0.f, 0.f, 0.f};
#pragma unroll
        for (int ai = 0; ai < 2; ++ai)
#pragma unroll
            for (int m = 0; m < 4; ++m) { bf16_t* rowp = base + (size_t)(row0 + ai * HALF + m * 16) * ldc + col0;
#pragma unroll
                for (int bj = 0; bj < 2; ++bj) { f32x4 v0 = acc[ai][bj][m][0] + bv[bj][0], v1 = acc[ai][bj][m][1] + bv[bj][1];
                    if (ACT == 1) { f32x2 a = gelu_pk((f32x2){v0[0], v0[1]}), b = gelu_pk((f32x2){v0[2], v0[3]}), c = gelu_pk((f32x2){v1[0], v1[1]}), d = gelu_pk((f32x2){v1[2], v1[3]});
                        v0 = (f32x4){a.x, a.y, b.x, b.y}; v1 = (f32x4){c.x, c.y, d.x, d.y}; }
                    v0 = v0 * sc; v1 = v1 * sc; u32x4 w; w.x = cvt_pk_bf16(v0[0], v0[1]); w.y = cvt_pk_bf16(v0[2], v0[3]); w.z = cvt_pk_bf16(v1[0], v1[1]); w.w = cvt_pk_bf16(v1[2], v1[3]);
                    *(u32x4*)(rowp + bj * HALF) = w; } }
    }
};
template <class Epi, class Sched, bool ALIGN_EPI = false, bool SP2 = false>
__device__ __forceinline__ void gemm_phase(PG8_LAS unsigned char* lds, const Gemm g, const Sched& S, const Epi& E, const int wid, const int lane) {
    const int tid = wid * 64 + lane, wr = wid >> 2, wc = wid & 3, fr = lane & 15, fq = lane >> 4;
    const int K = g.K, nt = K / BK;
    unsigned voffA[2], voffB[2];
#pragma unroll
    for (int i = 0; i < 2; ++i) { int R, C; stage_rc(tid * 16 + i * 8192, R, C); const int Rb = Epi::PERM ? ((R & ~31) + perm32(R & 31)) : R;
        voffA[i] = (unsigned)(R * K + C) * 2u; voffB[i] = (unsigned)(Rb * K + C) * 2u; }
    const size_t kstep = (size_t)(BK * 2);
    const size_t hstep = (size_t)HALF * K * 2;
    const size_t tstep = 2 * hstep;
    const unsigned ldsw = (unsigned)wid * 1024u;
    const int aoff = lds_byte(wr * 64 + fr, fq * 8), boff = lds_byte(wc * 32 + fr, fq * 8);
#define PG8_SA(b, h) (((b) * 2 + (h)) * HTB)
#define PG8_SB(b, h) ((4 + (b) * 2 + (h)) * HTB)
#define PG8_STAGE(bufoff, gbase, voff) do { _Pragma("unroll") for (int _i = 0; _i < 2; ++_i) \
        __builtin_amdgcn_global_load_lds((const unsigned*)((const char*)(gbase) + (voff)[_i]), (PG8_LAS unsigned*)(lds + (bufoff) + ldsw + _i * 8192), 16, 0, 0); } while (0)
#define PG8_LDA(dst, b, h) do { _Pragma("unroll") for (int m = 0; m < 4; ++m) _Pragma("unroll") for (int k = 0; k < 2; ++k) dst[m][k] = *(const PG8_LAS bf16x8*)(lds + PG8_SA(b, h) + aoff + m * 2048 + k * 1024); } while (0)
#define PG8_LDB(dst, b, h) do { _Pragma("unroll") for (int n = 0; n < 2; ++n) _Pragma("unroll") for (int k = 0; k < 2; ++k) dst[n][k] = *(const PG8_LAS bf16x8*)(lds + PG8_SB(b, h) + boff + n * 2048 + k * 1024); } while (0)
#define PG8_MMA(ai, bj, At, Bt) do { __builtin_amdgcn_s_setprio(1); _Pragma("unroll") for (int m = 0; m < 4; ++m) _Pragma("unroll") for (int n = 0; n < 2; ++n) _Pragma("unroll") for (int k = 0; k < 2; ++k) \
        acc[ai][bj][m][n] = __builtin_amdgcn_mfma_f32_16x16x32_bf16(Bt[n][k], At[m][k], acc[ai][bj][m][n], 0, 0, 0); __builtin_amdgcn_s_setprio(0); } while (0)
#define PG8_WAIT_V(n) asm volatile("s_waitcnt vmcnt(" #n ")" ::: "memory")
#define PG8_WAIT_L(n) asm volatile("s_waitcnt lgkmcnt(" #n ")" ::: "memory")
#define PG8_BAR __builtin_amdgcn_s_barrier()
#define PG8_SCHED __builtin_amdgcn_sched_barrier(0)
    Unit cur, nxt; int ui = 0;
    if (!S.next(0, cur)) return;
    f32x4 acc[2][2][4][2];
#pragma unroll
    for (int a = 0; a < 2; ++a)
#pragma unroll
        for (int b = 0; b < 2; ++b)
#pragma unroll
            for (int m = 0; m < 4; ++m)
#pragma unroll
                for (int n = 0; n < 2; ++n) acc[a][b][m][n] = (f32x4){0.f, 0.f, 0.f, 0.f};
    bf16x8 At[4][2], B0[2][2], B1[2][2];
    const char* cA = (const char*)g.A + (size_t)cur.pm * tstep; const char* cB = (const char*)g.Bt + (size_t)cur.pn * tstep;
    S.a_ready(cur);
    if constexpr (SP2) {
        PG8_STAGE(PG8_SB(0, 0), cB, voffB); PG8_STAGE(PG8_SB(0, 1), cB + hstep, voffB); PG8_STAGE(PG8_SA(0, 0), cA, voffA); PG8_STAGE(PG8_SA(0, 1), cA + hstep, voffA);
        if (wr == 1) PG8_BAR;
        PG8_WAIT_V(2); PG8_BAR;
        PG8_STAGE(PG8_SB(1, 0), cB + kstep, voffB); PG8_STAGE(PG8_SA(1, 0), cA + kstep, voffA); PG8_STAGE(PG8_SB(1, 1), cB + hstep + kstep, voffB);
        PG8_WAIT_V(6); PG8_BAR;
    } else {
        PG8_STAGE(PG8_SB(0, 0), cB, voffB); PG8_STAGE(PG8_SA(0, 0), cA, voffA); PG8_STAGE(PG8_SB(0, 1), cB + hstep, voffB); PG8_STAGE(PG8_SA(0, 1), cA + hstep, voffA);
        if (wr == 1) PG8_BAR;
        PG8_WAIT_V(4); PG8_BAR;
        PG8_STAGE(PG8_SB(1, 0), cB + kstep, voffB); PG8_STAGE(PG8_SA(1, 0), cA + kstep, voffA); PG8_STAGE(PG8_SB(1, 1), cB + hstep + kstep, voffB);
        PG8_WAIT_V(6); PG8_BAR;
    }
    for (;;) {
        const bool has_next = S.next(ui + 1, nxt);
        const char* nA = has_next ? (const char*)g.A + (size_t)nxt.pm * tstep : cA; const char* nB = has_next ? (const char*)g.Bt + (size_t)nxt.pn * tstep : cB;
        for (int t = 0; t < nt; t += 2) {
            const bool last = (t == nt - 2);
            const char* a1 = cA + (size_t)(t + 1) * kstep;
            const char* a2 = last ? nA : cA + (size_t)(t + 2) * kstep; const char* b2 = last ? nB : cB + (size_t)(t + 2) * kstep;
            const char* a3 = a2 + kstep; const char* b3 = b2 + kstep;
            if (last && has_next) S.a_ready(nxt);
            if constexpr (SP2) {
            PG8_LDB(B0, 0, 0); PG8_LDB(B1, 0, 1); PG8_SCHED; PG8_LDA(At, 0, 0); PG8_STAGE(PG8_SA(1, 1), a1 + hstep, voffA);
            PG8_WAIT_V(8); PG8_WAIT_L(0); PG8_BAR; PG8_MMA(0, 0, At, B0); PG8_MMA(0, 1, At, B1); PG8_BAR; PG8_SCHED;
            PG8_LDA(At, 0, 1); PG8_STAGE(PG8_SB(0, 0), b2, voffB); PG8_STAGE(PG8_SB(0, 1), b2 + hstep, voffB); PG8_STAGE(PG8_SA(0, 0), a2, voffA);
            PG8_WAIT_V(8); PG8_WAIT_L(0); PG8_BAR; PG8_MMA(1, 0, At, B0); PG8_MMA(1, 1, At, B1); PG8_BAR; PG8_SCHED;
            PG8_LDB(B0, 1, 0); PG8_LDB(B1, 1, 1); PG8_SCHED; PG8_LDA(At, 1, 0); PG8_STAGE(PG8_SA(0, 1), a2 + hstep, voffA);
            PG8_WAIT_V(8); PG8_WAIT_L(0); PG8_BAR; PG8_MMA(0, 0, At, B0); PG8_MMA(0, 1, At, B1); PG8_BAR; PG8_SCHED;
            PG8_LDA(At, 1, 1); PG8_STAGE(PG8_SB(1, 0), b3, voffB); PG8_STAGE(PG8_SB(1, 1), b3 + hstep, voffB); PG8_STAGE(PG8_SA(1, 0), a3, voffA);
            PG8_WAIT_V(8); PG8_WAIT_L(0); PG8_BAR; PG8_MMA(1, 0, At, B0); PG8_MMA(1, 1, At, B1); PG8_BAR; PG8_SCHED;
            } else {
            PG8_LDB(B0, 0, 0); PG8_SCHED; PG8_LDA(At, 0, 0); PG8_STAGE(PG8_SA(1, 1), a1 + hstep, voffA);
            PG8_WAIT_L(8); PG8_BAR; PG8_WAIT_L(0); PG8_MMA(0, 0, At, B0); PG8_BAR; PG8_SCHED;
            PG8_LDB(B1, 0, 1); PG8_STAGE(PG8_SB(0, 0), b2, voffB);
            PG8_BAR; PG8_WAIT_L(0); PG8_MMA(0, 1, At, B1); PG8_BAR;
            PG8_LDA(At, 0, 1); PG8_STAGE(PG8_SA(0, 0), a2, voffA);
            PG8_BAR; PG8_WAIT_L(0); PG8_MMA(1, 0, At, B0); PG8_BAR; PG8_SCHED;
            PG8_STAGE(PG8_SB(0, 1), b2 + hstep, voffB);
            PG8_WAIT_V(6); PG8_BAR; PG8_MMA(1, 1, At, B1); PG8_BAR;
            PG8_LDB(B0, 1, 0); PG8_SCHED; PG8_LDA(At, 1, 0); PG8_STAGE(PG8_SA(0, 1), a2 + hstep, voffA);
            PG8_WAIT_L(8); PG8_BAR; PG8_WAIT_L(0); PG8_MMA(0, 0, At, B0); PG8_BAR; PG8_SCHED;
            PG8_LDB(B1, 1, 1); PG8_STAGE(PG8_SB(1, 0), b3, voffB);
            PG8_BAR; PG8_WAIT_L(0); PG8_MMA(0, 1, At, B1); PG8_BAR;
            PG8_LDA(At, 1, 1); PG8_STAGE(PG8_SA(1, 0), a3, voffA);
            PG8_BAR; PG8_WAIT_L(0); PG8_MMA(1, 0, At, B0); PG8_BAR; PG8_SCHED;
            PG8_STAGE(PG8_SB(1, 1), b3 + hstep, voffB);
            PG8_WAIT_V(6); PG8_BAR; PG8_MMA(1, 1, At, B1); PG8_BAR;
            }
        }
        if constexpr (ALIGN_EPI) { if (wr == 0) PG8_BAR; }
        if constexpr (!Epi::AFTER_DRAIN) { E(acc, cur, wr, wc, fr, fq); S.done(cur); }
        if (!has_next) break;
#pragma unroll
        for (int a = 0; a < 2; ++a)
#pragma unroll
            for (int b = 0; b < 2; ++b)
#pragma unroll
                for (int m = 0; m < 4; ++m)
#pragma unroll
                    for (int n = 0; n < 2; ++n) acc[a][b][m][n] = (f32x4){0.f, 0.f, 0.f, 0.f};
        cur = nxt; cA = nA; cB = nB; ++ui;
        if constexpr (ALIGN_EPI) { if (wr == 1) PG8_BAR; }
    }
    PG8_WAIT_V(0);
    if constexpr (!ALIGN_EPI) { if (wr == 0) PG8_BAR; }
    PG8_BAR;
    if constexpr (Epi::AFTER_DRAIN) { E.fused(acc, cur, wr, wc, fr, fq, lds, wid, lane); S.done(cur); }
#undef PG8_SA
#undef PG8_SB
#undef PG8_STAGE
#undef PG8_LDA
#undef PG8_LDB
#undef PG8_MMA
#undef PG8_WAIT_V
#undef PG8_WAIT_L
#undef PG8_BAR
#undef PG8_SCHED
}
}
#define LAS __attribute__((address_space(3)))
#define GAS __attribute__((address_space(1)))
typedef GAS unsigned gu32;
typedef GAS unsigned long long gu64;
#define RLX_AGENT __ATOMIC_RELAXED, __HIP_MEMORY_SCOPE_AGENT
#define LDS_WAIT() asm volatile("s_waitcnt lgkmcnt(0)" ::: "memory")
#define VM_WAIT() asm volatile("s_waitcnt vmcnt(0)" ::: "memory")
__device__ __forceinline__ unsigned long long rt() { return __builtin_amdgcn_s_memrealtime(); }
#define XB_TMO      128
#define XB_XCNT(j)  (256  + 64 * (j))
#define XB_XSUB(j)  (1280 + 64 * (j))
#define XB_XGEN(j)  (2304 + 64 * (j))
#define XB_TOP      3328
#define XB_TOPGEN   3392
#define XCD_BAR_WORDS 3456
#define XB_SPIN_CAP (1u << 18)

__device__ __forceinline__ unsigned xb_ld(unsigned* p)              { return __hip_atomic_load(p, __ATOMIC_RELAXED, __HIP_MEMORY_SCOPE_AGENT); }
__device__ __forceinline__ unsigned xb_add(unsigned* p, unsigned v) { return __hip_atomic_fetch_add(p, v, __ATOMIC_RELAXED, __HIP_MEMORY_SCOPE_AGENT); }
__device__ __forceinline__ unsigned xb_xcc_id() { return (unsigned)__builtin_amdgcn_s_getreg((3 << 11) | 20) & 0xFu; }
#define XB_SPIN(cond, bar) do { unsigned _sp = 0; while (cond) { __builtin_amdgcn_s_sleep(1); \
    if ((++_sp & 255u) == 0u) { if (xb_ld(&(bar)[XB_TMO])) break; if (_sp > XB_SPIN_CAP) { atomicAdd(&(bar)[XB_TMO], 1u); break; } } } } while (0)

struct XcdBarrier {
    unsigned* bar; unsigned x;
    volatile LAS unsigned* st;
};

__device__ __forceinline__ XcdBarrier xcd_barrier_post(unsigned* bar, volatile LAS unsigned* st, const bool t0) {
    XcdBarrier b; b.bar = bar; b.x = xb_xcc_id(); b.st = st;
    if (t0) (void)xb_add(&bar[XB_XCNT(b.x)], 1u);
    return b;
}
__device__ __forceinline__ void xcd_barrier_complete(unsigned* bar, unsigned x, unsigned& nloc, unsigned& nx) {
    const unsigned G = gridDim.x * gridDim.y * gridDim.z;
    unsigned sum, cnt, mine, sp = 0u;
    for (;;) {
        sum = 0u; cnt = 0u; mine = 0u;
#pragma unroll
        for (unsigned j = 0; j < 16; ++j) { const unsigned c = xb_ld(&bar[XB_XCNT(j)]); sum += c; cnt += (c > 0u) ? 1u : 0u; mine = (j == x) ? c : mine; }
        if (sum == G) break;
        __builtin_amdgcn_s_sleep(1);
        if ((++sp & 255u) == 0u) { if (xb_ld(&bar[XB_TMO])) break; if (sp > XB_SPIN_CAP) { atomicAdd(&bar[XB_TMO], 1u); break; } }
    }
    nloc = mine > 0u ? mine : 1u; nx = cnt > 0u ? cnt : 1u;
}

__device__ __forceinline__ void xcd_barrier(const XcdBarrier& b, const bool t0) {
    asm volatile("s_waitcnt vmcnt(0)" ::: "memory");
    __syncthreads();
    if (t0) {
        unsigned* bar = b.bar;
        __builtin_amdgcn_s_waitcnt(0);
        unsigned nloc = b.st[0], nx = b.st[1];
        if (nloc == 0u) { xcd_barrier_complete(bar, b.x, nloc, nx); b.st[0] = nloc; b.st[1] = nx; }
        const unsigned old = xb_add(&bar[XB_XSUB(b.x)], 1u);
        const unsigned gen = old / nloc;
        if (old + 1u == (gen + 1u) * nloc) {
            __builtin_amdgcn_fence(__ATOMIC_RELEASE, "agent");
            asm volatile("s_waitcnt vmcnt(0)" ::: "memory");
            const unsigned og = xb_add(&bar[XB_TOP], 1u);
            const unsigned tg = og / nx;
            if (og + 1u == (tg + 1u) * nx) xb_add(&bar[XB_TOPGEN], 1u);
            else XB_SPIN(xb_ld(&bar[XB_TOPGEN]) == tg, bar);
            __builtin_amdgcn_fence(__ATOMIC_ACQUIRE, "agent");
            xb_add(&bar[XB_XGEN(b.x)], 1u);
            asm volatile("s_waitcnt vmcnt(0)" ::: "memory");
        } else {
            XB_SPIN(xb_ld(&bar[XB_XGEN(b.x)]) == gen, bar);
            __builtin_amdgcn_fence(__ATOMIC_ACQUIRE, "agent");
            asm volatile("s_waitcnt vmcnt(0)" ::: "memory");
        }
    }
    __syncthreads();
}
constexpr int BATCH = 2, SEQ = 16384, DM = 2048, MTOK = BATCH * SEQ;
constexpr int E_IN = 6144, O_INP = 8448  , O_LD = 8192;
constexpr int S5G = 64, S5P = 64, S5T = 128, S5NC = SEQ / S5T;
constexpr float LOG2E = 1.4426950408889634f;
constexpr float RMS_EPS = 1e-6f;
constexpr int NWAVES = 8;

#define LAS __attribute__((address_space(3)))
typedef unsigned short bf16_t;
typedef short bf16x8 __attribute__((ext_vector_type(8)));
typedef float f32x4 __attribute__((ext_vector_type(4)));
typedef float f32x2 __attribute__((ext_vector_type(2)));
typedef float f32x16 __attribute__((ext_vector_type(16)));
typedef unsigned u32x4 __attribute__((ext_vector_type(4)));
typedef unsigned u32x2 __attribute__((ext_vector_type(2)));
typedef short v4i16_t __attribute__((ext_vector_type(4)));
typedef __bf16 bf16x2_t __attribute__((ext_vector_type(2)));

constexpr size_t MiB = 1u << 20;
constexpr size_t WS_CTL = 0;
constexpr size_t WS_LAMB = 1 * MiB;
constexpr size_t WS_LAMT = 1 * MiB + 65536;
constexpr size_t WS_BBAR = 2 * MiB;
constexpr size_t WS_CMAT = 3 * MiB;
constexpr size_t WS_BIASDA = 4 * MiB;
constexpr size_t WS_BIASF = 5 * MiB;
constexpr size_t WS_FLOG = 7 * MiB;
constexpr size_t WS_S5ST = 9 * MiB;
constexpr size_t WS_WIN0 = 20 * MiB;
constexpr size_t WS_WOUT0 = 44 * MiB;
constexpr size_t WS_WGLU = 52 * MiB;
constexpr size_t WS_WIN1 = 54 * MiB;
constexpr size_t WS_WOUT1 = 87 * MiB;
constexpr size_t WS_HBUF = 96 * MiB;
constexpr size_t WS_PROJ = 224 * MiB;
constexpr size_t WS_YCAT = 736 * MiB;
constexpr size_t WS_END = 864 * MiB;
constexpr int CW_BAR = 4096;
constexpr int CW_QDA = 64, CW_QFOX = 128, CW_LAM = 192, CW_THRDA = 193, CW_THRF = 194;
constexpr float ZERO_THR = 105.f;

constexpr int LDS_MISC = 135168;
constexpr int LDS_BYTES = 147456;
constexpr int AL_K = 0, AL_V = 32768, AL_B = 65536;
constexpr int LDS_STASH = 69632;

__device__ __forceinline__ float bf2f(unsigned b) { return __uint_as_float(b << 16); }
__device__ __forceinline__ unsigned pk2(float lo, float hi) { f32x2 v = {lo, hi}; bf16x2_t b = __builtin_convertvector(v, bf16x2_t); return __builtin_bit_cast(unsigned, b); }
__device__ __forceinline__ float bflo(unsigned w) { return __uint_as_float(w << 16); }
__device__ __forceinline__ float bfhi(unsigned w) { return __uint_as_float(w & 0xffff0000u); }
__device__ __forceinline__ float sigmoidf_(float x) { return 1.f / (1.f + __expf(-x)); }
__device__ __forceinline__ float siluf_(float x) { return x * sigmoidf_(x); }
__device__ __forceinline__ float gelu_tanh(float x) { const float z = 0.7978845608028654f * (x + 0.044715f * x * x * x); const float t = 1.f - 2.f / (1.f + __expf(2.f * z)); return 0.5f * x * (1.f + t); }
#define DOT2(a, b, c) __builtin_amdgcn_fdot2_f32_bf16(__builtin_bit_cast(bf16x2_t, (unsigned)(a)), __builtin_bit_cast(bf16x2_t, (unsigned)(b)), (c), false)
__device__ __forceinline__ int crow(int r, int hi) { return (r & 3) + 8 * (r >> 2) + 4 * hi; }
__device__ __forceinline__ float wave_sum(float v) {
#pragma unroll
    for (int o = 1; o < 64; o <<= 1) v += __shfl_xor(v, o);
    return v;
}

struct Args {
    const float* in[27];
    float* out; unsigned char* ws;
    int ph_lo, ph_hi;
};

namespace pg8 {
struct EpiProj1 {
    static constexpr bool PERM = true, AFTER_DRAIN = false;
    bf16_t* O; float* flog;
    __device__ __forceinline__ void operator()(const f32x4 (&acc)[2][2][4][2], const Unit& u, int wr, int wc, int fr, int fq) const {
        const int row0 = u.pm * BM + wr * 64 + fr;
        if (u.pn < 32) {
            const int col0 = u.pn * BM + wc * 32 + 8 * fq;
#pragma unroll
            for (int ai = 0; ai < 2; ++ai)
#pragma unroll
                for (int m = 0; m < 4; ++m) { bf16_t* rowp = O + (size_t)(row0 + ai * HALF + m * 16) * O_LD + col0;
#pragma unroll
                    for (int bj = 0; bj < 2; ++bj) { const f32x4 v0 = acc[ai][bj][m][0], v1 = acc[ai][bj][m][1];
                        u32x4 w; w.x = cvt_pk_bf16(v0[0], v0[1]); w.y = cvt_pk_bf16(v0[2], v0[3]); w.z = cvt_pk_bf16(v1[0], v1[1]); w.w = cvt_pk_bf16(v1[2], v1[3]);
                        *(u32x4*)(rowp + bj * HALF) = w; } }
        } else if (wc == 0 && fq < 2) {
#pragma unroll
            for (int ai = 0; ai < 2; ++ai)
#pragma unroll
                for (int m = 0; m < 4; ++m) { float* rp = flog + (size_t)(row0 + ai * HALF + m * 16) * 16 + 8 * fq;
                    *(f32x4*)(rp) = acc[ai][0][m][0]; *(f32x4*)(rp + 4) = acc[ai][0][m][1]; }
        }
    }
};
struct EpiGlu {
    static constexpr bool PERM = true, AFTER_DRAIN = false;
    bf16_t* O; const bf16_t* yg; const bf16_t* proj0; const float* bglu;
    __device__ __forceinline__ void operator()(const f32x4 (&acc)[2][2][4][2], const Unit& u, int wr, int wc, int fr, int fq) const {
        const int row0 = u.pm * BM + wr * 64 + fr; const int col0 = u.pn * BM + wc * 32 + 8 * fq;
#pragma unroll
        for (int ai = 0; ai < 2; ++ai)
#pragma unroll
            for (int m = 0; m < 4; ++m) { const size_t row = (size_t)(row0 + ai * HALF + m * 16);
#pragma unroll
                for (int bj = 0; bj < 2; ++bj) { const int c = col0 + bj * HALF;
                    const f32x4 b0 = *(const f32x4*)(bglu + c), b1 = *(const f32x4*)(bglu + c + 4);
                    const u32x4 yv = *(const u32x4*)(yg + row * 1024 + c); const u32x4 zv = *(const u32x4*)(proj0 + row * E_IN + 1024 + c);
                    const f32x4 v0 = acc[ai][bj][m][0] + b0, v1 = acc[ai][bj][m][1] + b1;
                    float r[8];
#pragma unroll
                    for (int e = 0; e < 4; ++e) { const unsigned yw = yv[e], zw = zv[e];
                        const float a0 = e < 2 ? v0[2 * e] : v1[2 * e - 4], a1 = e < 2 ? v0[2 * e + 1] : v1[2 * e - 3];
                        r[2 * e] = bflo(yw) * sigmoidf_(a0) * siluf_(bflo(zw)); r[2 * e + 1] = bfhi(yw) * sigmoidf_(a1) * siluf_(bfhi(zw)); }
                    u32x4 w; w.x = cvt_pk_bf16(r[0], r[1]); w.y = cvt_pk_bf16(r[2], r[3]); w.z = cvt_pk_bf16(r[4], r[5]); w.w = cvt_pk_bf16(r[6], r[7]);
                    *(u32x4*)(O + row * DM + c) = w; } }
    }
};
struct EpiResid {
    static constexpr bool PERM = false, AFTER_DRAIN = false;
    const float* base; float* out;
    __device__ __forceinline__ void operator()(const f32x4 (&acc)[2][2][4][2], const Unit& u, int wr, int wc, int fr, int fq) const {
        const int row0 = u.pm * BM + wr * 64 + fr; const int col0 = u.pn * BM + wc * 32 + 4 * fq;
#pragma unroll
        for (int ai = 0; ai < 2; ++ai)
#pragma unroll
            for (int m = 0; m < 4; ++m) { const size_t off = (size_t)(row0 + ai * HALF + m * 16) * DM + col0;
#pragma unroll
                for (int bj = 0; bj < 2; ++bj)
#pragma unroll
                    for (int n = 0; n < 2; ++n) { const f32x4 bs = *(const f32x4*)(base + off + bj * HALF + n * 16); *(f32x4*)(out + off + bj * HALF + n * 16) = bs + acc[ai][bj][m][n]; } }
    }
};
}

__device__ __forceinline__ void transpose_item(const float* __restrict__ W, int K, int N, bf16_t* __restrict__ WT, LAS float* scr, int item, int nblk, int lane) {
    const int kb = item / nblk, nb = item % nblk, k0 = 64 * kb, n0 = 32 * nb;
    const int nc = n0 + (lane & 31);
#pragma unroll 8
    for (int i = 0; i < 32; ++i) { const int kk = 2 * i + (lane >> 5); scr[kk * 33 + (lane & 31)] = (nc < N) ? W[(size_t)(k0 + kk) * N + nc] : 0.f; }
    asm volatile("s_waitcnt lgkmcnt(0)" ::: "memory");
    const int c = lane & 7;
#pragma unroll
    for (int j = 0; j < 4; ++j) { const int n = (lane >> 3) + 8 * j; const LAS float* s = scr + (8 * c) * 33 + n;
        u32x4 o; o.x = pk2(s[0 * 33], s[1 * 33]); o.y = pk2(s[2 * 33], s[3 * 33]); o.z = pk2(s[4 * 33], s[5 * 33]); o.w = pk2(s[6 * 33], s[7 * 33]);
        *(u32x4*)(WT + (size_t)(n0 + n) * K + k0 + 8 * c) = o; }
    asm volatile("s_waitcnt lgkmcnt(0)" ::: "memory");
}
__device__ __forceinline__ void rms_row_to_bf16(const float* __restrict__ xrow, const float* __restrict__ gain, bf16_t* __restrict__ orow, int lane) {
    const f32x4* xr = (const f32x4*)xrow + lane; const f32x4* gr = (const f32x4*)gain + lane;
    f32x4 v[8]; float s = 0.f;
#pragma unroll
    for (int j = 0; j < 8; ++j) { v[j] = xr[64 * j]; s += (v[j].x * v[j].x + v[j].y * v[j].y) + (v[j].z * v[j].z + v[j].w * v[j].w); }
    const float r = 1.f / sqrtf(wave_sum(s) * (1.f / DM) + RMS_EPS);
    u32x2* o8 = (u32x2*)orow + lane;
#pragma unroll
    for (int j = 0; j < 8; ++j) { const f32x4 g = gr[64 * j]; u32x2 w; w.x = pk2(v[j].x * r * g.x, v[j].y * r * g.y); w.y = pk2(v[j].z * r * g.z, v[j].w * r * g.w); o8[64 * j] = w; }
}
template <int LPS>
__device__ __forceinline__ void qknorm16(bf16_t* p, const float* __restrict__ gain16, float mul, float inv_n) {
    u32x4 a = *(u32x4*)p, b = *(u32x4*)(p + 8);
    float v[16];
#pragma unroll
    for (int e = 0; e < 4; ++e) { v[2 * e] = bflo(a[e]); v[2 * e + 1] = bfhi(a[e]); v[8 + 2 * e] = bflo(b[e]); v[9 + 2 * e] = bfhi(b[e]); }
    float s = 0.f;
#pragma unroll
    for (int e = 0; e < 16; ++e) s += v[e] * v[e];
#pragma unroll
    for (int o = 1; o < LPS; o <<= 1) s += __shfl_xor(s, o);
    const float r = mul / sqrtf(s * inv_n + RMS_EPS);
#pragma unroll
    for (int e = 0; e < 16; ++e) v[e] = v[e] * r * gain16[e];
#pragma unroll
    for (int e = 0; e < 4; ++e) { a[e] = pk2(v[2 * e], v[2 * e + 1]); b[e] = pk2(v[8 + 2 * e], v[9 + 2 * e]); }
    *(u32x4*)p = a; *(u32x4*)(p + 8) = b;
}
__device__ __forceinline__ void rms_rows2_to_bf16(const float* __restrict__ x0, const float* __restrict__ x1, const bool has1, const float* __restrict__ gain, bf16_t* __restrict__ o0, bf16_t* __restrict__ o1, int lane) {
    const f32x4* xr0 = (const f32x4*)x0 + lane; const f32x4* xr1 = (const f32x4*)x1 + lane; const f32x4* gr = (const f32x4*)gain + lane;
    f32x4 v[8], w[8]; float s0 = 0.f, s1 = 0.f;
#pragma unroll
    for (int j = 0; j < 8; ++j) v[j] = xr0[64 * j];
    if (has1) {
#pragma unroll
        for (int j = 0; j < 8; ++j) w[j] = xr1[64 * j];
    }
#pragma unroll
    for (int j = 0; j < 8; ++j) s0 += (v[j].x * v[j].x + v[j].y * v[j].y) + (v[j].z * v[j].z + v[j].w * v[j].w);
    const float r0 = 1.f / sqrtf(wave_sum(s0) * (1.f / DM) + RMS_EPS);
    u32x2* p0 = (u32x2*)o0 + lane;
#pragma unroll
    for (int j = 0; j < 8; ++j) { const f32x4 g = gr[64 * j]; u32x2 q; q.x = pk2(v[j].x * r0 * g.x, v[j].y * r0 * g.y); q.y = pk2(v[j].z * r0 * g.z, v[j].w * r0 * g.w); p0[64 * j] = q; }
    if (has1) {
#pragma unroll
        for (int j = 0; j < 8; ++j) s1 += (w[j].x * w[j].x + w[j].y * w[j].y) + (w[j].z * w[j].z + w[j].w * w[j].w);
        const float r1 = 1.f / sqrtf(wave_sum(s1) * (1.f / DM) + RMS_EPS);
        u32x2* p1 = (u32x2*)o1 + lane;
#pragma unroll
        for (int j = 0; j < 8; ++j) { const f32x4 g = gr[64 * j]; u32x2 q; q.x = pk2(w[j].x * r1 * g.x, w[j].y * r1 * g.y); q.y = pk2(w[j].z * r1 * g.z, w[j].w * r1 * g.w); p1[64 * j] = q; }
    }
}
template <int LPS>
__device__ __forceinline__ void qknorm_regs(u32x4& a, u32x4& b, const float* __restrict__ gp, float mul, float inv_n) {
    float v[16];
#pragma unroll
    for (int e = 0; e < 4; ++e) { v[2 * e] = bflo(a[e]); v[2 * e + 1] = bfhi(a[e]); v[8 + 2 * e] = bflo(b[e]); v[9 + 2 * e] = bfhi(b[e]); }
    float s = 0.f;
#pragma unroll
    for (int e = 0; e < 16; ++e) s += v[e] * v[e];
#pragma unroll
    for (int o = 1; o < LPS; o <<= 1) s += __shfl_xor(s, o);
    const float r = mul / sqrtf(s * inv_n + RMS_EPS);
#pragma unroll
    for (int e = 0; e < 4; ++e) { const f32x4 gg = *(const f32x4*)(gp + 4 * e);
        v[4 * e] *= r * gg.x; v[4 * e + 1] *= r * gg.y; v[4 * e + 2] *= r * gg.z; v[4 * e + 3] *= r * gg.w; }
#pragma unroll
    for (int e = 0; e < 4; ++e) { a[e] = pk2(v[2 * e], v[2 * e + 1]); b[e] = pk2(v[8 + 2 * e], v[9 + 2 * e]); }
}
template <int NIT, int NQ, int LPS>
__device__ __forceinline__ void qknorm_rows2(bf16_t* p0, bf16_t* p1, const bool has1, const float* __restrict__ gq, const float* __restrict__ gk, const float qmul, const float inv_n, const int lane) {
    u32x4 a0[NIT], b0[NIT], a1[NIT], b1[NIT];
#pragma unroll
    for (int it = 0; it < NIT; ++it) { a0[it] = *(const u32x4*)(p0 + it * 1024 + lane * 16); b0[it] = *(const u32x4*)(p0 + it * 1024 + lane * 16 + 8); }
    if (has1) {
#pragma unroll
        for (int it = 0; it < NIT; ++it) { a1[it] = *(const u32x4*)(p1 + it * 1024 + lane * 16); b1[it] = *(const u32x4*)(p1 + it * 1024 + lane * 16 + 8); }
    }
#pragma unroll
    for (int it = 0; it < NIT; ++it) { const float* gp = (it < NQ ? gq : gk) + ((lane * 16) & 127);
        qknorm_regs<LPS>(a0[it], b0[it], gp, it < NQ ? qmul : 1.f, inv_n);
        *(u32x4*)(p0 + it * 1024 + lane * 16) = a0[it]; *(u32x4*)(p0 + it * 1024 + lane * 16 + 8) = b0[it]; }
    if (has1) {
#pragma unroll
        for (int it = 0; it < NIT; ++it) { const float* gp = (it < NQ ? gq : gk) + ((lane * 16) & 127);
            qknorm_regs<LPS>(a1[it], b1[it], gp, it < NQ ? qmul : 1.f, inv_n);
            *(u32x4*)(p1 + it * 1024 + lane * 16) = a1[it]; *(u32x4*)(p1 + it * 1024 + lane * 16 + 8) = b1[it]; }
    }
}

template <int DQK>
__device__ __forceinline__ void attn_pass(LAS unsigned char* lds, const bf16_t* __restrict__ Qg, const bf16_t* __restrict__ Kg, const bf16_t* __restrict__ Vg,
                                          const float* __restrict__ btab, const float bscale, const int pitch, const int q0, const int t_lo, f32x16 (&o)[4], const int wid, const int lane) {
    constexpr int NCH = DQK / 8, KS = DQK / 16, KROWB = DQK * 2, KI = NCH / 8;
    const int tid = wid * 64 + lane, r32 = lane & 31, hi = lane >> 5;
    const int NT = (q0 + 256) / 64;
    const int qrel = wid * 32 + r32;
    bf16x8 qf[KS];
#pragma unroll
    for (int s = 0; s < KS; ++s) qf[s] = *(const bf16x8*)(Qg + (size_t)(q0 + qrel) * pitch + 16 * s + 8 * hi);
    int kgo[KI], klo[KI], vgo[2], vlo[2];
#pragma unroll
    for (int i = 0; i < KI; ++i) { const int cid = tid + 512 * i, row = cid / NCH, ch = cid % NCH; const int sw = (DQK == 128) ? (row & 15) : ((row >> 1) & 7);
        kgo[i] = row * pitch + ch * 8; klo[i] = row * KROWB + ((ch ^ sw) << 4); }
#pragma unroll
    for (int i = 0; i < 2; ++i) { const int cid = tid + 512 * i, row = cid >> 4, ch = cid & 15;
        vgo[i] = row * pitch + ch * 8; vlo[i] = (ch >> 2) * 4096 + (row >> 3) * 512 + (row & 7) * 64 + (ch & 3) * 16; }
    const float bref = btab[q0];
    u32x4 kreg[KI], vreg[2]; float breg = 0.f;
#define AT_LOAD(t) do { const size_t kvb_ = (size_t)(64 * (t)) * pitch; \
        _Pragma("unroll") for (int i = 0; i < KI; ++i) kreg[i] = *(const u32x4*)(Kg + kvb_ + kgo[i]); \
        _Pragma("unroll") for (int i = 0; i < 2; ++i) vreg[i] = *(const u32x4*)(Vg + kvb_ + vgo[i]); \
        if (tid < 64) breg = (btab[64 * (t) + tid] - bref) * bscale; } while (0)
#define AT_STORE(buf) do { \
        _Pragma("unroll") for (int i = 0; i < KI; ++i) *(LAS u32x4*)(lds + AL_K + (buf) * 16384 + klo[i]) = kreg[i]; \
        _Pragma("unroll") for (int i = 0; i < 2; ++i) *(LAS u32x4*)(lds + AL_V + (buf) * 16384 + vlo[i]) = vreg[i]; \
        if (tid < 64) *(LAS float*)(lds + AL_B + (buf) * 256 + tid * 4) = breg; } while (0)
    float m_run = -INFINITY, l_run = 0.f;
#pragma unroll
    for (int b = 0; b < 4; ++b)
#pragma unroll
        for (int r = 0; r < 16; ++r) o[b][r] = 0.f;
    AT_LOAD(t_lo); AT_STORE(0); __syncthreads();
    const int ksw = (DQK == 128) ? (r32 & 15) : ((r32 >> 1) & 7);
    const int vlane = (4 * hi + ((lane & 15) >> 2)) * 64 + ((lane >> 4) & 1) * 32 + (lane & 3) * 8;
    for (int t = t_lo; t < NT; ++t) {
        const int cur = (t - t_lo) & 1;
        if (t + 1 < NT) AT_LOAD(t + 1);
        const int jb = t - (NT - 4);
        const bool skip = (jb >= 0) && (2 * jb > wid);
        if (!skip) {
            LAS const unsigned char* Kb = lds + AL_K + cur * 16384;
            f32x16 s0, s1;
            LAS const float* bl = (LAS const float*)(lds + AL_B + cur * 256);
#pragma unroll
            for (int g = 0; g < 4; ++g) { const f32x4 b0 = *(LAS const f32x4*)(bl + 8 * g + 4 * hi), b1 = *(LAS const f32x4*)(bl + 32 + 8 * g + 4 * hi);
#pragma unroll
                for (int e = 0; e < 4; ++e) { s0[4 * g + e] = b0[e]; s1[4 * g + e] = b1[e]; } }
#pragma unroll
            for (int s = 0; s < KS; ++s) { const int ch = 2 * s + hi;
                const bf16x8 a0 = *(LAS const bf16x8*)(Kb + r32 * KROWB + ((ch ^ ksw) << 4));
                const bf16x8 a1 = *(LAS const bf16x8*)(Kb + (32 + r32) * KROWB + ((ch ^ ksw) << 4));
                s0 = __builtin_amdgcn_mfma_f32_32x32x16_bf16(a0, qf[s], s0, 0, 0, 0);
                s1 = __builtin_amdgcn_mfma_f32_32x32x16_bf16(a1, qf[s], s1, 0, 0, 0); }
            if ((jb >= 0) && (2 * jb + 1 >= wid)) {
#pragma unroll
                for (int r = 0; r < 16; ++r) { const int kv = 64 * jb + crow(r, hi); if (kv > qrel) s0[r] = -INFINITY; if (kv + 32 > qrel) s1[r] = -INFINITY; }
            }
            float mx = fmaxf(s0[0], s1[0]);
#pragma unroll
            for (int r = 1; r < 16; ++r) mx = fmaxf(mx, fmaxf(s0[r], s1[r]));
            mx = fmaxf(mx, __shfl_xor(mx, 32));
            if (__any(mx > m_run + 8.f)) {
                const float m_new = fmaxf(m_run, mx);
                const float alpha = __builtin_amdgcn_exp2f(m_run - m_new);
                m_run = m_new; l_run *= alpha;
#pragma unroll
                for (int b = 0; b < 4; ++b)
#pragma unroll
                    for (int r = 0; r < 16; ++r) o[b][r] *= alpha;
            }
            float rs = 0.f;
#pragma unroll
            for (int r = 0; r < 16; ++r) { s0[r] = __builtin_amdgcn_exp2f(s0[r] - m_run); s1[r] = __builtin_amdgcn_exp2f(s1[r] - m_run); rs += s0[r] + s1[r]; }
            l_run += rs;
            u32x4 pw[4];
#pragma unroll
            for (int e = 0; e < 4; ++e) { pw[0][e] = pk2(s0[2 * e], s0[2 * e + 1]); pw[1][e] = pk2(s0[8 + 2 * e], s0[9 + 2 * e]); pw[2][e] = pk2(s1[2 * e], s1[2 * e + 1]); pw[3][e] = pk2(s1[8 + 2 * e], s1[9 + 2 * e]); }
            LAS const unsigned char* Vb = lds + AL_V + cur * 16384 + vlane;
#pragma unroll
            for (int b = 0; b < 4; ++b)
#pragma unroll
                for (int ks = 0; ks < 4; ++ks) {
                    const v4i16_t lo = __builtin_amdgcn_ds_read_tr16_b64_v4i16((LAS v4i16_t*)(Vb + b * 4096 + ks * 1024));
                    const v4i16_t hh = __builtin_amdgcn_ds_read_tr16_b64_v4i16((LAS v4i16_t*)(Vb + b * 4096 + ks * 1024 + 512));
                    const bf16x8 af = {lo[0], lo[1], lo[2], lo[3], hh[0], hh[1], hh[2], hh[3]};
                    o[b] = __builtin_amdgcn_mfma_f32_32x32x16_bf16(af, __builtin_bit_cast(bf16x8, pw[ks]), o[b], 0, 0, 0);
                }
        }
        if (t + 1 < NT) AT_STORE(cur ^ 1);
        __syncthreads();
    }
#undef AT_LOAD
#undef AT_STORE
    const float l = l_run + __shfl_xor(l_run, 32);
    const float inv = 1.f / l;
#pragma unroll
    for (int b = 0; b < 4; ++b)
#pragma unroll
        for (int r = 0; r < 16; ++r) o[b][r] *= inv;
}

template <int DQK>
__device__ __forceinline__ void qk_tile(LAS const unsigned char* Kb, LAS const float* bl, const bf16x8* qf, const int ksw, const int r32, const int hi, f32x16& s0, f32x16& s1) {
    constexpr int KS = DQK / 16, KROWB = DQK * 2;
#pragma unroll
    for (int g = 0; g < 4; ++g) { const f32x4 b0 = *(LAS const f32x4*)(bl + 8 * g + 4 * hi), b1 = *(LAS const f32x4*)(bl + 32 + 8 * g + 4 * hi);
#pragma unroll
        for (int e = 0; e < 4; ++e) { s0[4 * g + e] = b0[e]; s1[4 * g + e] = b1[e]; } }
#pragma unroll
    for (int s = 0; s < KS; ++s) { const int ch = 2 * s + hi;
        const bf16x8 a0 = *(LAS const bf16x8*)(Kb + r32 * KROWB + ((ch ^ ksw) << 4));
        const bf16x8 a1 = *(LAS const bf16x8*)(Kb + (32 + r32) * KROWB + ((ch ^ ksw) << 4));
        s0 = __builtin_amdgcn_mfma_f32_32x32x16_bf16(a0, qf[s], s0, 0, 0, 0);
        s1 = __builtin_amdgcn_mfma_f32_32x32x16_bf16(a1, qf[s], s1, 0, 0, 0); }
}
__device__ __forceinline__ void pv_tile(LAS const unsigned char* Vb, const u32x4* pw, f32x16 (&o)[4]) {
#pragma unroll
    for (int ks = 0; ks < 4; ++ks)
#pragma unroll
        for (int b = 0; b < 4; ++b) {
            const v4i16_t lo = __builtin_amdgcn_ds_read_tr16_b64_v4i16((LAS v4i16_t*)(Vb + b * 4096 + ks * 1024));
            const v4i16_t hh = __builtin_amdgcn_ds_read_tr16_b64_v4i16((LAS v4i16_t*)(Vb + b * 4096 + ks * 1024 + 512));
            const bf16x8 af = {lo[0], lo[1], lo[2], lo[3], hh[0], hh[1], hh[2], hh[3]};
            o[b] = __builtin_amdgcn_mfma_f32_32x32x16_bf16(af, __builtin_bit_cast(bf16x8, pw[ks]), o[b], 0, 0, 0);
        }
}
__device__ __forceinline__ void softmax_tile(f32x16& s0, f32x16& s1, float& m_run, float& l_run, float& alpha, bool& resc, u32x4* pw) {
    float mxa = __builtin_fmaxf(s0[0], s1[0]), mxb = __builtin_fmaxf(s0[1], s1[1]);
#pragma unroll
    for (int r = 2; r < 16; r += 2) { mxa = __builtin_fmaxf(__builtin_fmaxf(mxa, s0[r]), s1[r]); mxb = __builtin_fmaxf(__builtin_fmaxf(mxb, s0[r + 1]), s1[r + 1]); }
    float mx = __builtin_fmaxf(mxa, mxb);
    { auto rr = __builtin_amdgcn_permlane32_swap(__float_as_uint(mx), __float_as_uint(mx), false, false); mx = fmaxf(__uint_as_float(rr[0]), __uint_as_float(rr[1])); }
    resc = __any(mx > m_run + 8.f);
    alpha = 1.f;
    if (resc) { const float m_new = fmaxf(m_run, mx); alpha = __builtin_amdgcn_exp2f(m_run - m_new); m_run = m_new; l_run *= alpha; }
    float rs = 0.f;
#pragma unroll
    for (int r = 0; r < 16; ++r) { s0[r] = __builtin_amdgcn_exp2f(s0[r] - m_run); s1[r] = __builtin_amdgcn_exp2f(s1[r] - m_run); rs += s0[r] + s1[r]; }
    l_run += rs;
#pragma unroll
    for (int e = 0; e < 4; ++e) { pw[0][e] = pk2(s0[2 * e], s0[2 * e + 1]); pw[1][e] = pk2(s0[8 + 2 * e], s0[9 + 2 * e]); pw[2][e] = pk2(s1[2 * e], s1[2 * e + 1]); pw[3][e] = pk2(s1[8 + 2 * e], s1[9 + 2 * e]); }
}
__device__ __forceinline__ void softmax_tile_sm(f32x16& s0, f32x16& s1, float& m_run, float& l_run, float& alpha, bool& resc, u32x4* pw, const bool skipmax) {
    resc = false; alpha = 1.f;
    if (!skipmax) {
    float mxa = __builtin_fmaxf(s0[0], s1[0]), mxb = __builtin_fmaxf(s0[1], s1[1]);
#pragma unroll
    for (int r = 2; r < 16; r += 2) { mxa = __builtin_fmaxf(__builtin_fmaxf(mxa, s0[r]), s1[r]); mxb = __builtin_fmaxf(__builtin_fmaxf(mxb, s0[r + 1]), s1[r + 1]); }
    float mx = __builtin_fmaxf(mxa, mxb);
    { auto rr = __builtin_amdgcn_permlane32_swap(__float_as_uint(mx), __float_as_uint(mx), false, false); mx = fmaxf(__uint_as_float(rr[0]), __uint_as_float(rr[1])); }
    resc = __any(mx > m_run + 8.f);
    alpha = 1.f;
    if (resc) { const float m_new = fmaxf(m_run, mx); alpha = __builtin_amdgcn_exp2f(m_run - m_new); m_run = m_new; l_run *= alpha; }
    }
    float rs = 0.f;
#pragma unroll
    for (int r = 0; r < 16; ++r) { s0[r] = __builtin_amdgcn_exp2f(s0[r] - m_run); s1[r] = __builtin_amdgcn_exp2f(s1[r] - m_run); rs += s0[r] + s1[r]; }
    l_run += rs;
#pragma unroll
    for (int e = 0; e < 4; ++e) { pw[0][e] = pk2(s0[2 * e], s0[2 * e + 1]); pw[1][e] = pk2(s0[8 + 2 * e], s0[9 + 2 * e]); pw[2][e] = pk2(s1[2 * e], s1[2 * e + 1]); pw[3][e] = pk2(s1[8 + 2 * e], s1[9 + 2 * e]); }
}
template <int DQK>
__device__ __forceinline__ void attn_pass2(LAS unsigned char* lds, const bf16_t* __restrict__ Qg, const bf16_t* __restrict__ Kg, const bf16_t* __restrict__ Vg,
                                           const float* __restrict__ btab, const float bscale, const int pitch, const int q0, const int t_lo, f32x16 (&o)[4], const int wid, const int lane) {
    constexpr int NCH = DQK / 8, KS = DQK / 16, KROWB = DQK * 2, KI = NCH / 8;
    const int tid = wid * 64 + lane, r32 = lane & 31, hi = lane >> 5;
    const int NT = (q0 + 256) / 64;
    const int T_w = NT - 4 + (wid >> 1);
    const int qrel = wid * 32 + r32;
    bf16x8 qf[KS];
#pragma unroll
    for (int s = 0; s < KS; ++s) qf[s] = *(const bf16x8*)(Qg + (size_t)(q0 + qrel) * pitch + 16 * s + 8 * hi);
    int kgo[KI], klo[KI], vgo[2], vlo[2];
#pragma unroll
    for (int i = 0; i < KI; ++i) { const int cid = tid + 512 * i, row = cid / NCH, ch = cid % NCH; const int sw = (DQK == 128) ? (row & 15) : ((row >> 1) & 7);
        kgo[i] = row * pitch + ch * 8; klo[i] = row * KROWB + ((ch ^ sw) << 4); }
#pragma unroll
    for (int i = 0; i < 2; ++i) { const int cid = tid + 512 * i, row = cid >> 4, ch = cid & 15;
        vgo[i] = row * pitch + ch * 8; vlo[i] = (ch >> 2) * 4096 + (row >> 3) * 512 + (row & 7) * 64 + (ch & 3) * 16; }
    const float bref = btab[q0];
    u32x4 kreg[KI], vreg[2]; float breg = 0.f;
#define AT_LOADK(t) do { const size_t kvb_ = (size_t)(64 * (t)) * pitch; \
        _Pragma("unroll") for (int i = 0; i < KI; ++i) kreg[i] = *(const u32x4*)(Kg + kvb_ + kgo[i]); \
        if (tid < 64) breg = (btab[64 * (t) + tid] - bref) * bscale; } while (0)
#define AT_LOADV(t) do { const size_t kvb_ = (size_t)(64 * (t)) * pitch; \
        _Pragma("unroll") for (int i = 0; i < 2; ++i) vreg[i] = *(const u32x4*)(Vg + kvb_ + vgo[i]); } while (0)
#define AT_STOREK(buf) do { \
        _Pragma("unroll") for (int i = 0; i < KI; ++i) *(LAS u32x4*)(lds + AL_K + (buf) * 16384 + klo[i]) = kreg[i]; \
        if (tid < 64) *(LAS float*)(lds + AL_B + (buf) * 256 + tid * 4) = breg; } while (0)
#define AT_STOREV(buf) do { \
        _Pragma("unroll") for (int i = 0; i < 2; ++i) *(LAS u32x4*)(lds + AL_V + (buf) * 16384 + vlo[i]) = vreg[i]; } while (0)
    float m_run = -INFINITY, l_run = 0.f;
#pragma unroll
    for (int b = 0; b < 4; ++b)
#pragma unroll
        for (int r = 0; r < 16; ++r) o[b][r] = 0.f;
    const int ksw = (DQK == 128) ? (r32 & 15) : ((r32 >> 1) & 7);
    const int vlane = (4 * hi + ((lane & 15) >> 2)) * 64 + ((lane >> 4) & 1) * 32 + (lane & 3) * 8;
    AT_LOADK(t_lo); AT_STOREK(t_lo & 1);
    AT_LOADK(t_lo + 1); AT_STOREK((t_lo + 1) & 1);
    __syncthreads();
    f32x16 sc0, sc1, sn0, sn1;
    u32x4 pprev[4], pnew[4];
#pragma unroll
    for (int k = 0; k < 4; ++k) { pprev[k] = (u32x4){0u, 0u, 0u, 0u}; pnew[k] = (u32x4){0u, 0u, 0u, 0u}; }
    qk_tile<DQK>(lds + AL_K + (t_lo & 1) * 16384, (LAS const float*)(lds + AL_B + (t_lo & 1) * 256), qf, ksw, r32, hi, sc0, sc1);
#pragma unroll
    for (int r = 0; r < 16; ++r) { sn0[r] = 0.f; sn1[r] = 0.f; }
    for (int t = t_lo; t < NT; ++t) {
        const int pn = (t + 1) & 1, pc = t & 1;
        if (t + 2 < NT) AT_LOADK(t + 2);
        AT_LOADV(t);
        float alpha = 1.f; bool resc = false;
        if ((t > t_lo) && (t < NT - 4)) {
            qk_tile<DQK>(lds + AL_K + pn * 16384, (LAS const float*)(lds + AL_B + pn * 256), qf, ksw, r32, hi, sn0, sn1);
            pv_tile(lds + AL_V + pn * 16384 + vlane, pprev, o);
            softmax_tile(sc0, sc1, m_run, l_run, alpha, resc, pnew);
        } else {
            if (t + 1 <= T_w) qk_tile<DQK>(lds + AL_K + pn * 16384, (LAS const float*)(lds + AL_B + pn * 256), qf, ksw, r32, hi, sn0, sn1);
            if (t > t_lo && t - 1 <= T_w) pv_tile(lds + AL_V + pn * 16384 + vlane, pprev, o);
            if (t <= T_w) {
                const int jb = t - (NT - 4);
                if ((jb >= 0) && (2 * jb + 1 >= wid)) {
#pragma unroll
                    for (int r = 0; r < 16; ++r) { const int kv = 64 * jb + crow(r, hi); if (kv > qrel) sc0[r] = -INFINITY; if (kv + 32 > qrel) sc1[r] = -INFINITY; }
                }
                softmax_tile(sc0, sc1, m_run, l_run, alpha, resc, pnew);
            }
        }
        if (resc) {
#pragma unroll
            for (int b = 0; b < 4; ++b)
#pragma unroll
                for (int r = 0; r < 16; ++r) o[b][r] *= alpha;
        }
        if (t + 2 < NT) AT_STOREK(pc);
        AT_STOREV(pc);
        __syncthreads();
#pragma unroll
        for (int k = 0; k < 4; ++k) pprev[k] = pnew[k];
        sc0 = sn0; sc1 = sn1;
    }
    if (NT - 1 <= T_w) pv_tile(lds + AL_V + ((NT - 1) & 1) * 16384 + vlane, pprev, o);
    __syncthreads();
#undef AT_LOADK
#undef AT_LOADV
#undef AT_STOREK
#undef AT_STOREV
    const float l = l_run + __shfl_xor(l_run, 32);
    const float inv = 1.f / l;
#pragma unroll
    for (int b = 0; b < 4; ++b)
#pragma unroll
        for (int r = 0; r < 16; ++r) o[b][r] *= inv;
}

template <int DQK>
__device__ __forceinline__ void qk_tile_pf(LAS const unsigned char* Kb, LAS const float* bl, const bf16x8* qf, const int ksw, const int r32, const int hi, f32x16& s0, f32x16& s1) {
    constexpr int KS = DQK / 16, KROWB = DQK * 2;
    LAS const unsigned char* k0 = Kb + r32 * KROWB; LAS const unsigned char* k1 = Kb + (32 + r32) * KROWB;
    bf16x8 fa[2][2];
    { const int ch_ = hi; fa[0][0] = *(LAS const bf16x8*)(k0 + ((ch_ ^ ksw) << 4)); fa[0][1] = *(LAS const bf16x8*)(k1 + ((ch_ ^ ksw) << 4)); }
#pragma unroll
    for (int g = 0; g < 4; ++g) { const f32x4 b0 = *(LAS const f32x4*)(bl + 8 * g + 4 * hi), b1 = *(LAS const f32x4*)(bl + 32 + 8 * g + 4 * hi);
#pragma unroll
        for (int e = 0; e < 4; ++e) { s0[4 * g + e] = b0[e]; s1[4 * g + e] = b1[e]; } }
    __builtin_amdgcn_sched_barrier(0);
#pragma unroll
    for (int s = 0; s < KS; ++s) {
        if (s + 1 < KS) { const int ch_ = 2 * (s + 1) + hi; fa[(s + 1) & 1][0] = *(LAS const bf16x8*)(k0 + ((ch_ ^ ksw) << 4)); fa[(s + 1) & 1][1] = *(LAS const bf16x8*)(k1 + ((ch_ ^ ksw) << 4)); }
        s0 = __builtin_amdgcn_mfma_f32_32x32x16_bf16(fa[s & 1][0], qf[s], s0, 0, 0, 0);
        s1 = __builtin_amdgcn_mfma_f32_32x32x16_bf16(fa[s & 1][1], qf[s], s1, 0, 0, 0);
        __builtin_amdgcn_sched_barrier(0);
    }
}
__device__ __forceinline__ bool attn_static_ok(const float* __restrict__ btab, const float bscale, const float bq2, const int q0) {
    const float a = __uint_as_float(__builtin_amdgcn_readfirstlane(__float_as_uint(btab[q0]))), b = __uint_as_float(__builtin_amdgcn_readfirstlane(__float_as_uint(btab[q0 + 255])));
    return ((b - a) * bscale + bq2) <= 90.f;
}
template <int DQK, bool FASTM>
__device__ __forceinline__ void attn_pass3(LAS unsigned char* lds, const bf16_t* __restrict__ Qg, const bf16_t* __restrict__ Kg, const bf16_t* __restrict__ Vg,
                                           const float* __restrict__ btab, const float bscale, const float bq2, const float bref, const float brm, const int pitch, const int q0, const int t_lo, f32x16 (&o)[4], const int wid, const int lane_in) {
    constexpr int NCH = DQK / 8, KS = DQK / 16, KI = NCH / 8;
    int lane_l = lane_in; asm volatile("" : "+v"(lane_l));
    const int lane = lane_l, tid = wid * 64 + lane, r32 = lane & 31, hi = lane >> 5;
    const int NT = (q0 + 256) / 64;
    const int T_w = NT - 4 + (wid >> 1);
    const int qrel = wid * 32 + r32;
    bf16x8 qf[KS];
#pragma unroll
    for (int s = 0; s < KS; ++s) qf[s] = *(const bf16x8*)(Qg + (size_t)(q0 + qrel) * pitch + 16 * s + 8 * hi);
    int kgo0, vgo0;
    { const int p = wid * 64 + lane, row = p / NCH, cp = p % NCH; const int sw = (DQK == 128) ? (row & 15) : ((row >> 1) & 7); kgo0 = row * pitch + (cp ^ sw) * 8; }
    { const int p = wid * 64 + lane; const int row = ((p >> 5) & 7) * 8 + ((p >> 2) & 7), ch = (p >> 8) * 4 + (p & 3); vgo0 = row * pitch + ch * 8; }
    float breg = 0.f;
#define AT_DMAK(t, buf) do { const bf16_t* kp_ = Kg + (size_t)(64 * (t)) * pitch; \
        _Pragma("unroll") for (int i = 0; i < KI; ++i) __builtin_amdgcn_global_load_lds((const unsigned*)(kp_ + kgo0 + i * 32 * pitch), (LAS unsigned*)(lds + AL_K + (buf) * 16384 + (wid + 8 * i) * 1024), 16, 0, 0); } while (0)
#define AT_DMAV(t, buf) do { const bf16_t* vp_ = Vg + (size_t)(64 * (t)) * pitch; \
        _Pragma("unroll") for (int i = 0; i < 2; ++i) __builtin_amdgcn_global_load_lds((const unsigned*)(vp_ + vgo0 + i * 64), (LAS unsigned*)(lds + AL_V + (buf) * 16384 + (wid + 8 * i) * 1024), 16, 0, 0); } while (0)
    constexpr bool fastm = FASTM;
    const float cshift = fastm ? (brm + 0.5f * bq2) : 0.f;
#define AT_LOADB(t) do { if (wid == 0) breg = btab[64 * (t) + lane]; } while (0)
#define AT_STOREB(buf) do { if (wid == 0) *(LAS float*)(lds + AL_B + (buf) * 256 + lane * 4) = (breg - bref) * bscale - cshift; } while (0)
    float m_run = fastm ? 0.f : -INFINITY, l_run = 0.f;
#pragma unroll
    for (int b = 0; b < 4; ++b)
#pragma unroll
        for (int r = 0; r < 16; ++r) o[b][r] = 0.f;
    const int ksw = (DQK == 128) ? (r32 & 15) : ((r32 >> 1) & 7);
    const int vlane = (4 * hi + ((lane & 15) >> 2)) * 64 + ((lane >> 4) & 1) * 32 + (lane & 3) * 8;
    const int t0 = t_lo & ~1;
    AT_DMAK(t0, 0); AT_DMAK(t0 + 1, 1); AT_DMAV(t0, 0);
    {
        float b0r = 0.f, b1r = 0.f;
        if (wid == 0) { b0r = btab[64 * t0 + lane]; b1r = btab[64 * (t0 + 1) + lane]; }
        if (wid == 0) { *(LAS float*)(lds + AL_B + lane * 4) = (b0r - bref) * bscale - cshift; *(LAS float*)(lds + AL_B + 256 + lane * 4) = (b1r - bref) * bscale - cshift; }
    }
    asm volatile("s_waitcnt vmcnt(0)" ::: "memory");
    __syncthreads();
    f32x16 sc0, sc1, sn0, sn1;
    u32x4 pw[4];
    qk_tile<DQK>(lds + AL_K, (LAS const float*)(lds + AL_B), qf, ksw, r32, hi, sc0, sc1);
#define P3_STEP(t, pc, pn, C0, C1, N0, N1) do { \
        if ((t) + 2 < NT) { AT_DMAK((t) + 2, pc); AT_LOADB((t) + 2); } \
        if ((t) + 1 < NT) AT_DMAV((t) + 1, pn); \
        float alpha = 1.f; bool resc = false; \
        if ((t) <= T_w) { \
            if ((t) < T_w) { \
                qk_tile<DQK>(lds + AL_K + (pn) * 16384, (LAS const float*)(lds + AL_B + (pn) * 256), qf, ksw, r32, hi, N0, N1); \
            } else { \
                const int jb = (t) - (NT - 4); \
                _Pragma("unroll") for (int r = 0; r < 16; ++r) { const int kv = 64 * jb + crow(r, hi); if (kv > qrel) C0[r] = -INFINITY; if (kv + 32 > qrel) C1[r] = -INFINITY; } \
            } \
            softmax_tile_sm(C0, C1, m_run, l_run, alpha, resc, pw, fastm); \
            if (resc) { \
                _Pragma("unroll") for (int b = 0; b < 4; ++b) _Pragma("unroll") for (int r = 0; r < 16; ++r) o[b][r] *= alpha; \
            } \
            pv_tile(lds + AL_V + (pc) * 16384 + vlane, pw, o); \
        } \
        if ((t) + 2 < NT) AT_STOREB(pc); \
        asm volatile("s_waitcnt vmcnt(0)" ::: "memory"); \
        __syncthreads(); } while (0)
#define P3_MAIN(t, pc, pn, C0, C1, N0, N1) do { \
        AT_DMAK((t) + 2, pc); AT_LOADB((t) + 2); AT_DMAV((t) + 1, pn); \
        float alpha = 1.f; bool resc = false; \
        qk_tile_pf<DQK>(lds + AL_K + (pn) * 16384, (LAS const float*)(lds + AL_B + (pn) * 256), qf, ksw, r32, hi, N0, N1); \
        softmax_tile_sm(C0, C1, m_run, l_run, alpha, resc, pw, fastm); \
        if (resc) { \
            _Pragma("unroll") for (int b = 0; b < 4; ++b) _Pragma("unroll") for (int r = 0; r < 16; ++r) o[b][r] *= alpha; \
        } \
        pv_tile(lds + AL_V + (pc) * 16384 + vlane, pw, o); \
        AT_STOREB(pc); \
        asm volatile("s_waitcnt vmcnt(0)" ::: "memory"); \
        __syncthreads(); } while (0)
    int opq_ = 0; asm volatile("s_mov_b32 %0, 0" : "=s"(opq_));
#define P3_FAST(t, pc, pn, C0, C1, N0, N1) do { \
        AT_DMAK((t) + 2, pc); AT_LOADB((t) + 2); AT_DMAV((t) + 1, pn); \
        qk_tile_pf<DQK>(lds + AL_K + (pn) * 16384, (LAS const float*)(lds + AL_B + (pn) * 256), qf, ksw, r32, hi, N0, N1); \
        if (__builtin_expect(opq_ != 0, 0)) { asm volatile("s_nop 0" ::: "memory"); } \
        { f32x2 rs2_ = {0.f, 0.f}; \
          _Pragma("unroll") for (int r = 0; r < 16; ++r) { C0[r] = __builtin_amdgcn_exp2f(C0[r]); C1[r] = __builtin_amdgcn_exp2f(C1[r]); } \
          _Pragma("unroll") for (int r = 0; r < 16; r += 2) { rs2_ += (f32x2){C0[r], C0[r + 1]}; rs2_ += (f32x2){C1[r], C1[r + 1]}; } \
          l_run += rs2_.x + rs2_.y; \
          _Pragma("unroll") for (int e = 0; e < 4; ++e) { pw[0][e] = pk2(C0[2 * e], C0[2 * e + 1]); pw[1][e] = pk2(C0[8 + 2 * e], C0[9 + 2 * e]); pw[2][e] = pk2(C1[2 * e], C1[2 * e + 1]); pw[3][e] = pk2(C1[8 + 2 * e], C1[9 + 2 * e]); } } \
        pv_tile(lds + AL_V + (pc) * 16384 + vlane, pw, o); \
        AT_STOREB(pc); \
        asm volatile("s_waitcnt vmcnt(0)" ::: "memory"); \
        __syncthreads(); } while (0)
    int t = t0;
    if constexpr (fastm) {
        for (; t < NT - 4; t += 2) {
            P3_FAST(t, 0, 1, sc0, sc1, sn0, sn1);
            P3_FAST(t + 1, 1, 0, sn0, sn1, sc0, sc1);
        }
    } else {
        for (; t < NT - 4; t += 2) {
            P3_MAIN(t, 0, 1, sc0, sc1, sn0, sn1);
            P3_MAIN(t + 1, 1, 0, sn0, sn1, sc0, sc1);
        }
    }
#undef P3_FAST
    for (; t < NT; t += 2) {
        P3_STEP(t, 0, 1, sc0, sc1, sn0, sn1);
        P3_STEP(t + 1, 1, 0, sn0, sn1, sc0, sc1);
    }
#undef P3_MAIN
#undef P3_STEP
#undef AT_DMAK
#undef AT_DMAV
#undef AT_LOADB
#undef AT_STOREB
    const float l = l_run + __shfl_xor(l_run, 32);
    const float inv = 1.f / l;
#pragma unroll
    for (int b = 0; b < 4; ++b)
#pragma unroll
        for (int r = 0; r < 16; ++r) o[b][r] *= inv;
}

__global__ void __launch_bounds__(NWAVES * 64, 2) hybrid_fwd(Args args) {
    extern __shared__ __attribute__((aligned(16))) unsigned char lds_raw[];
    LAS unsigned char* lds = (LAS unsigned char*)lds_raw;
    const int wave = __builtin_amdgcn_readfirstlane((int)threadIdx.x >> 6);
#define LANE_FRESH() int lane; asm volatile("v_mbcnt_lo_u32_b32 %0, -1, 0\n\tv_mbcnt_hi_u32_b32 %0, -1, %0" : "=v"(lane)); const int tid = wave * 64 + lane; (void)tid
    const int G = gridDim.x, bid = blockIdx.x;
    const int gw = bid * NWAVES + wave, NGW = G * NWAVES;
    typedef const Args __attribute__((address_space(4)))* KArgP;
    KArgP ka0 = (KArgP)__builtin_amdgcn_kernarg_segment_ptr();
#define KA_FRESH() KArgP ka = ka0; asm volatile("" : "+s"(ka))
#define AIN(i) (ka->in[i])
#define WS_FRESH() unsigned char* ws = ka->ws; unsigned* ctl = (unsigned*)(ws + WS_CTL); bf16_t* win0 = (bf16_t*)(ws + WS_WIN0); bf16_t* wout0 = (bf16_t*)(ws + WS_WOUT0); bf16_t* wglu = (bf16_t*)(ws + WS_WGLU); bf16_t* win1 = (bf16_t*)(ws + WS_WIN1); bf16_t* wout1 = (bf16_t*)(ws + WS_WOUT1); bf16_t* hbuf = (bf16_t*)(ws + WS_HBUF); bf16_t* ygelu = (bf16_t*)(ws + WS_HBUF); bf16_t* proj = (bf16_t*)(ws + WS_PROJ); bf16_t* ycat = (bf16_t*)(ws + WS_YCAT); f32x2* lamb = (f32x2*)(ws + WS_LAMB); f32x2* lamt = (f32x2*)(ws + WS_LAMT); unsigned* bbar = (unsigned*)(ws + WS_BBAR); bf16_t* cmat = (bf16_t*)(ws + WS_CMAT); float* biasda = (float*)(ws + WS_BIASDA); float* biasf = (float*)(ws + WS_BIASF); float* flog = (float*)(ws + WS_FLOG); f32x2* s5st = (f32x2*)(ws + WS_S5ST); (void)ctl; (void)win0; (void)wout0; (void)wglu; (void)win1; (void)wout1; (void)hbuf; (void)ygelu; (void)proj; (void)ycat; (void)lamb; (void)lamt; (void)bbar; (void)cmat; (void)biasda; (void)biasf; (void)flog; (void)s5st
    cg::grid_group grid = cg::this_grid();
    XcdBarrier xbar;
    {
        int l0; asm volatile("v_mbcnt_lo_u32_b32 %0, -1, 0\n\tv_mbcnt_hi_u32_b32 %0, -1, %0" : "=v"(l0));
        if (wave == 0 && l0 < 32) ((LAS unsigned*)(lds + LDS_MISC))[l0] = 0u;
        __syncthreads();
        xbar = xcd_barrier_post((unsigned*)(args.ws + WS_CTL) + CW_BAR, (volatile LAS unsigned*)(lds + LDS_MISC) + 8, wave == 0 && l0 == 0);
    }
    const int lo = args.ph_lo, hi_ph = args.ph_hi;
#ifndef PH_MASK
#define PH_MASK 0x7ff
#endif
#define IN(k) (((PH_MASK >> (k)) & 1) && lo <= (k) && (k) < hi_ph)
#ifndef DUP_MASK
#define DUP_MASK 0
#endif
#define NREP(k) (((DUP_MASK >> (k)) & 1) ? 2 : 1)
#define SEAM(k) do { if (IN(k) && IN((k) + 1)) { if ((k) == 0) grid.sync(); else { int l0; asm volatile("v_mbcnt_lo_u32_b32 %0, -1, 0\n\tv_mbcnt_hi_u32_b32 %0, -1, %0" : "=v"(l0)); xcd_barrier(xbar, wave == 0 && l0 == 0); } } } while (0)

    if (IN(0)) {
        KA_FRESH(); LANE_FRESH(); WS_FRESH(); const float* x = AIN(0); float* out = ka->out; (void)x; (void)out;
        LAS float* scr = (LAS float*)(lds + wave * 16384);
        for (int rep = 0; rep < NREP(0); ++rep) {
        constexpr int I_IN0 = 32 * 192, I_OUT = 32 * 64, I_GLU = 16 * 32, I_IN1 = 32 * 264;
        constexpr int NITEMS = I_IN0 + 2 * I_OUT + I_GLU + I_IN1;
        for (int it = gw; it < NITEMS; it += NGW) {
            int r = it;
            if (r < I_IN0) { transpose_item(AIN(2), 2048, E_IN, win0, scr, r, 192, lane); continue; } r -= I_IN0;
            if (r < I_OUT) { transpose_item(AIN(3), 2048, 2048, wout0, scr, r, 64, lane); continue; } r -= I_OUT;
            if (r < I_GLU) { transpose_item(AIN(12), 1024, 1024, wglu, scr, r, 32, lane); continue; } r -= I_GLU;
            if (r < I_IN1) { transpose_item(AIN(22), 2048, 8208, win1, scr, r, 264, lane); continue; } r -= I_IN1;
            transpose_item(AIN(24), 2048, 2048, wout1, scr, r, 64, lane);
        }
        for (int m = gw; m < MTOK; m += 2 * NGW) { const int m1 = m + NGW; const bool h1 = m1 < MTOK; const int mm = h1 ? m1 : m;
            rms_rows2_to_bf16(x + (size_t)m * DM, x + (size_t)mm * DM, h1, AIN(1), hbuf + (size_t)m * DM, hbuf + (size_t)mm * DM, lane); }
        const int gt = bid * 512 + tid, NGT = G * 512;
        for (int i = gt; i < S5G * S5P; i += NGT) {
            const int g = i >> 6;
            const double dt = exp((double)AIN(6)[g]);
            const double lr = (double)AIN(4)[i], li = (double)AIN(5)[i];
            const double mag = exp(lr * dt), ar = mag * cos(li * dt), ai = mag * sin(li * dt);
            const double den = lr * lr + li * li, nr = ar - 1.0, ni = ai;
            const double kr = (nr * lr + ni * li) / den, ki = (ni * lr - nr * li) / den;
            lamb[i] = (f32x2){(float)ar, (float)ai};
            const double magT = exp(lr * dt * (double)S5T);
            lamt[i] = (f32x2){(float)(magT * cos(li * dt * (double)S5T)), (float)(magT * sin(li * dt * (double)S5T))};
#pragma unroll 2
            for (int j = 0; j < 8; ++j) { const double br0 = (double)AIN(7)[i * 16 + 2 * j], bi0 = (double)AIN(8)[i * 16 + 2 * j], br1 = (double)AIN(7)[i * 16 + 2 * j + 1], bi1 = (double)AIN(8)[i * 16 + 2 * j + 1];
                bbar[i * 16 + j] = pk2((float)(kr * br0 - ki * bi0), (float)(kr * br1 - ki * bi1));
                bbar[i * 16 + 8 + j] = pk2((float)(kr * bi0 + ki * br0), (float)(kr * bi1 + ki * br1)); }
        }
        for (int i = gt; i < S5G * 32 * 128; i += NGT) { const int k = i & 127, n = (i >> 7) & 31, g = i >> 12;
            float v = 0.f; if (n < 16) v = (k < 64) ? AIN(9)[(g * 16 + n) * 64 + k] : -AIN(10)[(g * 16 + n) * 64 + (k - 64)];
            cmat[i] = (bf16_t)(pk2(v, 0.f) & 0xffffu); }
        for (int i = gt; i < 8 * SEQ; i += NGT) { const int h = i / SEQ, j = i % SEQ; biasda[i] = exp2f(-(float)(h + 1)) * (float)j; }
        if (bid == 0 && tid == 0) {
            float d1 = 0.f, d2 = 0.f;
            for (int i = 0; i < 64; ++i) { d1 += AIN(16)[i] * AIN(17)[i]; d2 += AIN(18)[i] * AIN(19)[i]; }
            ((float*)ctl)[CW_LAM] = expf(d1) - expf(d2) + 0.2f;
            float gq = 0.f, gk = 0.f, fq_ = 0.f, fk_ = 0.f;
            for (int i = 0; i < 128; ++i) { gq = fmaxf(gq, fabsf(AIN(14)[i])); gk = fmaxf(gk, fabsf(AIN(15)[i])); fq_ = fmaxf(fq_, fabsf(AIN(25)[i])); fk_ = fmaxf(fk_, fabsf(AIN(26)[i])); }
            ((float*)ctl)[CW_THRDA] = ZERO_THR + 2.f * 8.f * gq * gk * 1.02f;
            ((float*)ctl)[CW_THRF] = ZERO_THR + 2.f * 11.3137085f * fq_ * fk_ * 1.02f;
            ctl[CW_QDA] = 0u; ctl[CW_QDA + 1] = 0u; ctl[CW_QFOX] = 0u; ctl[CW_QFOX + 1] = 0u;
        }
        }
#ifdef XSYNC
        for (int i = 0; i < XSYNC; ++i) grid.sync();
#endif
    }
    SEAM(0);
    if (IN(1)) {
        KA_FRESH(); LANE_FRESH(); WS_FRESH(); const float* x = AIN(0); float* out = ka->out; (void)x; (void)out;
        pg8::Gemm g{hbuf, win0, MTOK, E_IN, DM}; pg8::StaticOrder S; S.init(MTOK, E_IN, G, bid);
        pg8::EpiBf16<0> E{proj, E_IN, nullptr, 0, 0, 1.f};
        for (int rep = 0; rep < NREP(1); ++rep) pg8::gemm_phase<pg8::EpiBf16<0>, pg8::StaticOrder, true, true>(lds, g, S, E, wave, lane);
    }
    SEAM(1);
    if (IN(2)) {
        KA_FRESH(); LANE_FRESH(); WS_FRESH(); const float* x = AIN(0); float* out = ka->out; (void)x; (void)out;
        const float qmul = 0.125f * LOG2E;
        for (int m = gw; m < MTOK; m += 2 * NGW) { const int m1 = m + NGW; const bool h1 = m1 < MTOK; const int mm = h1 ? m1 : m;
            qknorm_rows2<2, 1, 4>(proj + (size_t)m * E_IN + 2048, proj + (size_t)mm * E_IN + 2048, h1, AIN(14), AIN(15), qmul, 1.f / 64.f, lane); }
        {
        const int r32 = lane & 31, hi = lane >> 5;
        for (int rep = 0; rep < NREP(12); ++rep)
        for (int u = gw; u < BATCH * S5G * S5NC; u += NGW) {
            const int g = u & 63, c = (u >> 6) & (S5NC - 1), b = u >> 13;
            const f32x2 la = lamb[g * 64 + lane];
            bf16x8 bre[2], bim[2];
#pragma unroll
            for (int ph = 0; ph < 2; ++ph) { const unsigned* bp = bbar + (size_t)(g * 64 + 32 * ph + r32) * 16 + 4 * hi;
                bre[ph] = __builtin_bit_cast(bf16x8, *(const u32x4*)bp); bim[ph] = __builtin_bit_cast(bf16x8, *(const u32x4*)(bp + 8)); }
            float hr = 0.f, hi_s = 0.f;
            const bf16_t* up = proj + (size_t)(b * SEQ + c * S5T + r32) * E_IN + g * 16 + 8 * hi;
            for (int sb = 0; sb < 4; ++sb) {
                const bf16x8 ua = *(const bf16x8*)(up + (size_t)(sb * 32) * E_IN);
                f32x16 z16;
#pragma unroll
                for (int r = 0; r < 16; ++r) z16[r] = 0.f;
                f32x16 xr0 = __builtin_amdgcn_mfma_f32_32x32x16_bf16(ua, bre[0], z16, 0, 0, 0), xr1 = __builtin_amdgcn_mfma_f32_32x32x16_bf16(ua, bre[1], z16, 0, 0, 0);
                f32x16 xi0 = __builtin_amdgcn_mfma_f32_32x32x16_bf16(ua, bim[0], z16, 0, 0, 0), xi1 = __builtin_amdgcn_mfma_f32_32x32x16_bf16(ua, bim[1], z16, 0, 0, 0);
#pragma unroll
                for (int r = 0; r < 16; ++r) {
                    auto sr = __builtin_amdgcn_permlane32_swap(__float_as_uint(xr0[r]), __float_as_uint(xr1[r]), false, false); xr0[r] = __uint_as_float(sr[0]); xr1[r] = __uint_as_float(sr[1]);
                    auto si = __builtin_amdgcn_permlane32_swap(__float_as_uint(xi0[r]), __float_as_uint(xi1[r]), false, false); xi0[r] = __uint_as_float(si[0]); xi1[r] = __uint_as_float(si[1]); }
#pragma unroll
                for (int t = 0; t < 32; ++t) { const int r = (t & 3) + 4 * (t >> 3); const bool odd = (t >> 2) & 1;
                    const float xr = odd ? xr1[r] : xr0[r], xi = odd ? xi1[r] : xi0[r];
                    const float nhr = la.x * hr - la.y * hi_s + xr, nhi = la.x * hi_s + la.y * hr + xi; hr = nhr; hi_s = nhi; }
            }
            s5st[((size_t)(b * S5NC + c) * 64 + g) * 64 + lane] = (f32x2){hr, hi_s};
        }
        }
    }
    SEAM(2);
    if (IN(3)) {
        KA_FRESH(); LANE_FRESH(); WS_FRESH(); const float* x = AIN(0); float* out = ka->out; (void)x; (void)out;
        {
            LAS unsigned char* Ht = lds + wave * 8192;
            const int r32 = lane & 31, hi = lane >> 5;
            for (int rep = 0; rep < NREP(11); ++rep)
            for (int u = gw; u < BATCH * S5G * (S5NC / 8); u += NGW) {
                const int g = u & 63, c0 = ((u >> 6) & 15) * 8, b = u >> 10;
                const int gp = g * 64 + lane;
                const f32x2 la = lamb[gp], lt = lamt[gp];
                bf16x8 bre[2], bim[2];
#pragma unroll
                for (int ph = 0; ph < 2; ++ph) { const unsigned* bp = bbar + (size_t)(g * 64 + 32 * ph + r32) * 16 + 4 * hi;
                    bre[ph] = __builtin_bit_cast(bf16x8, *(const u32x4*)bp); bim[ph] = __builtin_bit_cast(bf16x8, *(const u32x4*)(bp + 8)); }
                float hr = 0.f, hi_s = 0.f;
#pragma unroll 8
                for (int cc = 0; cc < c0; ++cc) { const f32x2 s = s5st[((size_t)(b * S5NC + cc) * 64 + g) * 64 + lane];
                    const float nhr = lt.x * hr - lt.y * hi_s + s.x, nhi = lt.x * hi_s + lt.y * hr + s.y; hr = nhr; hi_s = nhi; }
                bf16x8 cfr[8];
#pragma unroll
                for (int s = 0; s < 8; ++s) cfr[s] = *(const bf16x8*)(cmat + (size_t)(g * 32 + r32) * 128 + 16 * s + 8 * hi);
                const f32x4 dv0 = *(const f32x4*)(AIN(11) + g * 16 + 4 * hi), dv1 = *(const f32x4*)(AIN(11) + g * 16 + 8 + 4 * hi);
                for (int c = c0; c < c0 + 8; ++c) {
                const size_t row0 = (size_t)(b * SEQ + c * S5T);
                const bf16_t* up = proj + (row0 + r32) * E_IN + g * 16 + 8 * hi;
                for (int sb = 0; sb < 4; ++sb) {
                    const size_t orow = row0 + sb * 32 + r32;
                    const u32x2 uvA = *(const u32x2*)(proj + orow * E_IN + g * 16 + 4 * hi), uvB = *(const u32x2*)(proj + orow * E_IN + g * 16 + 8 + 4 * hi);
                    {
                    const bf16x8 ua = *(const bf16x8*)(up + (size_t)(sb * 32) * E_IN);
                    f32x16 z16;
#pragma unroll
                    for (int r = 0; r < 16; ++r) z16[r] = 0.f;
                    f32x16 xr0 = __builtin_amdgcn_mfma_f32_32x32x16_bf16(ua, bre[0], z16, 0, 0, 0), xr1 = __builtin_amdgcn_mfma_f32_32x32x16_bf16(ua, bre[1], z16, 0, 0, 0);
                    f32x16 xi0 = __builtin_amdgcn_mfma_f32_32x32x16_bf16(ua, bim[0], z16, 0, 0, 0), xi1 = __builtin_amdgcn_mfma_f32_32x32x16_bf16(ua, bim[1], z16, 0, 0, 0);
#pragma unroll
                    for (int r = 0; r < 16; ++r) {
                        auto sr = __builtin_amdgcn_permlane32_swap(__float_as_uint(xr0[r]), __float_as_uint(xr1[r]), false, false); xr0[r] = __uint_as_float(sr[0]); xr1[r] = __uint_as_float(sr[1]);
                        auto si = __builtin_amdgcn_permlane32_swap(__float_as_uint(xi0[r]), __float_as_uint(xi1[r]), false, false); xi0[r] = __uint_as_float(si[0]); xi1[r] = __uint_as_float(si[1]); }
#pragma unroll
                    for (int tt = 0; tt < 32; ++tt) { const int r = (tt & 3) + 4 * (tt >> 3); const bool odd = (tt >> 2) & 1;
                        const float xr = odd ? xr1[r] : xr0[r], xi = odd ? xi1[r] : xi0[r];
                        const float nhr = la.x * hr - la.y * hi_s + xr, nhi = la.x * hi_s + la.y * hr + xi; hr = nhr; hi_s = nhi;
                        const unsigned w = pk2(hr, hi_s);
                        const int sw = tt & 15;
                        *(LAS unsigned short*)(Ht + tt * 256 + ((((lane >> 3)) ^ sw) << 4) + ((lane & 7) << 1)) = (unsigned short)(w & 0xffffu);
                        *(LAS unsigned short*)(Ht + tt * 256 + ((((64 + lane) >> 3) ^ sw) << 4) + ((lane & 7) << 1)) = (unsigned short)(w >> 16);
                    }
                    }
                    asm volatile("s_waitcnt lgkmcnt(0)" ::: "memory");
                    f32x16 acc;
#pragma unroll
                    for (int r = 0; r < 16; ++r) acc[r] = 0.f;
#pragma unroll
                    for (int s = 0; s < 8; ++s) { const bf16x8 a = *(LAS const bf16x8*)(Ht + r32 * 256 + (((2 * s + hi) ^ (r32 & 15)) << 4));
                        acc = __builtin_amdgcn_mfma_f32_32x32x16_bf16(cfr[s], a, acc, 0, 0, 0); }
                    asm volatile("s_waitcnt lgkmcnt(0)" ::: "memory");
                    {
                        const float y0 = gelu_tanh(acc[0] + dv0.x * bflo(uvA.x)), y1 = gelu_tanh(acc[1] + dv0.y * bfhi(uvA.x)), y2 = gelu_tanh(acc[2] + dv0.z * bflo(uvA.y)), y3 = gelu_tanh(acc[3] + dv0.w * bfhi(uvA.y));
                        const float y4 = gelu_tanh(acc[4] + dv1.x * bflo(uvB.x)), y5 = gelu_tanh(acc[5] + dv1.y * bfhi(uvB.x)), y6 = gelu_tanh(acc[6] + dv1.z * bflo(uvB.y)), y7 = gelu_tanh(acc[7] + dv1.w * bfhi(uvB.y));
                        u32x2 wA, wB; wA.x = pk2(y0, y1); wA.y = pk2(y2, y3); wB.x = pk2(y4, y5); wB.y = pk2(y6, y7);
                        *(u32x2*)(ygelu + orow * 1024 + g * 16 + 4 * hi) = wA; *(u32x2*)(ygelu + orow * 1024 + g * 16 + 8 + 4 * hi) = wB;
                    }
                }
                }
            }
        }
        __syncthreads();
        {
            LANE_FRESH();
            LAS volatile int* misc = (LAS volatile int*)(lds + LDS_MISC);
            const float lam = ((const float*)ctl)[CW_LAM]; const float thr_da = ((const float*)ctl)[CW_THRDA];
            const int r32 = lane & 31, hi = lane >> 5;
            for (int rep = 0; rep < NREP(3); ++rep)
            for (;;) {
                if (tid == 0) misc[0] = (int)atomicAdd(ctl + CW_QDA + rep, 1u);
                __syncthreads();
                const int ui = misc[0];
                __syncthreads();
                if (ui >= BATCH * 8 * 64) break;
                const int qb = 63 - (ui >> 4), bh = ui & 15, b = bh >> 3, h = bh & 7;
                const int q0 = qb * 256;
                const bf16_t* pb = proj + (size_t)b * SEQ * E_IN;
                const float dskip = thr_da * exp2f((float)(h + 1));
                const int t_lo = max(0, (int)ceilf(((float)q0 - dskip - 63.f) * (1.f / 64.f)));
                f32x16 o[4];
                LAS unsigned* stash = (LAS unsigned*)(lds + LDS_STASH) + wave * 2048 + lane;
                const float bq2 = (thr_da - ZERO_THR) * LOG2E;
                const float* btq = biasda + h * SEQ;
                const float bref = __uint_as_float(__builtin_amdgcn_readfirstlane(__float_as_uint(btq[q0]))), bend = __uint_as_float(__builtin_amdgcn_readfirstlane(__float_as_uint(btq[q0 + 255])));
                const float brm = (bend - bref) * LOG2E;
                const bool fm = (brm + bq2) <= 90.f;
                if (fm) attn_pass3<64, true>(lds, pb + 2048 + h * 128, pb + 3072 + h * 128, pb + 4096 + h * 128, biasda + h * SEQ, LOG2E, bq2, bref, brm, E_IN, q0, t_lo, o, wave, lane);
                else attn_pass3<64, false>(lds, pb + 2048 + h * 128, pb + 3072 + h * 128, pb + 4096 + h * 128, biasda + h * SEQ, LOG2E, bq2, bref, brm, E_IN, q0, t_lo, o, wave, lane);
#pragma unroll
                for (int bl = 0; bl < 4; ++bl)
#pragma unroll
                    for (int e = 0; e < 8; ++e) stash[(bl * 8 + e) * 64] = pk2(o[bl][2 * e], o[bl][2 * e + 1]);
                if (fm) attn_pass3<64, true>(lds, pb + 2048 + h * 128 + 64, pb + 3072 + h * 128 + 64, pb + 4096 + h * 128, biasda + h * SEQ, LOG2E, bq2, bref, brm, E_IN, q0, t_lo, o, wave, lane);
                else attn_pass3<64, false>(lds, pb + 2048 + h * 128 + 64, pb + 3072 + h * 128 + 64, pb + 4096 + h * 128, biasda + h * SEQ, LOG2E, bq2, bref, brm, E_IN, q0, t_lo, o, wave, lane);
                int hi_e = hi, r32_e = r32; asm volatile("" : "+v"(hi_e), "+v"(r32_e));
                float ssq = 0.f;
#pragma unroll
                for (int bl = 0; bl < 4; ++bl)
#pragma unroll
                    for (int e = 0; e < 8; ++e) { const unsigned w0 = stash[(bl * 8 + e) * 64]; const float v0 = bflo(w0) - lam * o[bl][2 * e], v1 = bfhi(w0) - lam * o[bl][2 * e + 1];
                        o[bl][2 * e] = v0; o[bl][2 * e + 1] = v1; ssq += v0 * v0 + v1 * v1; }
                ssq += __shfl_xor(ssq, 32);
                const float rr = 0.8f / sqrtf(ssq * (1.f / 128.f) + RMS_EPS);
                const size_t tok = (size_t)b * SEQ + q0 + wave * 32 + r32_e;
#pragma unroll
                for (int bl = 0; bl < 4; ++bl)
#pragma unroll
                    for (int g = 0; g < 4; ++g) { const int dv0 = 32 * bl + 8 * g + 4 * hi_e;
                        const f32x4 gn = *(const f32x4*)(AIN(20) + dv0);
                        const u32x2 zw = *(const u32x2*)(proj + tok * E_IN + 5120 + h * 128 + dv0);
                        const float y0 = o[bl][4 * g] * rr * gn.x * siluf_(bflo(zw.x)), y1 = o[bl][4 * g + 1] * rr * gn.y * siluf_(bfhi(zw.x));
                        const float y2 = o[bl][4 * g + 2] * rr * gn.z * siluf_(bflo(zw.y)), y3 = o[bl][4 * g + 3] * rr * gn.w * siluf_(bfhi(zw.y));
                        u32x2 w; w.x = pk2(y0, y1); w.y = pk2(y2, y3);
                        *(u32x2*)(ycat + tok * DM + 1024 + h * 128 + dv0) = w; }
            }
        }
    }
    SEAM(3);
    if (IN(4)) {
        KA_FRESH(); LANE_FRESH(); WS_FRESH(); const float* x = AIN(0); float* out = ka->out; (void)x; (void)out;
        pg8::Gemm g{ygelu, wglu, MTOK, 1024, 1024}; pg8::StaticOrder S; S.init(MTOK, 1024, G, bid);
        pg8::EpiGlu E{ycat, ygelu, proj, AIN(13)};
        pg8::gemm_phase<pg8::EpiGlu, pg8::StaticOrder, true, true>(lds, g, S, E, wave, lane);
    }
    SEAM(4);
    if (IN(5)) {
        KA_FRESH(); LANE_FRESH(); WS_FRESH(); const float* x = AIN(0); float* out = ka->out; (void)x; (void)out;
        pg8::Gemm g{ycat, wout0, MTOK, DM, DM}; pg8::StaticOrder S; S.init(MTOK, DM, G, bid);
        pg8::EpiResid E{x, out};
        pg8::gemm_phase<pg8::EpiResid, pg8::StaticOrder, true, true>(lds, g, S, E, wave, lane);
    }
    SEAM(5);
    if (IN(6)) {
        KA_FRESH(); LANE_FRESH(); WS_FRESH(); const float* x = AIN(0); float* out = ka->out; (void)x; (void)out;
        for (int rep = 0; rep < NREP(6); ++rep)
        for (int m = gw; m < MTOK; m += 2 * NGW) { const int m1 = m + NGW; const bool h1 = m1 < MTOK; const int mm = h1 ? m1 : m;
            rms_rows2_to_bf16(out + (size_t)m * DM, out + (size_t)mm * DM, h1, AIN(21), hbuf + (size_t)m * DM, hbuf + (size_t)mm * DM, lane); }
    }
    SEAM(6);
    if (IN(7)) {
        KA_FRESH(); LANE_FRESH(); WS_FRESH(); const float* x = AIN(0); float* out = ka->out; (void)x; (void)out;
        pg8::Gemm g{hbuf, win1, MTOK, O_INP, DM}; pg8::StaticOrder S; S.init(MTOK, O_INP, G, bid);
        pg8::EpiProj1 E{proj, flog};
        for (int rep = 0; rep < NREP(7); ++rep) pg8::gemm_phase<pg8::EpiProj1, pg8::StaticOrder, true, true>(lds, g, S, E, wave, lane);
    }
    SEAM(7);
    if (IN(8)) {
        KA_FRESH(); LANE_FRESH(); WS_FRESH(); const float* x = AIN(0); float* out = ka->out; (void)x; (void)out;
        if (bid < 32) {
            const int b = bid >> 4, h = bid & 15;
            LAS double* dsum = (LAS double*)lds;
            const float bf_ = AIN(23)[h];
            const float* fl = flog + ((size_t)b * SEQ + tid * 32) * 16 + h;
            float lf[32];
#pragma unroll
            for (int i = 0; i < 32; ++i) lf[i] = fl[i * 16];
            double tot = 0.0;
#pragma unroll
            for (int i = 0; i < 32; ++i) { const float xv = lf[i] + bf_; lf[i] = fminf(xv, 0.f) - __logf(1.f + __expf(-fabsf(xv))); tot += (double)lf[i]; }
            dsum[tid] = tot;
            __syncthreads();
            double pre = 0.0;
#pragma unroll 8
            for (int i = 0; i < tid; ++i) pre += dsum[i];
            float* bo = biasf + ((size_t)(b * 16 + h)) * SEQ + tid * 32;
#pragma unroll
            for (int i = 0; i < 32; i += 4) { f32x4 w;
                pre += (double)lf[i]; w.x = (float)(-pre); pre += (double)lf[i + 1]; w.y = (float)(-pre); pre += (double)lf[i + 2]; w.z = (float)(-pre); pre += (double)lf[i + 3]; w.w = (float)(-pre);
                *(f32x4*)(bo + i) = w; }
            __syncthreads();
        }
        const float qmul = 0.08838834764831845f * LOG2E;
        for (int m = gw; m < MTOK; m += 2 * NGW) { const int m1 = m + NGW; const bool h1 = m1 < MTOK; const int mm = h1 ? m1 : m;
            qknorm_rows2<4, 2, 8>(proj + (size_t)m * O_LD, proj + (size_t)mm * O_LD, h1, AIN(25), AIN(26), qmul, 1.f / 128.f, lane); }
    }
    SEAM(8);
    if (IN(9)) {
        KA_FRESH(); LANE_FRESH(); WS_FRESH(); const float* x = AIN(0); float* out = ka->out; (void)x; (void)out;
        LAS volatile int* misc = (LAS volatile int*)(lds + LDS_MISC);
        const int r32 = lane & 31, hi = lane >> 5;
        const float thr_f = ((const float*)ctl)[CW_THRF];
        for (int rep = 0; rep < NREP(9); ++rep)
        for (;;) {
            if (wave == 0) {
                int u0 = 0; if (lane == 0) u0 = (int)atomicAdd(ctl + CW_QFOX + rep, 1u);
                u0 = __shfl(u0, 0);
                int tl = 0;
                if (u0 < BATCH * 16 * 64) {
                    const int qb_ = 63 - (u0 >> 5), bh_ = u0 & 31; const float* bt = biasf + (size_t)bh_ * SEQ; const float bref = bt[qb_ * 256];
                    int ln = lane; asm volatile("" : "+v"(ln));
#pragma unroll
                    for (int r = 0; r < 4; ++r) { const int t = ln + 64 * r; bool dead = false;
                        if (t < 4 * qb_) dead = (bt[64 * t + 63] - bref) < -thr_f;
                        tl += __popcll(__ballot(dead)); }
                }
                if (lane == 0) { misc[0] = u0; misc[1] = tl; }
            }
            __syncthreads();
            const int ui = misc[0], t_lo = misc[1];
            __syncthreads();
            if (ui >= BATCH * 16 * 64) break;
            const int qb = 63 - (ui >> 5), bh = ui & 31, b = bh >> 4, h = bh & 15;
            const int q0 = qb * 256;
            const bf16_t* pb = proj + (size_t)b * SEQ * O_LD;
            f32x16 o[4];
            const float bq2 = (thr_f - ZERO_THR) * LOG2E;
            const float* btq = biasf + (size_t)bh * SEQ;
            const float bref = __uint_as_float(__builtin_amdgcn_readfirstlane(__float_as_uint(btq[q0]))), bend = __uint_as_float(__builtin_amdgcn_readfirstlane(__float_as_uint(btq[q0 + 255])));
            const float brm = (bend - bref) * LOG2E;
            if ((brm + bq2) <= 90.f) attn_pass3<128, true>(lds, pb + h * 128, pb + 2048 + h * 128, pb + 4096 + h * 128, biasf + (size_t)bh * SEQ, LOG2E, bq2, bref, brm, O_LD, q0, t_lo, o, wave, lane);
            else attn_pass3<128, false>(lds, pb + h * 128, pb + 2048 + h * 128, pb + 4096 + h * 128, biasf + (size_t)bh * SEQ, LOG2E, bq2, bref, brm, O_LD, q0, t_lo, o, wave, lane);
            int hi_e = hi, r32_e = r32; asm volatile("" : "+v"(hi_e), "+v"(r32_e));
            const size_t tok = (size_t)b * SEQ + q0 + wave * 32 + r32_e;
#pragma unroll
            for (int bl = 0; bl < 4; ++bl)
#pragma unroll
                for (int g = 0; g < 4; ++g) { const int dv0 = 32 * bl + 8 * g + 4 * hi_e;
                    const u32x2 zw = *(const u32x2*)(proj + tok * O_LD + 6144 + h * 128 + dv0);
                    const float y0 = o[bl][4 * g] * siluf_(bflo(zw.x)), y1 = o[bl][4 * g + 1] * siluf_(bfhi(zw.x));
                    const float y2 = o[bl][4 * g + 2] * siluf_(bflo(zw.y)), y3 = o[bl][4 * g + 3] * siluf_(bfhi(zw.y));
                    u32x2 w; w.x = pk2(y0, y1); w.y = pk2(y2, y3);
                    *(u32x2*)(ycat + tok * DM + h * 128 + dv0) = w; }
        }
    }
    SEAM(9);
    if (IN(10)) {
        KA_FRESH(); LANE_FRESH(); WS_FRESH(); const float* x = AIN(0); float* out = ka->out; (void)x; (void)out;
        pg8::Gemm g{ycat, wout1, MTOK, DM, DM}; pg8::StaticOrder S; S.init(MTOK, DM, G, bid);
        pg8::EpiResid E{out, out};
        pg8::gemm_phase<pg8::EpiResid, pg8::StaticOrder, true, true>(lds, g, S, E, wave, lane);
    }
#undef IN
#undef SEAM
}

#ifndef ONE_LAUNCH
#define ONE_LAUNCH 1
#endif
constexpr int NPHASE = 11;
extern "C" void kernel_launch(void* const* d_in, const int* in_sizes, int n_in, void* d_out, int out_size, void* d_ws, size_t ws_size, hipStream_t stream) {
    static int grid = 0;
    if (grid == 0) {
        if (n_in != 27 || out_size != MTOK * DM || ws_size < WS_END) { fprintf(stderr, "kernel_launch: unexpected problem (n_in %d out %d ws %zu)\n", n_in, out_size, ws_size); grid = -1; return; }
        int dev = 0, cus = 0, per_cu = 0;
        hipGetDevice(&dev);
        hipDeviceGetAttribute(&cus, hipDeviceAttributeMultiprocessorCount, dev);
        if (hipFuncSetAttribute((const void*)hybrid_fwd, hipFuncAttributeMaxDynamicSharedMemorySize, LDS_BYTES) != hipSuccess) { fprintf(stderr, "kernel_launch: hipFuncSetAttribute failed\n"); grid = -1; return; }
        if (hipOccupancyMaxActiveBlocksPerMultiprocessor(&per_cu, (const void*)hybrid_fwd, NWAVES * 64, LDS_BYTES) != hipSuccess || per_cu < 1) { fprintf(stderr, "kernel_launch: occupancy query says %d\n", per_cu); per_cu = 1; }
        (void)hipGetLastError();
        grid = cus * 1;
    }
    if (grid < 0) return;
    if (hipMemsetAsync(d_ws, 0, 65536, stream) != hipSuccess) { fprintf(stderr, "kernel_launch: memset failed\n"); return; }
    Args a{};
    for (int i = 0; i < 27; ++i) a.in[i] = (const float*)d_in[i];
    a.out = (float*)d_out; a.ws = (unsigned char*)d_ws;
#if ONE_LAUNCH
    a.ph_lo = 0; a.ph_hi = NPHASE;
    void* kargs[] = {&a};
    hipError_t e = hipLaunchCooperativeKernel((const void*)hybrid_fwd, dim3(grid), dim3(NWAVES * 64), kargs, LDS_BYTES, stream);
    if (e != hipSuccess) fprintf(stderr, "cooperative launch failed: %s (grid %d)\n", hipGetErrorString(e), grid);
#else
    for (int p = 0; p < NPHASE; ++p) {
        a.ph_lo = p; a.ph_hi = p + 1;
        hipLaunchKernelGGL(hybrid_fwd, dim3(grid), dim3(NWAVES * 64), LDS_BYTES, stream, a);
    }
#endif
}
```

```cpp
#include <hip/hip_runtime.h>
#include <hip/hip_cooperative_groups.h>
#include <cstdio>
#include <cstdint>
#include <cmath>
namespace cg = cooperative_groups;
#define DUP_MASK 0
namespace pg8 {
#define PG8_LAS __attribute__((address_space(3)))
typedef unsigned short bf16_t;
typedef short bf16x8 __attribute__((ext_vector_type(8)));
typedef float f32x4 __attribute__((ext_vector_type(4)));
typedef unsigned u32x4 __attribute__((ext_vector_type(4)));
constexpr int BM = 256, BK = 64, HALF = 128, HTB = HALF * BK * 2  , STAGE_BYTES = 8 * HTB, NXCD = 8, WGM = 8;

__host__ __device__ __forceinline__ int lds_byte(int r, int c) { const int st = (r >> 4) * 2 + (c >> 5), rr = r & 15, cc = c & 31, ob = rr * 64 + cc * 2; return st * 1024 + (ob ^ (((ob >> 9) & 1) << 5)); }
__host__ __device__ __forceinline__ void stage_rc(int b, int& R, int& C) { const int st = b / 1024, sb = b % 1024, swz = sb ^ (((sb >> 9) & 1) << 5); R = (st >> 1) * 16 + swz / 64; C = (st & 1) * 32 + (swz % 64) / 2; }
__host__ __device__ __forceinline__ int perm32(int rho) { const int n = rho >> 4, i = rho & 15; return 8 * (i >> 2) + 4 * n + (i & 3); }

struct Unit { int pm, pn; };
struct Gemm { const bf16_t* A; const bf16_t* Bt; int M, N, K; };

struct StaticOrder {
    int nM, nN, nwg, G, c;
    __host__ __device__ void init(int M, int N, int G_, int c_) { nM = M / BM; nN = N / BM; nwg = nM * nN; G = G_; c = c_; }
    __host__ __device__ bool next(int i, Unit& u) const {
        const long L = (long)i * G + c; if (L >= nwg) return false;
        int wgid = (int)L; { const int q = nwg / NXCD, r = nwg % NXCD, xcd = wgid % NXCD, off = wgid / NXCD; wgid = (xcd < r ? xcd * (q + 1) : r * (q + 1) + (xcd - r) * q) + off; }
        const int nig = WGM * nN, gid = wgid / nig, fm = gid * WGM, gsz = (nM - fm) < WGM ? (nM - fm) : WGM;
        u.pm = fm + ((wgid % nig) % gsz); u.pn = (wgid % nig) / gsz; return true;
    }
    __device__ __forceinline__ void a_ready(const Unit&) const {}
    __device__ __forceinline__ void done(const Unit&) const {}
};

__device__ __forceinline__ unsigned cvt_pk_bf16(float lo, float hi) { unsigned r; asm volatile("v_cvt_pk_bf16_f32 %0, %1, %2" : "=v"(r) : "v"(lo), "v"(hi)); return r; }
typedef float f32x2 __attribute__((ext_vector_type(2)));
__device__ __forceinline__ f32x2 gelu_pk(f32x2 v) {
    const f32x2 av = __builtin_elementwise_abs(v), d = av * 0.2316418882f + 1.0f;
    f32x2 t; t.x = __builtin_amdgcn_rcpf(d.x); t.y = __builtin_amdgcn_rcpf(d.y);
    f32x2 q = t * 0.5307027145f + (-0.7265760135f); q = q * t + 0.7107068705f; q = q * t + (-0.142248368f); q = q * t + 0.127414796f; q = q * t;
    const f32x2 s = (v * v) * (-0.72134752044f);
    f32x2 e; e.x = __builtin_amdgcn_exp2f(s.x); e.y = __builtin_amdgcn_exp2f(s.y);
    const f32x2 m = v * (q * e), r = v - m;
    f32x2 o; o.x = v.x < 0.f ? m.x : r.x; o.y = v.y < 0.f ? m.y : r.y; return o;
}

template <int ACT  > struct EpiBf16 {
    static constexpr bool PERM = true, AFTER_DRAIN = false; static_assert(ACT == 0 || ACT == 1, "EpiBf16: ACT is 0 (none) or 1 (gelu_pk)");
    bf16_t* O; int ldc; const float* bias; int split_cols; size_t split_stride; float scale0;
    __device__ __forceinline__ void operator()(const f32x4 (&acc)[2][2][4][2], const Unit& u, int wr, int wc, int fr, int fq) const {
        const int row0 = u.pm * BM + wr * 64 + fr; int colt = u.pn * BM; bf16_t* base = O;
        float sc = 1.f; if (split_cols) { const int t = colt / split_cols; base += (size_t)t * split_stride; colt -= t * split_cols; if (t == 0) sc = scale0; }
        const int col0 = colt + wc * 32 + 8 * fq, bcol0 = u.pn * BM + wc * 32 + 8 * fq;
        f32x4 bv[2][2];
#pragma unroll
        for (int bj = 0; bj < 2; ++bj)
#pragma unroll
            for (int n = 0; n < 2; ++n) bv[bj][n] = bias ? *(const f32x4*)(bias + bcol0 + bj * HALF + 4 * n) : (f32x4){0.f, 0.f, 0.f, 0.f};
#pragma unroll
        for (int ai = 0; ai < 2; ++ai)
#pragma unroll
            for (int m = 0; m < 4; ++m) { bf16_t* rowp = base + (size_t)(row0 + ai * HALF + m * 16) * ldc + col0;
#pragma unroll
                for (int bj = 0; bj < 2; ++bj) { f32x4 v0 = acc[ai][bj][m][0] + bv[bj][0], v1 = acc[ai][bj][m][1] + bv[bj][1];
                    if (ACT == 1) { f32x2 a = gelu_pk((f32x2){v0[0], v0[1]}), b = gelu_pk((f32x2){v0[2], v0[3]}), c = gelu_pk((f32x2){v1[0], v1[1]}), d = gelu_pk((f32x2){v1[2], v1[3]});
                        v0 = (f32x4){a.x, a.y, b.x, b.y}; v1 = (f32x4){c.x, c.y, d.x, d.y}; }
                    v0 = v0 * sc; v1 = v1 * sc; u32x4 w; w.x = cvt_pk_bf16(v0[0], v0[1]); w.y = cvt_pk_bf16(v0[2], v0[3]); w.z = cvt_pk_bf16(v1[0], v1[1]); w.w = cvt_pk_bf16(v1[2], v1[3]);
                    *(u32x4*)(rowp + bj * HALF) = w; } }
    }
};
template <class Epi, class Sched, bool ALIGN_EPI = false, bool SP2 = false>
__device__ __forceinline__ void gemm_phase(PG8_LAS unsigned char* lds, const Gemm g, const Sched& S, const Epi& E, const int wid, const int lane) {
    const int tid = wid * 64 + lane, wr = wid >> 2, wc = wid & 3, fr = lane & 15, fq = lane >> 4;
    const int K = g.K, nt = K / BK;
    unsigned voffA[2], voffB[2];
#pragma unroll
    for (int i = 0; i < 2; ++i) { int R, C; stage_rc(tid * 16 + i * 8192, R, C); const int Rb = Epi::PERM ? ((R & ~31) + perm32(R & 31)) : R;
        voffA[i] = (unsigned)(R * K + C) * 2u; voffB[i] = (unsigned)(Rb * K + C) * 2u; }
    const size_t kstep = (size_t)(BK * 2);
    const size_t hstep = (size_t)HALF * K * 2;
    const size_t tstep = 2 * hstep;
    const unsigned ldsw = (unsigned)wid * 1024u;
    const int aoff = lds_byte(wr * 64 + fr, fq * 8), boff = lds_byte(wc * 32 + fr, fq * 8);
#define PG8_SA(b, h) (((b) * 2 + (h)) * HTB)
#define PG8_SB(b, h) ((4 + (b) * 2 + (h)) * HTB)
#define PG8_STAGE(bufoff, gbase, voff) do { _Pragma("unroll") for (int _i = 0; _i < 2; ++_i) \
        __builtin_amdgcn_global_load_lds((const unsigned*)((const char*)(gbase) + (voff)[_i]), (PG8_LAS unsigned*)(lds + (bufoff) + ldsw + _i * 8192), 16, 0, 0); } while (0)
#define PG8_LDA(dst, b, h) do { _Pragma("unroll") for (int m = 0; m < 4; ++m) _Pragma("unroll") for (int k = 0; k < 2; ++k) dst[m][k] = *(const PG8_LAS bf16x8*)(lds + PG8_SA(b, h) + aoff + m * 2048 + k * 1024); } while (0)
#define PG8_LDB(dst, b, h) do { _Pragma("unroll") for (int n = 0; n < 2; ++n) _Pragma("unroll") for (int k = 0; k < 2; ++k) dst[n][k] = *(const PG8_LAS bf16x8*)(lds + PG8_SB(b, h) + boff + n * 2048 + k * 1024); } while (0)
#define PG8_MMA(ai, bj, At, Bt) do { __builtin_amdgcn_s_setprio(1); _Pragma("unroll") for (int m = 0; m < 4; ++m) _Pragma("unroll") for (int n = 0; n < 2; ++n) _Pragma("unroll") for (int k = 0; k < 2; ++k) \
        acc[ai][bj][m][n] = __builtin_amdgcn_mfma_f32_16x16x32_bf16(Bt[n][k], At[m][k], acc[ai][bj][m][n], 0, 0, 0); __builtin_amdgcn_s_setprio(0); } while (0)
#define PG8_WAIT_V(n) asm volatile("s_waitcnt vmcnt(" #n ")" ::: "memory")
#define PG8_WAIT_L(n) asm volatile("s_waitcnt lgkmcnt(" #n ")" ::: "memory")
#define PG8_BAR __builtin_amdgcn_s_barrier()
#define PG8_SCHED __builtin_amdgcn_sched_barrier(0)
    Unit cur, nxt; int ui = 0;
    if (!S.next(0, cur)) return;
    f32x4 acc[2][2][4][2];
#pragma unroll
    for (int a = 0; a < 2; ++a)
#pragma unroll
        for (int b = 0; b < 2; ++b)
#pragma unroll
            for (int m = 0; m < 4; ++m)
#pragma unroll
                for (int n = 0; n < 2; ++n) acc[a][b][m][n] = (f32x4){0.f, 0.f, 0.f, 0.f};
    bf16x8 At[4][2], B0[2][2], B1[2][2];
    const char* cA = (const char*)g.A + (size_t)cur.pm * tstep; const char* cB = (const char*)g.Bt + (size_t)cur.pn * tstep;
    S.a_ready(cur);
    if constexpr (SP2) {
        PG8_STAGE(PG8_SB(0, 0), cB, voffB); PG8_STAGE(PG8_SB(0, 1), cB + hstep, voffB); PG8_STAGE(PG8_SA(0, 0), cA, voffA); PG8_STAGE(PG8_SA(0, 1), cA + hstep, voffA);
        if (wr == 1) PG8_BAR;
        PG8_WAIT_V(2); PG8_BAR;
        PG8_STAGE(PG8_SB(1, 0), cB + kstep, voffB); PG8_STAGE(PG8_SA(1, 0), cA + kstep, voffA); PG8_STAGE(PG8_SB(1, 1), cB + hstep + kstep, voffB);
        PG8_WAIT_V(6); PG8_BAR;
    } else {
        PG8_STAGE(PG8_SB(0, 0), cB, voffB); PG8_STAGE(PG8_SA(0, 0), cA, voffA); PG8_STAGE(PG8_SB(0, 1), cB + hstep, voffB); PG8_STAGE(PG8_SA(0, 1), cA + hstep, voffA);
        if (wr == 1) PG8_BAR;
        PG8_WAIT_V(4); PG8_BAR;
        PG8_STAGE(PG8_SB(1, 0), cB + kstep, voffB); PG8_STAGE(PG8_SA(1, 0), cA + kstep, voffA); PG8_STAGE(PG8_SB(1, 1), cB + hstep + kstep, voffB);
        PG8_WAIT_V(6); PG8_BAR;
    }
    for (;;) {
        const bool has_next = S.next(ui + 1, nxt);
        const char* nA = has_next ? (const char*)g.A + (size_t)nxt.pm * tstep : cA; const char* nB = has_next ? (const char*)g.Bt + (size_t)nxt.pn * tstep : cB;
        for (int t = 0; t < nt; t += 2) {
            const bool last = (t == nt - 2);
            const char* a1 = cA + (size_t)(t + 1) * kstep;
            const char* a2 = last ? nA : cA + (size_t)(t + 2) * kstep; const char* b2 = last ? nB : cB + (size_t)(t + 2) * kstep;
            const char* a3 = a2 + kstep; const char* b3 = b2 + kstep;
            if (last && has_next) S.a_ready(nxt);
            if constexpr (SP2) {
            PG8_LDB(B0, 0, 0); PG8_LDB(B1, 0, 1); PG8_SCHED; PG8_LDA(At, 0, 0); PG8_STAGE(PG8_SA(1, 1), a1 + hstep, voffA);
            PG8_WAIT_V(8); PG8_WAIT_L(0); PG8_BAR; PG8_MMA(0, 0, At, B0); PG8_MMA(0, 1, At, B1); PG8_BAR; PG8_SCHED;
            PG8_LDA(At, 0, 1); PG8_STAGE(PG8_SB(0, 0), b2, voffB); PG8_STAGE(PG8_SB(0, 1), b2 + hstep, voffB); PG8_STAGE(PG8_SA(0, 0), a2, voffA);
            PG8_WAIT_V(8); PG8_WAIT_L(0); PG8_BAR; PG8_MMA(1, 0, At, B0); PG8_MMA(1, 1, At, B1); PG8_BAR; PG8_SCHED;
            PG8_LDB(B0, 1, 0); PG8_LDB(B1, 1, 1); PG8_SCHED; PG8_LDA(At, 1, 0); PG8_STAGE(PG8_SA(0, 1), a2 + hstep, voffA);
            PG8_WAIT_V(8); PG8_WAIT_L(0); PG8_BAR; PG8_MMA(0, 0, At, B0); PG8_MMA(0, 1, At, B1); PG8_BAR; PG8_SCHED;
            PG8_LDA(At, 1, 1); PG8_STAGE(PG8_SB(1, 0), b3, voffB); PG8_STAGE(PG8_SB(1, 1), b3 + hstep, voffB); PG8_STAGE(PG8_SA(1, 0), a3, voffA);
            PG8_WAIT_V(8); PG8_WAIT_L(0); PG8_BAR; PG8_MMA(1, 0, At, B0); PG8_MMA(1, 1, At, B1); PG8_BAR; PG8_SCHED;
            } else {
            PG8_LDB(B0, 0, 0); PG8_SCHED; PG8_LDA(At, 0, 0); PG8_STAGE(PG8_SA(1, 1), a1 + hstep, voffA);
            PG8_WAIT_L(8); PG8_BAR; PG8_WAIT_L(0); PG8_MMA(0, 0, At, B0); PG8_BAR; PG8_SCHED;
            PG8_LDB(B1, 0, 1); PG8_STAGE(PG8_SB(0, 0), b2, voffB);
            PG8_BAR; PG8_WAIT_L(0); PG8_MMA(0, 1, At, B1); PG8_BAR;
            PG8_LDA(At, 0, 1); PG8_STAGE(PG8_SA(0, 0), a2, voffA);
            PG8_BAR; PG8_WAIT_L(0); PG8_MMA(1, 0, At, B0); PG8_BAR; PG8_SCHED;
            PG8_STAGE(PG8_SB(0, 1), b2 + hstep, voffB);
            PG8_WAIT_V(6); PG8_BAR; PG8_MMA(1, 1, At, B1); PG8_BAR;
            PG8_LDB(B0, 1, 0); PG8_SCHED; PG8_LDA(At, 1, 0); PG8_STAGE(PG8_SA(0, 1), a2 + hstep, voffA);
            PG8_WAIT_L(8); PG8_BAR; PG8_WAIT_L(0); PG8_MMA(0, 0, At, B0); PG8_BAR; PG8_SCHED;
            PG8_LDB(B1, 1, 1); PG8_STAGE(PG8_SB(1, 0), b3, voffB);
            PG8_BAR; PG8_WAIT_L(0); PG8_MMA(0, 1, At, B1); PG8_BAR;
            PG8_LDA(At, 1, 1); PG8_STAGE(PG8_SA(1, 0), a3, voffA);
            PG8_BAR; PG8_WAIT_L(0); PG8_MMA(1, 0, At, B0); PG8_BAR; PG8_SCHED;
            PG8_STAGE(PG8_SB(1, 1), b3 + hstep, voffB);
            PG8_WAIT_V(6); PG8_BAR; PG8_MMA(1, 1, At, B1); PG8_BAR;
            }
        }
        if constexpr (ALIGN_EPI) { if (wr == 0) PG8_BAR; }
        if constexpr (!Epi::AFTER_DRAIN) { E(acc, cur, wr, wc, fr, fq); S.done(cur); }
        if (!has_next) break;
#pragma unroll
        for (int a = 0; a < 2; ++a)
#pragma unroll
            for (int b = 0; b < 2; ++b)
#pragma unroll
                for (int m = 0; m < 4; ++m)
#pragma unroll
                    for (int n = 0; n < 2; ++n) acc[a][b][m][n] = (f32x4){0.f, 0.f, 0.f, 0.f};
        cur = nxt; cA = nA; cB = nB; ++ui;
        if constexpr (ALIGN_EPI) { if (wr == 1) PG8_BAR; }
    }
    PG8_WAIT_V(0);
    if constexpr (!ALIGN_EPI) { if (wr == 0) PG8_BAR; }
    PG8_BAR;
    if constexpr (Epi::AFTER_DRAIN) { E.fused(acc, cur, wr, wc, fr, fq, lds, wid, lane); S.done(cur); }
#undef PG8_SA
#undef PG8_SB
#undef PG8_STAGE
#undef PG8_LDA
#undef PG8_LDB
#undef PG8_MMA
#undef PG8_WAIT_V
#undef PG8_WAIT_L
#undef PG8_BAR
#undef PG8_SCHED
}
}
#define LAS __attribute__((address_space(3)))
#define GAS __attribute__((address_space(1)))
typedef GAS unsigned gu32;
typedef GAS unsigned long long gu64;
#define RLX_AGENT __ATOMIC_RELAXED, __HIP_MEMORY_SCOPE_AGENT
#define LDS_WAIT() asm volatile("s_waitcnt lgkmcnt(0)" ::: "memory")
#define VM_WAIT() asm volatile("s_waitcnt vmcnt(0)" ::: "memory")
__device__ __forceinline__ unsigned long long rt() { return __builtin_amdgcn_s_memrealtime(); }
#define XB_TMO      128
#define XB_XCNT(j)  (256  + 64 * (j))
#define XB_XSUB(j)  (1280 + 64 * (j))
#define XB_XGEN(j)  (2304 + 64 * (j))
#define XB_TOP      3328
#define XB_TOPGEN   3392
#define XCD_BAR_WORDS 3456
#define XB_SPIN_CAP (1u << 18)

__device__ __forceinline__ unsigned xb_ld(unsigned* p)              { return __hip_atomic_load(p, __ATOMIC_RELAXED, __HIP_MEMORY_SCOPE_AGENT); }
__device__ __forceinline__ unsigned xb_add(unsigned* p, unsigned v) { return __hip_atomic_fetch_add(p, v, __ATOMIC_RELAXED, __HIP_MEMORY_SCOPE_AGENT); }
__device__ __forceinline__ unsigned xb_xcc_id() { return (unsigned)__builtin_amdgcn_s_getreg((3 << 11) | 20) & 0xFu; }
#define XB_SPIN(cond, bar) do { unsigned _sp = 0; while (cond) { __builtin_amdgcn_s_sleep(1); \
    if ((++_sp & 255u) == 0u) { if (xb_ld(&(bar)[XB_TMO])) break; if (_sp > XB_SPIN_CAP) { atomicAdd(&(bar)[XB_TMO], 1u); break; } } } } while (0)

struct XcdBarrier {
    unsigned* bar; unsigned x;
    volatile LAS unsigned* st;
};

__device__ __forceinline__ XcdBarrier xcd_barrier_post(unsigned* bar, volatile LAS unsigned* st, const bool t0) {
    XcdBarrier b; b.bar = bar; b.x = xb_xcc_id(); b.st = st;
    if (t0) (void)xb_add(&bar[XB_XCNT(b.x)], 1u);
    return b;
}
__device__ __forceinline__ void xcd_barrier_complete(unsigned* bar, unsigned x, unsigned& nloc, unsigned& nx) {
    const unsigned G = gridDim.x * gridDim.y * gridDim.z;
    unsigned sum, cnt, mine, sp = 0u;
    for (;;) {
        sum = 0u; cnt = 0u; mine = 0u;
#pragma unroll
        for (unsigned j = 0; j < 16; ++j) { const unsigned c = xb_ld(&bar[XB_XCNT(j)]); sum += c; cnt += (c > 0u) ? 1u : 0u; mine = (j == x) ? c : mine; }
        if (sum == G) break;
        __builtin_amdgcn_s_sleep(1);
        if ((++sp & 255u) == 0u) { if (xb_ld(&bar[XB_TMO])) break; if (sp > XB_SPIN_CAP) { atomicAdd(&bar[XB_TMO], 1u); break; } }
    }
    nloc = mine > 0u ? mine : 1u; nx = cnt > 0u ? cnt : 1u;
}

__device__ __forceinline__ void xcd_barrier(const XcdBarrier& b, const bool t0) {
    asm volatile("s_waitcnt vmcnt(0)" ::: "memory");
    __syncthreads();
    if (t0) {
        unsigned* bar = b.bar;
        __builtin_amdgcn_s_waitcnt(0);
        unsigned nloc = b.st[0], nx = b.st[1];
        if (nloc == 0u) { xcd_barrier_complete(bar, b.x, nloc, nx); b.st[0] = nloc; b.st[1] = nx; }
        const unsigned old = xb_add(&bar[XB_XSUB(b.x)], 1u);
        const unsigned gen = old / nloc;
        if (old + 1u == (gen + 1u) * nloc) {
            __builtin_amdgcn_fence(__ATOMIC_RELEASE, "agent");
            asm volatile("s_waitcnt vmcnt(0)" ::: "memory");
            const unsigned og = xb_add(&bar[XB_TOP], 1u);
            const unsigned tg = og / nx;
            if (og + 1u == (tg + 1u) * nx) xb_add(&bar[XB_TOPGEN], 1u);
            else XB_SPIN(xb_ld(&bar[XB_TOPGEN]) == tg, bar);
            __builtin_amdgcn_fence(__ATOMIC_ACQUIRE, "agent");
            xb_add(&bar[XB_XGEN(b.x)], 1u);
            asm volatile("s_waitcnt vmcnt(0)" ::: "memory");
        } else {
            XB_SPIN(xb_ld(&bar[XB_XGEN(b.x)]) == gen, bar);
            __builtin_amdgcn_fence(__ATOMIC_ACQUIRE, "agent");
            asm volatile("s_waitcnt vmcnt(0)" ::: "memory");
        }
    }
    __syncthreads();
}
constexpr int BATCH = 2, SEQ = 16384, DM = 2048, MTOK = BATCH * SEQ;
constexpr int E_IN = 6144, O_INP = 8448  , O_LD = 8192;
constexpr int S5G = 64, S5P = 64, S5T = 128, S5NC = SEQ / S5T;
constexpr float LOG2E = 1.4426950408889634f;
constexpr float RMS_EPS = 1e-6f;
constexpr int NWAVES = 8;

#define LAS __attribute__((address_space(3)))
typedef unsigned short bf16_t;
typedef short bf16x8 __attribute__((ext_vector_type(8)));
typedef float f32x4 __attribute__((ext_vector_type(4)));
typedef float f32x2 __attribute__((ext_vector_type(2)));
typedef float f32x16 __attribute__((ext_vector_type(16)));
typedef unsigned u32x4 __attribute__((ext_vector_type(4)));
typedef unsigned u32x2 __attribute__((ext_vector_type(2)));
typedef short v4i16_t __attribute__((ext_vector_type(4)));
typedef __bf16 bf16x2_t __attribute__((ext_vector_type(2)));

constexpr size_t MiB = 1u << 20;
constexpr size_t WS_CTL = 0;
constexpr size_t WS_LAMB = 1 * MiB;
constexpr size_t WS_LAMT = 1 * MiB + 65536;
constexpr size_t WS_BBAR = 2 * MiB;
constexpr size_t WS_CMAT = 3 * MiB;
constexpr size_t WS_BIASDA = 4 * MiB;
constexpr size_t WS_BIASF = 5 * MiB;
constexpr size_t WS_FLOG = 7 * MiB;
constexpr size_t WS_S5ST = 9 * MiB;
constexpr size_t WS_WIN0 = 20 * MiB;
constexpr size_t WS_WOUT0 = 44 * MiB;
constexpr size_t WS_WGLU = 52 * MiB;
constexpr size_t WS_WIN1 = 54 * MiB;
constexpr size_t WS_WOUT1 = 87 * MiB;
constexpr size_t WS_HBUF = 96 * MiB;
constexpr size_t WS_PROJ = 224 * MiB;
constexpr size_t WS_YCAT = 736 * MiB;
constexpr size_t WS_END = 864 * MiB;
constexpr int CW_BAR = 4096;
constexpr int CW_QDA = 64, CW_QFOX = 128, CW_LAM = 192, CW_THRDA = 193, CW_THRF = 194;
constexpr float ZERO_THR = 105.f;

constexpr int LDS_MISC = 135168;
constexpr int LDS_BYTES = 147456;
constexpr int AL_K = 0, AL_V = 32768, AL_B = 65536;
constexpr int LDS_STASH = 69632;

__device__ __forceinline__ float bf2f(unsigned b) { return __uint_as_float(b << 16); }
__device__ __forceinline__ unsigned pk2(float lo, float hi) { f32x2 v = {lo, hi}; bf16x2_t b = __builtin_convertvector(v, bf16x2_t); return __builtin_bit_cast(unsigned, b); }
__device__ __forceinline__ float bflo(unsigned w) { return __uint_as_float(w << 16); }
__device__ __forceinline__ float bfhi(unsigned w) { return __uint_as_float(w & 0xffff0000u); }
__device__ __forceinline__ float sigmoidf_(float x) { return 1.f / (1.f + __expf(-x)); }
__device__ __forceinline__ float siluf_(float x) { return x * sigmoidf_(x); }
__device__ __forceinline__ float gelu_tanh(float x) { const float z = 0.7978845608028654f * (x + 0.044715f * x * x * x); const float t = 1.f - 2.f / (1.f + __expf(2.f * z)); return 0.5f * x * (1.f + t); }
#define DOT2(a, b, c) __builtin_amdgcn_fdot2_f32_bf16(__builtin_bit_cast(bf16x2_t, (unsigned)(a)), __builtin_bit_cast(bf16x2_t, (unsigned)(b)), (c), false)
__device__ __forceinline__ int crow(int r, int hi) { return (r & 3) + 8 * (r >> 2) + 4 * hi; }
__device__ __forceinline__ float wave_sum(float v) {
#pragma unroll
    for (int o = 1; o < 64; o <<= 1) v += __shfl_xor(v, o);
    return v;
}

struct Args {
    const float* in[27];
    float* out; unsigned char* ws;
    int ph_lo, ph_hi;
};

namespace pg8 {
struct EpiProj1 {
    static constexpr bool PERM = true, AFTER_DRAIN = false;
    bf16_t* O; float* flog;
    __device__ __forceinline__ void operator()(const f32x4 (&acc)[2][2][4][2], const Unit& u, int wr, int wc, int fr, int fq) const {
        const int row0 = u.pm * BM + wr * 64 + fr;
        if (u.pn < 32) {
            const int col0 = u.pn * BM + wc * 32 + 8 * fq;
#pragma unroll
            for (int ai = 0; ai < 2; ++ai)
#pragma unroll
                for (int m = 0; m < 4; ++m) { bf16_t* rowp = O + (size_t)(row0 + ai * HALF + m * 16) * O_LD + col0;
#pragma unroll
                    for (int bj = 0; bj < 2; ++bj) { const f32x4 v0 = acc[ai][bj][m][0], v1 = acc[ai][bj][m][1];
                        u32x4 w; w.x = cvt_pk_bf16(v0[0], v0[1]); w.y = cvt_pk_bf16(v0[2], v0[3]); w.z = cvt_pk_bf16(v1[0], v1[1]); w.w = cvt_pk_bf16(v1[2], v1[3]);
                        *(u32x4*)(rowp + bj * HALF) = w; } }
        } else if (wc == 0 && fq < 2) {
#pragma unroll
            for (int ai = 0; ai < 2; ++ai)
#pragma unroll
                for (int m = 0; m < 4; ++m) { float* rp = flog + (size_t)(row0 + ai * HALF + m * 16) * 16 + 8 * fq;
                    *(f32x4*)(rp) = acc[ai][0][m][0]; *(f32x4*)(rp + 4) = acc[ai][0][m][1]; }
        }
    }
};
struct EpiGlu {
    static constexpr bool PERM = true, AFTER_DRAIN = false;
    bf16_t* O; const bf16_t* yg; const bf16_t* proj0; const float* bglu;
    __device__ __forceinline__ void operator()(const f32x4 (&acc)[2][2][4][2], const Unit& u, int wr, int wc, int fr, int fq) const {
        const int row0 = u.pm * BM + wr * 64 + fr; const int col0 = u.pn * BM + wc * 32 + 8 * fq;
#pragma unroll
        for (int ai = 0; ai < 2; ++ai)
#pragma unroll
            for (int m = 0; m < 4; ++m) { const size_t row = (size_t)(row0 + ai * HALF + m * 16);
#pragma unroll
                for (int bj = 0; bj < 2; ++bj) { const int c = col0 + bj * HALF;
                    const f32x4 b0 = *(const f32x4*)(bglu + c), b1 = *(const f32x4*)(bglu + c + 4);
                    const u32x4 yv = *(const u32x4*)(yg + row * 1024 + c); const u32x4 zv = *(const u32x4*)(proj0 + row * E_IN + 1024 + c);
                    const f32x4 v0 = acc[ai][bj][m][0] + b0, v1 = acc[ai][bj][m][1] + b1;
                    float r[8];
#pragma unroll
                    for (int e = 0; e < 4; ++e) { const unsigned yw = yv[e], zw = zv[e];
                        const float a0 = e < 2 ? v0[2 * e] : v1[2 * e - 4], a1 = e < 2 ? v0[2 * e + 1] : v1[2 * e - 3];
                        r[2 * e] = bflo(yw) * sigmoidf_(a0) * siluf_(bflo(zw)); r[2 * e + 1] = bfhi(yw) * sigmoidf_(a1) * siluf_(bfhi(zw)); }
                    u32x4 w; w.x = cvt_pk_bf16(r[0], r[1]); w.y = cvt_pk_bf16(r[2], r[3]); w.z = cvt_pk_bf16(r[4], r[5]); w.w = cvt_pk_bf16(r[6], r[7]);
                    *(u32x4*)(O + row * DM + c) = w; } }
    }
};
struct EpiResid {
    static constexpr bool PERM = false, AFTER_DRAIN = false;
    const float* base; float* out;
    __device__ __forceinline__ void operator()(const f32x4 (&acc)[2][2][4][2], const Unit& u, int wr, int wc, int fr, int fq) const {
        const int row0 = u.pm * BM + wr * 64 + fr; const int col0 = u.pn * BM + wc * 32 + 4 * fq;
#pragma unroll
        for (int ai = 0; ai < 2; ++ai)
#pragma unroll
            for (int m = 0; m < 4; ++m) { const size_t off = (size_t)(row0 + ai * HALF + m * 16) * DM + col0;
#pragma unroll
                for (int bj = 0; bj < 2; ++bj)
#pragma unroll
                    for (int n = 0; n < 2; ++n) { const f32x4 bs = *(const f32x4*)(base + off + bj * HALF + n * 16); *(f32x4*)(out + off + bj * HALF + n * 16) = bs + acc[ai][bj][m][n]; } }
    }
};
}

__device__ __forceinline__ void transpose_item(const float* __restrict__ W, int K, int N, bf16_t* __restrict__ WT, LAS float* scr, int item, int nblk, int lane) {
    const int kb = item / nblk, nb = item % nblk, k0 = 64 * kb, n0 = 32 * nb;
    const int nc = n0 + (lane & 31);
#pragma unroll 8
    for (int i = 0; i < 32; ++i) { const int kk = 2 * i + (lane >> 5); scr[kk * 33 + (lane & 31)] = (nc < N) ? W[(size_t)(k0 + kk) * N + nc] : 0.f; }
    asm volatile("s_waitcnt lgkmcnt(0)" ::: "memory");
    const int c = lane & 7;
#pragma unroll
    for (int j = 0; j < 4; ++j) { const int n = (lane >> 3) + 8 * j; const LAS float* s = scr + (8 * c) * 33 + n;
        u32x4 o; o.x = pk2(s[0 * 33], s[1 * 33]); o.y = pk2(s[2 * 33], s[3 * 33]); o.z = pk2(s[4 * 33], s[5 * 33]); o.w = pk2(s[6 * 33], s[7 * 33]);
        *(u32x4*)(WT + (size_t)(n0 + n) * K + k0 + 8 * c) = o; }
    asm volatile("s_waitcnt lgkmcnt(0)" ::: "memory");
}
__device__ __forceinline__ void rms_row_to_bf16(const float* __restrict__ xrow, const float* __restrict__ gain, bf16_t* __restrict__ orow, int lane) {
    const f32x4* xr = (const f32x4*)xrow + lane; const f32x4* gr = (const f32x4*)gain + lane;
    f32x4 v[8]; float s = 0.f;
#pragma unroll
    for (int j = 0; j < 8; ++j) { v[j] = xr[64 * j]; s += (v[j].x * v[j].x + v[j].y * v[j].y) + (v[j].z * v[j].z + v[j].w * v[j].w); }
    const float r = 1.f / sqrtf(wave_sum(s) * (1.f / DM) + RMS_EPS);
    u32x2* o8 = (u32x2*)orow + lane;
#pragma unroll
    for (int j = 0; j < 8; ++j) { const f32x4 g = gr[64 * j]; u32x2 w; w.x = pk2(v[j].x * r * g.x, v[j].y * r * g.y); w.y = pk2(v[j].z * r * g.z, v[j].w * r * g.w); o8[64 * j] = w; }
}
template <int LPS>
__device__ __forceinline__ void qknorm16(bf16_t* p, const float* __restrict__ gain16, float mul, float inv_n) {
    u32x4 a = *(u32x4*)p, b = *(u32x4*)(p + 8);
    float v[16];
#pragma unroll
    for (int e = 0; e < 4; ++e) { v[2 * e] = bflo(a[e]); v[2 * e + 1] = bfhi(a[e]); v[8 + 2 * e] = bflo(b[e]); v[9 + 2 * e] = bfhi(b[e]); }
    float s = 0.f;
#pragma unroll
    for (int e = 0; e < 16; ++e) s += v[e] * v[e];
#pragma unroll
    for (int o = 1; o < LPS; o <<= 1) s += __shfl_xor(s, o);
    const float r = mul / sqrtf(s * inv_n + RMS_EPS);
#pragma unroll
    for (int e = 0; e < 16; ++e) v[e] = v[e] * r * gain16[e];
#pragma unroll
    for (int e = 0; e < 4; ++e) { a[e] = pk2(v[2 * e], v[2 * e + 1]); b[e] = pk2(v[8 + 2 * e], v[9 + 2 * e]); }
    *(u32x4*)p = a; *(u32x4*)(p + 8) = b;
}
__device__ __forceinline__ void rms_rows2_to_bf16(const float* __restrict__ x0, const float* __restrict__ x1, const bool has1, const float* __restrict__ gain, bf16_t* __restrict__ o0, bf16_t* __restrict__ o1, int lane) {
    const f32x4* xr0 = (const f32x4*)x0 + lane; const f32x4* xr1 = (const f32x4*)x1 + lane; const f32x4* gr = (const f32x4*)gain + lane;
    f32x4 v[8], w[8]; float s0 = 0.f, s1 = 0.f;
#pragma unroll
    for (int j = 0; j < 8; ++j) v[j] = xr0[64 * j];
    if (has1) {
#pragma unroll
        for (int j = 0; j < 8; ++j) w[j] = xr1[64 * j];
    }
#pragma unroll
    for (int j = 0; j < 8; ++j) s0 += (v[j].x * v[j].x + v[j].y * v[j].y) + (v[j].z * v[j].z + v[j].w * v[j].w);
    const float r0 = 1.f / sqrtf(wave_sum(s0) * (1.f / DM) + RMS_EPS);
    u32x2* p0 = (u32x2*)o0 + lane;
#pragma unroll
    for (int j = 0; j < 8; ++j) { const f32x4 g = gr[64 * j]; u32x2 q; q.x = pk2(v[j].x * r0 * g.x, v[j].y * r0 * g.y); q.y = pk2(v[j].z * r0 * g.z, v[j].w * r0 * g.w); p0[64 * j] = q; }
    if (has1) {
#pragma unroll
        for (int j = 0; j < 8; ++j) s1 += (w[j].x * w[j].x + w[j].y * w[j].y) + (w[j].z * w[j].z + w[j].w * w[j].w);
        const float r1 = 1.f / sqrtf(wave_sum(s1) * (1.f / DM) + RMS_EPS);
        u32x2* p1 = (u32x2*)o1 + lane;
#pragma unroll
        for (int j = 0; j < 8; ++j) { const f32x4 g = gr[64 * j]; u32x2 q; q.x = pk2(w[j].x * r1 * g.x, w[j].y * r1 * g.y); q.y = pk2(w[j].z * r1 * g.z, w[j].w * r1 * g.w); p1[64 * j] = q; }
    }
}
template <int LPS>
__device__ __forceinline__ void qknorm_regs(u32x4& a, u32x4& b, const float* __restrict__ gp, float mul, float inv_n) {
    float v[16];
#pragma unroll
    for (int e = 0; e < 4; ++e) { v[2 * e] = bflo(a[e]); v[2 * e + 1] = bfhi(a[e]); v[8 + 2 * e] = bflo(b[e]); v[9 + 2 * e] = bfhi(b[e]); }
    float s = 0.f;
#pragma unroll
    for (int e = 0; e < 16; ++e) s += v[e] * v[e];
#pragma unroll
    for (int o = 1; o < LPS; o <<= 1) s += __shfl_xor(s, o);
    const float r = mul / sqrtf(s * inv_n + RMS_EPS);
#pragma unroll
    for (int e = 0; e < 4; ++e) { const f32x4 gg = *(const f32x4*)(gp + 4 * e);
        v[4 * e] *= r * gg.x; v[4 * e + 1] *= r * gg.y; v[4 * e + 2] *= r * gg.z; v[4 * e + 3] *= r * gg.w; }
#pragma unroll
    for (int e = 0; e < 4; ++e) { a[e] = pk2(v[2 * e], v[2 * e + 1]); b[e] = pk2(v[8 + 2 * e], v[9 + 2 * e]); }
}
template <int NIT, int NQ, int LPS>
__device__ __forceinline__ void qknorm_rows2(bf16_t* p0, bf16_t* p1, const bool has1, const float* __restrict__ gq, const float* __restrict__ gk, const float qmul, const float inv_n, const int lane) {
    u32x4 a0[NIT], b0[NIT], a1[NIT], b1[NIT];
#pragma unroll
    for (int it = 0; it < NIT; ++it) { a0[it] = *(const u32x4*)(p0 + it * 1024 + lane * 16); b0[it] = *(const u32x4*)(p0 + it * 1024 + lane * 16 + 8); }
    if (has1) {
#pragma unroll
        for (int it = 0; it < NIT; ++it) { a1[it] = *(const u32x4*)(p1 + it * 1024 + lane * 16); b1[it] = *(const u32x4*)(p1 + it * 1024 + lane * 16 + 8); }
    }
#pragma unroll
    for (int it = 0; it < NIT; ++it) { const float* gp = (it < NQ ? gq : gk) + ((lane * 16) & 127);
        qknorm_regs<LPS>(a0[it], b0[it], gp, it < NQ ? qmul : 1.f, inv_n);
        *(u32x4*)(p0 + it * 1024 + lane * 16) = a0[it]; *(u32x4*)(p0 + it * 1024 + lane * 16 + 8) = b0[it]; }
    if (has1) {
#pragma unroll
        for (int it = 0; it < NIT; ++it) { const float* gp = (it < NQ ? gq : gk) + ((lane * 16) & 127);
            qknorm_regs<LPS>(a1[it], b1[it], gp, it < NQ ? qmul : 1.f, inv_n);
            *(u32x4*)(p1 + it * 1024 + lane * 16) = a1[it]; *(u32x4*)(p1 + it * 1024 + lane * 16 + 8) = b1[it]; }
    }
}

template <int DQK>
__device__ __forceinline__ void attn_pass(LAS unsigned char* lds, const bf16_t* __restrict__ Qg, const bf16_t* __restrict__ Kg, const bf16_t* __restrict__ Vg,
                                          const float* __restrict__ btab, const float bscale, const int pitch, const int q0, const int t_lo, f32x16 (&o)[4], const int wid, const int lane) {
    constexpr int NCH = DQK / 8, KS = DQK / 16, KROWB = DQK * 2, KI = NCH / 8;
    const int tid = wid * 64 + lane, r32 = lane & 31, hi = lane >> 5;
    const int NT = (q0 + 256) / 64;
    const int qrel = wid * 32 + r32;
    bf16x8 qf[KS];
#pragma unroll
    for (int s = 0; s < KS; ++s) qf[s] = *(const bf16x8*)(Qg + (size_t)(q0 + qrel) * pitch + 16 * s + 8 * hi);
    int kgo[KI], klo[KI], vgo[2], vlo[2];
#pragma unroll
    for (int i = 0; i < KI; ++i) { const int cid = tid + 512 * i, row = cid / NCH, ch = cid % NCH; const int sw = (DQK == 128) ? (row & 15) : ((row >> 1) & 7);
        kgo[i] = row * pitch + ch * 8; klo[i] = row * KROWB + ((ch ^ sw) << 4); }
#pragma unroll
    for (int i = 0; i < 2; ++i) { const int cid = tid + 512 * i, row = cid >> 4, ch = cid & 15;
        vgo[i] = row * pitch + ch * 8; vlo[i] = (ch >> 2) * 4096 + (row >> 3) * 512 + (row & 7) * 64 + (ch & 3) * 16; }
    const float bref = btab[q0];
    u32x4 kreg[KI], vreg[2]; float breg = 0.f;
#define AT_LOAD(t) do { const size_t kvb_ = (size_t)(64 * (t)) * pitch; \
        _Pragma("unroll") for (int i = 0; i < KI; ++i) kreg[i] = *(const u32x4*)(Kg + kvb_ + kgo[i]); \
        _Pragma("unroll") for (int i = 0; i < 2; ++i) vreg[i] = *(const u32x4*)(Vg + kvb_ + vgo[i]); \
        if (tid < 64) breg = (btab[64 * (t) + tid] - bref) * bscale; } while (0)
#define AT_STORE(buf) do { \
        _Pragma("unroll") for (int i = 0; i < KI; ++i) *(LAS u32x4*)(lds + AL_K + (buf) * 16384 + klo[i]) = kreg[i]; \
        _Pragma("unroll") for (int i = 0; i < 2; ++i) *(LAS u32x4*)(lds + AL_V + (buf) * 16384 + vlo[i]) = vreg[i]; \
        if (tid < 64) *(LAS float*)(lds + AL_B + (buf) * 256 + tid * 4) = breg; } while (0)
    float m_run = -INFINITY, l_run = 0.f;
#pragma unroll
    for (int b = 0; b < 4; ++b)
#pragma unroll
        for (int r = 0; r < 16; ++r) o[b][r] = 0.f;
    AT_LOAD(t_lo); AT_STORE(0); __syncthreads();
    const int ksw = (DQK == 128) ? (r32 & 15) : ((r32 >> 1) & 7);
    const int vlane = (4 * hi + ((lane & 15) >> 2)) * 64 + ((lane >> 4) & 1) * 32 + (lane & 3) * 8;
    for (int t = t_lo; t < NT; ++t) {
        const int cur = (t - t_lo) & 1;
        if (t + 1 < NT) AT_LOAD(t + 1);
        const int jb = t - (NT - 4);
        const bool skip = (jb >= 0) && (2 * jb > wid);
        if (!skip) {
            LAS const unsigned char* Kb = lds + AL_K + cur * 16384;
            f32x16 s0, s1;
            LAS const float* bl = (LAS const float*)(lds + AL_B + cur * 256);
#pragma unroll
            for (int g = 0; g < 4; ++g) { const f32x4 b0 = *(LAS const f32x4*)(bl + 8 * g + 4 * hi), b1 = *(LAS const f32x4*)(bl + 32 + 8 * g + 4 * hi);
#pragma unroll
                for (int e = 0; e < 4; ++e) { s0[4 * g + e] = b0[e]; s1[4 * g + e] = b1[e]; } }
#pragma unroll
            for (int s = 0; s < KS; ++s) { const int ch = 2 * s + hi;
                const bf16x8 a0 = *(LAS const bf16x8*)(Kb + r32 * KROWB + ((ch ^ ksw) << 4));
                const bf16x8 a1 = *(LAS const bf16x8*)(Kb + (32 + r32) * KROWB + ((ch ^ ksw) << 4));
                s0 = __builtin_amdgcn_mfma_f32_32x32x16_bf16(a0, qf[s], s0, 0, 0, 0);
                s1 = __builtin_amdgcn_mfma_f32_32x32x16_bf16(a1, qf[s], s1, 0, 0, 0); }
            if ((jb >= 0) && (2 * jb + 1 >= wid)) {
#pragma unroll
                for (int r = 0; r < 16; ++r) { const int kv = 64 * jb + crow(r, hi); if (kv > qrel) s0[r] = -INFINITY; if (kv + 32 > qrel) s1[r] = -INFINITY; }
            }
            float mx = fmaxf(s0[0], s1[0]);
#pragma unroll
            for (int r = 1; r < 16; ++r) mx = fmaxf(mx, fmaxf(s0[r], s1[r]));
            mx = fmaxf(mx, __shfl_xor(mx, 32));
            if (__any(mx > m_run + 8.f)) {
                const float m_new = fmaxf(m_run, mx);
                const float alpha = __builtin_amdgcn_exp2f(m_run - m_new);
                m_run = m_new; l_run *= alpha;
#pragma unroll
                for (int b = 0; b < 4; ++b)
#pragma unroll
                    for (int r = 0; r < 16; ++r) o[b][r] *= alpha;
            }
            float rs = 0.f;
#pragma unroll
            for (int r = 0; r < 16; ++r) { s0[r] = __builtin_amdgcn_exp2f(s0[r] - m_run); s1[r] = __builtin_amdgcn_exp2f(s1[r] - m_run); rs += s0[r] + s1[r]; }
            l_run += rs;
            u32x4 pw[4];
#pragma unroll
            for (int e = 0; e < 4; ++e) { pw[0][e] = pk2(s0[2 * e], s0[2 * e + 1]); pw[1][e] = pk2(s0[8 + 2 * e], s0[9 + 2 * e]); pw[2][e] = pk2(s1[2 * e], s1[2 * e + 1]); pw[3][e] = pk2(s1[8 + 2 * e], s1[9 + 2 * e]); }
            LAS const unsigned char* Vb = lds + AL_V + cur * 16384 + vlane;
#pragma unroll
            for (int b = 0; b < 4; ++b)
#pragma unroll
                for (int ks = 0; ks < 4; ++ks) {
                    const v4i16_t lo = __builtin_amdgcn_ds_read_tr16_b64_v4i16((LAS v4i16_t*)(Vb + b * 4096 + ks * 1024));
                    const v4i16_t hh = __builtin_amdgcn_ds_read_tr16_b64_v4i16((LAS v4i16_t*)(Vb + b * 4096 + ks * 1024 + 512));
                    const bf16x8 af = {lo[0], lo[1], lo[2], lo[3], hh[0], hh[1], hh[2], hh[3]};
                    o[b] = __builtin_amdgcn_mfma_f32_32x32x16_bf16(af, __builtin_bit_cast(bf16x8, pw[ks]), o[b], 0, 0, 0);
                }
        }
        if (t + 1 < NT) AT_STORE(cur ^ 1);
        __syncthreads();
    }
#undef AT_LOAD
#undef AT_STORE
    const float l = l_run + __shfl_xor(l_run, 32);
    const float inv = 1.f / l;
#pragma unroll
    for (int b = 0; b < 4; ++b)
#pragma unroll
        for (int r = 0; r < 16; ++r) o[b][r] *= inv;
}

template <int DQK>
__device__ __forceinline__ void qk_tile(LAS const unsigned char* Kb, LAS const float* bl, const bf16x8* qf, const int ksw, const int r32, const int hi, f32x16& s0, f32x16& s1) {
    constexpr int KS = DQK / 16, KROWB = DQK * 2;
#pragma unroll
    for (int g = 0; g < 4; ++g) { const f32x4 b0 = *(LAS const f32x4*)(bl + 8 * g + 4 * hi), b1 = *(LAS const f32x4*)(bl + 32 + 8 * g + 4 * hi);
#pragma unroll
        for (int e = 0; e < 4; ++e) { s0[4 * g + e] = b0[e]; s1[4 * g + e] = b1[e]; } }
#pragma unroll
    for (int s = 0; s < KS; ++s) { const int ch = 2 * s + hi;
        const bf16x8 a0 = *(LAS const bf16x8*)(Kb + r32 * KROWB + ((ch ^ ksw) << 4));
        const bf16x8 a1 = *(LAS const bf16x8*)(Kb + (32 + r32) * KROWB + ((ch ^ ksw) << 4));
        s0 = __builtin_amdgcn_mfma_f32_32x32x16_bf16(a0, qf[s], s0, 0, 0, 0);
        s1 = __builtin_amdgcn_mfma_f32_32x32x16_bf16(a1, qf[s], s1, 0, 0, 0); }
}
__device__ __forceinline__ void pv_tile(LAS const unsigned char* Vb, const u32x4* pw, f32x16 (&o)[4]) {
#pragma unroll
    for (int ks = 0; ks < 4; ++ks)
#pragma unroll
        for (int b = 0; b < 4; ++b) {
            const v4i16_t lo = __builtin_amdgcn_ds_read_tr16_b64_v4i16((LAS v4i16_t*)(Vb + b * 4096 + ks * 1024));
            const v4i16_t hh = __builtin_amdgcn_ds_read_tr16_b64_v4i16((LAS v4i16_t*)(Vb + b * 4096 + ks * 1024 + 512));
            const bf16x8 af = {lo[0], lo[1], lo[2], lo[3], hh[0], hh[1], hh[2], hh[3]};
            o[b] = __builtin_amdgcn_mfma_f32_32x32x16_bf16(af, __builtin_bit_cast(bf16x8, pw[ks]), o[b], 0, 0, 0);
        }
}
__device__ __forceinline__ void softmax_tile(f32x16& s0, f32x16& s1, float& m_run, float& l_run, float& alpha, bool& resc, u32x4* pw) {
    float mxa = __builtin_fmaxf(s0[0], s1[0]), mxb = __builtin_fmaxf(s0[1], s1[1]);
#pragma unroll
    for (int r = 2; r < 16; r += 2) { mxa = __builtin_fmaxf(__builtin_fmaxf(mxa, s0[r]), s1[r]); mxb = __builtin_fmaxf(__builtin_fmaxf(mxb, s0[r + 1]), s1[r + 1]); }
    float mx = __builtin_fmaxf(mxa, mxb);
    { auto rr = __builtin_amdgcn_permlane32_swap(__float_as_uint(mx), __float_as_uint(mx), false, false); mx = fmaxf(__uint_as_float(rr[0]), __uint_as_float(rr[1])); }
    resc = __any(mx > m_run + 8.f);
    alpha = 1.f;
    if (resc) { const float m_new = fmaxf(m_run, mx); alpha = __builtin_amdgcn_exp2f(m_run - m_new); m_run = m_new; l_run *= alpha; }
    float rs = 0.f;
#pragma unroll
    for (int r = 0; r < 16; ++r) { s0[r] = __builtin_amdgcn_exp2f(s0[r] - m_run); s1[r] = __builtin_amdgcn_exp2f(s1[r] - m_run); rs += s0[r] + s1[r]; }
    l_run += rs;
#pragma unroll
    for (int e = 0; e < 4; ++e) { pw[0][e] = pk2(s0[2 * e], s0[2 * e + 1]); pw[1][e] = pk2(s0[8 + 2 * e], s0[9 + 2 * e]); pw[2][e] = pk2(s1[2 * e], s1[2 * e + 1]); pw[3][e] = pk2(s1[8 + 2 * e], s1[9 + 2 * e]); }
}
__device__ __forceinline__ void softmax_tile_sm(f32x16& s0, f32x16& s1, float& m_run, float& l_run, float& alpha, bool& resc, u32x4* pw, const bool skipmax) {
    resc = false; alpha = 1.f;
    if (!skipmax) {
    float mxa = __builtin_fmaxf(s0[0], s1[0]), mxb = __builtin_fmaxf(s0[1], s1[1]);
#pragma unroll
    for (int r = 2; r < 16; r += 2) { mxa = __builtin_fmaxf(__builtin_fmaxf(mxa, s0[r]), s1[r]); mxb = __builtin_fmaxf(__builtin_fmaxf(mxb, s0[r + 1]), s1[r + 1]); }
    float mx = __builtin_fmaxf(mxa, mxb);
    { auto rr = __builtin_amdgcn_permlane32_swap(__float_as_uint(mx), __float_as_uint(mx), false, false); mx = fmaxf(__uint_as_float(rr[0]), __uint_as_float(rr[1])); }
    resc = __any(mx > m_run + 8.f);
    alpha = 1.f;
    if (resc) { const float m_new = fmaxf(m_run, mx); alpha = __builtin_amdgcn_exp2f(m_run - m_new); m_run = m_new; l_run *= alpha; }
    }
    float rs = 0.f;
#pragma unroll
    for (int r = 0; r < 16; ++r) { s0[r] = __builtin_amdgcn_exp2f(s0[r] - m_run); s1[r] = __builtin_amdgcn_exp2f(s1[r] - m_run); rs += s0[r] + s1[r]; }
    l_run += rs;
#pragma unroll
    for (int e = 0; e < 4; ++e) { pw[0][e] = pk2(s0[2 * e], s0[2 * e + 1]); pw[1][e] = pk2(s0[8 + 2 * e], s0[9 + 2 * e]); pw[2][e] = pk2(s1[2 * e], s1[2 * e + 1]); pw[3][e] = pk2(s1[8 + 2 * e], s1[9 + 2 * e]); }
}
template <int DQK>
__device__ __forceinline__ void attn_pass2(LAS unsigned char* lds, const bf16_t* __restrict__ Qg, const bf16_t* __restrict__ Kg, const bf16_t* __restrict__ Vg,
                                           const float* __restrict__ btab, const float bscale, const int pitch, const int q0, const int t_lo, f32x16 (&o)[4], const int wid, const int lane) {
    constexpr int NCH = DQK / 8, KS = DQK / 16, KROWB = DQK * 2, KI = NCH / 8;
    const int tid = wid * 64 + lane, r32 = lane & 31, hi = lane >> 5;
    const int NT = (q0 + 256) / 64;
    const int T_w = NT - 4 + (wid >> 1);
    const int qrel = wid * 32 + r32;
    bf16x8 qf[KS];
#pragma unroll
    for (int s = 0; s < KS; ++s) qf[s] = *(const bf16x8*)(Qg + (size_t)(q0 + qrel) * pitch + 16 * s + 8 * hi);
    int kgo[KI], klo[KI], vgo[2], vlo[2];
#pragma unroll
    for (int i = 0; i < KI; ++i) { const int cid = tid + 512 * i, row = cid / NCH, ch = cid % NCH; const int sw = (DQK == 128) ? (row & 15) : ((row >> 1) & 7);
        kgo[i] = row * pitch + ch * 8; klo[i] = row * KROWB + ((ch ^ sw) << 4); }
#pragma unroll
    for (int i = 0; i < 2; ++i) { const int cid = tid + 512 * i, row = cid >> 4, ch = cid & 15;
        vgo[i] = row * pitch + ch * 8; vlo[i] = (ch >> 2) * 4096 + (row >> 3) * 512 + (row & 7) * 64 + (ch & 3) * 16; }
    const float bref = btab[q0];
    u32x4 kreg[KI], vreg[2]; float breg = 0.f;
#define AT_LOADK(t) do { const size_t kvb_ = (size_t)(64 * (t)) * pitch; \
        _Pragma("unroll") for (int i = 0; i < KI; ++i) kreg[i] = *(const u32x4*)(Kg + kvb_ + kgo[i]); \
        if (tid < 64) breg = (btab[64 * (t) + tid] - bref) * bscale; } while (0)
#define AT_LOADV(t) do { const size_t kvb_ = (size_t)(64 * (t)) * pitch; \
        _Pragma("unroll") for (int i = 0; i < 2; ++i) vreg[i] = *(const u32x4*)(Vg + kvb_ + vgo[i]); } while (0)
#define AT_STOREK(buf) do { \
        _Pragma("unroll") for (int i = 0; i < KI; ++i) *(LAS u32x4*)(lds + AL_K + (buf) * 16384 + klo[i]) = kreg[i]; \
        if (tid < 64) *(LAS float*)(lds + AL_B + (buf) * 256 + tid * 4) = breg; } while (0)
#define AT_STOREV(buf) do { \
        _Pragma("unroll") for (int i = 0; i < 2; ++i) *(LAS u32x4*)(lds + AL_V + (buf) * 16384 + vlo[i]) = vreg[i]; } while (0)
    float m_run = -INFINITY, l_run = 0.f;
#pragma unroll
    for (int b = 0; b < 4; ++b)
#pragma unroll
        for (int r = 0; r < 16; ++r) o[b][r] = 0.f;
    const int ksw = (DQK == 128) ? (r32 & 15) : ((r32 >> 1) & 7);
    const int vlane = (4 * hi + ((lane & 15) >> 2)) * 64 + ((lane >> 4) & 1) * 32 + (lane & 3) * 8;
    AT_LOADK(t_lo); AT_STOREK(t_lo & 1);
    AT_LOADK(t_lo + 1); AT_STOREK((t_lo + 1) & 1);
    __syncthreads();
    f32x16 sc0, sc1, sn0, sn1;
    u32x4 pprev[4], pnew[4];
#pragma unroll
    for (int k = 0; k < 4; ++k) { pprev[k] = (u32x4){0u, 0u, 0u, 0u}; pnew[k] = (u32x4){0u, 0u, 0u, 0u}; }
    qk_tile<DQK>(lds + AL_K + (t_lo & 1) * 16384, (LAS const float*)(lds + AL_B + (t_lo & 1) * 256), qf, ksw, r32, hi, sc0, sc1);
#pragma unroll
    for (int r = 0; r < 16; ++r) { sn0[r] = 0.f; sn1[r] = 0.f; }
    for (int t = t_lo; t < NT; ++t) {
        const int pn = (t + 1) & 1, pc = t & 1;
        if (t + 2 < NT) AT_LOADK(t + 2);
        AT_LOADV(t);
        float alpha = 1.f; bool resc = false;
        if ((t > t_lo) && (t < NT - 4)) {
            qk_tile<DQK>(lds + AL_K + pn * 16384, (LAS const float*)(lds + AL_B + pn * 256), qf, ksw, r32, hi, sn0, sn1);
            pv_tile(lds + AL_V + pn * 16384 + vlane, pprev, o);
            softmax_tile(sc0, sc1, m_run, l_run, alpha, resc, pnew);
        } else {
            if (t + 1 <= T_w) qk_tile<DQK>(lds + AL_K + pn * 16384, (LAS const float*)(lds + AL_B + pn * 256), qf, ksw, r32, hi, sn0, sn1);
            if (t > t_lo && t - 1 <= T_w) pv_tile(lds + AL_V + pn * 16384 + vlane, pprev, o);
            if (t <= T_w) {
                const int jb = t - (NT - 4);
                if ((jb >= 0) && (2 * jb + 1 >= wid)) {
#pragma unroll
                    for (int r = 0; r < 16; ++r) { const int kv = 64 * jb + crow(r, hi); if (kv > qrel) sc0[r] = -INFINITY; if (kv + 32 > qrel) sc1[r] = -INFINITY; }
                }
                softmax_tile(sc0, sc1, m_run, l_run, alpha, resc, pnew);
            }
        }
        if (resc) {
#pragma unroll
            for (int b = 0; b < 4; ++b)
#pragma unroll
                for (int r = 0; r < 16; ++r) o[b][r] *= alpha;
        }
        if (t + 2 < NT) AT_STOREK(pc);
        AT_STOREV(pc);
        __syncthreads();
#pragma unroll
        for (int k = 0; k < 4; ++k) pprev[k] = pnew[k];
        sc0 = sn0; sc1 = sn1;
    }
    if (NT - 1 <= T_w) pv_tile(lds + AL_V + ((NT - 1) & 1) * 16384 + vlane, pprev, o);
    __syncthreads();
#undef AT_LOADK
#undef AT_LOADV
#undef AT_STOREK
#undef AT_STOREV
    const float l = l_run + __shfl_xor(l_run, 32);
    const float inv = 1.f / l;
#pragma unroll
    for (int b = 0; b < 4; ++b)
#pragma unroll
        for (int r = 0; r < 16; ++r) o[b][r] *= inv;
}

template <int DQK>
__device__ __forceinline__ void qk_tile_pf(LAS const unsigned char* Kb, LAS const float* bl, const bf16x8* qf, const int ksw, const int r32, const int hi, f32x16& s0, f32x16& s1) {
    constexpr int KS = DQK / 16, KROWB = DQK * 2;
    LAS const unsigned char* k0 = Kb + r32 * KROWB; LAS const unsigned char* k1 = Kb + (32 + r32) * KROWB;
    bf16x8 fa[2][2];
    { const int ch_ = hi; fa[0][0] = *(LAS const bf16x8*)(k0 + ((ch_ ^ ksw) << 4)); fa[0][1] = *(LAS const bf16x8*)(k1 + ((ch_ ^ ksw) << 4)); }
#pragma unroll
    for (int g = 0; g < 4; ++g) { const f32x4 b0 = *(LAS const f32x4*)(bl + 8 * g + 4 * hi), b1 = *(LAS const f32x4*)(bl + 32 + 8 * g + 4 * hi);
#pragma unroll
        for (int e = 0; e < 4; ++e) { s0[4 * g + e] = b0[e]; s1[4 * g + e] = b1[e]; } }
    __builtin_amdgcn_sched_barrier(0);
#pragma unroll
    for (int s = 0; s < KS; ++s) {
        if (s + 1 < KS) { const int ch_ = 2 * (s + 1) + hi; fa[(s + 1) & 1][0] = *(LAS const bf16x8*)(k0 + ((ch_ ^ ksw) << 4)); fa[(s + 1) & 1][1] = *(LAS const bf16x8*)(k1 + ((ch_ ^ ksw) << 4)); }
        s0 = __builtin_amdgcn_mfma_f32_32x32x16_bf16(fa[s & 1][0], qf[s], s0, 0, 0, 0);
        s1 = __builtin_amdgcn_mfma_f32_32x32x16_bf16(fa[s & 1][1], qf[s], s1, 0, 0, 0);
        __builtin_amdgcn_sched_barrier(0);
    }
}
__device__ __forceinline__ bool attn_static_ok(const float* __restrict__ btab, const float bscale, const float bq2, const int q0) {
    const float a = __uint_as_float(__builtin_amdgcn_readfirstlane(__float_as_uint(btab[q0]))), b = __uint_as_float(__builtin_amdgcn_readfirstlane(__float_as_uint(btab[q0 + 255])));
    return ((b - a) * bscale + bq2) <= 90.f;
}
template <int DQK, bool FASTM>
__device__ __forceinline__ void attn_pass3(LAS unsigned char* lds, const bf16_t* __restrict__ Qg, const bf16_t* __restrict__ Kg, const bf16_t* __restrict__ Vg,
                                           const float* __restrict__ btab, const float bscale, const float bq2, const float bref, const float brm, const int pitch, const int q0, const int t_lo, f32x16 (&o)[4], const int wid, const int lane_in) {
    constexpr int NCH = DQK / 8, KS = DQK / 16, KI = NCH / 8;
    int lane_l = lane_in; asm volatile("" : "+v"(lane_l));
    const int lane = lane_l, tid = wid * 64 + lane, r32 = lane & 31, hi = lane >> 5;
    const int NT = (q0 + 256) / 64;
    const int T_w = NT - 4 + (wid >> 1);
    const int qrel = wid * 32 + r32;
    bf16x8 qf[KS];
#pragma unroll
    for (int s = 0; s < KS; ++s) qf[s] = *(const bf16x8*)(Qg + (size_t)(q0 + qrel) * pitch + 16 * s + 8 * hi);
    int kgo0, vgo0;
    { const int p = wid * 64 + lane, row = p / NCH, cp = p % NCH; const int sw = (DQK == 128) ? (row & 15) : ((row >> 1) & 7); kgo0 = row * pitch + (cp ^ sw) * 8; }
    { const int p = wid * 64 + lane; const int row = ((p >> 5) & 7) * 8 + ((p >> 2) & 7), ch = (p >> 8) * 4 + (p & 3); vgo0 = row * pitch + ch * 8; }
    float breg = 0.f;
#define AT_DMAK(t, buf) do { const bf16_t* kp_ = Kg + (size_t)(64 * (t)) * pitch; \
        _Pragma("unroll") for (int i = 0; i < KI; ++i) __builtin_amdgcn_global_load_lds((const unsigned*)(kp_ + kgo0 + i * 32 * pitch), (LAS unsigned*)(lds + AL_K + (buf) * 16384 + (wid + 8 * i) * 1024), 16, 0, 0); } while (0)
#define AT_DMAV(t, buf) do { const bf16_t* vp_ = Vg + (size_t)(64 * (t)) * pitch; \
        _Pragma("unroll") for (int i = 0; i < 2; ++i) __builtin_amdgcn_global_load_lds((const unsigned*)(vp_ + vgo0 + i * 64), (LAS unsigned*)(lds + AL_V + (buf) * 16384 + (wid + 8 * i) * 1024), 16, 0, 0); } while (0)
    constexpr bool fastm = FASTM;
    const float cshift = fastm ? (brm + 0.5f * bq2) : 0.f;
#define AT_LOADB(t) do { if (wid == 0) breg = btab[64 * (t) + lane]; } while (0)
#define AT_STOREB(buf) do { if (wid == 0) *(LAS float*)(lds + AL_B + (buf) * 256 + lane * 4) = (breg - bref) * bscale - cshift; } while (0)
    float m_run = fastm ? 0.f : -INFINITY, l_run = 0.f;
#pragma unroll
    for (int b = 0; b < 4; ++b)
#pragma unroll
        for (int r = 0; r < 16; ++r) o[b][r] = 0.f;
    const int ksw = (DQK == 128) ? (r32 & 15) : ((r32 >> 1) & 7);
    const int vlane = (4 * hi + ((lane & 15) >> 2)) * 64 + ((lane >> 4) & 1) * 32 + (lane & 3) * 8;
    const int t0 = t_lo & ~1;
    AT_DMAK(t0, 0); AT_DMAK(t0 + 1, 1); AT_DMAV(t0, 0);
    {
        float b0r = 0.f, b1r = 0.f;
        if (wid == 0) { b0r = btab[64 * t0 + lane]; b1r = btab[64 * (t0 + 1) + lane]; }
        if (wid == 0) { *(LAS float*)(lds + AL_B + lane * 4) = (b0r - bref) * bscale - cshift; *(LAS float*)(lds + AL_B + 256 + lane * 4) = (b1r - bref) * bscale - cshift; }
    }
    asm volatile("s_waitcnt vmcnt(0)" ::: "memory");
    __syncthreads();
    f32x16 sc0, sc1, sn0, sn1;
    u32x4 pw[4];
    qk_tile<DQK>(lds + AL_K, (LAS const float*)(lds + AL_B), qf, ksw, r32, hi, sc0, sc1);
#define P3_STEP(t, pc, pn, C0, C1, N0, N1) do { \
        if ((t) + 2 < NT) { AT_DMAK((t) + 2, pc); AT_LOADB((t) + 2); } \
        if ((t) + 1 < NT) AT_DMAV((t) + 1, pn); \
        float alpha = 1.f; bool resc = false; \
        if ((t) <= T_w) { \
            if ((t) < T_w) { \
                qk_tile<DQK>(lds + AL_K + (pn) * 16384, (LAS const float*)(lds + AL_B + (pn) * 256), qf, ksw, r32, hi, N0, N1); \
            } else { \
                const int jb = (t) - (NT - 4); \
                _Pragma("unroll") for (int r = 0; r < 16; ++r) { const int kv = 64 * jb + crow(r, hi); if (kv > qrel) C0[r] = -INFINITY; if (kv + 32 > qrel) C1[r] = -INFINITY; } \
            } \
            softmax_tile_sm(C0, C1, m_run, l_run, alpha, resc, pw, fastm); \
            if (resc) { \
                _Pragma("unroll") for (int b = 0; b < 4; ++b) _Pragma("unroll") for (int r = 0; r < 16; ++r) o[b][r] *= alpha; \
            } \
            pv_tile(lds + AL_V + (pc) * 16384 + vlane, pw, o); \
        } \
        if ((t) + 2 < NT) AT_STOREB(pc); \
        asm volatile("s_waitcnt vmcnt(0)" ::: "memory"); \
        __syncthreads(); } while (0)
#define P3_MAIN(t, pc, pn, C0, C1, N0, N1) do { \
        AT_DMAK((t) + 2, pc); AT_LOADB((t) + 2); AT_DMAV((t) + 1, pn); \
        float alpha = 1.f; bool resc = false; \
        qk_tile_pf<DQK>(lds + AL_K + (pn) * 16384, (LAS const float*)(lds + AL_B + (pn) * 256), qf, ksw, r32, hi, N0, N1); \
        softmax_tile_sm(C0, C1, m_run, l_run, alpha, resc, pw, fastm); \
        if (resc) { \
            _Pragma("unroll") for (int b = 0; b < 4; ++b) _Pragma("unroll") for (int r = 0; r < 16; ++r) o[b][r] *= alpha; \
        } \
        pv_tile(lds + AL_V + (pc) * 16384 + vlane, pw, o); \
        AT_STOREB(pc); \
        asm volatile("s_waitcnt vmcnt(0)" ::: "memory"); \
        __syncthreads(); } while (0)
    int opq_ = 0; asm volatile("s_mov_b32 %0, 0" : "=s"(opq_));
#define P3_FAST(t, pc, pn, C0, C1, N0, N1) do { \
        AT_DMAK((t) + 2, pc); AT_LOADB((t) + 2); AT_DMAV((t) + 1, pn); \
        qk_tile_pf<DQK>(lds + AL_K + (pn) * 16384, (LAS const float*)(lds + AL_B + (pn) * 256), qf, ksw, r32, hi, N0, N1); \
        if (__builtin_expect(opq_ != 0, 0)) { asm volatile("s_nop 0" ::: "memory"); } \
        { f32x2 rs2_ = {0.f, 0.f}; \
          _Pragma("unroll") for (int r = 0; r < 16; ++r) { C0[r] = __builtin_amdgcn_exp2f(C0[r]); C1[r] = __builtin_amdgcn_exp2f(C1[r]); } \
          _Pragma("unroll") for (int r = 0; r < 16; r += 2) { rs2_ += (f32x2){C0[r], C0[r + 1]}; rs2_ += (f32x2){C1[r], C1[r + 1]}; } \
          l_run += rs2_.x + rs2_.y; \
          _Pragma("unroll") for (int e = 0; e < 4; ++e) { pw[0][e] = pk2(C0[2 * e], C0[2 * e + 1]); pw[1][e] = pk2(C0[8 + 2 * e], C0[9 + 2 * e]); pw[2][e] = pk2(C1[2 * e], C1[2 * e + 1]); pw[3][e] = pk2(C1[8 + 2 * e], C1[9 + 2 * e]); } } \
        pv_tile(lds + AL_V + (pc) * 16384 + vlane, pw, o); \
        AT_STOREB(pc); \
        asm volatile("s_waitcnt vmcnt(0)" ::: "memory"); \
        __syncthreads(); } while (0)
    int t = t0;
    if constexpr (fastm) {
        for (; t < NT - 4; t += 2) {
            P3_FAST(t, 0, 1, sc0, sc1, sn0, sn1);
            P3_FAST(t + 1, 1, 0, sn0, sn1, sc0, sc1);
        }
    } else {
        for (; t < NT - 4; t += 2) {
            P3_MAIN(t, 0, 1, sc0, sc1, sn0, sn1);
            P3_MAIN(t + 1, 1, 0, sn0, sn1, sc0, sc1);
        }
    }
#undef P3_FAST
    for (; t < NT; t += 2) {
        P3_STEP(t, 0, 1, sc0, sc1, sn0, sn1);
        P3_STEP(t + 1, 1, 0, sn0, sn1, sc0, sc1);
    }
#undef P3_MAIN
#undef P3_STEP
#undef AT_DMAK
#undef AT_DMAV
#undef AT_LOADB
#undef AT_STOREB
    const float l = l_run + __shfl_xor(l_run, 32);
    const float inv = 1.f / l;
#pragma unroll
    for (int b = 0; b < 4; ++b)
#pragma unroll
        for (int r = 0; r < 16; ++r) o[b][r] *= inv;
}

__global__ void __launch_bounds__(NWAVES * 64, 2) hybrid_fwd(Args args) {
    extern __shared__ __attribute__((aligned(16))) unsigned char lds_raw[];
    LAS unsigned char* lds = (LAS unsigned char*)lds_raw;
    const int wave = __builtin_amdgcn_readfirstlane((int)threadIdx.x >> 6);
#define LANE_FRESH() int lane; asm volatile("v_mbcnt_lo_u32_b32 %0, -1, 0\n\tv_mbcnt_hi_u32_b32 %0, -1, %0" : "=v"(lane)); const int tid = wave * 64 + lane; (void)tid
    const int G = gridDim.x, bid = blockIdx.x;
    const int gw = bid * NWAVES + wave, NGW = G * NWAVES;
    typedef const Args __attribute__((address_space(4)))* KArgP;
    KArgP ka0 = (KArgP)__builtin_amdgcn_kernarg_segment_ptr();
#define KA_FRESH() KArgP ka = ka0; asm volatile("" : "+s"(ka))
#define AIN(i) (ka->in[i])
#define WS_FRESH() unsigned char* ws = ka->ws; unsigned* ctl = (unsigned*)(ws + WS_CTL); bf16_t* win0 = (bf16_t*)(ws + WS_WIN0); bf16_t* wout0 = (bf16_t*)(ws + WS_WOUT0); bf16_t* wglu = (bf16_t*)(ws + WS_WGLU); bf16_t* win1 = (bf16_t*)(ws + WS_WIN1); bf16_t* wout1 = (bf16_t*)(ws + WS_WOUT1); bf16_t* hbuf = (bf16_t*)(ws + WS_HBUF); bf16_t* ygelu = (bf16_t*)(ws + WS_HBUF); bf16_t* proj = (bf16_t*)(ws + WS_PROJ); bf16_t* ycat = (bf16_t*)(ws + WS_YCAT); f32x2* lamb = (f32x2*)(ws + WS_LAMB); f32x2* lamt = (f32x2*)(ws + WS_LAMT); unsigned* bbar = (unsigned*)(ws + WS_BBAR); bf16_t* cmat = (bf16_t*)(ws + WS_CMAT); float* biasda = (float*)(ws + WS_BIASDA); float* biasf = (float*)(ws + WS_BIASF); float* flog = (float*)(ws + WS_FLOG); f32x2* s5st = (f32x2*)(ws + WS_S5ST); (void)ctl; (void)win0; (void)wout0; (void)wglu; (void)win1; (void)wout1; (void)hbuf; (void)ygelu; (void)proj; (void)ycat; (void)lamb; (void)lamt; (void)bbar; (void)cmat; (void)biasda; (void)biasf; (void)flog; (void)s5st
    cg::grid_group grid = cg::this_grid();
    XcdBarrier xbar;
    {
        int l0; asm volatile("v_mbcnt_lo_u32_b32 %0, -1, 0\n\tv_mbcnt_hi_u32_b32 %0, -1, %0" : "=v"(l0));
        if (wave == 0 && l0 < 32) ((LAS unsigned*)(lds + LDS_MISC))[l0] = 0u;
        __syncthreads();
        xbar = xcd_barrier_post((unsigned*)(args.ws + WS_CTL) + CW_BAR, (volatile LAS unsigned*)(lds + LDS_MISC) + 8, wave == 0 && l0 == 0);
    }
    const int lo = args.ph_lo, hi_ph = args.ph_hi;
#ifndef PH_MASK
#define PH_MASK 0x7ff
#endif
#define IN(k) (((PH_MASK >> (k)) & 1) && lo <= (k) && (k) < hi_ph)
#ifndef DUP_MASK
#define DUP_MASK 0
#endif
#define NREP(k) (((DUP_MASK >> (k)) & 1) ? 2 : 1)
#define SEAM(k) do { if (IN(k) && IN((k) + 1)) { if ((k) == 0) grid.sync(); else { int l0; asm volatile("v_mbcnt_lo_u32_b32 %0, -1, 0\n\tv_mbcnt_hi_u32_b32 %0, -1, %0" : "=v"(l0)); xcd_barrier(xbar, wave == 0 && l0 == 0); } } } while (0)

    if (IN(0)) {
        KA_FRESH(); LANE_FRESH(); WS_FRESH(); const float* x = AIN(0); float* out = ka->out; (void)x; (void)out;
        LAS float* scr = (LAS float*)(lds + wave * 16384);
        for (int rep = 0; rep < NREP(0); ++rep) {
        constexpr int I_IN0 = 32 * 192, I_OUT = 32 * 64, I_GLU = 16 * 32, I_IN1 = 32 * 264;
        constexpr int NITEMS = I_IN0 + 2 * I_OUT + I_GLU + I_IN1;
        for (int it = gw; it < NITEMS; it += NGW) {
            int r = it;
            if (r < I_IN0) { transpose_item(AIN(2), 2048, E_IN, win0, scr, r, 192, lane); continue; } r -= I_IN0;
            if (r < I_OUT) { transpose_item(AIN(3), 2048, 2048, wout0, scr, r, 64, lane); continue; } r -= I_OUT;
            if (r < I_GLU) { transpose_item(AIN(12), 1024, 1024, wglu, scr, r, 32, lane); continue; } r -= I_GLU;
            if (r < I_IN1) { transpose_item(AIN(22), 2048, 8208, win1, scr, r, 264, lane); continue; } r -= I_IN1;
            transpose_item(AIN(24), 2048, 2048, wout1, scr, r, 64, lane);
        }
        for (int m = gw; m < MTOK; m += 2 * NGW) { const int m1 = m + NGW; const bool h1 = m1 < MTOK; const int mm = h1 ? m1 : m;
            rms_rows2_to_bf16(x + (size_t)m * DM, x + (size_t)mm * DM, h1, AIN(1), hbuf + (size_t)m * DM, hbuf + (size_t)mm * DM, lane); }
        const int gt = bid * 512 + tid, NGT = G * 512;
        for (int i = gt; i < S5G * S5P; i += NGT) {
            const int g = i >> 6;
            const double dt = exp((double)AIN(6)[g]);
            const double lr = (double)AIN(4)[i], li = (double)AIN(5)[i];
            const double mag = exp(lr * dt), ar = mag * cos(li * dt), ai = mag * sin(li * dt);
            const double den = lr * lr + li * li, nr = ar - 1.0, ni = ai;
            const double kr = (nr * lr + ni * li) / den, ki = (ni * lr - nr * li) / den;
            lamb[i] = (f32x2){(float)ar, (float)ai};
            const double magT = exp(lr * dt * (double)S5T);
            lamt[i] = (f32x2){(float)(magT * cos(li * dt * (double)S5T)), (float)(magT * sin(li * dt * (double)S5T))};
#pragma unroll 2
            for (int j = 0; j < 8; ++j) { const double br0 = (double)AIN(7)[i * 16 + 2 * j], bi0 = (double)AIN(8)[i * 16 + 2 * j], br1 = (double)AIN(7)[i * 16 + 2 * j + 1], bi1 = (double)AIN(8)[i * 16 + 2 * j + 1];
                bbar[i * 16 + j] = pk2((float)(kr * br0 - ki * bi0), (float)(kr * br1 - ki * bi1));
                bbar[i * 16 + 8 + j] = pk2((float)(kr * bi0 + ki * br0), (float)(kr * bi1 + ki * br1)); }
        }
        for (int i = gt; i < S5G * 32 * 128; i += NGT) { const int k = i & 127, n = (i >> 7) & 31, g = i >> 12;
            float v = 0.f; if (n < 16) v = ((k & 1) == 0) ? AIN(9)[(g * 16 + n) * 64 + (k >> 1)] : -AIN(10)[(g * 16 + n) * 64 + (k >> 1)];
            cmat[i] = (bf16_t)(pk2(v, 0.f) & 0xffffu); }
        for (int i = gt; i < 8 * SEQ; i += NGT) { const int h = i / SEQ, j = i % SEQ; biasda[i] = exp2f(-(float)(h + 1)) * (float)j; }
        if (bid == 0 && tid == 0) {
            float d1 = 0.f, d2 = 0.f;
            for (int i = 0; i < 64; ++i) { d1 += AIN(16)[i] * AIN(17)[i]; d2 += AIN(18)[i] * AIN(19)[i]; }
            ((float*)ctl)[CW_LAM] = expf(d1) - expf(d2) + 0.2f;
            float gq = 0.f, gk = 0.f, fq_ = 0.f, fk_ = 0.f;
            for (int i = 0; i < 128; ++i) { gq = fmaxf(gq, fabsf(AIN(14)[i])); gk = fmaxf(gk, fabsf(AIN(15)[i])); fq_ = fmaxf(fq_, fabsf(AIN(25)[i])); fk_ = fmaxf(fk_, fabsf(AIN(26)[i])); }
            ((float*)ctl)[CW_THRDA] = ZERO_THR + 2.f * 8.f * gq * gk * 1.02f;
            ((float*)ctl)[CW_THRF] = ZERO_THR + 2.f * 11.3137085f * fq_ * fk_ * 1.02f;
            ctl[CW_QDA] = 0u; ctl[CW_QDA + 1] = 0u; ctl[CW_QFOX] = 0u; ctl[CW_QFOX + 1] = 0u;
        }
        }
#ifdef XSYNC
        for (int i = 0; i < XSYNC; ++i) grid.sync();
#endif
    }
    SEAM(0);
    if (IN(1)) {
        KA_FRESH(); LANE_FRESH(); WS_FRESH(); const float* x = AIN(0); float* out = ka->out; (void)x; (void)out;
        pg8::Gemm g{hbuf, win0, MTOK, E_IN, DM}; pg8::StaticOrder S; S.init(MTOK, E_IN, G, bid);
        pg8::EpiBf16<0> E{proj, E_IN, nullptr, 0, 0, 1.f};
        for (int rep = 0; rep < NREP(1); ++rep) pg8::gemm_phase<pg8::EpiBf16<0>, pg8::StaticOrder, true, true>(lds, g, S, E, wave, lane);
    }
    SEAM(1);
    if (IN(2)) {
        KA_FRESH(); LANE_FRESH(); WS_FRESH(); const float* x = AIN(0); float* out = ka->out; (void)x; (void)out;
        const float qmul = 0.125f * LOG2E;
        for (int m = gw; m < MTOK; m += 2 * NGW) { const int m1 = m + NGW; const bool h1 = m1 < MTOK; const int mm = h1 ? m1 : m;
            qknorm_rows2<2, 1, 4>(proj + (size_t)m * E_IN + 2048, proj + (size_t)mm * E_IN + 2048, h1, AIN(14), AIN(15), qmul, 1.f / 64.f, lane); }
        {
        const int r32 = lane & 31, hi = lane >> 5;
        for (int rep = 0; rep < NREP(12); ++rep)
        for (int u = gw; u < BATCH * S5G * S5NC; u += NGW) {
            const int g = u & 63, c = (u >> 6) & (S5NC - 1), b = u >> 13;
            const f32x2 la = lamb[g * 64 + lane];
            bf16x8 bre[2], bim[2];
#pragma unroll
            for (int ph = 0; ph < 2; ++ph) { const unsigned* bp = bbar + (size_t)(g * 64 + 32 * ph + r32) * 16 + 4 * hi;
                bre[ph] = __builtin_bit_cast(bf16x8, *(const u32x4*)bp); bim[ph] = __builtin_bit_cast(bf16x8, *(const u32x4*)(bp + 8)); }
            float hr = 0.f, hi_s = 0.f;
            const bf16_t* up = proj + (size_t)(b * SEQ + c * S5T + r32) * E_IN + g * 16 + 8 * hi;
            for (int sb = 0; sb < 4; ++sb) {
                const bf16x8 ua = *(const bf16x8*)(up + (size_t)(sb * 32) * E_IN);
                f32x16 z16;
#pragma unroll
                for (int r = 0; r < 16; ++r) z16[r] = 0.f;
                f32x16 xr0 = __builtin_amdgcn_mfma_f32_32x32x16_bf16(ua, bre[0], z16, 0, 0, 0), xr1 = __builtin_amdgcn_mfma_f32_32x32x16_bf16(ua, bre[1], z16, 0, 0, 0);
                f32x16 xi0 = __builtin_amdgcn_mfma_f32_32x32x16_bf16(ua, bim[0], z16, 0, 0, 0), xi1 = __builtin_amdgcn_mfma_f32_32x32x16_bf16(ua, bim[1], z16, 0, 0, 0);
#pragma unroll
                for (int r = 0; r < 16; ++r) {
                    auto sr = __builtin_amdgcn_permlane32_swap(__float_as_uint(xr0[r]), __float_as_uint(xr1[r]), false, false); xr0[r] = __uint_as_float(sr[0]); xr1[r] = __uint_as_float(sr[1]);
                    auto si = __builtin_amdgcn_permlane32_swap(__float_as_uint(xi0[r]), __float_as_uint(xi1[r]), false, false); xi0[r] = __uint_as_float(si[0]); xi1[r] = __uint_as_float(si[1]); }
#pragma unroll
                for (int t = 0; t < 32; ++t) { const int r = (t & 3) + 4 * (t >> 3); const bool odd = (t >> 2) & 1;
                    const float xr = odd ? xr1[r] : xr0[r], xi = odd ? xi1[r] : xi0[r];
                    const float nhr = la.x * hr - la.y * hi_s + xr, nhi = la.x * hi_s + la.y * hr + xi; hr = nhr; hi_s = nhi; }
            }
            s5st[((size_t)(b * S5NC + c) * 64 + g) * 64 + lane] = (f32x2){hr, hi_s};
        }
        }
    }
    SEAM(2);
    if (IN(3)) {
        KA_FRESH(); LANE_FRESH(); WS_FRESH(); const float* x = AIN(0); float* out = ka->out; (void)x; (void)out;
        {
            LAS unsigned char* Ht = lds + wave * 8192;
            const int r32 = lane & 31, hi = lane >> 5;
            for (int rep = 0; rep < NREP(11); ++rep)
            for (int u = gw; u < BATCH * S5G * (S5NC / 8); u += NGW) {
                const int g = u & 63, c0 = ((u >> 6) & 15) * 8, b = u >> 10;
                const int gp = g * 64 + lane;
                const f32x2 la = lamb[gp], lt = lamt[gp];
                bf16x8 bre[2], bim[2];
#pragma unroll
                for (int ph = 0; ph < 2; ++ph) { const unsigned* bp = bbar + (size_t)(g * 64 + 32 * ph + r32) * 16 + 4 * hi;
                    bre[ph] = __builtin_bit_cast(bf16x8, *(const u32x4*)bp); bim[ph] = __builtin_bit_cast(bf16x8, *(const u32x4*)(bp + 8)); }
                float hr = 0.f, hi_s = 0.f;
#pragma unroll 8
                for (int cc = 0; cc < c0; ++cc) { const f32x2 s = s5st[((size_t)(b * S5NC + cc) * 64 + g) * 64 + lane];
                    const float nhr = lt.x * hr - lt.y * hi_s + s.x, nhi = lt.x * hi_s + lt.y * hr + s.y; hr = nhr; hi_s = nhi; }
                bf16x8 cfr[8];
#pragma unroll
                for (int s = 0; s < 8; ++s) cfr[s] = *(const bf16x8*)(cmat + (size_t)(g * 32 + r32) * 128 + 16 * s + 8 * hi);
                const f32x4 dv0 = *(const f32x4*)(AIN(11) + g * 16 + 4 * hi), dv1 = *(const f32x4*)(AIN(11) + g * 16 + 8 + 4 * hi);
                for (int c = c0; c < c0 + 8; ++c) {
                const size_t row0 = (size_t)(b * SEQ + c * S5T);
                const bf16_t* up = proj + (row0 + r32) * E_IN + g * 16 + 8 * hi;
                for (int sb = 0; sb < 4; ++sb) {
                    const size_t orow = row0 + sb * 32 + r32;
                    const u32x2 uvA = *(const u32x2*)(proj + orow * E_IN + g * 16 + 4 * hi), uvB = *(const u32x2*)(proj + orow * E_IN + g * 16 + 8 + 4 * hi);
                    {
                    const bf16x8 ua = *(const bf16x8*)(up + (size_t)(sb * 32) * E_IN);
                    f32x16 z16;
#pragma unroll
                    for (int r = 0; r < 16; ++r) z16[r] = 0.f;
                    f32x16 xr0 = __builtin_amdgcn_mfma_f32_32x32x16_bf16(ua, bre[0], z16, 0, 0, 0), xr1 = __builtin_amdgcn_mfma_f32_32x32x16_bf16(ua, bre[1], z16, 0, 0, 0);
                    f32x16 xi0 = __builtin_amdgcn_mfma_f32_32x32x16_bf16(ua, bim[0], z16, 0, 0, 0), xi1 = __builtin_amdgcn_mfma_f32_32x32x16_bf16(ua, bim[1], z16, 0, 0, 0);
#pragma unroll
                    for (int r = 0; r < 16; ++r) {
                        auto sr = __builtin_amdgcn_permlane32_swap(__float_as_uint(xr0[r]), __float_as_uint(xr1[r]), false, false); xr0[r] = __uint_as_float(sr[0]); xr1[r] = __uint_as_float(sr[1]);
                        auto si = __builtin_amdgcn_permlane32_swap(__float_as_uint(xi0[r]), __float_as_uint(xi1[r]), false, false); xi0[r] = __uint_as_float(si[0]); xi1[r] = __uint_as_float(si[1]); }
#pragma unroll
                    for (int tt = 0; tt < 32; ++tt) { const int r = (tt & 3) + 4 * (tt >> 3); const bool odd = (tt >> 2) & 1;
                        const float xr = odd ? xr1[r] : xr0[r], xi = odd ? xi1[r] : xi0[r];
                        const float nhr = la.x * hr - la.y * hi_s + xr, nhi = la.x * hi_s + la.y * hr + xi; hr = nhr; hi_s = nhi;
                        const int sw = tt & 15;
                        *(LAS unsigned*)(Ht + tt * 256 + ((((lane >> 2)) ^ sw) << 4) + ((lane & 3) << 2)) = pk2(hr, hi_s);
                    }
                    }
                    asm volatile("s_waitcnt lgkmcnt(0)" ::: "memory");
                    f32x16 acc;
#pragma unroll
                    for (int r = 0; r < 16; ++r) acc[r] = 0.f;
#pragma unroll
                    for (int s = 0; s < 8; ++s) { const bf16x8 a = *(LAS const bf16x8*)(Ht + r32 * 256 + (((2 * s + hi) ^ (r32 & 15)) << 4));
                        acc = __builtin_amdgcn_mfma_f32_32x32x16_bf16(cfr[s], a, acc, 0, 0, 0); }
                    asm volatile("s_waitcnt lgkmcnt(0)" ::: "memory");
                    {
                        const float y0 = gelu_tanh(acc[0] + dv0.x * bflo(uvA.x)), y1 = gelu_tanh(acc[1] + dv0.y * bfhi(uvA.x)), y2 = gelu_tanh(acc[2] + dv0.z * bflo(uvA.y)), y3 = gelu_tanh(acc[3] + dv0.w * bfhi(uvA.y));
                        const float y4 = gelu_tanh(acc[4] + dv1.x * bflo(uvB.x)), y5 = gelu_tanh(acc[5] + dv1.y * bfhi(uvB.x)), y6 = gelu_tanh(acc[6] + dv1.z * bflo(uvB.y)), y7 = gelu_tanh(acc[7] + dv1.w * bfhi(uvB.y));
                        u32x2 wA, wB; wA.x = pk2(y0, y1); wA.y = pk2(y2, y3); wB.x = pk2(y4, y5); wB.y = pk2(y6, y7);
                        *(u32x2*)(ygelu + orow * 1024 + g * 16 + 4 * hi) = wA; *(u32x2*)(ygelu + orow * 1024 + g * 16 + 8 + 4 * hi) = wB;
                    }
                }
                }
            }
        }
        __syncthreads();
        {
            LANE_FRESH();
            LAS volatile int* misc = (LAS volatile int*)(lds + LDS_MISC);
            const float lam = ((const float*)ctl)[CW_LAM]; const float thr_da = ((const float*)ctl)[CW_THRDA];
            const int r32 = lane & 31, hi = lane >> 5;
            for (int rep = 0; rep < NREP(3); ++rep)
            for (;;) {
                if (tid == 0) misc[0] = (int)atomicAdd(ctl + CW_QDA + rep, 1u);
                __syncthreads();
                const int ui = misc[0];
                __syncthreads();
                if (ui >= BATCH * 8 * 64) break;
                const int qb = 63 - (ui >> 4), bh = ui & 15, b = bh >> 3, h = bh & 7;
                const int q0 = qb * 256;
                const bf16_t* pb = proj + (size_t)b * SEQ * E_IN;
                const float dskip = thr_da * exp2f((float)(h + 1));
                const int t_lo = max(0, (int)ceilf(((float)q0 - dskip - 63.f) * (1.f / 64.f)));
                f32x16 o[4];
                LAS unsigned* stash = (LAS unsigned*)(lds + LDS_STASH) + wave * 2048 + lane;
                const float bq2 = (thr_da - ZERO_THR) * LOG2E;
                const float* btq = biasda + h * SEQ;
                const float bref = __uint_as_float(__builtin_amdgcn_readfirstlane(__float_as_uint(btq[q0]))), bend = __uint_as_float(__builtin_amdgcn_readfirstlane(__float_as_uint(btq[q0 + 255])));
                const float brm = (bend - bref) * LOG2E;
                const bool fm = (brm + bq2) <= 90.f;
                if (fm) attn_pass3<64, true>(lds, pb + 2048 + h * 128, pb + 3072 + h * 128, pb + 4096 + h * 128, biasda + h * SEQ, LOG2E, bq2, bref, brm, E_IN, q0, t_lo, o, wave, lane);
                else attn_pass3<64, false>(lds, pb + 2048 + h * 128, pb + 3072 + h * 128, pb + 4096 + h * 128, biasda + h * SEQ, LOG2E, bq2, bref, brm, E_IN, q0, t_lo, o, wave, lane);
#pragma unroll
                for (int bl = 0; bl < 4; ++bl)
#pragma unroll
                    for (int e = 0; e < 8; ++e) stash[(bl * 8 + e) * 64] = pk2(o[bl][2 * e], o[bl][2 * e + 1]);
                if (fm) attn_pass3<64, true>(lds, pb + 2048 + h * 128 + 64, pb + 3072 + h * 128 + 64, pb + 4096 + h * 128, biasda + h * SEQ, LOG2E, bq2, bref, brm, E_IN, q0, t_lo, o, wave, lane);
                else attn_pass3<64, false>(lds, pb + 2048 + h * 128 + 64, pb + 3072 + h * 128 + 64, pb + 4096 + h * 128, biasda + h * SEQ, LOG2E, bq2, bref, brm, E_IN, q0, t_lo, o, wave, lane);
                int hi_e = hi, r32_e = r32; asm volatile("" : "+v"(hi_e), "+v"(r32_e));
                float ssq = 0.f;
#pragma unroll
                for (int bl = 0; bl < 4; ++bl)
#pragma unroll
                    for (int e = 0; e < 8; ++e) { const unsigned w0 = stash[(bl * 8 + e) * 64]; const float v0 = bflo(w0) - lam * o[bl][2 * e], v1 = bfhi(w0) - lam * o[bl][2 * e + 1];
                        o[bl][2 * e] = v0; o[bl][2 * e + 1] = v1; ssq += v0 * v0 + v1 * v1; }
                ssq += __shfl_xor(ssq, 32);
                const float rr = 0.8f / sqrtf(ssq * (1.f / 128.f) + RMS_EPS);
                const size_t tok = (size_t)b * SEQ + q0 + wave * 32 + r32_e;
#pragma unroll
                for (int bl = 0; bl < 4; ++bl)
#pragma unroll
                    for (int g = 0; g < 4; ++g) { const int dv0 = 32 * bl + 8 * g + 4 * hi_e;
                        const f32x4 gn = *(const f32x4*)(AIN(20) + dv0);
                        const u32x2 zw = *(const u32x2*)(proj + tok * E_IN + 5120 + h * 128 + dv0);
                        const float y0 = o[bl][4 * g] * rr * gn.x * siluf_(bflo(zw.x)), y1 = o[bl][4 * g + 1] * rr * gn.y * siluf_(bfhi(zw.x));
                        const float y2 = o[bl][4 * g + 2] * rr * gn.z * siluf_(bflo(zw.y)), y3 = o[bl][4 * g + 3] * rr * gn.w * siluf_(bfhi(zw.y));
                        u32x2 w; w.x = pk2(y0, y1); w.y = pk2(y2, y3);
                        *(u32x2*)(ycat + tok * DM + 1024 + h * 128 + dv0) = w; }
            }
        }
    }
    SEAM(3);
    if (IN(4)) {
        KA_FRESH(); LANE_FRESH(); WS_FRESH(); const float* x = AIN(0); float* out = ka->out; (void)x; (void)out;
        pg8::Gemm g{ygelu, wglu, MTOK, 1024, 1024}; pg8::StaticOrder S; S.init(MTOK, 1024, G, bid);
        pg8::EpiGlu E{ycat, ygelu, proj, AIN(13)};
        pg8::gemm_phase<pg8::EpiGlu, pg8::StaticOrder, true, true>(lds, g, S, E, wave, lane);
    }
    SEAM(4);
    if (IN(5)) {
        KA_FRESH(); LANE_FRESH(); WS_FRESH(); const float* x = AIN(0); float* out = ka->out; (void)x; (void)out;
        pg8::Gemm g{ycat, wout0, MTOK, DM, DM}; pg8::StaticOrder S; S.init(MTOK, DM, G, bid);
        pg8::EpiResid E{x, out};
        pg8::gemm_phase<pg8::EpiResid, pg8::StaticOrder, true, true>(lds, g, S, E, wave, lane);
    }
    SEAM(5);
    if (IN(6)) {
        KA_FRESH(); LANE_FRESH(); WS_FRESH(); const float* x = AIN(0); float* out = ka->out; (void)x; (void)out;
        for (int rep = 0; rep < NREP(6); ++rep)
        for (int m = gw; m < MTOK; m += 2 * NGW) { const int m1 = m + NGW; const bool h1 = m1 < MTOK; const int mm = h1 ? m1 : m;
            rms_rows2_to_bf16(out + (size_t)m * DM, out + (size_t)mm * DM, h1, AIN(21), hbuf + (size_t)m * DM, hbuf + (size_t)mm * DM, lane); }
    }
    SEAM(6);
    if (IN(7)) {
        KA_FRESH(); LANE_FRESH(); WS_FRESH(); const float* x = AIN(0); float* out = ka->out; (void)x; (void)out;
        pg8::Gemm g{hbuf, win1, MTOK, O_INP, DM}; pg8::StaticOrder S; S.init(MTOK, O_INP, G, bid);
        pg8::EpiProj1 E{proj, flog};
        for (int rep = 0; rep < NREP(7); ++rep) pg8::gemm_phase<pg8::EpiProj1, pg8::StaticOrder, true, true>(lds, g, S, E, wave, lane);
    }
    SEAM(7);
    if (IN(8)) {
        KA_FRESH(); LANE_FRESH(); WS_FRESH(); const float* x = AIN(0); float* out = ka->out; (void)x; (void)out;
        if (bid < 32) {
            const int b = bid >> 4, h = bid & 15;
            LAS double* dsum = (LAS double*)lds;
            const float bf_ = AIN(23)[h];
            const float* fl = flog + ((size_t)b * SEQ + tid * 32) * 16 + h;
            float lf[32];
#pragma unroll
            for (int i = 0; i < 32; ++i) lf[i] = fl[i * 16];
            double tot = 0.0;
#pragma unroll
            for (int i = 0; i < 32; ++i) { const float xv = lf[i] + bf_; lf[i] = fminf(xv, 0.f) - __logf(1.f + __expf(-fabsf(xv))); tot += (double)lf[i]; }
            dsum[tid] = tot;
            __syncthreads();
            double pre = 0.0;
#pragma unroll 8
            for (int i = 0; i < tid; ++i) pre += dsum[i];
            float* bo = biasf + ((size_t)(b * 16 + h)) * SEQ + tid * 32;
#pragma unroll
            for (int i = 0; i < 32; i += 4) { f32x4 w;
                pre += (double)lf[i]; w.x = (float)(-pre); pre += (double)lf[i + 1]; w.y = (float)(-pre); pre += (double)lf[i + 2]; w.z = (float)(-pre); pre += (double)lf[i + 3]; w.w = (float)(-pre);
                *(f32x4*)(bo + i) = w; }
            __syncthreads();
        }
        const float qmul = 0.08838834764831845f * LOG2E;
        for (int m = gw; m < MTOK; m += 2 * NGW) { const int m1 = m + NGW; const bool h1 = m1 < MTOK; const int mm = h1 ? m1 : m;
            qknorm_rows2<4, 2, 8>(proj + (size_t)m * O_LD, proj + (size_t)mm * O_LD, h1, AIN(25), AIN(26), qmul, 1.f / 128.f, lane); }
    }
    SEAM(8);
    if (IN(9)) {
        KA_FRESH(); LANE_FRESH(); WS_FRESH(); const float* x = AIN(0); float* out = ka->out; (void)x; (void)out;
        LAS volatile int* misc = (LAS volatile int*)(lds + LDS_MISC);
        const int r32 = lane & 31, hi = lane >> 5;
        const float thr_f = ((const float*)ctl)[CW_THRF];
        for (int rep = 0; rep < NREP(9); ++rep)
        for (;;) {
            if (wave == 0) {
                int u0 = 0; if (lane == 0) u0 = (int)atomicAdd(ctl + CW_QFOX + rep, 1u);
                u0 = __shfl(u0, 0);
                int tl = 0;
                if (u0 < BATCH * 16 * 64) {
                    const int qb_ = 63 - (u0 >> 5), bh_ = u0 & 31; const float* bt = biasf + (size_t)bh_ * SEQ; const float bref = bt[qb_ * 256];
                    int ln = lane; asm volatile("" : "+v"(ln));
#pragma unroll
                    for (int r = 0; r < 4; ++r) { const int t = ln + 64 * r; bool dead = false;
                        if (t < 4 * qb_) dead = (bt[64 * t + 63] - bref) < -thr_f;
                        tl += __popcll(__ballot(dead)); }
                }
                if (lane == 0) { misc[0] = u0; misc[1] = tl; }
            }
            __syncthreads();
            const int ui = misc[0], t_lo = misc[1];
            __syncthreads();
            if (ui >= BATCH * 16 * 64) break;
            const int qb = 63 - (ui >> 5), bh = ui & 31, b = bh >> 4, h = bh & 15;
            const int q0 = qb * 256;
            const bf16_t* pb = proj + (size_t)b * SEQ * O_LD;
            f32x16 o[4];
            const float bq2 = (thr_f - ZERO_THR) * LOG2E;
            const float* btq = biasf + (size_t)bh * SEQ;
            const float bref = __uint_as_float(__builtin_amdgcn_readfirstlane(__float_as_uint(btq[q0]))), bend = __uint_as_float(__builtin_amdgcn_readfirstlane(__float_as_uint(btq[q0 + 255])));
            const float brm = (bend - bref) * LOG2E;
            if ((brm + bq2) <= 90.f) attn_pass3<128, true>(lds, pb + h * 128, pb + 2048 + h * 128, pb + 4096 + h * 128, biasf + (size_t)bh * SEQ, LOG2E, bq2, bref, brm, O_LD, q0, t_lo, o, wave, lane);
            else attn_pass3<128, false>(lds, pb + h * 128, pb + 2048 + h * 128, pb + 4096 + h * 128, biasf + (size_t)bh * SEQ, LOG2E, bq2, bref, brm, O_LD, q0, t_lo, o, wave, lane);
            int hi_e = hi, r32_e = r32; asm volatile("" : "+v"(hi_e), "+v"(r32_e));
            const size_t tok = (size_t)b * SEQ + q0 + wave * 32 + r32_e;
#pragma unroll
            for (int bl = 0; bl < 4; ++bl)
#pragma unroll
                for (int g = 0; g < 4; ++g) { const int dv0 = 32 * bl + 8 * g + 4 * hi_e;
                    const u32x2 zw = *(const u32x2*)(proj + tok * O_LD + 6144 + h * 128 + dv0);
                    const float y0 = o[bl][4 * g] * siluf_(bflo(zw.x)), y1 = o[bl][4 * g + 1] * siluf_(bfhi(zw.x));
                    const float y2 = o[bl][4 * g + 2] * siluf_(bflo(zw.y)), y3 = o[bl][4 * g + 3] * siluf_(bfhi(zw.y));
                    u32x2 w; w.x = pk2(y0, y1); w.y = pk2(y2, y3);
                    *(u32x2*)(ycat + tok * DM + h * 128 + dv0) = w; }
        }
    }
    SEAM(9);
    if (IN(10)) {
        KA_FRESH(); LANE_FRESH(); WS_FRESH(); const float* x = AIN(0); float* out = ka->out; (void)x; (void)out;
        pg8::Gemm g{ycat, wout1, MTOK, DM, DM}; pg8::StaticOrder S; S.init(MTOK, DM, G, bid);
        pg8::EpiResid E{out, out};
        pg8::gemm_phase<pg8::EpiResid, pg8::StaticOrder, true, true>(lds, g, S, E, wave, lane);
    }
#undef IN
#undef SEAM
}

#ifndef ONE_LAUNCH
#define ONE_LAUNCH 1
#endif
constexpr int NPHASE = 11;
extern "C" void kernel_launch(void* const* d_in, const int* in_sizes, int n_in, void* d_out, int out_size, void* d_ws, size_t ws_size, hipStream_t stream) {
    static int grid = 0;
    if (grid == 0) {
        if (n_in != 27 || out_size != MTOK * DM || ws_size < WS_END) { fprintf(stderr, "kernel_launch: unexpected problem (n_in %d out %d ws %zu)\n", n_in, out_size, ws_size); grid = -1; return; }
        int dev = 0, cus = 0, per_cu = 0;
        hipGetDevice(&dev);
        hipDeviceGetAttribute(&cus, hipDeviceAttributeMultiprocessorCount, dev);
        if (hipFuncSetAttribute((const void*)hybrid_fwd, hipFuncAttributeMaxDynamicSharedMemorySize, LDS_BYTES) != hipSuccess) { fprintf(stderr, "kernel_launch: hipFuncSetAttribute failed\n"); grid = -1; return; }
        if (hipOccupancyMaxActiveBlocksPerMultiprocessor(&per_cu, (const void*)hybrid_fwd, NWAVES * 64, LDS_BYTES) != hipSuccess || per_cu < 1) { fprintf(stderr, "kernel_launch: occupancy query says %d\n", per_cu); per_cu = 1; }
        (void)hipGetLastError();
        grid = cus * 1;
    }
    if (grid < 0) return;
    if (hipMemsetAsync(d_ws, 0, 65536, stream) != hipSuccess) { fprintf(stderr, "kernel_launch: memset failed\n"); return; }
    Args a{};
    for (int i = 0; i < 27; ++i) a.in[i] = (const float*)d_in[i];
    a.out = (float*)d_out; a.ws = (unsigned char*)d_ws;
#if ONE_LAUNCH
    a.ph_lo = 0; a.ph_hi = NPHASE;
    void* kargs[] = {&a};
    hipError_t e = hipLaunchCooperativeKernel((const void*)hybrid_fwd, dim3(grid), dim3(NWAVES * 64), kargs, LDS_BYTES, stream);
    if (e != hipSuccess) fprintf(stderr, "cooperative launch failed: %s (grid %d)\n", hipGetErrorString(e), grid);
#else
    for (int p = 0; p < NPHASE; ++p) {
        a.ph_lo = p; a.ph_hi = p + 1;
        hipLaunchKernelGGL(hybrid_fwd, dim3(grid), dim3(NWAVES * 64), LDS_BYTES, stream, a);
    }
#endif
}
```
